# Optimizing an MI355X kernel written in HIP

```python
import math
import jax, jax.numpy as jnp
from jax import lax
import numpy as np

D_MODEL = 1024
BATCH = 16
SEQ = 2048
DEPTH = 2

N_A_LAYERS = DEPTH // 2
N_B_LAYERS = DEPTH - N_A_LAYERS
N_DENSE_LAYERS = (DEPTH + 1) // 2
N_MOE_LAYERS = DEPTH // 2

SSM_GROUP_CH = 16
SSM_GROUPS = D_MODEL // SSM_GROUP_CH
SSM_STATE = 64
DT_MIN = 1e-3
DT_MAX = 1e-1

N_HEADS = 16
HEAD_DIM = 64
N_KV_HEADS = 4
Q_PER_KV = N_HEADS // N_KV_HEADS
KV_DIM = N_KV_HEADS * HEAD_DIM
WINDOW = 128
BLOCK = 128
ROT_DIM = HEAD_DIM // 4
ROPE_THETA = 500000.0
MAX_POS_OFFSET = 4096

FFN_DIM = 2816
N_EXPERTS = 8
TOP_K = 2
EXPERT_DIM = 1024

DEEPNORM_ALPHA = (2 * DEPTH) ** 0.25
DEEPNORM_BETA = (8 * DEPTH) ** -0.25
LN_EPS = 1e-5

kernel_name = "yoco_s5_swa_sink_moe_deepnorm"


def layer_norm(x, g, b):
    xf = x.astype(jnp.float32)
    mu = jnp.mean(xf, axis=-1, keepdims=True)
    xc = xf - mu
    var = jnp.mean(xc * xc, axis=-1, keepdims=True)
    return (xc * lax.rsqrt(var + LN_EPS) * g.astype(jnp.float32) + b.astype(jnp.float32)).astype(x.dtype)


def _ssm_combine(e1, e2):
    a1r, a1i, b1r, b1i = e1
    a2r, a2i, b2r, b2i = e2
    ar = a2r * a1r - a2i * a1i
    ai = a2r * a1i + a2i * a1r
    br = a2r * b1r - a2i * b1i + b2r
    bi = a2r * b1i + a2i * b1r + b2i
    return (ar, ai, br, bi)


def s5_mixer(u, lam_re, lam_im, log_step, b_re, b_im, c_re, c_im, d_skip, w_glu):
    bsz, seq, _ = u.shape
    uf = u.astype(jnp.float32)
    ug = uf.reshape(bsz, seq, SSM_GROUPS, SSM_GROUP_CH)
    lr = lam_re.astype(jnp.float32)
    li = lam_im.astype(jnp.float32)
    dt = jnp.exp(log_step.astype(jnp.float32))[:, None]
    mag = jnp.exp(lr * dt)
    ar = mag * jnp.cos(li * dt)
    ai = mag * jnp.sin(li * dt)
    nr = ar - 1.0
    den = lr * lr + li * li
    kr = (nr * lr + ai * li) / den
    ki = (ai * lr - nr * li) / den
    br = b_re.astype(jnp.float32)
    bi = b_im.astype(jnp.float32)
    bbar_r = kr[..., None] * br - ki[..., None] * bi
    bbar_i = kr[..., None] * bi + ki[..., None] * br
    bu_r = jnp.einsum('blgc,gpc->blgp', ug, bbar_r)
    bu_i = jnp.einsum('blgc,gpc->blgp', ug, bbar_i)
    a_r = jnp.broadcast_to(ar[None, None], (1, seq, SSM_GROUPS, SSM_STATE))
    a_i = jnp.broadcast_to(ai[None, None], (1, seq, SSM_GROUPS, SSM_STATE))
    _, _, h_r, h_i = lax.associative_scan(_ssm_combine, (a_r, a_i, bu_r, bu_i), axis=1)
    y = (jnp.einsum('blgp,gcp->blgc', h_r, c_re.astype(jnp.float32))
         - jnp.einsum('blgp,gcp->blgc', h_i, c_im.astype(jnp.float32)))
    y = y.reshape(bsz, seq, D_MODEL) + d_skip.astype(jnp.float32) * uf
    g = jax.nn.gelu(y).astype(u.dtype)
    val, gate = jnp.split(g @ w_glu, 2, axis=-1)
    return val * jax.nn.sigmoid(gate)


def rope_tables(positions):
    inv_freq = ROPE_THETA ** (-jnp.arange(0, ROT_DIM, 2, dtype=jnp.float32) / ROT_DIM)
    ang = positions.astype(jnp.float32)[..., None] * inv_freq
    return jnp.cos(ang)[:, :, None, :], jnp.sin(ang)[:, :, None, :]


def apply_partial_rope(t, cos, sin):
    half = ROT_DIM // 2
    r = t[..., :ROT_DIM].astype(jnp.float32)
    x1, x2 = r[..., :half], r[..., half:]
    rot = jnp.concatenate([x1 * cos - x2 * sin, x2 * cos + x1 * sin], axis=-1).astype(t.dtype)
    return jnp.concatenate([rot, t[..., ROT_DIM:]], axis=-1)


def shared_kv(h, kv_w, cos, sin):
    bsz, seq, _ = h.shape
    k, v = jnp.split(h @ kv_w, 2, axis=-1)
    k = apply_partial_rope(k.reshape(bsz, seq, N_KV_HEADS, HEAD_DIM), cos, sin)
    v = v.reshape(bsz, seq, N_KV_HEADS, HEAD_DIM)
    return k, v


def _band(t):
    prev = jnp.pad(t[:, :-1], ((0, 0), (1, 0), (0, 0), (0, 0), (0, 0)))
    return jnp.concatenate([prev, t], axis=2)


def sliding_window_attention(h, k, v, w_q, sinks, w_out, cos, sin):
    bsz, seq, _ = h.shape
    nb = seq // BLOCK
    q = apply_partial_rope((h @ w_q).reshape(bsz, seq, N_HEADS, HEAD_DIM), cos, sin)
    q = q.reshape(bsz, nb, BLOCK, N_KV_HEADS, Q_PER_KV, HEAD_DIM)
    kb = _band(k.reshape(bsz, nb, BLOCK, N_KV_HEADS, HEAD_DIM))
    vb = _band(v.reshape(bsz, nb, BLOCK, N_KV_HEADS, HEAD_DIM))
    s = jnp.einsum('bnqkgd,bnskd->bnkgqs', q, kb).astype(jnp.float32) * (HEAD_DIM ** -0.5)
    q_idx = jnp.arange(BLOCK)[:, None]
    s_idx = jnp.arange(2 * BLOCK)[None, :]
    rel = q_idx + BLOCK - s_idx
    valid = (rel >= 0) & (rel < WINDOW)
    has_prev = (jnp.arange(nb)[:, None, None] > 0) | (s_idx[None] >= BLOCK)
    mask = valid[None] & has_prev
    s = jnp.where(mask[None, :, None, None], s, -jnp.inf)
    sink = sinks.astype(jnp.float32).reshape(N_KV_HEADS, Q_PER_KV)[None, None, :, :, None, None]
    m = jnp.maximum(jnp.max(s, axis=-1, keepdims=True), sink)
    p = jnp.exp(s - m)
    denom = jnp.sum(p, axis=-1, keepdims=True) + jnp.exp(sink - m)
    p = (p / denom).astype(v.dtype)
    o = jnp.einsum('bnkgqs,bnskd->bnqkgd', p, vb).reshape(bsz, seq, N_HEADS * HEAD_DIM)
    return o @ w_out


def swiglu(t, w_gate, w_up, w_down):
    return (jax.nn.silu(t @ w_gate) * (t @ w_up)) @ w_down


def moe_swiglu(h, w_router, b_router, w_gate, w_up, w_down):
    bsz, seq, d = h.shape
    t = h.reshape(-1, d)
    logits = (t @ w_router).astype(jnp.float32) + b_router.astype(jnp.float32)
    top_vals, top_idx = lax.top_k(logits, TOP_K)
    top_w = jax.nn.softmax(top_vals, axis=-1)
    combine = jnp.sum(jax.nn.one_hot(top_idx, N_EXPERTS, dtype=jnp.float32) * top_w[..., None], axis=1).astype(h.dtype)
    out = jnp.zeros_like(t)
    for e in range(N_EXPERTS):
        out = out + combine[:, e:e + 1] * swiglu(t, w_gate[e], w_up[e], w_down[e])
    return out.reshape(bsz, seq, d)


def setup_inputs(seed: int = 0) -> dict:
    key = jax.random.key(seed)
    ks = iter(jax.random.split(key, 40))
    f32 = jnp.float32

    def nrm(shape, scale):
        return jax.random.normal(next(ks), shape, f32) * scale

    beta = DEEPNORM_BETA
    x = nrm((BATCH, SEQ, D_MODEL), 1.0)
    offs = jax.random.randint(next(ks), (BATCH, 1), 0, MAX_POS_OFFSET, dtype=jnp.int32)
    positions = (offs + jnp.arange(SEQ, dtype=jnp.int32)[None, :]).astype(jnp.int32)
    ln_g = 1.0 + nrm((DEPTH, 2, D_MODEL), 0.02)
    ln_b = nrm((DEPTH, 2, D_MODEL), 0.02)
    ssm_lambda_re = -0.5 + nrm((N_A_LAYERS, SSM_GROUPS, SSM_STATE), 0.01)
    ssm_lambda_im = math.pi * jnp.arange(SSM_STATE, dtype=f32)[None, None, :] + nrm((N_A_LAYERS, SSM_GROUPS, SSM_STATE), 0.01)
    ssm_log_step = jax.random.uniform(next(ks), (N_A_LAYERS, SSM_GROUPS), f32, math.log(DT_MIN), math.log(DT_MAX))
    ssm_b_re = nrm((N_A_LAYERS, SSM_GROUPS, SSM_STATE, SSM_GROUP_CH), (2 * SSM_GROUP_CH) ** -0.5)
    ssm_b_im = nrm((N_A_LAYERS, SSM_GROUPS, SSM_STATE, SSM_GROUP_CH), (2 * SSM_GROUP_CH) ** -0.5)
    ssm_c_re = nrm((N_A_LAYERS, SSM_GROUPS, SSM_GROUP_CH, SSM_STATE), (2 * SSM_STATE) ** -0.5)
    ssm_c_im = nrm((N_A_LAYERS, SSM_GROUPS, SSM_GROUP_CH, SSM_STATE), (2 * SSM_STATE) ** -0.5)
    ssm_d = nrm((N_A_LAYERS, D_MODEL), 1.0)
    ssm_w_glu = jnp.concatenate([nrm((N_A_LAYERS, D_MODEL, D_MODEL), D_MODEL ** -0.5 * beta),
                                 nrm((N_A_LAYERS, D_MODEL, D_MODEL), D_MODEL ** -0.5)], axis=-1)
    kv_w = jnp.concatenate([nrm((D_MODEL, KV_DIM), D_MODEL ** -0.5),
                            nrm((D_MODEL, KV_DIM), D_MODEL ** -0.5 * beta)], axis=-1)
    attn_w_q = nrm((N_B_LAYERS, D_MODEL, N_HEADS * HEAD_DIM), D_MODEL ** -0.5)
    attn_sinks = nrm((N_B_LAYERS, N_HEADS), 0.5)
    attn_w_out = nrm((N_B_LAYERS, N_HEADS * HEAD_DIM, D_MODEL), (N_HEADS * HEAD_DIM) ** -0.5 * beta)
    ffn_w_gate = nrm((N_DENSE_LAYERS, D_MODEL, FFN_DIM), D_MODEL ** -0.5 * beta)
    ffn_w_up = nrm((N_DENSE_LAYERS, D_MODEL, FFN_DIM), D_MODEL ** -0.5 * beta)
    ffn_w_down = nrm((N_DENSE_LAYERS, FFN_DIM, D_MODEL), FFN_DIM ** -0.5 * beta)
    moe_w_router = nrm((N_MOE_LAYERS, D_MODEL, N_EXPERTS), D_MODEL ** -0.5)
    moe_b_router = nrm((N_MOE_LAYERS, N_EXPERTS), 0.01)
    moe_w_gate = nrm((N_MOE_LAYERS, N_EXPERTS, D_MODEL, EXPERT_DIM), D_MODEL ** -0.5 * beta)
    moe_w_up = nrm((N_MOE_LAYERS, N_EXPERTS, D_MODEL, EXPERT_DIM), D_MODEL ** -0.5 * beta)
    moe_w_down = nrm((N_MOE_LAYERS, N_EXPERTS, EXPERT_DIM, D_MODEL), EXPERT_DIM ** -0.5 * beta)
    return {"x": x, "positions": positions, "ln_g": ln_g, "ln_b": ln_b,
            "ssm_lambda_re": ssm_lambda_re, "ssm_lambda_im": ssm_lambda_im, "ssm_log_step": ssm_log_step,
            "ssm_b_re": ssm_b_re, "ssm_b_im": ssm_b_im, "ssm_c_re": ssm_c_re, "ssm_c_im": ssm_c_im,
            "ssm_d": ssm_d, "ssm_w_glu": ssm_w_glu, "kv_w": kv_w,
            "attn_w_q": attn_w_q, "attn_sinks": attn_sinks, "attn_w_out": attn_w_out,
            "ffn_w_gate": ffn_w_gate, "ffn_w_up": ffn_w_up, "ffn_w_down": ffn_w_down,
            "moe_w_router": moe_w_router, "moe_b_router": moe_b_router,
            "moe_w_gate": moe_w_gate, "moe_w_up": moe_w_up, "moe_w_down": moe_w_down}


def reference(x, positions, ln_g, ln_b, ssm_lambda_re, ssm_lambda_im, ssm_log_step,
              ssm_b_re, ssm_b_im, ssm_c_re, ssm_c_im, ssm_d, ssm_w_glu, kv_w,
              attn_w_q, attn_sinks, attn_w_out, ffn_w_gate, ffn_w_up, ffn_w_down,
              moe_w_router, moe_b_router, moe_w_gate, moe_w_up, moe_w_down):
    cos, sin = rope_tables(positions)
    h = x
    k_shared = None
    v_shared = None
    for layer in range(DEPTH):
        if layer < N_A_LAYERS:
            a = layer
            mix = s5_mixer(h, ssm_lambda_re[a], ssm_lambda_im[a], ssm_log_step[a],
                           ssm_b_re[a], ssm_b_im[a], ssm_c_re[a], ssm_c_im[a], ssm_d[a], ssm_w_glu[a])
        else:
            bl = layer - N_A_LAYERS
            mix = sliding_window_attention(h, k_shared, v_shared, attn_w_q[bl], attn_sinks[bl],
                                           attn_w_out[bl], cos, sin)
        h = layer_norm(DEEPNORM_ALPHA * h + mix, ln_g[layer, 0], ln_b[layer, 0])
        c = layer // 2
        if layer % 2 == 0:
            ff = swiglu(h, ffn_w_gate[c], ffn_w_up[c], ffn_w_down[c])
        else:
            ff = moe_swiglu(h, moe_w_router[c], moe_b_router[c], moe_w_gate[c], moe_w_up[c], moe_w_down[c])
        h = layer_norm(DEEPNORM_ALPHA * h + ff, ln_g[layer, 1], ln_b[layer, 1])
        if layer == N_A_LAYERS - 1 and N_B_LAYERS > 0:
            k_shared, v_shared = shared_kv(h, kv_w, cos, sin)
    return h
```

```cpp
#include <hip/hip_runtime.h>
#include <hip/hip_cooperative_groups.h>
#include <cstdio>
namespace cg = cooperative_groups;

#ifndef LEVEL
#define LEVEL 4
#endif

#define LAS __attribute__((address_space(3)))
typedef unsigned short bf16_t;
typedef short bf16x8 __attribute__((ext_vector_type(8)));
typedef float f32x4 __attribute__((ext_vector_type(4)));
typedef float f32x16 __attribute__((ext_vector_type(16)));
typedef unsigned u32x4 __attribute__((ext_vector_type(4)));
typedef unsigned u32x2 __attribute__((ext_vector_type(2)));

constexpr int T_ = 32768, D_ = 1024, FF_ = 2816;
constexpr float ALPHA = 1.41421356237309515f;
constexpr float LN_EPS = 1e-5f;
constexpr size_t MiB = 1ull << 20;
constexpr size_t WS_CNT = 0, WS_A32 = 65536, WS_ROPEC = 1 * MiB, WS_ROPES = 2 * MiB, WS_LIST = 3 * MiB, WS_TOK = 4 * MiB;
constexpr size_t WS_WMUP = 8 * MiB, WS_WMDN = 40 * MiB, WS_WGLU = 56 * MiB, WS_WUP = 60 * MiB, WS_WDN = 71 * MiB, WS_WQKV = 77 * MiB, WS_WO = 80 * MiB;
constexpr size_t WS_H16 = 82 * MiB, WS_BT2 = 146 * MiB, WS_BT1 = 186 * MiB, WS_XA = 202 * MiB, WS_SST = 282 * MiB, WS_GA = 146 * MiB, WS_Y = 146 * MiB;
constexpr size_t WS_BIG = 314 * MiB, WS_END = 490 * MiB;
constexpr int LDS_BYTES = 131072;

struct Params {
    const float* x; const int* pos; const float* ln_g; const float* ln_b;
    const float* lam_re; const float* lam_im; const float* log_step; const float* b_re; const float* b_im; const float* c_re; const float* c_im;
    const float* ssm_d; const float* w_glu; const float* kv_w; const float* w_q; const float* sinks; const float* w_out;
    const float* ffn_g; const float* ffn_u; const float* ffn_d; const float* w_router; const float* b_router;
    const float* moe_g; const float* moe_u; const float* moe_d;
    float* out; unsigned char* ws;
};

__device__ __forceinline__ unsigned pk_bf16(float lo, float hi) { unsigned r; asm volatile("v_cvt_pk_bf16_f32 %0, %1, %2" : "=v"(r) : "v"(lo), "v"(hi)); return r; }
__device__ __forceinline__ float bf_lo(unsigned w) { return __uint_as_float(w << 16); }
__device__ __forceinline__ float bf_hi(unsigned w) { return __uint_as_float(w & 0xffff0000u); }
__device__ __forceinline__ float sigmoidf_(float x) { return __builtin_amdgcn_rcpf(1.0f + __expf(-x)); }
__device__ __forceinline__ float gelu_tanh(float y) { const float u = 1.5957691216057308f * (y + 0.044715f * y * y * y); return y * sigmoidf_(u); }
__device__ __forceinline__ float wave_sum(float v) {
    v += __shfl_xor(v, 32); v += __shfl_xor(v, 16); v += __shfl_xor(v, 8); v += __shfl_xor(v, 4); v += __shfl_xor(v, 2); v += __shfl_xor(v, 1); return v; }

namespace pg8 {
constexpr int BM = 256, BK = 64, HALF = 128, HTB = HALF * BK * 2, NXCD = 8, WGM = 8;
__device__ __forceinline__ int lds_byte(int r, int c) { const int st = (r >> 4) * 2 + (c >> 5), rr = r & 15, cc = c & 31, ob = rr * 64 + cc * 2; return st * 1024 + (ob ^ (((ob >> 9) & 1) << 5)); }
__device__ __forceinline__ void stage_rc(int b, int& R, int& C) { const int st = b / 1024, sb = b % 1024, swz = sb ^ (((sb >> 9) & 1) << 5); R = (st >> 1) * 16 + swz / 64; C = (st & 1) * 32 + (swz % 64) / 2; }
__device__ __forceinline__ int perm32(int rho) { const int n = rho >> 4, i = rho & 15; return 8 * (i >> 2) + 4 * n + (i & 3); }
__device__ __forceinline__ int xcd_remap(int L, int nwg) { const int q = nwg / NXCD, r = nwg % NXCD, xcd = L % NXCD, off = L / NXCD; return (xcd < r ? xcd * (q + 1) : r * (q + 1) + (xcd - r) * q) + off; }

struct Unit { int pm, pn, aux, pad; size_t a_off, b_off; };

struct SchedDense {
    int nM, nN, nwg, G, c, lda, K;
    __device__ __forceinline__ void init(int M, int N, int K_, int lda_, int G_, int c_) { nM = M / BM; nN = N / BM; nwg = nM * nN; G = G_; c = c_; lda = lda_; K = K_; }
    __device__ __forceinline__ bool next(int i, Unit& u) const {
        const int L = i * G + c; if (L >= nwg) return false;
        const int wgid = xcd_remap(L, nwg);
        const int nig = WGM * nN, gid = wgid / nig, fm = gid * WGM, gsz = (nM - fm) < WGM ? (nM - fm) : WGM;
        u.pm = fm + ((wgid % nig) % gsz); u.pn = (wgid % nig) / gsz; u.aux = 0; u.pad = 0;
        u.a_off = (size_t)u.pm * BM * lda * 2; u.b_off = (size_t)u.pn * BM * K * 2; return true;
    }
    __device__ __forceinline__ unsigned voffA(int R, int C) const { return (unsigned)(R * lda + C) * 2u; }
    __device__ __forceinline__ size_t a_kstep() const { return BK * 2; }
    __device__ __forceinline__ size_t a_hstep() const { return (size_t)HALF * lda * 2; }
};
struct SchedMoe {
    int nM, nN, nwg, G, c, K; int tb[9]; size_t estride;
    __device__ __forceinline__ void init(const int* cnt, int N, int K_, size_t estride_, int G_, int c_) {
        tb[0] = 0;
#pragma unroll
        for (int e = 0; e < 8; ++e) tb[e + 1] = tb[e] + ((cnt[e] + 255) >> 8);
        nM = tb[8]; nN = N / BM; nwg = nM * nN; G = G_; c = c_; K = K_; estride = estride_; }
    __device__ __forceinline__ bool next(int i, Unit& u) const {
        const int L = i * G + c; if (L >= nwg) return false;
        const int wgid = xcd_remap(L, nwg);
        const int nig = WGM * nN, gid = wgid / nig, fm = gid * WGM, gsz = (nM - fm) < WGM ? (nM - fm) : WGM;
        u.pm = fm + ((wgid % nig) % gsz); u.pn = (wgid % nig) / gsz; int e = 0;
#pragma unroll
        for (int k = 1; k < 8; ++k) e += (u.pm >= tb[k]) ? 1 : 0;
        u.aux = e; u.pad = 0;
        u.a_off = (size_t)u.pm * BM * 1024 * 2; u.b_off = (size_t)e * estride + (size_t)u.pn * BM * K * 2; return true;
    }
    __device__ __forceinline__ unsigned voffA(int R, int C) const { return (unsigned)(R * 1024 + C) * 2u; }
    __device__ __forceinline__ size_t a_kstep() const { return BK * 2; }
    __device__ __forceinline__ size_t a_hstep() const { return (size_t)HALF * 1024 * 2; }
};
struct SchedSsm {
    int nN, nwg, G, c, K, N;
    __device__ __forceinline__ void init(int N_, int K_, int G_, int c_) { N = N_; nN = N_ / BM; nwg = 64 * 4 * nN; G = G_; c = c_; K = K_; }
    __device__ __forceinline__ bool next(int i, Unit& u) const {
        const int L = i * G + c; if (L >= nwg) return false;
        const int wgid = xcd_remap(L, nwg);
        const int per = 4 * nN, g = wgid / per, rem = wgid % per;
        u.pm = rem & 3; u.pn = rem >> 2; u.aux = g; u.pad = 0;
        u.a_off = ((size_t)u.pm * BM * 40 * 1024 + (size_t)g * 16) * 2; u.b_off = (size_t)g * N * K * 2 + (size_t)u.pn * BM * K * 2; return true;
    }
    __device__ __forceinline__ unsigned voffA(int R, int C) const { return (unsigned)((R * 40 + (C >> 4)) * 1024 + (C & 15)) * 2u; }
    __device__ __forceinline__ size_t a_kstep() const { return 4 * 1024 * 2; }
    __device__ __forceinline__ size_t a_hstep() const { return (size_t)HALF * 40 * 1024 * 2; }
};

template <class Epi, class Sched>
__device__ __forceinline__ void gemm_phase(LAS unsigned char* lds, const char* Ab, const char* Bb, const int K, const Sched& S, const Epi& E) {
    const int tid = threadIdx.x, wid = __builtin_amdgcn_readfirstlane(tid >> 6), lane = tid & 63, wr = wid >> 2, wc = wid & 3, fr = lane & 15, fq = lane >> 4;
    const int nt = K / BK;
    unsigned voffA[2], voffB[2];
#pragma unroll
    for (int i = 0; i < 2; ++i) { int R, C; stage_rc(tid * 16 + i * 8192, R, C); const int Rb = Epi::PERM ? ((R & ~31) + perm32(R & 31)) : R;
        voffA[i] = S.voffA(R, C); voffB[i] = (unsigned)(Rb * K + C) * 2u; }
    const size_t kstepA = S.a_kstep(), hstepA = S.a_hstep(), kstepB = (size_t)(BK * 2), hstepB = (size_t)HALF * K * 2;
    const unsigned ldsw = (unsigned)wid * 1024u;
    const int aoff = lds_byte(wr * 64 + fr, fq * 8), boff = lds_byte(wc * 32 + fr, fq * 8);
#define PG8_SA(b, h) (((b) * 2 + (h)) * HTB)
#define PG8_SB(b, h) ((4 + (b) * 2 + (h)) * HTB)
#define PG8_STAGE(bufoff, gbase, voff) do { _Pragma("unroll") for (int _i = 0; _i < 2; ++_i) \
        __builtin_amdgcn_global_load_lds((const unsigned*)((const char*)(gbase) + (voff)[_i]), (LAS unsigned*)(lds + (bufoff) + ldsw + _i * 8192), 16, 0, 0); } while (0)
#define PG8_LDA(dst, b, h) do { _Pragma("unroll") for (int m = 0; m < 4; ++m) _Pragma("unroll") for (int k = 0; k < 2; ++k) dst[m][k] = *(const LAS bf16x8*)(lds + PG8_SA(b, h) + aoff + m * 2048 + k * 1024); } while (0)
#define PG8_LDB(dst, b, h) do { _Pragma("unroll") for (int n = 0; n < 2; ++n) _Pragma("unroll") for (int k = 0; k < 2; ++k) dst[n][k] = *(const LAS bf16x8*)(lds + PG8_SB(b, h) + boff + n * 2048 + k * 1024); } while (0)
#define PG8_MMA(ai, bj, At, Bt) do { __builtin_amdgcn_s_setprio(1); _Pragma("unroll") for (int m = 0; m < 4; ++m) _Pragma("unroll") for (int n = 0; n < 2; ++n) _Pragma("unroll") for (int k = 0; k < 2; ++k) \
        acc[ai][bj][m][n] = __builtin_amdgcn_mfma_f32_16x16x32_bf16(Bt[n][k], At[m][k], acc[ai][bj][m][n], 0, 0, 0); __builtin_amdgcn_s_setprio(0); } while (0)
#define PG8_WAIT_V(n) asm volatile("s_waitcnt vmcnt(" #n ")" ::: "memory")
#define PG8_WAIT_L(n) asm volatile("s_waitcnt lgkmcnt(" #n ")" ::: "memory")
#define PG8_BAR __builtin_amdgcn_s_barrier()
#define PG8_SCHED __builtin_amdgcn_sched_barrier(0)
    Unit cur, nxt; int ui = 0;
    if (!S.next(0, cur)) return;
    f32x4 acc[2][2][4][2];
#pragma unroll
    for (int a = 0; a < 2; ++a)
#pragma unroll
        for (int b = 0; b < 2; ++b)
#pragma unroll
            for (int m = 0; m < 4; ++m)
#pragma unroll
                for (int n = 0; n < 2; ++n) acc[a][b][m][n] = (f32x4){0.f, 0.f, 0.f, 0.f};
    bf16x8 At[4][2], B0[2][2], B1[2][2];
    const char* cA = Ab + cur.a_off; const char* cB = Bb + cur.b_off;
    PG8_STAGE(PG8_SB(0, 0), cB, voffB); PG8_STAGE(PG8_SA(0, 0), cA, voffA); PG8_STAGE(PG8_SB(0, 1), cB + hstepB, voffB); PG8_STAGE(PG8_SA(0, 1), cA + hstepA, voffA);
    if (wr == 1) PG8_BAR;
    PG8_WAIT_V(4); PG8_BAR;
    PG8_STAGE(PG8_SB(1, 0), cB + kstepB, voffB); PG8_STAGE(PG8_SA(1, 0), cA + kstepA, voffA); PG8_STAGE(PG8_SB(1, 1), cB + hstepB + kstepB, voffB);
    PG8_WAIT_V(6); PG8_BAR;
    for (;;) {
        const bool has_next = S.next(ui + 1, nxt);
        const char* nA = has_next ? Ab + nxt.a_off : cA; const char* nB = has_next ? Bb + nxt.b_off : cB;
        for (int t = 0; t < nt; t += 2) {
            const bool last = (t == nt - 2);
            const char* a1 = cA + (size_t)(t + 1) * kstepA;
            const char* a2 = last ? nA : cA + (size_t)(t + 2) * kstepA; const char* b2 = last ? nB : cB + (size_t)(t + 2) * kstepB;
            const char* a3 = a2 + kstepA; const char* b3 = b2 + kstepB;
            PG8_LDB(B0, 0, 0); PG8_SCHED; PG8_LDA(At, 0, 0); PG8_STAGE(PG8_SA(1, 1), a1 + hstepA, voffA);
            PG8_WAIT_L(8); PG8_BAR; PG8_WAIT_L(0); PG8_MMA(0, 0, At, B0); PG8_BAR; PG8_SCHED;
            PG8_LDB(B1, 0, 1); PG8_STAGE(PG8_SB(0, 0), b2, voffB);
            PG8_BAR; PG8_WAIT_L(0); PG8_MMA(0, 1, At, B1); PG8_BAR;
            PG8_LDA(At, 0, 1); PG8_STAGE(PG8_SA(0, 0), a2, voffA);
            PG8_BAR; PG8_WAIT_L(0); PG8_MMA(1, 0, At, B0); PG8_BAR; PG8_SCHED;
            PG8_STAGE(PG8_SB(0, 1), b2 + hstepB, voffB);
            PG8_WAIT_V(6); PG8_BAR; PG8_MMA(1, 1, At, B1); PG8_BAR;
            PG8_LDB(B0, 1, 0); PG8_SCHED; PG8_LDA(At, 1, 0); PG8_STAGE(PG8_SA(0, 1), a2 + hstepA, voffA);
            PG8_WAIT_L(8); PG8_BAR; PG8_WAIT_L(0); PG8_MMA(0, 0, At, B0); PG8_BAR; PG8_SCHED;
            PG8_LDB(B1, 1, 1); PG8_STAGE(PG8_SB(1, 0), b3, voffB);
            PG8_BAR; PG8_WAIT_L(0); PG8_MMA(0, 1, At, B1); PG8_BAR;
            PG8_LDA(At, 1, 1); PG8_STAGE(PG8_SA(1, 0), a3, voffA);
            PG8_BAR; PG8_WAIT_L(0); PG8_MMA(1, 0, At, B0); PG8_BAR; PG8_SCHED;
            PG8_STAGE(PG8_SB(1, 1), b3 + hstepB, voffB);
            PG8_WAIT_V(6); PG8_BAR; PG8_MMA(1, 1, At, B1); PG8_BAR;
        }
        E(acc, cur, wr, wc, fr, fq);
        if (!has_next) break;
#pragma unroll
        for (int a = 0; a < 2; ++a)
#pragma unroll
            for (int b = 0; b < 2; ++b)
#pragma unroll
                for (int m = 0; m < 4; ++m)
#pragma unroll
                    for (int n = 0; n < 2; ++n) acc[a][b][m][n] = (f32x4){0.f, 0.f, 0.f, 0.f};
        cur = nxt; cA = nA; cB = nB; ++ui;
    }
    PG8_WAIT_V(0);
    if (wr == 0) PG8_BAR;
    PG8_BAR;
#undef PG8_SA
#undef PG8_SB
#undef PG8_STAGE
#undef PG8_LDA
#undef PG8_LDB
#undef PG8_MMA
#undef PG8_WAIT_V
#undef PG8_WAIT_L
#undef PG8_BAR
#undef PG8_SCHED
}

typedef const f32x4 (&AccRef)[2][2][4][2];

struct EpiS1 {
    static constexpr bool PERM = false; float* sst;
    __device__ __forceinline__ void operator()(AccRef acc, const Unit& u, int wr, int wc, int fr, int fq) const {
#pragma unroll
        for (int ai = 0; ai < 2; ++ai)
#pragma unroll
            for (int m = 0; m < 4; ++m) { const int row = u.pm * BM + ai * HALF + wr * 64 + m * 16 + fr; float* rp = sst + ((size_t)row * 64 + u.aux) * 128 + wc * 32 + 4 * fq;
#pragma unroll
                for (int n = 0; n < 2; ++n) *(f32x4*)(rp + 16 * n) = acc[ai][0][m][n]; }
    }
};
struct EpiS2 {
    static constexpr bool PERM = true; const float* x; const float* dsk; bf16_t* g16;
    __device__ __forceinline__ void operator()(AccRef acc, const Unit& u, int wr, int wc, int fr, int fq) const {
        const int ch = u.aux * 16 + 8 * (fq & 1);
        const f32x4 d0 = *(const f32x4*)(dsk + ch), d1 = *(const f32x4*)(dsk + ch + 4);
#pragma unroll
        for (int ai = 0; ai < 2; ++ai)
#pragma unroll
            for (int m = 0; m < 4; ++m) { const int row = u.pm * BM + ai * HALF + wr * 64 + m * 16 + fr;
#pragma unroll
                for (int bj = 0; bj < 2; ++bj) { const int t = 16 * u.pn + 8 * bj + 2 * wc + (fq >> 1); const size_t off = ((size_t)row * 32 + t) * 1024 + ch;
                    const f32x4 x0 = *(const f32x4*)(x + off), x1 = *(const f32x4*)(x + off + 4);
                    const f32x4 y0 = acc[ai][bj][m][0] + d0 * x0, y1 = acc[ai][bj][m][1] + d1 * x1;
                    u32x4 w; w.x = pk_bf16(gelu_tanh(y0[0]), gelu_tanh(y0[1])); w.y = pk_bf16(gelu_tanh(y0[2]), gelu_tanh(y0[3]));
                    w.z = pk_bf16(gelu_tanh(y1[0]), gelu_tanh(y1[1])); w.w = pk_bf16(gelu_tanh(y1[2]), gelu_tanh(y1[3]));
                    *(u32x4*)(g16 + off) = w; } }
    }
};
struct EpiGlu {
    static constexpr bool PERM = false; const float* x; float* out;
    __device__ __forceinline__ void operator()(AccRef acc, const Unit& u, int wr, int wc, int fr, int fq) const {
#pragma unroll
        for (int ai = 0; ai < 2; ++ai)
#pragma unroll
            for (int m = 0; m < 4; ++m) { const int row = u.pm * BM + ai * HALF + wr * 64 + m * 16 + fr; const size_t off = (size_t)row * 1024 + u.pn * 128 + wc * 32 + 4 * fq;
#pragma unroll
                for (int n = 0; n < 2; ++n) { const f32x4 xv = *(const f32x4*)(x + off + 16 * n); const f32x4 v = acc[ai][0][m][n], g = acc[ai][1][m][n]; f32x4 o;
#pragma unroll
                    for (int j = 0; j < 4; ++j) o[j] = ALPHA * xv[j] + v[j] * sigmoidf_(g[j]);
                    *(f32x4*)(out + off + 16 * n) = o; } }
    }
};
struct EpiUp {
    static constexpr bool PERM = true; bf16_t* act; int ld;
    __device__ __forceinline__ void operator()(AccRef acc, const Unit& u, int wr, int wc, int fr, int fq) const {
#pragma unroll
        for (int ai = 0; ai < 2; ++ai)
#pragma unroll
            for (int m = 0; m < 4; ++m) { const int row = u.pm * BM + ai * HALF + wr * 64 + m * 16 + fr; float r[8];
#pragma unroll
                for (int n = 0; n < 2; ++n)
#pragma unroll
                    for (int j = 0; j < 4; ++j) { const float g = acc[ai][0][m][n][j], up = acc[ai][1][m][n][j]; r[4 * n + j] = g * sigmoidf_(g) * up; }
                u32x4 w; w.x = pk_bf16(r[0], r[1]); w.y = pk_bf16(r[2], r[3]); w.z = pk_bf16(r[4], r[5]); w.w = pk_bf16(r[6], r[7]);
                *(u32x4*)(act + (size_t)row * ld + u.pn * 128 + wc * 32 + 8 * fq) = w; }
    }
};
struct EpiRes {
    static constexpr bool PERM = false; float* h;
    __device__ __forceinline__ void operator()(AccRef acc, const Unit& u, int wr, int wc, int fr, int fq) const {
#pragma unroll
        for (int ai = 0; ai < 2; ++ai)
#pragma unroll
            for (int m = 0; m < 4; ++m) { const int row = u.pm * BM + ai * HALF + wr * 64 + m * 16 + fr; float* rp = h + (size_t)row * 1024 + u.pn * BM + wc * 32 + 4 * fq;
#pragma unroll
                for (int bj = 0; bj < 2; ++bj)
#pragma unroll
                    for (int n = 0; n < 2; ++n) { float* p = rp + bj * HALF + 16 * n; const f32x4 hv = *(const f32x4*)p; *(f32x4*)p = ALPHA * hv + acc[ai][bj][m][n]; } }
    }
};
struct EpiQkv {
    static constexpr bool PERM = true; bf16_t* q; bf16_t* k; bf16_t* v; const float* rc; const float* rs;
    __device__ __forceinline__ void operator()(AccRef acc, const Unit& u, int wr, int wc, int fr, int fq) const {
        const bool rope = (u.pn <= 4) && ((wc & 1) == 0);
        bf16_t* base; int ld, colt; float scale = 1.0f;
        if (u.pn < 4) { base = q; ld = 1024; colt = u.pn * BM; scale = 0.125f; } else if (u.pn == 4) { base = k; ld = 256; colt = 0; } else { base = v; ld = 256; colt = 0; }
#pragma unroll
        for (int ai = 0; ai < 2; ++ai)
#pragma unroll
            for (int m = 0; m < 4; ++m) { const int row = u.pm * BM + ai * HALF + wr * 64 + m * 16 + fr;
                f32x4 c0 = {1.f, 1.f, 1.f, 1.f}, c1 = c0, s0 = {0.f, 0.f, 0.f, 0.f}, s1 = s0;
                if (rope && fq < 2) { c0 = *(const f32x4*)(rc + (size_t)row * 8); c1 = *(const f32x4*)(rc + (size_t)row * 8 + 4); s0 = *(const f32x4*)(rs + (size_t)row * 8); s1 = *(const f32x4*)(rs + (size_t)row * 8 + 4);
                    if (fq == 0) { s0 = -s0; s1 = -s1; } }
#pragma unroll
                for (int bj = 0; bj < 2; ++bj) { f32x4 v0 = acc[ai][bj][m][0], v1 = acc[ai][bj][m][1];
                    if (rope) { f32x4 p0, p1;
#pragma unroll
                        for (int j = 0; j < 4; ++j) { p0[j] = __shfl_xor(v0[j], 16); p1[j] = __shfl_xor(v1[j], 16); }
                        v0 = v0 * c0 + p0 * s0; v1 = v1 * c1 + p1 * s1; }
                    v0 = v0 * scale; v1 = v1 * scale;
                    u32x4 w; w.x = pk_bf16(v0[0], v0[1]); w.y = pk_bf16(v0[2], v0[3]); w.z = pk_bf16(v1[0], v1[1]); w.w = pk_bf16(v1[2], v1[3]);
                    *(u32x4*)(base + (size_t)row * ld + colt + bj * HALF + wc * 32 + 8 * fq) = w; } }
    }
};
struct EpiBf16 {
    static constexpr bool PERM = true; bf16_t* o; int ld;
    __device__ __forceinline__ void operator()(AccRef acc, const Unit& u, int wr, int wc, int fr, int fq) const {
#pragma unroll
        for (int ai = 0; ai < 2; ++ai)
#pragma unroll
            for (int m = 0; m < 4; ++m) { const int row = u.pm * BM + ai * HALF + wr * 64 + m * 16 + fr;
#pragma unroll
                for (int bj = 0; bj < 2; ++bj) { const f32x4 v0 = acc[ai][bj][m][0], v1 = acc[ai][bj][m][1];
                    u32x4 w; w.x = pk_bf16(v0[0], v0[1]); w.y = pk_bf16(v0[2], v0[3]); w.z = pk_bf16(v1[0], v1[1]); w.w = pk_bf16(v1[2], v1[3]);
                    *(u32x4*)(o + (size_t)row * ld + u.pn * BM + bj * HALF + wc * 32 + 8 * fq) = w; } }
    }
};
}

__device__ __forceinline__ void transpose_tile(const float* __restrict__ src, int ld, int k0, int col0, bf16_t* __restrict__ dst, int Kd, int n0, float* tile) {
    const int tid = threadIdx.x;
#pragma unroll
    for (int i = 0; i < 8; ++i) { const int kk = (tid >> 6) + 8 * i, nn = tid & 63; tile[kk * 65 + nn] = src[(size_t)(k0 + kk) * ld + col0 + nn]; }
    __syncthreads();
    { const int n = tid >> 3, ks = (tid & 7) * 8; float r[8];
#pragma unroll
      for (int j = 0; j < 8; ++j) r[j] = tile[(ks + j) * 65 + n];
      u32x4 w; w.x = pk_bf16(r[0], r[1]); w.y = pk_bf16(r[2], r[3]); w.z = pk_bf16(r[4], r[5]); w.w = pk_bf16(r[6], r[7]);
      *(u32x4*)(dst + (size_t)(n0 + n) * Kd + k0 + ks) = w; }
    __syncthreads();
}

__device__ void ssm_tables(const Params& P, int g, unsigned char* lds) {
    const int tid = threadIdx.x;
    float* apr = (float*)lds;
    float* api = apr + 33 * 64;
    float* bbr = api + 33 * 64;
    float* bbi = bbr + 1024;
    float* ccr = bbi + 1024;
    float* cci = ccr + 1024;
    float* kg = cci + 1024;
    const float dtf = expf(P.log_step[g]);
    for (int idx = tid; idx < 33 * 64; idx += 512) { const int tau = idx >> 6, p = idx & 63;
        const float lr = P.lam_re[g * 64 + p], li = P.lam_im[g * 64 + p];
        const double dt = (double)dtf; double rev = (double)li * dt * (double)tau * 0.15915494309189535; rev -= floor(rev);
        const float ang = (float)(rev * 6.283185307179586); float sn, cs; sincosf(ang, &sn, &cs);
        const float mag = expf((float)((double)lr * dt * (double)tau));
        apr[idx] = mag * cs; api[idx] = mag * sn; }
    for (int idx = tid; idx < 1024; idx += 512) { ccr[idx] = P.c_re[g * 1024 + idx]; cci[idx] = P.c_im[g * 1024 + idx]; }
    __syncthreads();
    for (int idx = tid; idx < 1024; idx += 512) { const int p = idx >> 4;
        const float lr = P.lam_re[g * 64 + p], li = P.lam_im[g * 64 + p], ar = apr[64 + p], ai = api[64 + p];
        const float nr = ar - 1.0f, den = lr * lr + li * li, kr = (nr * lr + ai * li) / den, ki = (ai * lr - nr * li) / den;
        const float br = P.b_re[g * 1024 + idx], bi = P.b_im[g * 1024 + idx];
        bbr[idx] = kr * br - ki * bi; bbi[idx] = kr * bi + ki * br; }
    __syncthreads();
    { const int cp = tid & 15, c = (tid >> 4) & 15, t0 = tid >> 8;
      for (int i = 0; i < 16; ++i) { const int tau = t0 + 2 * i; float s = 0.f;
          for (int p = 0; p < 64; ++p) { const float cr = ccr[c * 64 + p], ci = cci[c * 64 + p], ar = apr[tau * 64 + p], ai = api[tau * 64 + p];
              const float zr = cr * ar - ci * ai, zi = cr * ai + ci * ar; s += zr * bbr[p * 16 + cp] - zi * bbi[p * 16 + cp]; }
          kg[(tau * 16 + c) * 16 + cp] = s; } }
    __syncthreads();
    bf16_t* bt2 = (bf16_t*)(P.ws + WS_BT2) + (size_t)g * 512 * 640;
    for (int pc = tid; pc < 512 * 80; pc += 512) { const int n = pc / 80, k8 = (pc % 80) * 8, t = n >> 4, c = n & 15; float r[8];
        if (k8 < 512) { const int s = k8 >> 4, c0 = k8 & 15;
#pragma unroll
            for (int j = 0; j < 8; ++j) r[j] = (t >= s) ? kg[((t - s) * 16 + c) * 16 + c0 + j] : 0.f;
        } else { const int q0 = k8 - 512;
#pragma unroll
            for (int j = 0; j < 8; j += 2) { const int p = (q0 + j) >> 1; const float cr = ccr[c * 64 + p], ci = cci[c * 64 + p], ar = apr[(t + 1) * 64 + p], ai = api[(t + 1) * 64 + p];
                r[j] = cr * ar - ci * ai; r[j + 1] = -(cr * ai + ci * ar); } }
        u32x4 w; w.x = pk_bf16(r[0], r[1]); w.y = pk_bf16(r[2], r[3]); w.z = pk_bf16(r[4], r[5]); w.w = pk_bf16(r[6], r[7]);
        *(u32x4*)(bt2 + (size_t)n * 640 + k8) = w; }
    bf16_t* bt1 = (bf16_t*)(P.ws + WS_BT1) + (size_t)g * 256 * 512;
    for (int pc = tid; pc < 256 * 64; pc += 512) { const int q = pc >> 6, k8 = (pc & 63) * 8; float r[8];
        if (q < 128) { const int p = q >> 1, s = k8 >> 4, c0 = k8 & 15; const float ar = apr[(31 - s) * 64 + p], ai = api[(31 - s) * 64 + p];
#pragma unroll
            for (int j = 0; j < 8; ++j) { const float br = bbr[p * 16 + c0 + j], bi = bbi[p * 16 + c0 + j]; r[j] = (q & 1) ? (ar * bi + ai * br) : (ar * br - ai * bi); }
        } else {
#pragma unroll
            for (int j = 0; j < 8; ++j) r[j] = 0.f; }
        u32x4 w; w.x = pk_bf16(r[0], r[1]); w.y = pk_bf16(r[2], r[3]); w.z = pk_bf16(r[4], r[5]); w.w = pk_bf16(r[6], r[7]);
        *(u32x4*)(bt1 + (size_t)q * 512 + k8) = w; }
    float* a32 = (float*)(P.ws + WS_A32);
    if (tid < 64) { a32[(g * 64 + tid) * 2] = apr[32 * 64 + tid]; a32[(g * 64 + tid) * 2 + 1] = api[32 * 64 + tid]; }
    __syncthreads();
}

__device__ void p0_prep(const Params& P, unsigned char* lds) {
    const int tid = threadIdx.x, G = gridDim.x;
    if (blockIdx.x == 0 && tid < 8) ((int*)(P.ws + WS_CNT))[tid] = 0;
    constexpr int J_SSM = 64, J_X = 512, J_ROPE = 512, J_T = 9408;
    constexpr int NJ = J_SSM + J_X + J_ROPE + J_T;
    for (int job = blockIdx.x; job < NJ; job += G) {
        if (job < J_SSM) {
#if LEVEL >= 1
            ssm_tables(P, job, lds);
#endif
        }
        else if (job < J_SSM + J_X) {
            const int r0 = (job - J_SSM) * 64; bf16_t* xa = (bf16_t*)(P.ws + WS_XA);
#pragma unroll 4
            for (int i = 0; i < 16; ++i) { const int piece = tid + 512 * i, r = r0 + (piece >> 7), c8 = (piece & 127) * 8;
                const f32x4 a = *(const f32x4*)(P.x + (size_t)r * 1024 + c8), b = *(const f32x4*)(P.x + (size_t)r * 1024 + c8 + 4);
                u32x4 w; w.x = pk_bf16(a[0], a[1]); w.y = pk_bf16(a[2], a[3]); w.z = pk_bf16(b[0], b[1]); w.w = pk_bf16(b[2], b[3]);
                *(u32x4*)(xa + ((size_t)(r >> 5) * 40 + (r & 31)) * 1024 + c8) = w;
#if LEVEL < 1
                *(f32x4*)(P.out + (size_t)r * 1024 + c8) = a; *(f32x4*)(P.out + (size_t)r * 1024 + c8 + 4) = b;
#endif
            }
        }
        else if (job < J_SSM + J_X + J_ROPE) {
            const int tok = (job - J_SSM - J_X) * 64 + (tid >> 3), i = tid & 7;
            const float invf[8] = {1.0f, 0.19392274474868576f, 0.03760603093086393f, 0.007292664737217109f, 0.001414213562373095f, 0.0002742481756762073f, 5.318295896944988e-05f, 1.031338537721246e-05f};
            float f = invf[0];
#pragma unroll
            for (int k = 1; k < 8; ++k) f = (i == k) ? invf[k] : f;
            const float ang = (float)P.pos[tok] * f; float sn, cs; sincosf(ang, &sn, &cs);
            ((float*)(P.ws + WS_ROPEC))[tok * 8 + i] = cs; ((float*)(P.ws + WS_ROPES))[tok * 8 + i] = sn;
        }
        else {
            int jt = job - J_SSM - J_X - J_ROPE; float* tile = (float*)lds;
            if (jt < 512) { const int kt = jt & 15, n0 = (jt >> 4) * 64, pn = n0 >> 8, s = (n0 >> 7) & 1, xo = n0 & 127;
                transpose_tile(P.w_glu, 2048, kt * 64, s * 1024 + 128 * pn + xo, (bf16_t*)(P.ws + WS_WGLU), 1024, n0, tile); }
            else if ((jt -= 512) < 1408) { const int kt = jt & 15, n0 = (jt >> 4) * 64, pn = n0 >> 8, s = (n0 >> 7) & 1, xo = n0 & 127;
                transpose_tile(s ? P.ffn_u : P.ffn_g, 2816, kt * 64, 128 * pn + xo, (bf16_t*)(P.ws + WS_WUP), 1024, n0, tile); }
            else if ((jt -= 1408) < 704) { const int kt = jt % 44, n0 = (jt / 44) * 64;
                transpose_tile(P.ffn_d, 1024, kt * 64, n0, (bf16_t*)(P.ws + WS_WDN), 2816, n0, tile); }
            else if ((jt -= 704) < 256) { const int kt = jt & 15, n0 = (jt >> 4) * 64;
                transpose_tile(P.w_q, 1024, kt * 64, n0, (bf16_t*)(P.ws + WS_WQKV), 1024, n0, tile); }
            else if ((jt -= 256) < 128) { const int kt = jt & 15, n0 = (jt >> 4) * 64;
                transpose_tile(P.kv_w, 512, kt * 64, n0, (bf16_t*)(P.ws + WS_WQKV), 1024, 1024 + n0, tile); }
            else if ((jt -= 128) < 256) { const int kt = jt & 15, n0 = (jt >> 4) * 64;
                transpose_tile(P.w_out, 1024, kt * 64, n0, (bf16_t*)(P.ws + WS_WO), 1024, n0, tile); }
            else if ((jt -= 256) < 4096) { const int e = jt >> 9, r = jt & 511, kt = r & 15, n0 = (r >> 4) * 64, pn = n0 >> 8, s = (n0 >> 7) & 1, xo = n0 & 127;
                transpose_tile((s ? P.moe_u : P.moe_g) + (size_t)e * 1048576, 1024, kt * 64, 128 * pn + xo, (bf16_t*)(P.ws + WS_WMUP) + (size_t)e * 2048 * 1024, 1024, n0, tile); }
            else { jt -= 4096; const int e = jt >> 8, r = jt & 255, kt = r & 15, n0 = (r >> 4) * 64;
                transpose_tile(P.moe_d + (size_t)e * 1048576, 1024, kt * 64, n0, (bf16_t*)(P.ws + WS_WMDN) + (size_t)e * 1048576, 1024, n0, tile); }
        }
    }
}

__device__ void p2_scan(const Params& P) {
    const float* sst = (const float*)(P.ws + WS_SST); const float* a32 = (const float*)(P.ws + WS_A32); bf16_t* xa = (bf16_t*)(P.ws + WS_XA);
    for (int idx = blockIdx.x * 512 + threadIdx.x; idx < 16 * 64 * 64; idx += gridDim.x * 512) {
        const int p = idx & 63, g = (idx >> 6) & 63, b = idx >> 12;
        const float ar = a32[(g * 64 + p) * 2], ai = a32[(g * 64 + p) * 2 + 1];
        float hr = 0.f, hi = 0.f;
        const int q = 2 * p;
#pragma unroll 8
        for (int j = 0; j < 64; ++j) { const int row = b * 64 + j;
            *(unsigned*)(xa + ((size_t)row * 40 + 32 + (q >> 4)) * 1024 + g * 16 + (q & 15)) = pk_bf16(hr, hi);
            const float2 s = *(const float2*)(sst + ((size_t)row * 64 + g) * 128 + q);
            const float nr = ar * hr - ai * hi + s.x, ni = ar * hi + ai * hr + s.y; hr = nr; hi = ni; }
    }
}

template <int MODE>
__device__ void ln_phase(const Params& P, float* h, const float* gam, const float* bet, unsigned char* lds) {
    const int tid = threadIdx.x, wid = tid >> 6, lane = tid & 63;
    bf16_t* h16 = (bf16_t*)(P.ws + WS_H16);
    float* wrt = (float*)lds;
    int* cnt = (int*)(P.ws + WS_CNT); int* lists = (int*)(P.ws + WS_LIST); int* toki = (int*)(P.ws + WS_TOK);
    const bf16_t* Y = (const bf16_t*)(P.ws + WS_Y);
    int base[8];
    if (MODE == 1) { for (int k = 0; k < 16; ++k) { const int idx = tid + 512 * k; wrt[(idx & 7) * 1024 + (idx >> 3)] = P.w_router[idx]; } __syncthreads(); }
    if (MODE == 2) { int acc = 0;
#pragma unroll
        for (int e = 0; e < 8; ++e) { base[e] = acc; acc += ((cnt[e] + 255) >> 8) << 8; } }
    f32x4 gv[4], bv[4];
#pragma unroll
    for (int i = 0; i < 4; ++i) { gv[i] = *(const f32x4*)(gam + 256 * i + lane * 4); bv[i] = *(const f32x4*)(bet + 256 * i + lane * 4); }
    for (int row = blockIdx.x * 8 + wid; row < T_; row += gridDim.x * 8) {
        f32x4 v[4];
#pragma unroll
        for (int i = 0; i < 4; ++i) v[i] = *(const f32x4*)(h + (size_t)row * 1024 + 256 * i + lane * 4);
        if (MODE == 2) {
            const int e1 = toki[row * 8 + 0], p1 = toki[row * 8 + 1], e2 = toki[row * 8 + 2], p2 = toki[row * 8 + 3];
            const float w1 = __int_as_float(toki[row * 8 + 4]), w2 = __int_as_float(toki[row * 8 + 5]);
            int b1 = 0, b2 = 0;
#pragma unroll
            for (int e = 0; e < 8; ++e) { b1 = (e1 == e) ? base[e] : b1; b2 = (e2 == e) ? base[e] : b2; }
            const bf16_t* y1 = Y + (size_t)(b1 + p1) * 1024; const bf16_t* y2 = Y + (size_t)(b2 + p2) * 1024;
#pragma unroll
            for (int i = 0; i < 4; ++i) { const u32x2 a = *(const u32x2*)(y1 + 256 * i + lane * 4), b = *(const u32x2*)(y2 + 256 * i + lane * 4);
                v[i][0] = ALPHA * v[i][0] + (w1 * bf_lo(a.x) + w2 * bf_lo(b.x)); v[i][1] = ALPHA * v[i][1] + (w1 * bf_hi(a.x) + w2 * bf_hi(b.x));
                v[i][2] = ALPHA * v[i][2] + (w1 * bf_lo(a.y) + w2 * bf_lo(b.y)); v[i][3] = ALPHA * v[i][3] + (w1 * bf_hi(a.y) + w2 * bf_hi(b.y)); }
        }
        float s = 0.f;
#pragma unroll
        for (int i = 0; i < 4; ++i) s += (v[i][0] + v[i][1]) + (v[i][2] + v[i][3]);
        const float mu = wave_sum(s) * (1.0f / 1024.0f);
        float q = 0.f;
#pragma unroll
        for (int i = 0; i < 4; ++i) { v[i] = v[i] - mu; q += (v[i][0] * v[i][0] + v[i][1] * v[i][1]) + (v[i][2] * v[i][2] + v[i][3] * v[i][3]); }
        const float rstd = rsqrtf(wave_sum(q) * (1.0f / 1024.0f) + LN_EPS);
#pragma unroll
        for (int i = 0; i < 4; ++i) { v[i] = v[i] * rstd * gv[i] + bv[i]; *(f32x4*)(h + (size_t)row * 1024 + 256 * i + lane * 4) = v[i];
            if (MODE != 2) { u32x2 w; w.x = pk_bf16(v[i][0], v[i][1]); w.y = pk_bf16(v[i][2], v[i][3]); *(u32x2*)(h16 + (size_t)row * 1024 + 256 * i + lane * 4) = w; } }
        if (MODE == 1) {
            float lg[8];
#pragma unroll
            for (int e = 0; e < 8; ++e) { float a = 0.f;
#pragma unroll
                for (int i = 0; i < 4; ++i) { const f32x4 w = *(const f32x4*)(wrt + e * 1024 + 256 * i + lane * 4); a += (v[i][0] * w[0] + v[i][1] * w[1]) + (v[i][2] * w[2] + v[i][3] * w[3]); }
                lg[e] = wave_sum(a) + P.b_router[e]; }
            int e1 = 0; float v1 = lg[0];
#pragma unroll
            for (int e = 1; e < 8; ++e) if (lg[e] > v1) { v1 = lg[e]; e1 = e; }
            int e2 = -1; float v2 = -3.0e38f;
#pragma unroll
            for (int e = 0; e < 8; ++e) if (e != e1 && lg[e] > v2) { v2 = lg[e]; e2 = e; }
            const float ex = __expf(v2 - v1), w1 = 1.0f / (1.0f + ex), w2 = ex / (1.0f + ex);
            if (lane == 0) { const int p1 = atomicAdd(cnt + e1, 1), p2 = atomicAdd(cnt + e2, 1);
                lists[e1 * T_ + p1] = row; lists[e2 * T_ + p2] = row;
                toki[row * 8 + 0] = e1; toki[row * 8 + 1] = p1; toki[row * 8 + 2] = e2; toki[row * 8 + 3] = p2; toki[row * 8 + 4] = __float_as_int(w1); toki[row * 8 + 5] = __float_as_int(w2); }
        }
    }
}

__device__ void gather_phase(const Params& P) {
    const int tid = threadIdx.x, wid = tid >> 6, lane = tid & 63;
    const int* cnt = (const int*)(P.ws + WS_CNT); const int* lists = (const int*)(P.ws + WS_LIST);
    const bf16_t* h16 = (const bf16_t*)(P.ws + WS_H16); bf16_t* ga = (bf16_t*)(P.ws + WS_GA);
    int base[9], c[8]; base[0] = 0;
#pragma unroll
    for (int e = 0; e < 8; ++e) { c[e] = cnt[e]; base[e + 1] = base[e] + (((c[e] + 255) >> 8) << 8); }
    for (int r = blockIdx.x * 8 + wid; r < base[8]; r += gridDim.x * 8) {
        int e = 0;
#pragma unroll
        for (int k = 1; k < 8; ++k) e += (r >= base[k]) ? 1 : 0;
        int be = 0, ce = 0;
#pragma unroll
        for (int k = 0; k < 8; ++k) { be = (e == k) ? base[k] : be; ce = (e == k) ? c[k] : ce; }
        const int pos = r - be; u32x4 a = {0u, 0u, 0u, 0u}, b = a;
        if (pos < ce) { const int tok = lists[e * T_ + pos]; a = *(const u32x4*)(h16 + (size_t)tok * 1024 + lane * 8); b = *(const u32x4*)(h16 + (size_t)tok * 1024 + 512 + lane * 8); }
        *(u32x4*)(ga + (size_t)r * 1024 + lane * 8) = a; *(u32x4*)(ga + (size_t)r * 1024 + 512 + lane * 8) = b;
    }
}

__device__ void attn_phase(const Params& P, unsigned char* lds) {
    const int tid = threadIdx.x, wid = tid >> 6, lane = tid & 63, n = lane & 31, hh = lane >> 5;
    bf16_t* Ks = (bf16_t*)lds;
    bf16_t* Vt = (bf16_t*)(lds + 256 * 144);
    const bf16_t* QB = (const bf16_t*)(P.ws + WS_BIG); const bf16_t* KB = (const bf16_t*)(P.ws + WS_BIG + 64 * MiB); const bf16_t* VB = (const bf16_t*)(P.ws + WS_BIG + 80 * MiB);
    bf16_t* OB = (bf16_t*)(P.ws + WS_BIG + 96 * MiB);
    for (int item = blockIdx.x; item < 1024; item += gridDim.x) {
        const int kvh = item & 3, nb = (item >> 2) & 15, b = item >> 6;
        const int tok0 = b * 2048 + nb * 128;
        __syncthreads();
#pragma unroll
        for (int i = 0; i < 4; ++i) { const int piece = tid + 512 * i, s = piece >> 3, pc = piece & 7; u32x4 v = {0u, 0u, 0u, 0u};
            if (nb > 0 || s >= 128) v = *(const u32x4*)(KB + (size_t)(tok0 - 128 + s) * 256 + kvh * 64 + pc * 8);
            *(u32x4*)(Ks + s * 72 + pc * 8) = v; }
#pragma unroll
        for (int i = 0; i < 2; ++i) { const int s = 2 * (tid & 127), pc = (tid >> 7) + 4 * i; u32x4 v0 = {0u, 0u, 0u, 0u}, v1 = v0;
            if (nb > 0 || s >= 128) { v0 = *(const u32x4*)(VB + (size_t)(tok0 - 128 + s) * 256 + kvh * 64 + pc * 8); v1 = *(const u32x4*)(VB + (size_t)(tok0 - 127 + s) * 256 + kvh * 64 + pc * 8); }
            unsigned* vt = (unsigned*)(Vt + (pc * 8) * 264 + s);
            vt[0 * 132] = (v0.x & 0xffffu) | (v1.x << 16); vt[1 * 132] = (v0.x >> 16) | (v1.x & 0xffff0000u);
            vt[2 * 132] = (v0.y & 0xffffu) | (v1.y << 16); vt[3 * 132] = (v0.y >> 16) | (v1.y & 0xffff0000u);
            vt[4 * 132] = (v0.z & 0xffffu) | (v1.z << 16); vt[5 * 132] = (v0.z >> 16) | (v1.z & 0xffff0000u);
            vt[6 * 132] = (v0.w & 0xffffu) | (v1.w << 16); vt[7 * 132] = (v0.w >> 16) | (v1.w & 0xffff0000u); }
        __syncthreads();
        const int hq = kvh * 4 + (wid >> 1);
        const float sink = P.sinks[hq];
        for (int qq = 0; qq < 2; ++qq) {
            const int kb0 = (wid & 1) * 2 + qq, i0 = 32 * kb0, qi = i0 + n;
            const bf16_t* qp = QB + (size_t)(tok0 + qi) * 1024 + hq * 64 + 8 * hh;
            bf16x8 qf[4];
#pragma unroll
            for (int ks = 0; ks < 4; ++ks) qf[ks] = *(const bf16x8*)(qp + 16 * ks);
            f32x16 sacc[5];
#pragma unroll
            for (int kb = 0; kb < 5; ++kb) {
#pragma unroll
                for (int i = 0; i < 16; ++i) sacc[kb][i] = 0.f;
                const bf16_t* kp = Ks + (32 * (kb0 + kb) + n) * 72 + 8 * hh;
#pragma unroll
                for (int ks = 0; ks < 4; ++ks) { const bf16x8 a = *(const bf16x8*)(kp + 16 * ks); sacc[kb] = __builtin_amdgcn_mfma_f32_32x32x16_bf16(a, qf[ks], sacc[kb], 0, 0, 0); } }
            float mx = sink;
#pragma unroll
            for (int kb = 0; kb < 5; ++kb)
#pragma unroll
                for (int i = 0; i < 16; ++i) { const int s = 32 * (kb0 + kb) + 8 * (i >> 2) + 4 * hh + (i & 3);
                    const bool valid = (s >= qi + 1) && (s <= qi + 128) && (nb > 0 || s >= 128);
                    const float v = valid ? sacc[kb][i] : -1.0e30f; sacc[kb][i] = v; mx = fmaxf(mx, v); }
            mx = fmaxf(mx, __shfl_xor(mx, 32));
            float sum = 0.f;
#pragma unroll
            for (int kb = 0; kb < 5; ++kb)
#pragma unroll
                for (int i = 0; i < 16; ++i) { const float p = __expf(sacc[kb][i] - mx); sacc[kb][i] = p; sum += p; }
            sum += __shfl_xor(sum, 32); sum += __expf(sink - mx);
            f32x16 oacc[2];
#pragma unroll
            for (int i = 0; i < 16; ++i) { oacc[0][i] = 0.f; oacc[1][i] = 0.f; }
#pragma unroll
            for (int kb = 0; kb < 5; ++kb)
#pragma unroll
                for (int sl = 0; sl < 2; ++sl) {
                    union { u32x4 u; bf16x8 v; } pb;
                    pb.u.x = pk_bf16(sacc[kb][8 * sl + 0], sacc[kb][8 * sl + 1]); pb.u.y = pk_bf16(sacc[kb][8 * sl + 2], sacc[kb][8 * sl + 3]);
                    pb.u.z = pk_bf16(sacc[kb][8 * sl + 4], sacc[kb][8 * sl + 5]); pb.u.w = pk_bf16(sacc[kb][8 * sl + 6], sacc[kb][8 * sl + 7]);
#pragma unroll
                    for (int mb = 0; mb < 2; ++mb) { const bf16_t* vp = Vt + (32 * mb + n) * 264 + 32 * (kb0 + kb) + 16 * sl + 4 * hh;
                        union { u32x4 u; bf16x8 v; } va; const u32x2 lo = *(const u32x2*)vp, hi = *(const u32x2*)(vp + 8); va.u.x = lo.x; va.u.y = lo.y; va.u.z = hi.x; va.u.w = hi.y;
                        oacc[mb] = __builtin_amdgcn_mfma_f32_32x32x16_bf16(va.v, pb.v, oacc[mb], 0, 0, 0); } }
            const float inv = 1.0f / sum;
            bf16_t* op = OB + (size_t)(tok0 + qi) * 1024 + hq * 64 + 4 * hh;
#pragma unroll
            for (int mb = 0; mb < 2; ++mb)
#pragma unroll
                for (int g4 = 0; g4 < 4; ++g4) { u32x2 w; w.x = pk_bf16(oacc[mb][4 * g4 + 0] * inv, oacc[mb][4 * g4 + 1] * inv); w.y = pk_bf16(oacc[mb][4 * g4 + 2] * inv, oacc[mb][4 * g4 + 3] * inv);
                    *(u32x2*)(op + 32 * mb + 8 * g4) = w; }
        }
    }
}

__global__ void __launch_bounds__(512, 2) yoco_fwd(Params P) {
    extern __shared__ __attribute__((aligned(16))) unsigned char lds[];
    cg::grid_group grid = cg::this_grid();
    LAS unsigned char* ldsl = (LAS unsigned char*)lds;
    const int G = gridDim.x, c = blockIdx.x;
    unsigned char* ws = P.ws;
    float* H = P.out;

    p0_prep(P, lds);
    grid.sync();
#if LEVEL >= 1
    {
        pg8::SchedSsm S; S.init(256, 512, G, c); pg8::EpiS1 E{(float*)(ws + WS_SST)};
        pg8::gemm_phase(ldsl, (const char*)(ws + WS_XA), (const char*)(ws + WS_BT1), 512, S, E); }
    grid.sync();
    p2_scan(P);
    grid.sync();
    {
        pg8::SchedSsm S; S.init(512, 640, G, c); pg8::EpiS2 E{P.x, P.ssm_d, (bf16_t*)(ws + WS_BIG)};
        pg8::gemm_phase(ldsl, (const char*)(ws + WS_XA), (const char*)(ws + WS_BT2), 640, S, E); }
    grid.sync();
    {
        pg8::SchedDense S; S.init(T_, 2048, 1024, 1024, G, c); pg8::EpiGlu E{P.x, H};
        pg8::gemm_phase(ldsl, (const char*)(ws + WS_BIG), (const char*)(ws + WS_WGLU), 1024, S, E); }
    grid.sync();
#endif
    ln_phase<0>(P, H, P.ln_g, P.ln_b, lds);
    grid.sync();
#if LEVEL >= 2
    {
        pg8::SchedDense S; S.init(T_, 2 * FF_, 1024, 1024, G, c); pg8::EpiUp E{(bf16_t*)(ws + WS_BIG), FF_};
        pg8::gemm_phase(ldsl, (const char*)(ws + WS_H16), (const char*)(ws + WS_WUP), 1024, S, E); }
    grid.sync();
    {
        pg8::SchedDense S; S.init(T_, 1024, FF_, FF_, G, c); pg8::EpiRes E{H};
        pg8::gemm_phase(ldsl, (const char*)(ws + WS_BIG), (const char*)(ws + WS_WDN), FF_, S, E); }
    grid.sync();
#endif
    ln_phase<0>(P, H, P.ln_g + 1024, P.ln_b + 1024, lds);
    grid.sync();
#if LEVEL >= 3
    {
        pg8::SchedDense S; S.init(T_, 1536, 1024, 1024, G, c);
        pg8::EpiQkv E{(bf16_t*)(ws + WS_BIG), (bf16_t*)(ws + WS_BIG + 64 * MiB), (bf16_t*)(ws + WS_BIG + 80 * MiB), (const float*)(ws + WS_ROPEC), (const float*)(ws + WS_ROPES)};
        pg8::gemm_phase(ldsl, (const char*)(ws + WS_H16), (const char*)(ws + WS_WQKV), 1024, S, E); }
    grid.sync();
    attn_phase(P, lds);
    grid.sync();
    {
        pg8::SchedDense S; S.init(T_, 1024, 1024, 1024, G, c); pg8::EpiRes E{H};
        pg8::gemm_phase(ldsl, (const char*)(ws + WS_BIG + 96 * MiB), (const char*)(ws + WS_WO), 1024, S, E); }
    grid.sync();
#endif
#if LEVEL >= 4
    ln_phase<1>(P, H, P.ln_g + 2048, P.ln_b + 2048, lds);
    grid.sync();
    gather_phase(P);
    grid.sync();
    {
        pg8::SchedMoe S; S.init((const int*)(ws + WS_CNT), 2048, 1024, (size_t)2048 * 1024 * 2, G, c); pg8::EpiUp E{(bf16_t*)(ws + WS_BIG), 1024};
        pg8::gemm_phase(ldsl, (const char*)(ws + WS_GA), (const char*)(ws + WS_WMUP), 1024, S, E); }
    grid.sync();
    {
        pg8::SchedMoe S; S.init((const int*)(ws + WS_CNT), 1024, 1024, (size_t)1024 * 1024 * 2, G, c); pg8::EpiBf16 E{(bf16_t*)(ws + WS_Y), 1024};
        pg8::gemm_phase(ldsl, (const char*)(ws + WS_BIG), (const char*)(ws + WS_WMDN), 1024, S, E); }
    grid.sync();
    ln_phase<2>(P, H, P.ln_g + 3072, P.ln_b + 3072, lds);
#else
    ln_phase<0>(P, H, P.ln_g + 2048, P.ln_b + 2048, lds);
    grid.sync();
    ln_phase<0>(P, H, P.ln_g + 3072, P.ln_b + 3072, lds);
#endif
}

extern "C" void kernel_launch(void* const* d_in, const int* in_sizes, int n_in, void* d_out, int out_size, void* d_ws, size_t ws_size, hipStream_t stream) {
    static int grid_blocks = 0;
    if (grid_blocks == 0) {
        if (n_in != 25 || out_size != T_ * D_ || ws_size < WS_END) { fprintf(stderr, "kernel_launch: unexpected shapes (n_in %d out %d ws %zu)\n", n_in, out_size, ws_size); grid_blocks = -1; return; }
        int dev = 0, cus = 0, per_cu = 0;
        hipGetDevice(&dev); hipDeviceGetAttribute(&cus, hipDeviceAttributeMultiprocessorCount, dev);
        if (hipFuncSetAttribute((const void*)yoco_fwd, hipFuncAttributeMaxDynamicSharedMemorySize, LDS_BYTES) != hipSuccess) { fprintf(stderr, "kernel_launch: hipFuncSetAttribute failed\n"); grid_blocks = -1; return; }
        if (hipOccupancyMaxActiveBlocksPerMultiprocessor(&per_cu, (const void*)yoco_fwd, 512, LDS_BYTES) != hipSuccess || per_cu < 1) { fprintf(stderr, "kernel_launch: occupancy query says %d\n", per_cu); per_cu = 1; (void)hipGetLastError(); }
        grid_blocks = cus * 1;
    }
    if (grid_blocks < 0) return;
    Params p{};
    p.x = (const float*)d_in[0]; p.pos = (const int*)d_in[1]; p.ln_g = (const float*)d_in[2]; p.ln_b = (const float*)d_in[3];
    p.lam_re = (const float*)d_in[4]; p.lam_im = (const float*)d_in[5]; p.log_step = (const float*)d_in[6]; p.b_re = (const float*)d_in[7]; p.b_im = (const float*)d_in[8];
    p.c_re = (const float*)d_in[9]; p.c_im = (const float*)d_in[10]; p.ssm_d = (const float*)d_in[11]; p.w_glu = (const float*)d_in[12]; p.kv_w = (const float*)d_in[13];
    p.w_q = (const float*)d_in[14]; p.sinks = (const float*)d_in[15]; p.w_out = (const float*)d_in[16]; p.ffn_g = (const float*)d_in[17]; p.ffn_u = (const float*)d_in[18]; p.ffn_d = (const float*)d_in[19];
    p.w_router = (const float*)d_in[20]; p.b_router = (const float*)d_in[21]; p.moe_g = (const float*)d_in[22]; p.moe_u = (const float*)d_in[23]; p.moe_d = (const float*)d_in[24];
    p.out = (float*)d_out; p.ws = (unsigned char*)d_ws;
    void* args[] = {&p};
    hipError_t e = hipLaunchCooperativeKernel((const void*)yoco_fwd, dim3(grid_blocks), dim3(512), args, LDS_BYTES, stream);
    if (e != hipSuccess) fprintf(stderr, "cooperative launch failed: %s (grid %d)\n", hipGetErrorString(e), grid_blocks);
}
```

```cpp
#include <hip/hip_runtime.h>
#include <hip/hip_cooperative_groups.h>
#include <cstdio>
namespace cg = cooperative_groups;

#ifndef LEVEL
#define LEVEL 4
#endif

#define LAS __attribute__((address_space(3)))
typedef unsigned short bf16_t;
typedef short bf16x8 __attribute__((ext_vector_type(8)));
typedef float f32x4 __attribute__((ext_vector_type(4)));
typedef float f32x16 __attribute__((ext_vector_type(16)));
typedef unsigned u32x4 __attribute__((ext_vector_type(4)));
typedef unsigned u32x2 __attribute__((ext_vector_type(2)));

constexpr int T_ = 32768, D_ = 1024, FF_ = 2816;
constexpr float ALPHA = 1.41421356237309515f;
constexpr float LN_EPS = 1e-5f;
constexpr size_t MiB = 1ull << 20;
constexpr size_t WS_CNT = 0, WS_BAR = 4096, WS_A32 = 65536, WS_ROPEC = 1 * MiB, WS_ROPES = 2 * MiB, WS_LIST = 3 * MiB, WS_TOK = 4 * MiB;
constexpr size_t WS_WMUP = 8 * MiB, WS_WMDN = 40 * MiB, WS_WGLU = 56 * MiB, WS_WUP = 60 * MiB, WS_WDN = 71 * MiB, WS_WQKV = 77 * MiB, WS_WO = 80 * MiB;
constexpr size_t WS_H16 = 82 * MiB, WS_BT2 = 146 * MiB, WS_BT1 = 186 * MiB, WS_XA = 202 * MiB, WS_SST = 282 * MiB, WS_GA = 146 * MiB, WS_Y = 146 * MiB;
constexpr size_t WS_BIG = 314 * MiB, WS_END = 490 * MiB;
constexpr int LDS_BYTES = 131072 + 16;

struct Params {
    const float* x; const int* pos; const float* ln_g; const float* ln_b;
    const float* lam_re; const float* lam_im; const float* log_step; const float* b_re; const float* b_im; const float* c_re; const float* c_im;
    const float* ssm_d; const float* w_glu; const float* kv_w; const float* w_q; const float* sinks; const float* w_out;
    const float* ffn_g; const float* ffn_u; const float* ffn_d; const float* w_router; const float* b_router;
    const float* moe_g; const float* moe_u; const float* moe_d;
    float* out; unsigned char* ws;
};

__device__ __forceinline__ unsigned pk_bf16(float lo, float hi) { unsigned r; asm volatile("v_cvt_pk_bf16_f32 %0, %1, %2" : "=v"(r) : "v"(lo), "v"(hi)); return r; }
__device__ __forceinline__ float bf_lo(unsigned w) { return __uint_as_float(w << 16); }
__device__ __forceinline__ float bf_hi(unsigned w) { return __uint_as_float(w & 0xffff0000u); }
__device__ __forceinline__ float sigmoidf_(float x) { return __builtin_amdgcn_rcpf(1.0f + __expf(-x)); }
__device__ __forceinline__ float gelu_tanh(float y) { const float u = 1.5957691216057308f * (y + 0.044715f * y * y * y); return y * sigmoidf_(u); }
__device__ __forceinline__ float wave_sum(float v) {
    v += __shfl_xor(v, 32); v += __shfl_xor(v, 16); v += __shfl_xor(v, 8); v += __shfl_xor(v, 4); v += __shfl_xor(v, 2); v += __shfl_xor(v, 1); return v; }


#define XB_TMO      128
#define XB_XCNT(j)  (256  + 64 * (j))
#define XB_XSUB(j)  (1280 + 64 * (j))
#define XB_XGEN(j)  (2304 + 64 * (j))
#define XB_TOP      3328
#define XB_TOPGEN   3392
#define XCD_BAR_WORDS 3456
#define XB_SPIN_CAP (1u << 22)
__device__ __forceinline__ unsigned xb_ld(unsigned* p)              { return __hip_atomic_load(p, __ATOMIC_RELAXED, __HIP_MEMORY_SCOPE_AGENT); }
__device__ __forceinline__ unsigned xb_add(unsigned* p, unsigned v) { return __hip_atomic_fetch_add(p, v, __ATOMIC_RELAXED, __HIP_MEMORY_SCOPE_AGENT); }
__device__ __forceinline__ unsigned xb_xcc_id() { return (unsigned)__builtin_amdgcn_s_getreg((3 << 11) | 20) & 0xFu; }
#define XB_SPIN(cond, bar) do { unsigned _sp = 0; while (cond) { __builtin_amdgcn_s_sleep(1); \
    if ((++_sp & 255u) == 0u) { if (xb_ld(&(bar)[XB_TMO])) break; if (_sp > XB_SPIN_CAP) { atomicAdd(&(bar)[XB_TMO], 1u); break; } } } } while (0)
__device__ __forceinline__ void xcd_barrier_complete(unsigned* bar, unsigned x, unsigned& nloc, unsigned& nx) {
    const unsigned G = gridDim.x * gridDim.y * gridDim.z;
    unsigned sum, cnt, mine, sp = 0u;
    for (;;) {
        sum = 0u; cnt = 0u; mine = 0u;
#pragma unroll
        for (unsigned j = 0; j < 16; ++j) { const unsigned c = xb_ld(&bar[XB_XCNT(j)]); sum += c; cnt += (c > 0u) ? 1u : 0u; mine = (j == x) ? c : mine; }
        if (sum == G) break;
        __builtin_amdgcn_s_sleep(1);
        if ((++sp & 255u) == 0u) { if (xb_ld(&bar[XB_TMO])) break; if (sp > XB_SPIN_CAP) { atomicAdd(&bar[XB_TMO], 1u); break; } }
    }
    nloc = mine > 0u ? mine : 1u; nx = cnt > 0u ? cnt : 1u;
}
__device__ __forceinline__ void xcd_barrier(unsigned* bar, volatile LAS unsigned* st) {
    asm volatile("s_waitcnt vmcnt(0)" ::: "memory");
    __syncthreads();
    if (threadIdx.x == 0) {
        const unsigned x = xb_xcc_id();
        __builtin_amdgcn_s_waitcnt(0);
        unsigned nloc = st[0], nx = st[1];
        if (nloc == 0u) { xcd_barrier_complete(bar, x, nloc, nx); st[0] = nloc; st[1] = nx; }
        const unsigned old = xb_add(&bar[XB_XSUB(x)], 1u);
        const unsigned gen = old / nloc;
        if (old + 1u == (gen + 1u) * nloc) {
            __builtin_amdgcn_fence(__ATOMIC_RELEASE, "agent");
            asm volatile("s_waitcnt vmcnt(0)" ::: "memory");
            const unsigned og = xb_add(&bar[XB_TOP], 1u);
            const unsigned tg = og / nx;
            if (og + 1u == (tg + 1u) * nx) xb_add(&bar[XB_TOPGEN], 1u);
            else XB_SPIN(xb_ld(&bar[XB_TOPGEN]) == tg, bar);
            __builtin_amdgcn_fence(__ATOMIC_ACQUIRE, "agent");
            xb_add(&bar[XB_XGEN(x)], 1u);
            asm volatile("s_waitcnt vmcnt(0)" ::: "memory");
        } else {
            XB_SPIN(xb_ld(&bar[XB_XGEN(x)]) == gen, bar);
            __builtin_amdgcn_fence(__ATOMIC_ACQUIRE, "agent");
            asm volatile("s_waitcnt vmcnt(0)" ::: "memory");
        }
    }
    __syncthreads();
}

namespace pg8 {
constexpr int BM = 256, BK = 64, HALF = 128, HTB = HALF * BK * 2, NXCD = 8, WGM = 8;
__device__ __forceinline__ int lds_byte(int r, int c) { const int st = (r >> 4) * 2 + (c >> 5), rr = r & 15, cc = c & 31, ob = rr * 64 + cc * 2; return st * 1024 + (ob ^ (((ob >> 9) & 1) << 5)); }
__device__ __forceinline__ void stage_rc(int b, int& R, int& C) { const int st = b / 1024, sb = b % 1024, swz = sb ^ (((sb >> 9) & 1) << 5); R = (st >> 1) * 16 + swz / 64; C = (st & 1) * 32 + (swz % 64) / 2; }
__device__ __forceinline__ int perm32(int rho) { const int n = rho >> 4, i = rho & 15; return 8 * (i >> 2) + 4 * n + (i & 3); }
__device__ __forceinline__ int xcd_remap(int L, int nwg) { const int q = nwg / NXCD, r = nwg % NXCD, xcd = L % NXCD, off = L / NXCD; return (xcd < r ? xcd * (q + 1) : r * (q + 1) + (xcd - r) * q) + off; }

struct Unit { int pm, pn, aux, pad; size_t a_off, b_off; };

struct SchedDense {
    int nM, nN, nwg, G, c, lda, K;
    __device__ __forceinline__ void init(int M, int N, int K_, int lda_, int G_, int c_) { nM = M / BM; nN = N / BM; nwg = nM * nN; G = G_; c = c_; lda = lda_; K = K_; }
    __device__ __forceinline__ bool next(int i, Unit& u) const {
        const int L = i * G + c; if (L >= nwg) return false;
        const int wgid = xcd_remap(L, nwg);
        const int nig = WGM * nN, gid = wgid / nig, fm = gid * WGM, gsz = (nM - fm) < WGM ? (nM - fm) : WGM;
        u.pm = fm + ((wgid % nig) % gsz); u.pn = (wgid % nig) / gsz; u.aux = 0; u.pad = 0;
        u.a_off = (size_t)u.pm * BM * lda * 2; u.b_off = (size_t)u.pn * BM * K * 2; return true;
    }
    __device__ __forceinline__ unsigned voffA(int R, int C) const { return (unsigned)(R * lda + C) * 2u; }
    __device__ __forceinline__ size_t a_kstep() const { return BK * 2; }
    __device__ __forceinline__ size_t a_hstep() const { return (size_t)HALF * lda * 2; }
};
struct SchedMoe {
    int nM, nN, nwg, G, c, K; int tb[9]; size_t estride;
    __device__ __forceinline__ void init(const int* cnt, int N, int K_, size_t estride_, int G_, int c_) {
        tb[0] = 0;
#pragma unroll
        for (int e = 0; e < 8; ++e) tb[e + 1] = tb[e] + ((cnt[e] + 255) >> 8);
        nM = tb[8]; nN = N / BM; nwg = nM * nN; G = G_; c = c_; K = K_; estride = estride_; }
    __device__ __forceinline__ bool next(int i, Unit& u) const {
        const int L = i * G + c; if (L >= nwg) return false;
        const int wgid = xcd_remap(L, nwg);
        const int nig = WGM * nN, gid = wgid / nig, fm = gid * WGM, gsz = (nM - fm) < WGM ? (nM - fm) : WGM;
        u.pm = fm + ((wgid % nig) % gsz); u.pn = (wgid % nig) / gsz; int e = 0;
#pragma unroll
        for (int k = 1; k < 8; ++k) e += (u.pm >= tb[k]) ? 1 : 0;
        u.aux = e; u.pad = 0;
        u.a_off = (size_t)u.pm * BM * 1024 * 2; u.b_off = (size_t)e * estride + (size_t)u.pn * BM * K * 2; return true;
    }
    __device__ __forceinline__ unsigned voffA(int R, int C) const { return (unsigned)(R * 1024 + C) * 2u; }
    __device__ __forceinline__ size_t a_kstep() const { return BK * 2; }
    __device__ __forceinline__ size_t a_hstep() const { return (size_t)HALF * 1024 * 2; }
};
struct SchedSsm {
    int nN, nwg, G, c, K, N;
    __device__ __forceinline__ void init(int N_, int K_, int G_, int c_) { N = N_; nN = N_ / BM; nwg = 64 * 4 * nN; G = G_; c = c_; K = K_; }
    __device__ __forceinline__ bool next(int i, Unit& u) const {
        const int L = i * G + c; if (L >= nwg) return false;
        const int wgid = xcd_remap(L, nwg);
        const int per = 4 * nN, g = wgid / per, rem = wgid % per;
        u.pm = rem & 3; u.pn = rem >> 2; u.aux = g; u.pad = 0;
        u.a_off = ((size_t)u.pm * BM * 40 * 1024 + (size_t)g * 16) * 2; u.b_off = (size_t)g * N * K * 2 + (size_t)u.pn * BM * K * 2; return true;
    }
    __device__ __forceinline__ unsigned voffA(int R, int C) const { return (unsigned)((R * 40 + (C >> 4)) * 1024 + (C & 15)) * 2u; }
    __device__ __forceinline__ size_t a_kstep() const { return 4 * 1024 * 2; }
    __device__ __forceinline__ size_t a_hstep() const { return (size_t)HALF * 40 * 1024 * 2; }
};

template <class Epi, class Sched>
__device__ __forceinline__ void gemm_phase(LAS unsigned char* lds, const char* Ab, const char* Bb, const int K, const Sched& S, const Epi& E) {
    const int tid = threadIdx.x, wid = __builtin_amdgcn_readfirstlane(tid >> 6), lane = tid & 63, wr = wid >> 2, wc = wid & 3, fr = lane & 15, fq = lane >> 4;
    const int nt = K / BK;
    unsigned voffA[2], voffB[2];
#pragma unroll
    for (int i = 0; i < 2; ++i) { int R, C; stage_rc(tid * 16 + i * 8192, R, C); const int Rb = Epi::PERM ? ((R & ~31) + perm32(R & 31)) : R;
        voffA[i] = S.voffA(R, C); voffB[i] = (unsigned)(Rb * K + C) * 2u; }
    const size_t kstepA = S.a_kstep(), hstepA = S.a_hstep(), kstepB = (size_t)(BK * 2), hstepB = (size_t)HALF * K * 2;
    const unsigned ldsw = (unsigned)wid * 1024u;
    const int aoff = lds_byte(wr * 64 + fr, fq * 8), boff = lds_byte(wc * 32 + fr, fq * 8);
#define PG8_SA(b, h) (((b) * 2 + (h)) * HTB)
#define PG8_SB(b, h) ((4 + (b) * 2 + (h)) * HTB)
#define PG8_STAGE(bufoff, gbase, voff) do { _Pragma("unroll") for (int _i = 0; _i < 2; ++_i) \
        __builtin_amdgcn_global_load_lds((const unsigned*)((const char*)(gbase) + (voff)[_i]), (LAS unsigned*)(lds + (bufoff) + ldsw + _i * 8192), 16, 0, 0); } while (0)
#define PG8_LDA(dst, b, h) do { _Pragma("unroll") for (int m = 0; m < 4; ++m) _Pragma("unroll") for (int k = 0; k < 2; ++k) dst[m][k] = *(const LAS bf16x8*)(lds + PG8_SA(b, h) + aoff + m * 2048 + k * 1024); } while (0)
#define PG8_LDB(dst, b, h) do { _Pragma("unroll") for (int n = 0; n < 2; ++n) _Pragma("unroll") for (int k = 0; k < 2; ++k) dst[n][k] = *(const LAS bf16x8*)(lds + PG8_SB(b, h) + boff + n * 2048 + k * 1024); } while (0)
#define PG8_MMA(ai, bj, At, Bt) do { __builtin_amdgcn_s_setprio(1); _Pragma("unroll") for (int m = 0; m < 4; ++m) _Pragma("unroll") for (int n = 0; n < 2; ++n) _Pragma("unroll") for (int k = 0; k < 2; ++k) \
        acc[ai][bj][m][n] = __builtin_amdgcn_mfma_f32_16x16x32_bf16(Bt[n][k], At[m][k], acc[ai][bj][m][n], 0, 0, 0); __builtin_amdgcn_s_setprio(0); } while (0)
#define PG8_WAIT_V(n) asm volatile("s_waitcnt vmcnt(" #n ")" ::: "memory")
#define PG8_WAIT_L(n) asm volatile("s_waitcnt lgkmcnt(" #n ")" ::: "memory")
#define PG8_BAR __builtin_amdgcn_s_barrier()
#define PG8_SCHED __builtin_amdgcn_sched_barrier(0)
    Unit cur, nxt; int ui = 0;
    if (!S.next(0, cur)) return;
    f32x4 acc[2][2][4][2];
#pragma unroll
    for (int a = 0; a < 2; ++a)
#pragma unroll
        for (int b = 0; b < 2; ++b)
#pragma unroll
            for (int m = 0; m < 4; ++m)
#pragma unroll
                for (int n = 0; n < 2; ++n) acc[a][b][m][n] = (f32x4){0.f, 0.f, 0.f, 0.f};
    bf16x8 At[4][2], B0[2][2], B1[2][2];
    const char* cA = Ab + cur.a_off; const char* cB = Bb + cur.b_off;
    PG8_STAGE(PG8_SB(0, 0), cB, voffB); PG8_STAGE(PG8_SA(0, 0), cA, voffA); PG8_STAGE(PG8_SB(0, 1), cB + hstepB, voffB); PG8_STAGE(PG8_SA(0, 1), cA + hstepA, voffA);
    if (wr == 1) PG8_BAR;
    PG8_WAIT_V(4); PG8_BAR;
    PG8_STAGE(PG8_SB(1, 0), cB + kstepB, voffB); PG8_STAGE(PG8_SA(1, 0), cA + kstepA, voffA); PG8_STAGE(PG8_SB(1, 1), cB + hstepB + kstepB, voffB);
    PG8_WAIT_V(6); PG8_BAR;
    for (;;) {
        const bool has_next = S.next(ui + 1, nxt);
        const char* nA = has_next ? Ab + nxt.a_off : cA; const char* nB = has_next ? Bb + nxt.b_off : cB;
        for (int t = 0; t < nt; t += 2) {
            const bool last = (t == nt - 2);
            const char* a1 = cA + (size_t)(t + 1) * kstepA;
            const char* a2 = last ? nA : cA + (size_t)(t + 2) * kstepA; const char* b2 = last ? nB : cB + (size_t)(t + 2) * kstepB;
            const char* a3 = a2 + kstepA; const char* b3 = b2 + kstepB;
            PG8_LDB(B0, 0, 0); PG8_SCHED; PG8_LDA(At, 0, 0); PG8_STAGE(PG8_SA(1, 1), a1 + hstepA, voffA);
            PG8_WAIT_L(8); PG8_BAR; PG8_WAIT_L(0); PG8_MMA(0, 0, At, B0); PG8_BAR; PG8_SCHED;
            PG8_LDB(B1, 0, 1); PG8_STAGE(PG8_SB(0, 0), b2, voffB);
            PG8_BAR; PG8_WAIT_L(0); PG8_MMA(0, 1, At, B1); PG8_BAR;
            PG8_LDA(At, 0, 1); PG8_STAGE(PG8_SA(0, 0), a2, voffA);
            PG8_BAR; PG8_WAIT_L(0); PG8_MMA(1, 0, At, B0); PG8_BAR; PG8_SCHED;
            PG8_STAGE(PG8_SB(0, 1), b2 + hstepB, voffB);
            PG8_WAIT_V(6); PG8_BAR; PG8_MMA(1, 1, At, B1); PG8_BAR;
            PG8_LDB(B0, 1, 0); PG8_SCHED; PG8_LDA(At, 1, 0); PG8_STAGE(PG8_SA(0, 1), a2 + hstepA, voffA);
            PG8_WAIT_L(8); PG8_BAR; PG8_WAIT_L(0); PG8_MMA(0, 0, At, B0); PG8_BAR; PG8_SCHED;
            PG8_LDB(B1, 1, 1); PG8_STAGE(PG8_SB(1, 0), b3, voffB);
            PG8_BAR; PG8_WAIT_L(0); PG8_MMA(0, 1, At, B1); PG8_BAR;
            PG8_LDA(At, 1, 1); PG8_STAGE(PG8_SA(1, 0), a3, voffA);
            PG8_BAR; PG8_WAIT_L(0); PG8_MMA(1, 0, At, B0); PG8_BAR; PG8_SCHED;
            PG8_STAGE(PG8_SB(1, 1), b3 + hstepB, voffB);
            PG8_WAIT_V(6); PG8_BAR; PG8_MMA(1, 1, At, B1); PG8_BAR;
        }
        E(acc, cur, wr, wc, fr, fq);
        if (!has_next) break;
#pragma unroll
        for (int a = 0; a < 2; ++a)
#pragma unroll
            for (int b = 0; b < 2; ++b)
#pragma unroll
                for (int m = 0; m < 4; ++m)
#pragma unroll
                    for (int n = 0; n < 2; ++n) acc[a][b][m][n] = (f32x4){0.f, 0.f, 0.f, 0.f};
        cur = nxt; cA = nA; cB = nB; ++ui;
    }
    PG8_WAIT_V(0);
    if (wr == 0) PG8_BAR;
    PG8_BAR;
#undef PG8_SA
#undef PG8_SB
#undef PG8_STAGE
#undef PG8_LDA
#undef PG8_LDB
#undef PG8_MMA
#undef PG8_WAIT_V
#undef PG8_WAIT_L
#undef PG8_BAR
#undef PG8_SCHED
}

typedef const f32x4 (&AccRef)[2][2][4][2];

struct EpiS1 {
    static constexpr bool PERM = false; float* sst;
    __device__ __forceinline__ void operator()(AccRef acc, const Unit& u, int wr, int wc, int fr, int fq) const {
#pragma unroll
        for (int ai = 0; ai < 2; ++ai)
#pragma unroll
            for (int m = 0; m < 4; ++m) { const int row = u.pm * BM + ai * HALF + wr * 64 + m * 16 + fr; float* rp = sst + ((size_t)row * 64 + u.aux) * 128 + wc * 32 + 4 * fq;
#pragma unroll
                for (int n = 0; n < 2; ++n) *(f32x4*)(rp + 16 * n) = acc[ai][0][m][n]; }
    }
};
struct EpiS2 {
    static constexpr bool PERM = true; const float* x; const float* dsk; bf16_t* g16;
    __device__ __forceinline__ void operator()(AccRef acc, const Unit& u, int wr, int wc, int fr, int fq) const {
        const int ch = u.aux * 16 + 8 * (fq & 1);
        const f32x4 d0 = *(const f32x4*)(dsk + ch), d1 = *(const f32x4*)(dsk + ch + 4);
#pragma unroll
        for (int ai = 0; ai < 2; ++ai)
#pragma unroll
            for (int m = 0; m < 4; ++m) { const int row = u.pm * BM + ai * HALF + wr * 64 + m * 16 + fr;
#pragma unroll
                for (int bj = 0; bj < 2; ++bj) { const int t = 16 * u.pn + 8 * bj + 2 * wc + (fq >> 1); const size_t off = ((size_t)row * 32 + t) * 1024 + ch;
                    const f32x4 x0 = *(const f32x4*)(x + off), x1 = *(const f32x4*)(x + off + 4);
                    const f32x4 y0 = acc[ai][bj][m][0] + d0 * x0, y1 = acc[ai][bj][m][1] + d1 * x1;
                    u32x4 w; w.x = pk_bf16(gelu_tanh(y0[0]), gelu_tanh(y0[1])); w.y = pk_bf16(gelu_tanh(y0[2]), gelu_tanh(y0[3]));
                    w.z = pk_bf16(gelu_tanh(y1[0]), gelu_tanh(y1[1])); w.w = pk_bf16(gelu_tanh(y1[2]), gelu_tanh(y1[3]));
                    *(u32x4*)(g16 + off) = w; }
                asm volatile("" ::: "memory"); }
    }
};
struct EpiGlu {
    static constexpr bool PERM = false; const float* x; float* out;
    __device__ __forceinline__ void operator()(AccRef acc, const Unit& u, int wr, int wc, int fr, int fq) const {
#pragma unroll
        for (int ai = 0; ai < 2; ++ai)
#pragma unroll
            for (int m = 0; m < 4; ++m) { const int row = u.pm * BM + ai * HALF + wr * 64 + m * 16 + fr; const size_t off = (size_t)row * 1024 + u.pn * 128 + wc * 32 + 4 * fq;
#pragma unroll
                for (int n = 0; n < 2; ++n) { const f32x4 xv = *(const f32x4*)(x + off + 16 * n); const f32x4 v = acc[ai][0][m][n], g = acc[ai][1][m][n]; f32x4 o;
#pragma unroll
                    for (int j = 0; j < 4; ++j) o[j] = ALPHA * xv[j] + v[j] * sigmoidf_(g[j]);
                    *(f32x4*)(out + off + 16 * n) = o; }
                asm volatile("" ::: "memory"); }
    }
};
struct EpiUp {
    static constexpr bool PERM = true; bf16_t* act; int ld;
    __device__ __forceinline__ void operator()(AccRef acc, const Unit& u, int wr, int wc, int fr, int fq) const {
#pragma unroll
        for (int ai = 0; ai < 2; ++ai)
#pragma unroll
            for (int m = 0; m < 4; ++m) { const int row = u.pm * BM + ai * HALF + wr * 64 + m * 16 + fr; float r[8];
#pragma unroll
                for (int n = 0; n < 2; ++n)
#pragma unroll
                    for (int j = 0; j < 4; ++j) { const float g = acc[ai][0][m][n][j], up = acc[ai][1][m][n][j]; r[4 * n + j] = g * sigmoidf_(g) * up; }
                u32x4 w; w.x = pk_bf16(r[0], r[1]); w.y = pk_bf16(r[2], r[3]); w.z = pk_bf16(r[4], r[5]); w.w = pk_bf16(r[6], r[7]);
                *(u32x4*)(act + (size_t)row * ld + u.pn * 128 + wc * 32 + 8 * fq) = w; }
    }
};
struct EpiRes {
    static constexpr bool PERM = false; float* h;
    __device__ __forceinline__ void operator()(AccRef acc, const Unit& u, int wr, int wc, int fr, int fq) const {
#pragma unroll
        for (int ai = 0; ai < 2; ++ai)
#pragma unroll
            for (int m = 0; m < 4; ++m) { const int row = u.pm * BM + ai * HALF + wr * 64 + m * 16 + fr; float* rp = h + (size_t)row * 1024 + u.pn * BM + wc * 32 + 4 * fq;
#pragma unroll
                for (int bj = 0; bj < 2; ++bj)
#pragma unroll
                    for (int n = 0; n < 2; ++n) { float* p = rp + bj * HALF + 16 * n; const f32x4 hv = *(const f32x4*)p; *(f32x4*)p = ALPHA * hv + acc[ai][bj][m][n]; }
                asm volatile("" ::: "memory"); }
    }
};
struct EpiQkv {
    static constexpr bool PERM = true; bf16_t* q; bf16_t* k; bf16_t* v; const float* rc; const float* rs;
    __device__ __forceinline__ void operator()(AccRef acc, const Unit& u, int wr, int wc, int fr, int fq) const {
        const bool rope = (u.pn <= 4) && ((wc & 1) == 0);
        bf16_t* base; int ld, colt; float scale = 1.0f;
        if (u.pn < 4) { base = q; ld = 1024; colt = u.pn * BM; scale = 0.125f * 1.4426950408889634f; } else if (u.pn == 4) { base = k; ld = 256; colt = 0; } else { base = v; ld = 256; colt = 0; }
#pragma unroll
        for (int ai = 0; ai < 2; ++ai)
#pragma unroll
            for (int m = 0; m < 4; ++m) { const int row = u.pm * BM + ai * HALF + wr * 64 + m * 16 + fr;
                f32x4 c0 = {1.f, 1.f, 1.f, 1.f}, c1 = c0, s0 = {0.f, 0.f, 0.f, 0.f}, s1 = s0;
                if (rope && fq < 2) { c0 = *(const f32x4*)(rc + (size_t)row * 8); c1 = *(const f32x4*)(rc + (size_t)row * 8 + 4); s0 = *(const f32x4*)(rs + (size_t)row * 8); s1 = *(const f32x4*)(rs + (size_t)row * 8 + 4);
                    if (fq == 0) { s0 = -s0; s1 = -s1; } }
#pragma unroll
                for (int bj = 0; bj < 2; ++bj) { f32x4 v0 = acc[ai][bj][m][0], v1 = acc[ai][bj][m][1];
                    if (rope) { f32x4 p0, p1;
#pragma unroll
                        for (int j = 0; j < 4; ++j) { p0[j] = __shfl_xor(v0[j], 16); p1[j] = __shfl_xor(v1[j], 16); }
                        v0 = v0 * c0 + p0 * s0; v1 = v1 * c1 + p1 * s1; }
                    v0 = v0 * scale; v1 = v1 * scale;
                    u32x4 w; w.x = pk_bf16(v0[0], v0[1]); w.y = pk_bf16(v0[2], v0[3]); w.z = pk_bf16(v1[0], v1[1]); w.w = pk_bf16(v1[2], v1[3]);
                    *(u32x4*)(base + (size_t)row * ld + colt + bj * HALF + wc * 32 + 8 * fq) = w; }
                asm volatile("" ::: "memory"); }
    }
};
struct EpiBf16 {
    static constexpr bool PERM = true; bf16_t* o; int ld;
    __device__ __forceinline__ void operator()(AccRef acc, const Unit& u, int wr, int wc, int fr, int fq) const {
#pragma unroll
        for (int ai = 0; ai < 2; ++ai)
#pragma unroll
            for (int m = 0; m < 4; ++m) { const int row = u.pm * BM + ai * HALF + wr * 64 + m * 16 + fr;
#pragma unroll
                for (int bj = 0; bj < 2; ++bj) { const f32x4 v0 = acc[ai][bj][m][0], v1 = acc[ai][bj][m][1];
                    u32x4 w; w.x = pk_bf16(v0[0], v0[1]); w.y = pk_bf16(v0[2], v0[3]); w.z = pk_bf16(v1[0], v1[1]); w.w = pk_bf16(v1[2], v1[3]);
                    *(u32x4*)(o + (size_t)row * ld + u.pn * BM + bj * HALF + wc * 32 + 8 * fq) = w; } }
    }
};
}

__device__ __forceinline__ void transpose_tile(const float* __restrict__ src, int ld, int k0, int col0, bf16_t* __restrict__ dst, int Kd, int n0, float* tile) {
    const int tid = threadIdx.x;
#pragma unroll
    for (int i = 0; i < 8; ++i) { const int kk = (tid >> 6) + 8 * i, nn = tid & 63; tile[kk * 65 + nn] = src[(size_t)(k0 + kk) * ld + col0 + nn]; }
    __syncthreads();
    { const int n = tid >> 3, ks = (tid & 7) * 8; float r[8];
#pragma unroll
      for (int j = 0; j < 8; ++j) r[j] = tile[(ks + j) * 65 + n];
      u32x4 w; w.x = pk_bf16(r[0], r[1]); w.y = pk_bf16(r[2], r[3]); w.z = pk_bf16(r[4], r[5]); w.w = pk_bf16(r[6], r[7]);
      *(u32x4*)(dst + (size_t)(n0 + n) * Kd + k0 + ks) = w; }
    __syncthreads();
}

__device__ void ssm_tables(const Params& P, int g, unsigned char* lds) {
    const int tid = threadIdx.x;
    float* apr = (float*)lds;
    float* api = apr + 33 * 64;
    float* bbr = api + 33 * 64;
    float* bbi = bbr + 1024;
    float* ccr = bbi + 1024;
    float* cci = ccr + 1024;
    float* kg = cci + 1024;
    const float dtf = expf(P.log_step[g]);
    for (int idx = tid; idx < 33 * 64; idx += 512) { const int tau = idx >> 6, p = idx & 63;
        const float lr = P.lam_re[g * 64 + p], li = P.lam_im[g * 64 + p];
        const double dt = (double)dtf; double rev = (double)li * dt * (double)tau * 0.15915494309189535; rev -= floor(rev);
        const float ang = (float)(rev * 6.283185307179586); float sn, cs; sincosf(ang, &sn, &cs);
        const float mag = expf((float)((double)lr * dt * (double)tau));
        apr[idx] = mag * cs; api[idx] = mag * sn; }
    for (int idx = tid; idx < 1024; idx += 512) { ccr[idx] = P.c_re[g * 1024 + idx]; cci[idx] = P.c_im[g * 1024 + idx]; }
    __syncthreads();
    for (int idx = tid; idx < 1024; idx += 512) { const int p = idx >> 4;
        const float lr = P.lam_re[g * 64 + p], li = P.lam_im[g * 64 + p], ar = apr[64 + p], ai = api[64 + p];
        const float nr = ar - 1.0f, den = lr * lr + li * li, kr = (nr * lr + ai * li) / den, ki = (ai * lr - nr * li) / den;
        const float br = P.b_re[g * 1024 + idx], bi = P.b_im[g * 1024 + idx];
        bbr[idx] = kr * br - ki * bi; bbi[idx] = kr * bi + ki * br; }
    __syncthreads();
    { const int cp = tid & 15, c = (tid >> 4) & 15, t0 = tid >> 8;
      for (int i = 0; i < 16; ++i) { const int tau = t0 + 2 * i; float s = 0.f;
          for (int p = 0; p < 64; ++p) { const float cr = ccr[c * 64 + p], ci = cci[c * 64 + p], ar = apr[tau * 64 + p], ai = api[tau * 64 + p];
              const float zr = cr * ar - ci * ai, zi = cr * ai + ci * ar; s += zr * bbr[p * 16 + cp] - zi * bbi[p * 16 + cp]; }
          kg[(tau * 16 + c) * 16 + cp] = s; } }
    __syncthreads();
    bf16_t* bt2 = (bf16_t*)(P.ws + WS_BT2) + (size_t)g * 512 * 640;
    for (int pc = tid; pc < 512 * 80; pc += 512) { const int n = pc / 80, k8 = (pc % 80) * 8, t = n >> 4, c = n & 15; float r[8];
        if (k8 < 512) { const int s = k8 >> 4, c0 = k8 & 15;
#pragma unroll
            for (int j = 0; j < 8; ++j) r[j] = (t >= s) ? kg[((t - s) * 16 + c) * 16 + c0 + j] : 0.f;
        } else { const int q0 = k8 - 512;
#pragma unroll
            for (int j = 0; j < 8; j += 2) { const int p = (q0 + j) >> 1; const float cr = ccr[c * 64 + p], ci = cci[c * 64 + p], ar = apr[(t + 1) * 64 + p], ai = api[(t + 1) * 64 + p];
                r[j] = cr * ar - ci * ai; r[j + 1] = -(cr * ai + ci * ar); } }
        u32x4 w; w.x = pk_bf16(r[0], r[1]); w.y = pk_bf16(r[2], r[3]); w.z = pk_bf16(r[4], r[5]); w.w = pk_bf16(r[6], r[7]);
        *(u32x4*)(bt2 + (size_t)n * 640 + k8) = w; }
    bf16_t* bt1 = (bf16_t*)(P.ws + WS_BT1) + (size_t)g * 256 * 512;
    for (int pc = tid; pc < 256 * 64; pc += 512) { const int q = pc >> 6, k8 = (pc & 63) * 8; float r[8];
        if (q < 128) { const int p = q >> 1, s = k8 >> 4, c0 = k8 & 15; const float ar = apr[(31 - s) * 64 + p], ai = api[(31 - s) * 64 + p];
#pragma unroll
            for (int j = 0; j < 8; ++j) { const float br = bbr[p * 16 + c0 + j], bi = bbi[p * 16 + c0 + j]; r[j] = (q & 1) ? (ar * bi + ai * br) : (ar * br - ai * bi); }
        } else {
#pragma unroll
            for (int j = 0; j < 8; ++j) r[j] = 0.f; }
        u32x4 w; w.x = pk_bf16(r[0], r[1]); w.y = pk_bf16(r[2], r[3]); w.z = pk_bf16(r[4], r[5]); w.w = pk_bf16(r[6], r[7]);
        *(u32x4*)(bt1 + (size_t)q * 512 + k8) = w; }
    float* a32 = (float*)(P.ws + WS_A32);
    if (tid < 64) { a32[(g * 64 + tid) * 2] = apr[32 * 64 + tid]; a32[(g * 64 + tid) * 2 + 1] = api[32 * 64 + tid]; }
    __syncthreads();
}

__device__ void p0_prep(const Params& P, unsigned char* lds) {
    const int tid = threadIdx.x, G = gridDim.x;
    if (blockIdx.x == 0 && tid < 8) ((int*)(P.ws + WS_CNT))[tid] = 0;
    if (blockIdx.x == 0) for (int i = tid; i < XCD_BAR_WORDS; i += 512) ((unsigned*)(P.ws + WS_BAR))[i] = 0u;
    constexpr int J_SSM = 64, J_X = 512, J_ROPE = 512, J_T = 9408;
    constexpr int NJ = J_SSM + J_X + J_ROPE + J_T;
    for (int job = blockIdx.x; job < NJ; job += G) {
        if (job < J_SSM) {
#if LEVEL >= 1
            ssm_tables(P, job, lds);
#endif
        }
        else if (job < J_SSM + J_X) {
            const int r0 = (job - J_SSM) * 64; bf16_t* xa = (bf16_t*)(P.ws + WS_XA);
#pragma unroll 4
            for (int i = 0; i < 16; ++i) { const int piece = tid + 512 * i, r = r0 + (piece >> 7), c8 = (piece & 127) * 8;
                const f32x4 a = *(const f32x4*)(P.x + (size_t)r * 1024 + c8), b = *(const f32x4*)(P.x + (size_t)r * 1024 + c8 + 4);
                u32x4 w; w.x = pk_bf16(a[0], a[1]); w.y = pk_bf16(a[2], a[3]); w.z = pk_bf16(b[0], b[1]); w.w = pk_bf16(b[2], b[3]);
                *(u32x4*)(xa + ((size_t)(r >> 5) * 40 + (r & 31)) * 1024 + c8) = w;
#if LEVEL < 1
                *(f32x4*)(P.out + (size_t)r * 1024 + c8) = a; *(f32x4*)(P.out + (size_t)r * 1024 + c8 + 4) = b;
#endif
            }
        }
        else if (job < J_SSM + J_X + J_ROPE) {
            const int tok = (job - J_SSM - J_X) * 64 + (tid >> 3), i = tid & 7;
            const float invf[8] = {1.0f, 0.19392274474868576f, 0.03760603093086393f, 0.007292664737217109f, 0.001414213562373095f, 0.0002742481756762073f, 5.318295896944988e-05f, 1.031338537721246e-05f};
            float f = invf[0];
#pragma unroll
            for (int k = 1; k < 8; ++k) f = (i == k) ? invf[k] : f;
            const float ang = (float)P.pos[tok] * f; float sn, cs; sincosf(ang, &sn, &cs);
            ((float*)(P.ws + WS_ROPEC))[tok * 8 + i] = cs; ((float*)(P.ws + WS_ROPES))[tok * 8 + i] = sn;
        }
        else {
            int jt = job - J_SSM - J_X - J_ROPE; float* tile = (float*)lds;
            if (jt < 512) { const int kt = jt & 15, n0 = (jt >> 4) * 64, pn = n0 >> 8, s = (n0 >> 7) & 1, xo = n0 & 127;
                transpose_tile(P.w_glu, 2048, kt * 64, s * 1024 + 128 * pn + xo, (bf16_t*)(P.ws + WS_WGLU), 1024, n0, tile); }
            else if ((jt -= 512) < 1408) { const int kt = jt & 15, n0 = (jt >> 4) * 64, pn = n0 >> 8, s = (n0 >> 7) & 1, xo = n0 & 127;
                transpose_tile(s ? P.ffn_u : P.ffn_g, 2816, kt * 64, 128 * pn + xo, (bf16_t*)(P.ws + WS_WUP), 1024, n0, tile); }
            else if ((jt -= 1408) < 704) { const int kt = jt % 44, n0 = (jt / 44) * 64;
                transpose_tile(P.ffn_d, 1024, kt * 64, n0, (bf16_t*)(P.ws + WS_WDN), 2816, n0, tile); }
            else if ((jt -= 704) < 256) { const int kt = jt & 15, n0 = (jt >> 4) * 64;
                transpose_tile(P.w_q, 1024, kt * 64, n0, (bf16_t*)(P.ws + WS_WQKV), 1024, n0, tile); }
            else if ((jt -= 256) < 128) { const int kt = jt & 15, n0 = (jt >> 4) * 64;
                transpose_tile(P.kv_w, 512, kt * 64, n0, (bf16_t*)(P.ws + WS_WQKV), 1024, 1024 + n0, tile); }
            else if ((jt -= 128) < 256) { const int kt = jt & 15, n0 = (jt >> 4) * 64;
                transpose_tile(P.w_out, 1024, kt * 64, n0, (bf16_t*)(P.ws + WS_WO), 1024, n0, tile); }
            else if ((jt -= 256) < 4096) { const int e = jt >> 9, r = jt & 511, kt = r & 15, n0 = (r >> 4) * 64, pn = n0 >> 8, s = (n0 >> 7) & 1, xo = n0 & 127;
                transpose_tile((s ? P.moe_u : P.moe_g) + (size_t)e * 1048576, 1024, kt * 64, 128 * pn + xo, (bf16_t*)(P.ws + WS_WMUP) + (size_t)e * 2048 * 1024, 1024, n0, tile); }
            else { jt -= 4096; const int e = jt >> 8, r = jt & 255, kt = r & 15, n0 = (r >> 4) * 64;
                transpose_tile(P.moe_d + (size_t)e * 1048576, 1024, kt * 64, n0, (bf16_t*)(P.ws + WS_WMDN) + (size_t)e * 1048576, 1024, n0, tile); }
        }
    }
}

__device__ void p2_scan(const Params& P) {
    const float* sst = (const float*)(P.ws + WS_SST); const float* a32 = (const float*)(P.ws + WS_A32); bf16_t* xa = (bf16_t*)(P.ws + WS_XA);
    for (int idx = blockIdx.x * 512 + threadIdx.x; idx < 16 * 64 * 64; idx += gridDim.x * 512) {
        const int p = idx & 63, g = (idx >> 6) & 63, b = idx >> 12;
        const float ar = a32[(g * 64 + p) * 2], ai = a32[(g * 64 + p) * 2 + 1];
        float hr = 0.f, hi = 0.f;
        const int q = 2 * p;
#pragma unroll 8
        for (int j = 0; j < 64; ++j) { const int row = b * 64 + j;
            *(unsigned*)(xa + ((size_t)row * 40 + 32 + (q >> 4)) * 1024 + g * 16 + (q & 15)) = pk_bf16(hr, hi);
            const float2 s = *(const float2*)(sst + ((size_t)row * 64 + g) * 128 + q);
            const float nr = ar * hr - ai * hi + s.x, ni = ar * hi + ai * hr + s.y; hr = nr; hi = ni; }
    }
}

template <int MODE>
__device__ void ln_phase(const Params& P, float* h, const float* gam, const float* bet, unsigned char* lds, float* hout, bf16_t* h16) {
    const int tid = threadIdx.x, wid = tid >> 6, lane = tid & 63;
    float* wrt = (float*)lds;
    int* cnt = (int*)(P.ws + WS_CNT); int* lists = (int*)(P.ws + WS_LIST); int* toki = (int*)(P.ws + WS_TOK);
    const bf16_t* Y = (const bf16_t*)(P.ws + WS_Y);
    int base[8];
    if (MODE == 1) { for (int k = 0; k < 16; ++k) { const int idx = tid + 512 * k; wrt[(idx & 7) * 1024 + (idx >> 3)] = P.w_router[idx]; } __syncthreads(); }
    if (MODE == 2) { int acc = 0;
#pragma unroll
        for (int e = 0; e < 8; ++e) { base[e] = acc; acc += ((cnt[e] + 255) >> 8) << 8; } }
    f32x4 gv[4], bv[4];
#pragma unroll
    for (int i = 0; i < 4; ++i) { gv[i] = *(const f32x4*)(gam + 256 * i + lane * 4); bv[i] = *(const f32x4*)(bet + 256 * i + lane * 4); }
    for (int row = blockIdx.x * 8 + wid; row < T_; row += gridDim.x * 8) {
        f32x4 v[4];
#pragma unroll
        for (int i = 0; i < 4; ++i) v[i] = *(const f32x4*)(h + (size_t)row * 1024 + 256 * i + lane * 4);
        if (MODE == 2) {
            const int e1 = toki[row * 8 + 0], p1 = toki[row * 8 + 1], e2 = toki[row * 8 + 2], p2 = toki[row * 8 + 3];
            const float w1 = __int_as_float(toki[row * 8 + 4]), w2 = __int_as_float(toki[row * 8 + 5]);
            int b1 = 0, b2 = 0;
#pragma unroll
            for (int e = 0; e < 8; ++e) { b1 = (e1 == e) ? base[e] : b1; b2 = (e2 == e) ? base[e] : b2; }
            const bf16_t* y1 = Y + (size_t)(b1 + p1) * 1024; const bf16_t* y2 = Y + (size_t)(b2 + p2) * 1024;
#pragma unroll
            for (int i = 0; i < 4; ++i) { const u32x2 a = *(const u32x2*)(y1 + 256 * i + lane * 4), b = *(const u32x2*)(y2 + 256 * i + lane * 4);
                v[i][0] = ALPHA * v[i][0] + (w1 * bf_lo(a.x) + w2 * bf_lo(b.x)); v[i][1] = ALPHA * v[i][1] + (w1 * bf_hi(a.x) + w2 * bf_hi(b.x));
                v[i][2] = ALPHA * v[i][2] + (w1 * bf_lo(a.y) + w2 * bf_lo(b.y)); v[i][3] = ALPHA * v[i][3] + (w1 * bf_hi(a.y) + w2 * bf_hi(b.y)); }
        }
        float s = 0.f;
#pragma unroll
        for (int i = 0; i < 4; ++i) s += (v[i][0] + v[i][1]) + (v[i][2] + v[i][3]);
        const float mu = wave_sum(s) * (1.0f / 1024.0f);
        float q = 0.f;
#pragma unroll
        for (int i = 0; i < 4; ++i) { v[i] = v[i] - mu; q += (v[i][0] * v[i][0] + v[i][1] * v[i][1]) + (v[i][2] * v[i][2] + v[i][3] * v[i][3]); }
        const float rstd = rsqrtf(wave_sum(q) * (1.0f / 1024.0f) + LN_EPS);
#pragma unroll
        for (int i = 0; i < 4; ++i) { v[i] = v[i] * rstd * gv[i] + bv[i]; *(f32x4*)(hout + (size_t)row * 1024 + 256 * i + lane * 4) = v[i];
            if (MODE != 2) { u32x2 w; w.x = pk_bf16(v[i][0], v[i][1]); w.y = pk_bf16(v[i][2], v[i][3]); *(u32x2*)(h16 + (size_t)row * 1024 + 256 * i + lane * 4) = w; } }
        if (MODE == 1) {
            float lg[8];
#pragma unroll
            for (int e = 0; e < 8; ++e) { float a = 0.f;
#pragma unroll
                for (int i = 0; i < 4; ++i) { const f32x4 w = *(const f32x4*)(wrt + e * 1024 + 256 * i + lane * 4); a += (v[i][0] * w[0] + v[i][1] * w[1]) + (v[i][2] * w[2] + v[i][3] * w[3]); }
                lg[e] = wave_sum(a) + P.b_router[e]; }
            int e1 = 0; float v1 = lg[0];
#pragma unroll
            for (int e = 1; e < 8; ++e) if (lg[e] > v1) { v1 = lg[e]; e1 = e; }
            int e2 = -1; float v2 = -3.0e38f;
#pragma unroll
            for (int e = 0; e < 8; ++e) if (e != e1 && lg[e] > v2) { v2 = lg[e]; e2 = e; }
            const float ex = __expf(v2 - v1), w1 = 1.0f / (1.0f + ex), w2 = ex / (1.0f + ex);
            if (lane == 0) { const int p1 = atomicAdd(cnt + e1, 1), p2 = atomicAdd(cnt + e2, 1);
                lists[e1 * T_ + p1] = row; lists[e2 * T_ + p2] = row;
                toki[row * 8 + 0] = e1; toki[row * 8 + 1] = p1; toki[row * 8 + 2] = e2; toki[row * 8 + 3] = p2; toki[row * 8 + 4] = __float_as_int(w1); toki[row * 8 + 5] = __float_as_int(w2); }
        }
    }
}

__device__ void gather_phase(const Params& P) {
    const int tid = threadIdx.x, wid = tid >> 6, lane = tid & 63;
    const int* cnt = (const int*)(P.ws + WS_CNT); const int* lists = (const int*)(P.ws + WS_LIST);
    const bf16_t* h16 = (const bf16_t*)(P.ws + WS_H16); bf16_t* ga = (bf16_t*)(P.ws + WS_GA);
    int base[9], c[8]; base[0] = 0;
#pragma unroll
    for (int e = 0; e < 8; ++e) { c[e] = cnt[e]; base[e + 1] = base[e] + (((c[e] + 255) >> 8) << 8); }
    for (int r = blockIdx.x * 8 + wid; r < base[8]; r += gridDim.x * 8) {
        int e = 0;
#pragma unroll
        for (int k = 1; k < 8; ++k) e += (r >= base[k]) ? 1 : 0;
        int be = 0, ce = 0;
#pragma unroll
        for (int k = 0; k < 8; ++k) { be = (e == k) ? base[k] : be; ce = (e == k) ? c[k] : ce; }
        const int pos = r - be; u32x4 a = {0u, 0u, 0u, 0u}, b = a;
        if (pos < ce) { const int tok = lists[e * T_ + pos]; a = *(const u32x4*)(h16 + (size_t)tok * 1024 + lane * 8); b = *(const u32x4*)(h16 + (size_t)tok * 1024 + 512 + lane * 8); }
        *(u32x4*)(ga + (size_t)r * 1024 + lane * 8) = a; *(u32x4*)(ga + (size_t)r * 1024 + 512 + lane * 8) = b;
    }
}

__device__ void attn_phase(const Params& P, unsigned char* lds) {
    const int tid = threadIdx.x, wid = tid >> 6, lane = tid & 63, n = lane & 31, hh = lane >> 5;
    bf16_t* Ks = (bf16_t*)lds;
    bf16_t* Vt = (bf16_t*)(lds + 256 * 144);
    const bf16_t* QB = (const bf16_t*)(P.ws + WS_BIG); const bf16_t* KB = (const bf16_t*)(P.ws + WS_BIG + 64 * MiB); const bf16_t* VB = (const bf16_t*)(P.ws + WS_BIG + 80 * MiB);
    bf16_t* OB = (bf16_t*)(P.ws + WS_BIG + 96 * MiB);
#ifdef DUP_ATT
    constexpr int NITEM = 2048;
#else
    constexpr int NITEM = 1024;
#endif
    for (int item = blockIdx.x; item < NITEM; item += gridDim.x) {
        const int kvh = item & 3, nb = (item >> 2) & 15, b = (item >> 6) & 15;
        const int tok0 = b * 2048 + nb * 128;
        __syncthreads();
#pragma unroll
        for (int i = 0; i < 4; ++i) { const int piece = tid + 512 * i, s = piece >> 3, pc = piece & 7; u32x4 v = {0u, 0u, 0u, 0u};
            if (nb > 0 || s >= 128) v = *(const u32x4*)(KB + (size_t)(tok0 - 128 + s) * 256 + kvh * 64 + pc * 8);
            *(u32x4*)(Ks + s * 72 + pc * 8) = v; }
#pragma unroll
        for (int i = 0; i < 2; ++i) { const int s = 2 * (tid & 127), pc = (tid >> 7) + 4 * i; u32x4 v0 = {0u, 0u, 0u, 0u}, v1 = v0;
            if (nb > 0 || s >= 128) { v0 = *(const u32x4*)(VB + (size_t)(tok0 - 128 + s) * 256 + kvh * 64 + pc * 8); v1 = *(const u32x4*)(VB + (size_t)(tok0 - 127 + s) * 256 + kvh * 64 + pc * 8); }
            unsigned* vt = (unsigned*)(Vt + (pc * 8) * 264 + s);
            vt[0 * 132] = (v0.x & 0xffffu) | (v1.x << 16); vt[1 * 132] = (v0.x >> 16) | (v1.x & 0xffff0000u);
            vt[2 * 132] = (v0.y & 0xffffu) | (v1.y << 16); vt[3 * 132] = (v0.y >> 16) | (v1.y & 0xffff0000u);
            vt[4 * 132] = (v0.z & 0xffffu) | (v1.z << 16); vt[5 * 132] = (v0.z >> 16) | (v1.z & 0xffff0000u);
            vt[6 * 132] = (v0.w & 0xffffu) | (v1.w << 16); vt[7 * 132] = (v0.w >> 16) | (v1.w & 0xffff0000u); }
        __syncthreads();
        const int hq = kvh * 4 + (wid >> 1);
        const float sink = P.sinks[hq] * 1.4426950408889634f;
#pragma unroll 1
        for (int qq = 0; qq < 2; ++qq) {
            const int kb0 = (wid & 1) * 2 + qq, i0 = 32 * kb0, qi = i0 + n;
            const bf16_t* qp = QB + (size_t)(tok0 + qi) * 1024 + hq * 64 + 8 * hh;
            bf16x8 qf[4];
#pragma unroll
            for (int ks = 0; ks < 4; ++ks) qf[ks] = *(const bf16x8*)(qp + 16 * ks);
            f32x16 sacc[5];
#pragma unroll
            for (int kb = 0; kb < 5; ++kb) {
#pragma unroll
                for (int i = 0; i < 16; ++i) sacc[kb][i] = 0.f;
                const bf16_t* kp = Ks + (32 * (kb0 + kb) + n) * 72 + 8 * hh;
#pragma unroll
                for (int ks = 0; ks < 4; ++ks) { const bf16x8 a = *(const bf16x8*)(kp + 16 * ks); sacc[kb] = __builtin_amdgcn_mfma_f32_32x32x16_bf16(a, qf[ks], sacc[kb], 0, 0, 0); }
                asm volatile("" ::: "memory"); }
            const int nn4 = n - 4 * hh;
#pragma unroll
            for (int i = 0; i < 16; ++i) { const int r = 8 * (i >> 2) + (i & 3);
                sacc[0][i] = (r > nn4) ? sacc[0][i] : -1.0e30f; sacc[4][i] = (r <= nn4) ? sacc[4][i] : -1.0e30f; }
            if (nb == 0) {
#pragma unroll
                for (int kb = 0; kb < 4; ++kb) if (kb0 + kb < 4) {
#pragma unroll
                    for (int i = 0; i < 16; ++i) sacc[kb][i] = -1.0e30f; } }
            float mx = sink;
#pragma unroll
            for (int kb = 0; kb < 5; ++kb)
#pragma unroll
                for (int i = 0; i < 16; ++i) mx = fmaxf(mx, sacc[kb][i]);
            mx = fmaxf(mx, __shfl_xor(mx, 32));
            float sum = 0.f;
#pragma unroll
            for (int kb = 0; kb < 5; ++kb)
#pragma unroll
                for (int i = 0; i < 16; ++i) { const float p = __builtin_amdgcn_exp2f(sacc[kb][i] - mx); sacc[kb][i] = p; sum += p; }
            sum += __shfl_xor(sum, 32); sum += __builtin_amdgcn_exp2f(sink - mx);
            f32x16 oacc[2];
#pragma unroll
            for (int i = 0; i < 16; ++i) { oacc[0][i] = 0.f; oacc[1][i] = 0.f; }
#pragma unroll
            for (int kb = 0; kb < 5; ++kb)
#pragma unroll
                for (int sl = 0; sl < 2; ++sl) {
                    union { u32x4 u; bf16x8 v; } pb;
                    pb.u.x = pk_bf16(sacc[kb][8 * sl + 0], sacc[kb][8 * sl + 1]); pb.u.y = pk_bf16(sacc[kb][8 * sl + 2], sacc[kb][8 * sl + 3]);
                    pb.u.z = pk_bf16(sacc[kb][8 * sl + 4], sacc[kb][8 * sl + 5]); pb.u.w = pk_bf16(sacc[kb][8 * sl + 6], sacc[kb][8 * sl + 7]);
#pragma unroll
                    for (int mb = 0; mb < 2; ++mb) { const bf16_t* vp = Vt + (32 * mb + n) * 264 + 32 * (kb0 + kb) + 16 * sl + 4 * hh;
                        union { u32x4 u; bf16x8 v; } va; const u32x2 lo = *(const u32x2*)vp, hi = *(const u32x2*)(vp + 8); va.u.x = lo.x; va.u.y = lo.y; va.u.z = hi.x; va.u.w = hi.y;
                        oacc[mb] = __builtin_amdgcn_mfma_f32_32x32x16_bf16(va.v, pb.v, oacc[mb], 0, 0, 0); }
                    asm volatile("" ::: "memory"); }
            const float inv = 1.0f / sum;
            bf16_t* op = OB + (size_t)(tok0 + qi) * 1024 + hq * 64 + 4 * hh;
#pragma unroll
            for (int mb = 0; mb < 2; ++mb)
#pragma unroll
                for (int g4 = 0; g4 < 4; ++g4) { u32x2 w; w.x = pk_bf16(oacc[mb][4 * g4 + 0] * inv, oacc[mb][4 * g4 + 1] * inv); w.y = pk_bf16(oacc[mb][4 * g4 + 2] * inv, oacc[mb][4 * g4 + 3] * inv);
                    *(u32x2*)(op + 32 * mb + 8 * g4) = w; }
        }
    }
}

#if defined(__HIP_DEVICE_COMPILE__)
typedef const Params __attribute__((address_space(4)))* KParams;
__device__ __forceinline__ Params load_params() { KParams p = (KParams)__builtin_amdgcn_kernarg_segment_ptr(); asm volatile("" : "+s"(p)); return *p; }
#else
__device__ __forceinline__ Params load_params() { return Params{}; }
#endif
#define LP const Params P = load_params(); unsigned char* const ws = P.ws; float* const H = P.out; (void)ws; (void)H
__global__ void __launch_bounds__(512, 2) yoco_fwd(Params P_arg) {
    extern __shared__ __attribute__((aligned(16))) unsigned char lds[];
    cg::grid_group grid = cg::this_grid();
    LAS unsigned char* ldsl = (LAS unsigned char*)lds;
    const int G = gridDim.x, c = blockIdx.x;
    if (threadIdx.x == 0) { ((LAS unsigned*)(ldsl + 131072))[0] = 0u; ((LAS unsigned*)(ldsl + 131072))[1] = 0u; }
    __syncthreads();
#define GSYNC() do { LP; xcd_barrier((unsigned*)(ws + WS_BAR), (volatile LAS unsigned*)(ldsl + 131072)); } while (0)

#ifdef PROF_A_HI
#define STAMP(k) do { LP; if (((k) == PROF_A_LO || (k) == PROF_A_HI || (k) == PROF_B_LO || (k) == PROF_B_HI) && blockIdx.x == 0 && threadIdx.x == 0) ((unsigned long long*)(P.ws + WS_CNT + 1024))[k] = __builtin_amdgcn_s_memrealtime(); } while (0)
#else
#define STAMP(k) do { } while (0)
#endif
    STAMP(0);
    { LP; p0_prep(P, lds); }
    grid.sync();
    { LP; if (threadIdx.x == 0) (void)xb_add(&((unsigned*)(ws + WS_BAR))[XB_XCNT(xb_xcc_id())], 1u); }
#ifdef DUP_SYNC
#pragma unroll 1
    for (int r = 0; r < 16; ++r) GSYNC();
#endif
#ifdef DUP_P0
    { LP; p0_prep(P, lds); }
    GSYNC();
#endif
    STAMP(1);
#if LEVEL >= 1
#ifndef SKIP_S1
    {   LP;
        pg8::SchedSsm S; S.init(256, 512, G, c); pg8::EpiS1 E{(float*)(ws + WS_SST)};
        pg8::gemm_phase(ldsl, (const char*)(ws + WS_XA), (const char*)(ws + WS_BT1), 512, S, E); }
#endif
    GSYNC(); STAMP(2);
#ifndef SKIP_SCAN
    { LP; p2_scan(P); }
#endif
    GSYNC(); STAMP(3);
#ifndef SKIP_S2
    {   LP;
        pg8::SchedSsm S; S.init(512, 640, G, c); pg8::EpiS2 E{P.x, P.ssm_d, (bf16_t*)(ws + WS_BIG)};
        pg8::gemm_phase(ldsl, (const char*)(ws + WS_XA), (const char*)(ws + WS_BT2), 640, S, E); }
#endif
    GSYNC(); STAMP(4);
#ifndef SKIP_GLU
    {   LP;
        pg8::SchedDense S; S.init(T_, 2048, 1024, 1024, G, c); pg8::EpiGlu E{P.x, H};
        pg8::gemm_phase(ldsl, (const char*)(ws + WS_BIG), (const char*)(ws + WS_WGLU), 1024, S, E); }
#endif
    GSYNC(); STAMP(5);
#endif
#ifdef DUP_LN
    { LP; ln_phase<0>(P, H, P.ln_g, P.ln_b, lds, (float*)(ws + WS_GA), (bf16_t*)(ws + WS_GA + 128 * MiB)); }
    GSYNC();
#endif
    { LP; ln_phase<0>(P, H, P.ln_g, P.ln_b, lds, H, (bf16_t*)(ws + WS_H16)); }
    GSYNC(); STAMP(6);
#if LEVEL >= 2
#ifndef SKIP_FUP
    {   LP;
        pg8::SchedDense S; S.init(T_, 2 * FF_, 1024, 1024, G, c); pg8::EpiUp E{(bf16_t*)(ws + WS_BIG), FF_};
        pg8::gemm_phase(ldsl, (const char*)(ws + WS_H16), (const char*)(ws + WS_WUP), 1024, S, E); }
#ifdef DUP_FUP
    GSYNC();
    {   LP;
        pg8::SchedDense S; S.init(T_, 2 * FF_, 1024, 1024, G, c); pg8::EpiUp E{(bf16_t*)(ws + WS_BIG), FF_};
        pg8::gemm_phase(ldsl, (const char*)(ws + WS_H16), (const char*)(ws + WS_WUP), 1024, S, E); }
#endif
#endif
    GSYNC(); STAMP(7);
#ifndef SKIP_FDN
    {   LP;
        pg8::SchedDense S; S.init(T_, 1024, FF_, FF_, G, c); pg8::EpiRes E{H};
        pg8::gemm_phase(ldsl, (const char*)(ws + WS_BIG), (const char*)(ws + WS_WDN), FF_, S, E); }
#endif
    GSYNC(); STAMP(8);
#endif
    { LP; ln_phase<0>(P, H, P.ln_g + 1024, P.ln_b + 1024, lds, H, (bf16_t*)(ws + WS_H16)); }
    GSYNC(); STAMP(9);
#if LEVEL >= 3
#ifndef SKIP_QKV
    {   LP;
        pg8::SchedDense S; S.init(T_, 1536, 1024, 1024, G, c);
        pg8::EpiQkv E{(bf16_t*)(ws + WS_BIG), (bf16_t*)(ws + WS_BIG + 64 * MiB), (bf16_t*)(ws + WS_BIG + 80 * MiB), (const float*)(ws + WS_ROPEC), (const float*)(ws + WS_ROPES)};
        pg8::gemm_phase(ldsl, (const char*)(ws + WS_H16), (const char*)(ws + WS_WQKV), 1024, S, E); }
#endif
    GSYNC(); STAMP(10);
#ifndef SKIP_ATT
    { LP; attn_phase(P, lds); }
#endif
    GSYNC(); STAMP(11);
#ifndef SKIP_OUT
    {   LP;
        pg8::SchedDense S; S.init(T_, 1024, 1024, 1024, G, c); pg8::EpiRes E{H};
        pg8::gemm_phase(ldsl, (const char*)(ws + WS_BIG + 96 * MiB), (const char*)(ws + WS_WO), 1024, S, E); }
#endif
    GSYNC(); STAMP(12);
#endif
#if LEVEL >= 4
    { LP; ln_phase<1>(P, H, P.ln_g + 2048, P.ln_b + 2048, lds, H, (bf16_t*)(ws + WS_H16)); }
    GSYNC(); STAMP(13);
#ifndef SKIP_GATH
    { LP; gather_phase(P); }
#endif
    GSYNC(); STAMP(14);
#ifndef SKIP_MUP
    {   LP;
        pg8::SchedMoe S; S.init((const int*)(ws + WS_CNT), 2048, 1024, (size_t)2048 * 1024 * 2, G, c); pg8::EpiUp E{(bf16_t*)(ws + WS_BIG), 1024};
        pg8::gemm_phase(ldsl, (const char*)(ws + WS_GA), (const char*)(ws + WS_WMUP), 1024, S, E); }
#endif
    GSYNC(); STAMP(15);
#ifndef SKIP_MDN
    {   LP;
        pg8::SchedMoe S; S.init((const int*)(ws + WS_CNT), 1024, 1024, (size_t)1024 * 1024 * 2, G, c); pg8::EpiBf16 E{(bf16_t*)(ws + WS_Y), 1024};
        pg8::gemm_phase(ldsl, (const char*)(ws + WS_BIG), (const char*)(ws + WS_WMDN), 1024, S, E); }
#endif
    GSYNC(); STAMP(16);
    { LP; ln_phase<2>(P, H, P.ln_g + 3072, P.ln_b + 3072, lds, H, (bf16_t*)(ws + WS_H16)); }
#ifdef PROF_A_HI
    GSYNC(); STAMP(17);
    {   LP; const unsigned long long* stamps = (const unsigned long long*)(P.ws + WS_CNT + 1024);
        const float tA = (float)(stamps[PROF_A_HI] - stamps[PROF_A_LO]) * 0.01f, tB = (float)(stamps[PROF_B_HI] - stamps[PROF_B_LO]) * 0.01f;
        for (int i = blockIdx.x * 512 + threadIdx.x; i < (1 << 22); i += gridDim.x * 512) H[(size_t)i * 8 + 1] = tB;
        if (blockIdx.x == 0 && threadIdx.x == 0) H[0] = 64.0f * tA; }
#endif
#else
    { LP; ln_phase<0>(P, H, P.ln_g + 2048, P.ln_b + 2048, lds, H, (bf16_t*)(ws + WS_H16)); }
    GSYNC(); STAMP(13);
    { LP; ln_phase<0>(P, H, P.ln_g + 3072, P.ln_b + 3072, lds, H, (bf16_t*)(ws + WS_H16)); }
#endif
}

extern "C" void kernel_launch(void* const* d_in, const int* in_sizes, int n_in, void* d_out, int out_size, void* d_ws, size_t ws_size, hipStream_t stream) {
    static int grid_blocks = 0;
    if (grid_blocks == 0) {
        if (n_in != 25 || out_size != T_ * D_ || ws_size < WS_END) { fprintf(stderr, "kernel_launch: unexpected shapes (n_in %d out %d ws %zu)\n", n_in, out_size, ws_size); grid_blocks = -1; return; }
        int dev = 0, cus = 0, per_cu = 0;
        hipGetDevice(&dev); hipDeviceGetAttribute(&cus, hipDeviceAttributeMultiprocessorCount, dev);
        if (hipFuncSetAttribute((const void*)yoco_fwd, hipFuncAttributeMaxDynamicSharedMemorySize, LDS_BYTES) != hipSuccess) { fprintf(stderr, "kernel_launch: hipFuncSetAttribute failed\n"); grid_blocks = -1; return; }
        if (hipOccupancyMaxActiveBlocksPerMultiprocessor(&per_cu, (const void*)yoco_fwd, 512, LDS_BYTES) != hipSuccess || per_cu < 1) { fprintf(stderr, "kernel_launch: occupancy query says %d\n", per_cu); per_cu = 1; (void)hipGetLastError(); }
        grid_blocks = cus * 1;
    }
    if (grid_blocks < 0) return;
    Params p{};
    p.x = (const float*)d_in[0]; p.pos = (const int*)d_in[1]; p.ln_g = (const float*)d_in[2]; p.ln_b = (const float*)d_in[3];
    p.lam_re = (const float*)d_in[4]; p.lam_im = (const float*)d_in[5]; p.log_step = (const float*)d_in[6]; p.b_re = (const float*)d_in[7]; p.b_im = (const float*)d_in[8];
    p.c_re = (const float*)d_in[9]; p.c_im = (const float*)d_in[10]; p.ssm_d = (const float*)d_in[11]; p.w_glu = (const float*)d_in[12]; p.kv_w = (const float*)d_in[13];
    p.w_q = (const float*)d_in[14]; p.sinks = (const float*)d_in[15]; p.w_out = (const float*)d_in[16]; p.ffn_g = (const float*)d_in[17]; p.ffn_u = (const float*)d_in[18]; p.ffn_d = (const float*)d_in[19];
    p.w_router = (const float*)d_in[20]; p.b_router = (const float*)d_in[21]; p.moe_g = (const float*)d_in[22]; p.moe_u = (const float*)d_in[23]; p.moe_d = (const float*)d_in[24];
    p.out = (float*)d_out; p.ws = (unsigned char*)d_ws;
    void* args[] = {&p};
    hipError_t e = hipLaunchCooperativeKernel((const void*)yoco_fwd, dim3(grid_blocks), dim3(512), args, LDS_BYTES, stream);
    if (e != hipSuccess) fprintf(stderr, "cooperative launch failed: %s (grid %d)\n", hipGetErrorString(e), grid_blocks);
}
```

```cpp
#include <hip/hip_runtime.h>
#include <hip/hip_cooperative_groups.h>
#include <cstdio>
namespace cg = cooperative_groups;

#ifndef LEVEL
#define LEVEL 4
#endif

#ifdef DUP_S1
#define NREP_S1 2
#else
#define NREP_S1 1
#endif
#ifdef DUP_S2
#define NREP_S2 2
#else
#define NREP_S2 1
#endif
#ifdef DUP_GLU
#define NREP_GLU 2
#else
#define NREP_GLU 1
#endif
#ifdef DUP_FUP
#define NREP_FUP 2
#else
#define NREP_FUP 1
#endif
#if defined(DUP_FDN) || defined(DUP_FDNNULL)
#define NREP_FDN 2
#else
#define NREP_FDN 1
#endif
#ifdef DUP_QKV
#define NREP_QKV 2
#else
#define NREP_QKV 1
#endif
#if defined(DUP_OUT) || defined(DUP_OUTNULL)
#define NREP_OUT 2
#else
#define NREP_OUT 1
#endif
#ifdef DUP_MUP
#define NREP_MUP 2
#else
#define NREP_MUP 1
#endif
#ifdef DUP_MDN
#define NREP_MDN 2
#else
#define NREP_MDN 1
#endif
#ifdef DUP_SCAN
#define NREP_SCAN 2
#else
#define NREP_SCAN 1
#endif
#ifdef DUP_GATH
#define NREP_GATH 2
#else
#define NREP_GATH 1
#endif
#ifdef DUP_OUTNULL
#define SKIP_EPI_OUT (rep == 0)
#else
#define SKIP_EPI_OUT false
#endif
#ifdef DUP_FDNNULL
#define SKIP_EPI_FDN (rep == 0)
#else
#define SKIP_EPI_FDN false
#endif
#define LAS __attribute__((address_space(3)))
typedef unsigned short bf16_t;
typedef short bf16x8 __attribute__((ext_vector_type(8)));
typedef float f32x4 __attribute__((ext_vector_type(4)));
typedef float f32x16 __attribute__((ext_vector_type(16)));
typedef unsigned u32x4 __attribute__((ext_vector_type(4)));
typedef unsigned u32x2 __attribute__((ext_vector_type(2)));

constexpr int T_ = 32768, D_ = 1024, FF_ = 2816;
constexpr float ALPHA = 1.41421356237309515f;
constexpr float LN_EPS = 1e-5f;
constexpr size_t MiB = 1ull << 20;
constexpr size_t WS_CNT = 0, WS_BAR = 4096, WS_A32 = 65536, WS_ROPEC = 1 * MiB, WS_ROPES = 2 * MiB, WS_LIST = 3 * MiB, WS_TOK = 4 * MiB;
constexpr size_t WS_WMUP = 8 * MiB, WS_WMDN = 40 * MiB, WS_WGLU = 56 * MiB, WS_WUP = 60 * MiB, WS_WDN = 71 * MiB, WS_WQKV = 77 * MiB, WS_WO = 80 * MiB;
constexpr size_t WS_H16 = 82 * MiB, WS_BT2 = 146 * MiB, WS_BT1 = 186 * MiB, WS_XA = 202 * MiB, WS_SST = 282 * MiB, WS_GA = 146 * MiB, WS_Y = 146 * MiB;
constexpr size_t WS_BIG = 314 * MiB, WS_END = 490 * MiB;
constexpr int LDS_BYTES = 131072 + 16;

struct Params {
    const float* x; const int* pos; const float* ln_g; const float* ln_b;
    const float* lam_re; const float* lam_im; const float* log_step; const float* b_re; const float* b_im; const float* c_re; const float* c_im;
    const float* ssm_d; const float* w_glu; const float* kv_w; const float* w_q; const float* sinks; const float* w_out;
    const float* ffn_g; const float* ffn_u; const float* ffn_d; const float* w_router; const float* b_router;
    const float* moe_g; const float* moe_u; const float* moe_d;
    float* out; unsigned char* ws;
};

__device__ __forceinline__ unsigned pk_bf16(float lo, float hi) { unsigned r; asm volatile("v_cvt_pk_bf16_f32 %0, %1, %2" : "=v"(r) : "v"(lo), "v"(hi)); return r; }
__device__ __forceinline__ float bf_lo(unsigned w) { return __uint_as_float(w << 16); }
__device__ __forceinline__ float bf_hi(unsigned w) { return __uint_as_float(w & 0xffff0000u); }
__device__ __forceinline__ float sigmoidf_(float x) { return __builtin_amdgcn_rcpf(1.0f + __expf(-x)); }
__device__ __forceinline__ float gelu_tanh(float y) { const float u = 1.5957691216057308f * (y + 0.044715f * y * y * y); return y * sigmoidf_(u); }
__device__ __forceinline__ float wave_sum(float v) {
    v += __shfl_xor(v, 32); v += __shfl_xor(v, 16); v += __shfl_xor(v, 8); v += __shfl_xor(v, 4); v += __shfl_xor(v, 2); v += __shfl_xor(v, 1); return v; }


#define XB_TMO      128
#define XB_XCNT(j)  (256  + 64 * (j))
#define XB_XSUB(j)  (1280 + 64 * (j))
#define XB_XGEN(j)  (2304 + 64 * (j))
#define XB_TOP      3328
#define XB_TOPGEN   3392
#define XCD_BAR_WORDS 3456
#define XB_SPIN_CAP (1u << 22)
__device__ __forceinline__ unsigned xb_ld(unsigned* p)              { return __hip_atomic_load(p, __ATOMIC_RELAXED, __HIP_MEMORY_SCOPE_AGENT); }
__device__ __forceinline__ unsigned xb_add(unsigned* p, unsigned v) { return __hip_atomic_fetch_add(p, v, __ATOMIC_RELAXED, __HIP_MEMORY_SCOPE_AGENT); }
__device__ __forceinline__ unsigned xb_xcc_id() { return (unsigned)__builtin_amdgcn_s_getreg((3 << 11) | 20) & 0xFu; }
#define XB_SPIN(cond, bar) do { unsigned _sp = 0; while (cond) { __builtin_amdgcn_s_sleep(1); \
    if ((++_sp & 255u) == 0u) { if (xb_ld(&(bar)[XB_TMO])) break; if (_sp > XB_SPIN_CAP) { atomicAdd(&(bar)[XB_TMO], 1u); break; } } } } while (0)
__device__ __forceinline__ void xcd_barrier_complete(unsigned* bar, unsigned x, unsigned& nloc, unsigned& nx) {
    const unsigned G = gridDim.x * gridDim.y * gridDim.z;
    unsigned sum, cnt, mine, sp = 0u;
    for (;;) {
        sum = 0u; cnt = 0u; mine = 0u;
#pragma unroll
        for (unsigned j = 0; j < 16; ++j) { const unsigned c = xb_ld(&bar[XB_XCNT(j)]); sum += c; cnt += (c > 0u) ? 1u : 0u; mine = (j == x) ? c : mine; }
        if (sum == G) break;
        __builtin_amdgcn_s_sleep(1);
        if ((++sp & 255u) == 0u) { if (xb_ld(&bar[XB_TMO])) break; if (sp > XB_SPIN_CAP) { atomicAdd(&bar[XB_TMO], 1u); break; } }
    }
    nloc = mine > 0u ? mine : 1u; nx = cnt > 0u ? cnt : 1u;
}
__device__ __forceinline__ void xcd_barrier(unsigned* bar, volatile LAS unsigned* st) {
    asm volatile("s_waitcnt vmcnt(0)" ::: "memory");
    __syncthreads();
    if (threadIdx.x == 0) {
        const unsigned x = xb_xcc_id();
        __builtin_amdgcn_s_waitcnt(0);
        unsigned nloc = st[0], nx = st[1];
        if (nloc == 0u) { xcd_barrier_complete(bar, x, nloc, nx); st[0] = nloc; st[1] = nx; }
        const unsigned old = xb_add(&bar[XB_XSUB(x)], 1u);
        const unsigned gen = old / nloc;
        if (old + 1u == (gen + 1u) * nloc) {
            __builtin_amdgcn_fence(__ATOMIC_RELEASE, "agent");
            asm volatile("s_waitcnt vmcnt(0)" ::: "memory");
            const unsigned og = xb_add(&bar[XB_TOP], 1u);
            const unsigned tg = og / nx;
            if (og + 1u == (tg + 1u) * nx) xb_add(&bar[XB_TOPGEN], 1u);
            else XB_SPIN(xb_ld(&bar[XB_TOPGEN]) == tg, bar);
            __builtin_amdgcn_fence(__ATOMIC_ACQUIRE, "agent");
            xb_add(&bar[XB_XGEN(x)], 1u);
            asm volatile("s_waitcnt vmcnt(0)" ::: "memory");
        } else {
            XB_SPIN(xb_ld(&bar[XB_XGEN(x)]) == gen, bar);
            __builtin_amdgcn_fence(__ATOMIC_ACQUIRE, "agent");
            asm volatile("s_waitcnt vmcnt(0)" ::: "memory");
        }
    }
    __syncthreads();
}

namespace pg8 {
constexpr int BM = 256, BK = 64, HALF = 128, HTB = HALF * BK * 2, NXCD = 8, WGM = 8;
__device__ __forceinline__ int lds_byte(int r, int c) { const int st = (r >> 4) * 2 + (c >> 5), rr = r & 15, cc = c & 31, ob = rr * 64 + cc * 2; return st * 1024 + (ob ^ (((ob >> 9) & 1) << 5)); }
__device__ __forceinline__ void stage_rc(int b, int& R, int& C) { const int st = b / 1024, sb = b % 1024, swz = sb ^ (((sb >> 9) & 1) << 5); R = (st >> 1) * 16 + swz / 64; C = (st & 1) * 32 + (swz % 64) / 2; }
__device__ __forceinline__ int perm32(int rho) { const int n = rho >> 4, i = rho & 15; return 8 * (i >> 2) + 4 * n + (i & 3); }
__device__ __forceinline__ int xcd_remap(int L, int nwg) { const int q = nwg / NXCD, r = nwg % NXCD, xcd = L % NXCD, off = L / NXCD; return (xcd < r ? xcd * (q + 1) : r * (q + 1) + (xcd - r) * q) + off; }

struct Unit { int pm, pn, aux, pad; size_t a_off, b_off; };

struct SchedDense {
    int nM, nN, nwg, G, c, lda, K;
    __device__ __forceinline__ void init(int M, int N, int K_, int lda_, int G_, int c_) { nM = M / BM; nN = N / BM; nwg = nM * nN; G = G_; c = c_; lda = lda_; K = K_; }
    __device__ __forceinline__ bool next(int i, Unit& u) const {
        const int L = i * G + c; if (L >= nwg) return false;
        const int wgid = xcd_remap(L, nwg);
        const int nig = WGM * nN, gid = wgid / nig, fm = gid * WGM, gsz = (nM - fm) < WGM ? (nM - fm) : WGM;
        u.pm = fm + ((wgid % nig) % gsz); u.pn = (wgid % nig) / gsz; u.aux = 0; u.pad = 0;
        u.a_off = (size_t)u.pm * BM * lda * 2; u.b_off = (size_t)u.pn * BM * K * 2; return true;
    }
    __device__ __forceinline__ unsigned voffA(int R, int C) const { return (unsigned)(R * lda + C) * 2u; }
    __device__ __forceinline__ size_t a_kstep() const { return BK * 2; }
    __device__ __forceinline__ size_t a_hstep() const { return (size_t)HALF * lda * 2; }
};
struct SchedMoe {
    int nM, nN, nwg, G, c, K; int tb[9]; size_t estride;
    __device__ __forceinline__ void init(const int* cnt, int N, int K_, size_t estride_, int G_, int c_) {
        tb[0] = 0;
#pragma unroll
        for (int e = 0; e < 8; ++e) tb[e + 1] = tb[e] + ((cnt[e] + 255) >> 8);
        nM = tb[8]; nN = N / BM; nwg = nM * nN; G = G_; c = c_; K = K_; estride = estride_; }
    __device__ __forceinline__ bool next(int i, Unit& u) const {
        const int L = i * G + c; if (L >= nwg) return false;
        const int wgid = xcd_remap(L, nwg);
        const int nig = WGM * nN, gid = wgid / nig, fm = gid * WGM, gsz = (nM - fm) < WGM ? (nM - fm) : WGM;
        u.pm = fm + ((wgid % nig) % gsz); u.pn = (wgid % nig) / gsz; int e = 0;
#pragma unroll
        for (int k = 1; k < 8; ++k) e += (u.pm >= tb[k]) ? 1 : 0;
        u.aux = e; u.pad = 0;
        u.a_off = (size_t)u.pm * BM * 1024 * 2; u.b_off = (size_t)e * estride + (size_t)u.pn * BM * K * 2; return true;
    }
    __device__ __forceinline__ unsigned voffA(int R, int C) const { return (unsigned)(R * 1024 + C) * 2u; }
    __device__ __forceinline__ size_t a_kstep() const { return BK * 2; }
    __device__ __forceinline__ size_t a_hstep() const { return (size_t)HALF * 1024 * 2; }
};
struct SchedSsm {
    int nN, nwg, G, c, K, N;
    __device__ __forceinline__ void init(int N_, int K_, int G_, int c_) { N = N_; nN = N_ / BM; nwg = 64 * 4 * nN; G = G_; c = c_; K = K_; }
    __device__ __forceinline__ bool next(int i, Unit& u) const {
        const int L = i * G + c; if (L >= nwg) return false;
        const int wgid = xcd_remap(L, nwg);
        const int per = 4 * nN, g = wgid / per, rem = wgid % per;
        u.pm = rem & 3; u.pn = rem >> 2; u.aux = g; u.pad = 0;
        u.a_off = ((size_t)u.pm * BM * 40 * 1024 + (size_t)g * 16) * 2; u.b_off = (size_t)g * N * K * 2 + (size_t)u.pn * BM * K * 2; return true;
    }
    __device__ __forceinline__ unsigned voffA(int R, int C) const { return (unsigned)((R * 40 + (C >> 4)) * 1024 + (C & 15)) * 2u; }
    __device__ __forceinline__ size_t a_kstep() const { return 4 * 1024 * 2; }
    __device__ __forceinline__ size_t a_hstep() const { return (size_t)HALF * 40 * 1024 * 2; }
};

template <class Epi, class Sched>
__device__ __forceinline__ void gemm_phase(LAS unsigned char* lds, const char* Ab, const char* Bb, const int K, const Sched& S, const Epi& E) {
    const int tid = threadIdx.x, wid = __builtin_amdgcn_readfirstlane(tid >> 6), lane = tid & 63, wr = wid >> 2, wc = wid & 3, fr = lane & 15, fq = lane >> 4;
    const int nt = K / BK;
    unsigned voffA[2], voffB[2];
#pragma unroll
    for (int i = 0; i < 2; ++i) { int R, C; stage_rc(tid * 16 + i * 8192, R, C); const int Rb = Epi::PERM ? ((R & ~31) + perm32(R & 31)) : R;
        voffA[i] = S.voffA(R, C); voffB[i] = (unsigned)(Rb * K + C) * 2u; }
    const size_t kstepA = S.a_kstep(), hstepA = S.a_hstep(), kstepB = (size_t)(BK * 2), hstepB = (size_t)HALF * K * 2;
    const unsigned ldsw = (unsigned)wid * 1024u;
    const int aoff = lds_byte(wr * 64 + fr, fq * 8), boff = lds_byte(wc * 32 + fr, fq * 8);
#define PG8_SA(b, h) (((b) * 2 + (h)) * HTB)
#define PG8_SB(b, h) ((4 + (b) * 2 + (h)) * HTB)
#define PG8_STAGE(bufoff, gbase, voff) do { _Pragma("unroll") for (int _i = 0; _i < 2; ++_i) \
        __builtin_amdgcn_global_load_lds((const unsigned*)((const char*)(gbase) + (voff)[_i]), (LAS unsigned*)(lds + (bufoff) + ldsw + _i * 8192), 16, 0, 0); } while (0)
#define PG8_LDA(dst, b, h) do { _Pragma("unroll") for (int m = 0; m < 4; ++m) _Pragma("unroll") for (int k = 0; k < 2; ++k) dst[m][k] = *(const LAS bf16x8*)(lds + PG8_SA(b, h) + aoff + m * 2048 + k * 1024); } while (0)
#define PG8_LDB(dst, b, h) do { _Pragma("unroll") for (int n = 0; n < 2; ++n) _Pragma("unroll") for (int k = 0; k < 2; ++k) dst[n][k] = *(const LAS bf16x8*)(lds + PG8_SB(b, h) + boff + n * 2048 + k * 1024); } while (0)
#define PG8_MMA(ai, bj, At, Bt) do { __builtin_amdgcn_s_setprio(1); _Pragma("unroll") for (int m = 0; m < 4; ++m) _Pragma("unroll") for (int n = 0; n < 2; ++n) _Pragma("unroll") for (int k = 0; k < 2; ++k) \
        acc[ai][bj][m][n] = __builtin_amdgcn_mfma_f32_16x16x32_bf16(Bt[n][k], At[m][k], acc[ai][bj][m][n], 0, 0, 0); __builtin_amdgcn_s_setprio(0); } while (0)
#define PG8_WAIT_V(n) asm volatile("s_waitcnt vmcnt(" #n ")" ::: "memory")
#define PG8_WAIT_L(n) asm volatile("s_waitcnt lgkmcnt(" #n ")" ::: "memory")
#define PG8_BAR __builtin_amdgcn_s_barrier()
#define PG8_SCHED __builtin_amdgcn_sched_barrier(0)
    Unit cur, nxt; int ui = 0;
    if (!S.next(0, cur)) return;
    f32x4 acc[2][2][4][2];
#pragma unroll
    for (int a = 0; a < 2; ++a)
#pragma unroll
        for (int b = 0; b < 2; ++b)
#pragma unroll
            for (int m = 0; m < 4; ++m)
#pragma unroll
                for (int n = 0; n < 2; ++n) acc[a][b][m][n] = (f32x4){0.f, 0.f, 0.f, 0.f};
    bf16x8 At[4][2], B0[2][2], B1[2][2];
    const char* cA = Ab + cur.a_off; const char* cB = Bb + cur.b_off;
    PG8_STAGE(PG8_SB(0, 0), cB, voffB); PG8_STAGE(PG8_SA(0, 0), cA, voffA); PG8_STAGE(PG8_SB(0, 1), cB + hstepB, voffB); PG8_STAGE(PG8_SA(0, 1), cA + hstepA, voffA);
    if (wr == 1) PG8_BAR;
    PG8_WAIT_V(4); PG8_BAR;
    PG8_STAGE(PG8_SB(1, 0), cB + kstepB, voffB); PG8_STAGE(PG8_SA(1, 0), cA + kstepA, voffA); PG8_STAGE(PG8_SB(1, 1), cB + hstepB + kstepB, voffB);
    PG8_WAIT_V(6); PG8_BAR;
    for (;;) {
        const bool has_next = S.next(ui + 1, nxt);
        const char* nA = has_next ? Ab + nxt.a_off : cA; const char* nB = has_next ? Bb + nxt.b_off : cB;
        for (int t = 0; t < nt; t += 2) {
            const bool last = (t == nt - 2);
            const char* a1 = cA + (size_t)(t + 1) * kstepA;
            const char* a2 = last ? nA : cA + (size_t)(t + 2) * kstepA; const char* b2 = last ? nB : cB + (size_t)(t + 2) * kstepB;
            const char* a3 = a2 + kstepA; const char* b3 = b2 + kstepB;
            PG8_LDB(B0, 0, 0); PG8_SCHED; PG8_LDA(At, 0, 0); PG8_STAGE(PG8_SA(1, 1), a1 + hstepA, voffA);
            PG8_WAIT_L(8); PG8_BAR; PG8_WAIT_L(0); PG8_MMA(0, 0, At, B0); PG8_BAR; PG8_SCHED;
            PG8_LDB(B1, 0, 1); PG8_STAGE(PG8_SB(0, 0), b2, voffB);
            PG8_BAR; PG8_WAIT_L(0); PG8_MMA(0, 1, At, B1); PG8_BAR;
            PG8_LDA(At, 0, 1); PG8_STAGE(PG8_SA(0, 0), a2, voffA);
            PG8_BAR; PG8_WAIT_L(0); PG8_MMA(1, 0, At, B0); PG8_BAR; PG8_SCHED;
            PG8_STAGE(PG8_SB(0, 1), b2 + hstepB, voffB);
            PG8_WAIT_V(6); PG8_BAR; PG8_MMA(1, 1, At, B1); PG8_BAR;
            PG8_LDB(B0, 1, 0); PG8_SCHED; PG8_LDA(At, 1, 0); PG8_STAGE(PG8_SA(0, 1), a2 + hstepA, voffA);
            PG8_WAIT_L(8); PG8_BAR; PG8_WAIT_L(0); PG8_MMA(0, 0, At, B0); PG8_BAR; PG8_SCHED;
            PG8_LDB(B1, 1, 1); PG8_STAGE(PG8_SB(1, 0), b3, voffB);
            PG8_BAR; PG8_WAIT_L(0); PG8_MMA(0, 1, At, B1); PG8_BAR;
            PG8_LDA(At, 1, 1); PG8_STAGE(PG8_SA(1, 0), a3, voffA);
            PG8_BAR; PG8_WAIT_L(0); PG8_MMA(1, 0, At, B0); PG8_BAR; PG8_SCHED;
            PG8_STAGE(PG8_SB(1, 1), b3 + hstepB, voffB);
            PG8_WAIT_V(6); PG8_BAR; PG8_MMA(1, 1, At, B1); PG8_BAR;
        }
        E(acc, cur, wr, wc, fr, fq);
        if (!has_next) break;
#pragma unroll
        for (int a = 0; a < 2; ++a)
#pragma unroll
            for (int b = 0; b < 2; ++b)
#pragma unroll
                for (int m = 0; m < 4; ++m)
#pragma unroll
                    for (int n = 0; n < 2; ++n) acc[a][b][m][n] = (f32x4){0.f, 0.f, 0.f, 0.f};
        cur = nxt; cA = nA; cB = nB; ++ui;
    }
    PG8_WAIT_V(0);
    if (wr == 0) PG8_BAR;
    PG8_BAR;
#undef PG8_SA
#undef PG8_SB
#undef PG8_STAGE
#undef PG8_LDA
#undef PG8_LDB
#undef PG8_MMA
#undef PG8_WAIT_V
#undef PG8_WAIT_L
#undef PG8_BAR
#undef PG8_SCHED
}

typedef const f32x4 (&AccRef)[2][2][4][2];

struct EpiS1 {
    static constexpr bool PERM = false; float* sst;
    __device__ __forceinline__ void operator()(AccRef acc, const Unit& u, int wr, int wc, int fr, int fq) const {
#pragma unroll
        for (int ai = 0; ai < 2; ++ai)
#pragma unroll
            for (int m = 0; m < 4; ++m) { const int row = u.pm * BM + ai * HALF + wr * 64 + m * 16 + fr; float* rp = sst + ((size_t)row * 64 + u.aux) * 128 + wc * 32 + 4 * fq;
#pragma unroll
                for (int n = 0; n < 2; ++n) *(f32x4*)(rp + 16 * n) = acc[ai][0][m][n]; }
    }
};
struct EpiS2 {
    static constexpr bool PERM = true; const bf16_t* xa; const float* dsk; bf16_t* g16;
    __device__ __forceinline__ void operator()(AccRef acc, const Unit& u, int wr, int wc, int fr, int fq) const {
        const int ch = u.aux * 16 + 8 * (fq & 1);
        const f32x4 d0 = *(const f32x4*)(dsk + ch), d1 = *(const f32x4*)(dsk + ch + 4);
#pragma unroll
        for (int ai = 0; ai < 2; ++ai)
#pragma unroll
            for (int m = 0; m < 4; ++m) { const int row = u.pm * BM + ai * HALF + wr * 64 + m * 16 + fr;
#pragma unroll
                for (int bj = 0; bj < 2; ++bj) { const int t = 16 * u.pn + 8 * bj + 2 * wc + (fq >> 1);
                    const u32x4 xv = *(const u32x4*)(xa + ((size_t)row * 40 + t) * 1024 + ch);
                    const f32x4 x0 = {bf_lo(xv.x), bf_hi(xv.x), bf_lo(xv.y), bf_hi(xv.y)}, x1 = {bf_lo(xv.z), bf_hi(xv.z), bf_lo(xv.w), bf_hi(xv.w)};
                    const f32x4 y0 = acc[ai][bj][m][0] + d0 * x0, y1 = acc[ai][bj][m][1] + d1 * x1;
                    u32x4 w; w.x = pk_bf16(gelu_tanh(y0[0]), gelu_tanh(y0[1])); w.y = pk_bf16(gelu_tanh(y0[2]), gelu_tanh(y0[3]));
                    w.z = pk_bf16(gelu_tanh(y1[0]), gelu_tanh(y1[1])); w.w = pk_bf16(gelu_tanh(y1[2]), gelu_tanh(y1[3]));
                    *(u32x4*)(g16 + ((size_t)row * 32 + t) * 1024 + ch) = w; } }
    }
};
struct EpiGlu {
    static constexpr bool PERM = false; const float* x; float* out;
    __device__ __forceinline__ void operator()(AccRef acc, const Unit& u, int wr, int wc, int fr, int fq) const {
#pragma unroll
        for (int ai = 0; ai < 2; ++ai)
#pragma unroll
            for (int m = 0; m < 4; ++m) { const int row = u.pm * BM + ai * HALF + wr * 64 + m * 16 + fr; const size_t off = (size_t)row * 1024 + u.pn * 128 + wc * 32 + 4 * fq;
#pragma unroll
                for (int n = 0; n < 2; ++n) { const f32x4 xv = *(const f32x4*)(x + off + 16 * n); const f32x4 v = acc[ai][0][m][n], g = acc[ai][1][m][n]; f32x4 o;
#pragma unroll
                    for (int j = 0; j < 4; ++j) o[j] = ALPHA * xv[j] + v[j] * sigmoidf_(g[j]);
                    *(f32x4*)(out + off + 16 * n) = o; } }
    }
};
template <int ACT> struct EpiUp {
    static constexpr bool PERM = true; bf16_t* act; int ld;
    __device__ __forceinline__ void operator()(AccRef acc, const Unit& u, int wr, int wc, int fr, int fq) const {
#pragma unroll
        for (int ai = 0; ai < 2; ++ai)
#pragma unroll
            for (int m = 0; m < 4; ++m) { const int row = u.pm * BM + ai * HALF + wr * 64 + m * 16 + fr; float r[8];
#pragma unroll
                for (int n = 0; n < 2; ++n)
#pragma unroll
                    for (int j = 0; j < 4; ++j) { const float g = acc[ai][0][m][n][j], up = acc[ai][1][m][n][j]; r[4 * n + j] = (ACT == 0) ? g * sigmoidf_(g) * up : g * sigmoidf_(up); }
                u32x4 w; w.x = pk_bf16(r[0], r[1]); w.y = pk_bf16(r[2], r[3]); w.z = pk_bf16(r[4], r[5]); w.w = pk_bf16(r[6], r[7]);
                *(u32x4*)(act + (size_t)row * ld + u.pn * 128 + wc * 32 + 8 * fq) = w; }
    }
};
struct EpiRes {
    static constexpr bool PERM = false; const float* hin; float* h; bool skip;
    __device__ __forceinline__ void operator()(AccRef acc, const Unit& u, int wr, int wc, int fr, int fq) const {
        if (skip) return;
#pragma unroll
        for (int ai = 0; ai < 2; ++ai)
#pragma unroll
            for (int m = 0; m < 4; ++m) { const int row = u.pm * BM + ai * HALF + wr * 64 + m * 16 + fr; const size_t ro = (size_t)row * 1024 + u.pn * BM + wc * 32 + 4 * fq;
#pragma unroll
                for (int bj = 0; bj < 2; ++bj)
#pragma unroll
                    for (int n = 0; n < 2; ++n) { const size_t o = ro + bj * HALF + 16 * n; const f32x4 hv = *(const f32x4*)(hin + o); *(f32x4*)(h + o) = ALPHA * hv + acc[ai][bj][m][n]; } }
    }
};
struct EpiQkv {
    static constexpr bool PERM = true; bf16_t* q; bf16_t* k; bf16_t* v; const float* rc; const float* rs;
    __device__ __forceinline__ void operator()(AccRef acc, const Unit& u, int wr, int wc, int fr, int fq) const {
        const bool rope = (u.pn <= 4) && ((wc & 1) == 0);
        bf16_t* base; int ld, colt; float scale = 1.0f;
        if (u.pn < 4) { base = q; ld = 1024; colt = u.pn * BM; scale = 0.125f * 1.4426950408889634f; } else if (u.pn == 4) { base = k; ld = 256; colt = 0; } else { base = v; ld = 256; colt = 0; }
#pragma unroll
        for (int ai = 0; ai < 2; ++ai)
#pragma unroll
            for (int m = 0; m < 4; ++m) { const int row = u.pm * BM + ai * HALF + wr * 64 + m * 16 + fr;
                f32x4 c0 = {1.f, 1.f, 1.f, 1.f}, c1 = c0, s0 = {0.f, 0.f, 0.f, 0.f}, s1 = s0;
                if (rope && fq < 2) { c0 = *(const f32x4*)(rc + (size_t)row * 8); c1 = *(const f32x4*)(rc + (size_t)row * 8 + 4); s0 = *(const f32x4*)(rs + (size_t)row * 8); s1 = *(const f32x4*)(rs + (size_t)row * 8 + 4);
                    if (fq == 0) { s0 = -s0; s1 = -s1; } }
#pragma unroll
                for (int bj = 0; bj < 2; ++bj) { f32x4 v0 = acc[ai][bj][m][0], v1 = acc[ai][bj][m][1];
                    if (rope) { f32x4 p0, p1;
#pragma unroll
                        for (int j = 0; j < 4; ++j) { p0[j] = __shfl_xor(v0[j], 16); p1[j] = __shfl_xor(v1[j], 16); }
                        v0 = v0 * c0 + p0 * s0; v1 = v1 * c1 + p1 * s1; }
                    v0 = v0 * scale; v1 = v1 * scale;
                    u32x4 w; w.x = pk_bf16(v0[0], v0[1]); w.y = pk_bf16(v0[2], v0[3]); w.z = pk_bf16(v1[0], v1[1]); w.w = pk_bf16(v1[2], v1[3]);
                    *(u32x4*)(base + (size_t)row * ld + colt + bj * HALF + wc * 32 + 8 * fq) = w; } }
    }
};
struct EpiBf16 {
    static constexpr bool PERM = true; bf16_t* o; int ld;
    __device__ __forceinline__ void operator()(AccRef acc, const Unit& u, int wr, int wc, int fr, int fq) const {
#pragma unroll
        for (int ai = 0; ai < 2; ++ai)
#pragma unroll
            for (int m = 0; m < 4; ++m) { const int row = u.pm * BM + ai * HALF + wr * 64 + m * 16 + fr;
#pragma unroll
                for (int bj = 0; bj < 2; ++bj) { const f32x4 v0 = acc[ai][bj][m][0], v1 = acc[ai][bj][m][1];
                    u32x4 w; w.x = pk_bf16(v0[0], v0[1]); w.y = pk_bf16(v0[2], v0[3]); w.z = pk_bf16(v1[0], v1[1]); w.w = pk_bf16(v1[2], v1[3]);
                    *(u32x4*)(o + (size_t)row * ld + u.pn * BM + bj * HALF + wc * 32 + 8 * fq) = w; } }
    }
};
struct EpiNull {
    static constexpr bool PERM = false; float* h;
    __device__ __forceinline__ void operator()(AccRef acc, const Unit& u, int wr, int wc, int fr, int fq) const {
        if (u.pm < 0) {
#pragma unroll
            for (int ai = 0; ai < 2; ++ai)
#pragma unroll
                for (int m = 0; m < 4; ++m)
#pragma unroll
                    for (int bj = 0; bj < 2; ++bj)
#pragma unroll
                        for (int n = 0; n < 2; ++n) *(f32x4*)(h + ((ai * 4 + m) * 4 + bj * 2 + n) * 256 + fr * 16 + fq * 4) = acc[ai][bj][m][n]; }
    }
};
}

__device__ __forceinline__ void transpose_tile(const float* __restrict__ src, int ld, int k0, int col0, bf16_t* __restrict__ dst, int Kd, int n0, float* tile) {
    const int tid = threadIdx.x;
#pragma unroll
    for (int i = 0; i < 8; ++i) { const int kk = (tid >> 6) + 8 * i, nn = tid & 63; tile[kk * 65 + nn] = src[(size_t)(k0 + kk) * ld + col0 + nn]; }
    __syncthreads();
    { const int n = tid >> 3, ks = (tid & 7) * 8; float r[8];
#pragma unroll
      for (int j = 0; j < 8; ++j) r[j] = tile[(ks + j) * 65 + n];
      u32x4 w; w.x = pk_bf16(r[0], r[1]); w.y = pk_bf16(r[2], r[3]); w.z = pk_bf16(r[4], r[5]); w.w = pk_bf16(r[6], r[7]);
      *(u32x4*)(dst + (size_t)(n0 + n) * Kd + k0 + ks) = w; }
    __syncthreads();
}

__device__ void ssm_tables(const Params& P, int g, unsigned char* lds) {
    const int tid = threadIdx.x;
    float* apr = (float*)lds;
    float* api = apr + 33 * 64;
    float* bbr = api + 33 * 64;
    float* bbi = bbr + 1024;
    float* ccr = bbi + 1024;
    float* cci = ccr + 1024;
    float* kg = cci + 1024;
    const float dtf = expf(P.log_step[g]);
    for (int idx = tid; idx < 33 * 64; idx += 512) { const int tau = idx >> 6, p = idx & 63;
        const float lr = P.lam_re[g * 64 + p], li = P.lam_im[g * 64 + p];
        const double dt = (double)dtf; double rev = (double)li * dt * (double)tau * 0.15915494309189535; rev -= floor(rev);
        const float ang = (float)(rev * 6.283185307179586); float sn, cs; sincosf(ang, &sn, &cs);
        const float mag = expf((float)((double)lr * dt * (double)tau));
        apr[idx] = mag * cs; api[idx] = mag * sn; }
    for (int idx = tid; idx < 1024; idx += 512) { ccr[idx] = P.c_re[g * 1024 + idx]; cci[idx] = P.c_im[g * 1024 + idx]; }
    __syncthreads();
    for (int idx = tid; idx < 1024; idx += 512) { const int p = idx >> 4;
        const float lr = P.lam_re[g * 64 + p], li = P.lam_im[g * 64 + p], ar = apr[64 + p], ai = api[64 + p];
        const float nr = ar - 1.0f, den = lr * lr + li * li, kr = (nr * lr + ai * li) / den, ki = (ai * lr - nr * li) / den;
        const float br = P.b_re[g * 1024 + idx], bi = P.b_im[g * 1024 + idx];
        bbr[idx] = kr * br - ki * bi; bbi[idx] = kr * bi + ki * br; }
    __syncthreads();
    { const int cp = tid & 15, c = (tid >> 4) & 15, t0 = tid >> 8;
      for (int i = 0; i < 16; ++i) { const int tau = t0 + 2 * i; float s = 0.f;
          for (int p = 0; p < 64; ++p) { const float cr = ccr[c * 64 + p], ci = cci[c * 64 + p], ar = apr[tau * 64 + p], ai = api[tau * 64 + p];
              const float zr = cr * ar - ci * ai, zi = cr * ai + ci * ar; s += zr * bbr[p * 16 + cp] - zi * bbi[p * 16 + cp]; }
          kg[(tau * 16 + c) * 16 + cp] = s; } }
    __syncthreads();
    bf16_t* bt2 = (bf16_t*)(P.ws + WS_BT2) + (size_t)g * 512 * 640;
    for (int pc = tid; pc < 512 * 80; pc += 512) { const int n = pc / 80, k8 = (pc % 80) * 8, t = n >> 4, c = n & 15; float r[8];
        if (k8 < 512) { const int s = k8 >> 4, c0 = k8 & 15;
#pragma unroll
            for (int j = 0; j < 8; ++j) r[j] = (t >= s) ? kg[((t - s) * 16 + c) * 16 + c0 + j] : 0.f;
        } else { const int q0 = k8 - 512;
#pragma unroll
            for (int j = 0; j < 8; j += 2) { const int p = (q0 + j) >> 1; const float cr = ccr[c * 64 + p], ci = cci[c * 64 + p], ar = apr[(t + 1) * 64 + p], ai = api[(t + 1) * 64 + p];
                r[j] = cr * ar - ci * ai; r[j + 1] = -(cr * ai + ci * ar); } }
        u32x4 w; w.x = pk_bf16(r[0], r[1]); w.y = pk_bf16(r[2], r[3]); w.z = pk_bf16(r[4], r[5]); w.w = pk_bf16(r[6], r[7]);
        *(u32x4*)(bt2 + (size_t)n * 640 + k8) = w; }
    bf16_t* bt1 = (bf16_t*)(P.ws + WS_BT1) + (size_t)g * 256 * 512;
    for (int pc = tid; pc < 256 * 64; pc += 512) { const int q = pc >> 6, k8 = (pc & 63) * 8; float r[8];
        if (q < 128) { const int p = q >> 1, s = k8 >> 4, c0 = k8 & 15; const float ar = apr[(31 - s) * 64 + p], ai = api[(31 - s) * 64 + p];
#pragma unroll
            for (int j = 0; j < 8; ++j) { const float br = bbr[p * 16 + c0 + j], bi = bbi[p * 16 + c0 + j]; r[j] = (q & 1) ? (ar * bi + ai * br) : (ar * br - ai * bi); }
        } else {
#pragma unroll
            for (int j = 0; j < 8; ++j) r[j] = 0.f; }
        u32x4 w; w.x = pk_bf16(r[0], r[1]); w.y = pk_bf16(r[2], r[3]); w.z = pk_bf16(r[4], r[5]); w.w = pk_bf16(r[6], r[7]);
        *(u32x4*)(bt1 + (size_t)q * 512 + k8) = w; }
    float* a32 = (float*)(P.ws + WS_A32);
    if (tid < 64) { a32[(g * 64 + tid) * 2] = apr[32 * 64 + tid]; a32[(g * 64 + tid) * 2 + 1] = api[32 * 64 + tid]; }
    __syncthreads();
}

__device__ void p0_prep(const Params& P, unsigned char* lds) {
    const int tid = threadIdx.x, G = gridDim.x;
    if (blockIdx.x == 0 && tid < 8) ((int*)(P.ws + WS_CNT))[tid] = 0;
    if (blockIdx.x == 0) for (int i = tid; i < XCD_BAR_WORDS; i += 512) ((unsigned*)(P.ws + WS_BAR))[i] = 0u;
    constexpr int J_SSM = 64, J_X = 512, J_ROPE = 512, J_T = 9408;
    constexpr int NJ = J_SSM + J_X + J_ROPE + J_T;
    for (int job = blockIdx.x; job < NJ; job += G) {
        if (job < J_SSM) {
#if LEVEL >= 1
            ssm_tables(P, job, lds);
#endif
        }
        else if (job < J_SSM + J_X) {
            const int r0 = (job - J_SSM) * 64; bf16_t* xa = (bf16_t*)(P.ws + WS_XA);
#pragma unroll 4
            for (int i = 0; i < 16; ++i) { const int piece = tid + 512 * i, r = r0 + (piece >> 7), c8 = (piece & 127) * 8;
                const f32x4 a = *(const f32x4*)(P.x + (size_t)r * 1024 + c8), b = *(const f32x4*)(P.x + (size_t)r * 1024 + c8 + 4);
                u32x4 w; w.x = pk_bf16(a[0], a[1]); w.y = pk_bf16(a[2], a[3]); w.z = pk_bf16(b[0], b[1]); w.w = pk_bf16(b[2], b[3]);
                *(u32x4*)(xa + ((size_t)(r >> 5) * 40 + (r & 31)) * 1024 + c8) = w;
#if LEVEL < 1
                *(f32x4*)(P.out + (size_t)r * 1024 + c8) = a; *(f32x4*)(P.out + (size_t)r * 1024 + c8 + 4) = b;
#endif
            }
        }
        else if (job < J_SSM + J_X + J_ROPE) {
            const int tok = (job - J_SSM - J_X) * 64 + (tid >> 3), i = tid & 7;
            const float invf[8] = {1.0f, 0.19392274474868576f, 0.03760603093086393f, 0.007292664737217109f, 0.001414213562373095f, 0.0002742481756762073f, 5.318295896944988e-05f, 1.031338537721246e-05f};
            float f = invf[0];
#pragma unroll
            for (int k = 1; k < 8; ++k) f = (i == k) ? invf[k] : f;
            const float ang = (float)P.pos[tok] * f; float sn, cs; sincosf(ang, &sn, &cs);
            ((float*)(P.ws + WS_ROPEC))[tok * 8 + i] = cs; ((float*)(P.ws + WS_ROPES))[tok * 8 + i] = sn;
        }
        else {
            int jt = job - J_SSM - J_X - J_ROPE; float* tile = (float*)lds;
            if (jt < 512) { const int kt = jt & 15, n0 = (jt >> 4) * 64, pn = n0 >> 8, s = (n0 >> 7) & 1, xo = n0 & 127;
                transpose_tile(P.w_glu, 2048, kt * 64, s * 1024 + 128 * pn + xo, (bf16_t*)(P.ws + WS_WGLU), 1024, n0, tile); }
            else if ((jt -= 512) < 1408) { const int kt = jt & 15, n0 = (jt >> 4) * 64, pn = n0 >> 8, s = (n0 >> 7) & 1, xo = n0 & 127;
                transpose_tile(s ? P.ffn_u : P.ffn_g, 2816, kt * 64, 128 * pn + xo, (bf16_t*)(P.ws + WS_WUP), 1024, n0, tile); }
            else if ((jt -= 1408) < 704) { const int kt = jt % 44, n0 = (jt / 44) * 64;
                transpose_tile(P.ffn_d, 1024, kt * 64, n0, (bf16_t*)(P.ws + WS_WDN), 2816, n0, tile); }
            else if ((jt -= 704) < 256) { const int kt = jt & 15, n0 = (jt >> 4) * 64;
                transpose_tile(P.w_q, 1024, kt * 64, n0, (bf16_t*)(P.ws + WS_WQKV), 1024, n0, tile); }
            else if ((jt -= 256) < 128) { const int kt = jt & 15, n0 = (jt >> 4) * 64;
                transpose_tile(P.kv_w, 512, kt * 64, n0, (bf16_t*)(P.ws + WS_WQKV), 1024, 1024 + n0, tile); }
            else if ((jt -= 128) < 256) { const int kt = jt & 15, n0 = (jt >> 4) * 64;
                transpose_tile(P.w_out, 1024, kt * 64, n0, (bf16_t*)(P.ws + WS_WO), 1024, n0, tile); }
            else if ((jt -= 256) < 4096) { const int e = jt >> 9, r = jt & 511, kt = r & 15, n0 = (r >> 4) * 64, pn = n0 >> 8, s = (n0 >> 7) & 1, xo = n0 & 127;
                transpose_tile((s ? P.moe_u : P.moe_g) + (size_t)e * 1048576, 1024, kt * 64, 128 * pn + xo, (bf16_t*)(P.ws + WS_WMUP) + (size_t)e * 2048 * 1024, 1024, n0, tile); }
            else { jt -= 4096; const int e = jt >> 8, r = jt & 255, kt = r & 15, n0 = (r >> 4) * 64;
                transpose_tile(P.moe_d + (size_t)e * 1048576, 1024, kt * 64, n0, (bf16_t*)(P.ws + WS_WMDN) + (size_t)e * 1048576, 1024, n0, tile); }
        }
    }
}

__device__ void p2_scan(const Params& P) {
    const float* sst = (const float*)(P.ws + WS_SST); const float* a32 = (const float*)(P.ws + WS_A32); bf16_t* xa = (bf16_t*)(P.ws + WS_XA);
    for (int idx = blockIdx.x * 512 + threadIdx.x; idx < 16 * 64 * 64; idx += gridDim.x * 512) {
        const int p = idx & 63, g = (idx >> 6) & 63, b = idx >> 12;
        const float ar = a32[(g * 64 + p) * 2], ai = a32[(g * 64 + p) * 2 + 1];
        float hr = 0.f, hi = 0.f;
        const int q = 2 * p;
#pragma unroll 8
        for (int j = 0; j < 64; ++j) { const int row = b * 64 + j;
            *(unsigned*)(xa + ((size_t)row * 40 + 32 + (q >> 4)) * 1024 + g * 16 + (q & 15)) = pk_bf16(hr, hi);
            const float2 s = *(const float2*)(sst + ((size_t)row * 64 + g) * 128 + q);
            const float nr = ar * hr - ai * hi + s.x, ni = ar * hi + ai * hr + s.y; hr = nr; hi = ni; }
    }
}

template <int MODE>
__device__ void ln_phase(const Params& P, const float* h, const float* gam, const float* bet, unsigned char* lds, float* hout, bf16_t* h16, const bf16_t* d16) {
    const int tid = threadIdx.x, wid = tid >> 6, lane = tid & 63;
    float* wrt = (float*)lds;
    int* cnt = (int*)(P.ws + WS_CNT); int* lists = (int*)(P.ws + WS_LIST); int* toki = (int*)(P.ws + WS_TOK);
    const bf16_t* Y = (const bf16_t*)(P.ws + WS_Y);
    int base[8];
    if (MODE == 1) { for (int k = 0; k < 16; ++k) { const int idx = tid + 512 * k; wrt[(idx & 7) * 1024 + (idx >> 3)] = P.w_router[idx]; } __syncthreads(); }
    if (MODE == 2) { int acc = 0;
#pragma unroll
        for (int e = 0; e < 8; ++e) { base[e] = acc; acc += ((cnt[e] + 255) >> 8) << 8; } }
    f32x4 gv[4], bv[4];
#pragma unroll
    for (int i = 0; i < 4; ++i) { gv[i] = *(const f32x4*)(gam + 256 * i + lane * 4); bv[i] = *(const f32x4*)(bet + 256 * i + lane * 4); }
    for (int row = blockIdx.x * 8 + wid; row < T_; row += gridDim.x * 8) {
        f32x4 v[4];
#pragma unroll
        for (int i = 0; i < 4; ++i) v[i] = *(const f32x4*)(h + (size_t)row * 1024 + 256 * i + lane * 4);
        if (MODE != 2 && d16 != nullptr) {
#pragma unroll
            for (int i = 0; i < 4; ++i) { const u32x2 a = *(const u32x2*)(d16 + (size_t)row * 1024 + 256 * i + lane * 4);
                v[i][0] = ALPHA * v[i][0] + bf_lo(a.x); v[i][1] = ALPHA * v[i][1] + bf_hi(a.x); v[i][2] = ALPHA * v[i][2] + bf_lo(a.y); v[i][3] = ALPHA * v[i][3] + bf_hi(a.y); }
        }
        if (MODE == 2) {
            const int e1 = toki[row * 8 + 0], p1 = toki[row * 8 + 1], e2 = toki[row * 8 + 2], p2 = toki[row * 8 + 3];
            const float w1 = __int_as_float(toki[row * 8 + 4]), w2 = __int_as_float(toki[row * 8 + 5]);
            int b1 = 0, b2 = 0;
#pragma unroll
            for (int e = 0; e < 8; ++e) { b1 = (e1 == e) ? base[e] : b1; b2 = (e2 == e) ? base[e] : b2; }
            const bf16_t* y1 = Y + (size_t)(b1 + p1) * 1024; const bf16_t* y2 = Y + (size_t)(b2 + p2) * 1024;
#pragma unroll
            for (int i = 0; i < 4; ++i) { const u32x2 a = *(const u32x2*)(y1 + 256 * i + lane * 4), b = *(const u32x2*)(y2 + 256 * i + lane * 4);
                v[i][0] = ALPHA * v[i][0] + (w1 * bf_lo(a.x) + w2 * bf_lo(b.x)); v[i][1] = ALPHA * v[i][1] + (w1 * bf_hi(a.x) + w2 * bf_hi(b.x));
                v[i][2] = ALPHA * v[i][2] + (w1 * bf_lo(a.y) + w2 * bf_lo(b.y)); v[i][3] = ALPHA * v[i][3] + (w1 * bf_hi(a.y) + w2 * bf_hi(b.y)); }
        }
        float s = 0.f;
#pragma unroll
        for (int i = 0; i < 4; ++i) s += (v[i][0] + v[i][1]) + (v[i][2] + v[i][3]);
        const float mu = wave_sum(s) * (1.0f / 1024.0f);
        float q = 0.f;
#pragma unroll
        for (int i = 0; i < 4; ++i) { v[i] = v[i] - mu; q += (v[i][0] * v[i][0] + v[i][1] * v[i][1]) + (v[i][2] * v[i][2] + v[i][3] * v[i][3]); }
        const float rstd = rsqrtf(wave_sum(q) * (1.0f / 1024.0f) + LN_EPS);
#pragma unroll
        for (int i = 0; i < 4; ++i) { v[i] = v[i] * rstd * gv[i] + bv[i]; *(f32x4*)(hout + (size_t)row * 1024 + 256 * i + lane * 4) = v[i];
            if (MODE != 2) { u32x2 w; w.x = pk_bf16(v[i][0], v[i][1]); w.y = pk_bf16(v[i][2], v[i][3]); *(u32x2*)(h16 + (size_t)row * 1024 + 256 * i + lane * 4) = w; } }
        if (MODE == 1) {
            float lg[8];
#pragma unroll
            for (int e = 0; e < 8; ++e) { float a = 0.f;
#pragma unroll
                for (int i = 0; i < 4; ++i) { const f32x4 w = *(const f32x4*)(wrt + e * 1024 + 256 * i + lane * 4); a += (v[i][0] * w[0] + v[i][1] * w[1]) + (v[i][2] * w[2] + v[i][3] * w[3]); }
                lg[e] = wave_sum(a) + P.b_router[e]; }
            int e1 = 0; float v1 = lg[0];
#pragma unroll
            for (int e = 1; e < 8; ++e) if (lg[e] > v1) { v1 = lg[e]; e1 = e; }
            int e2 = -1; float v2 = -3.0e38f;
#pragma unroll
            for (int e = 0; e < 8; ++e) if (e != e1 && lg[e] > v2) { v2 = lg[e]; e2 = e; }
            const float ex = __expf(v2 - v1), w1 = 1.0f / (1.0f + ex), w2 = ex / (1.0f + ex);
            if (lane == 0) { const int p1 = atomicAdd(cnt + e1, 1), p2 = atomicAdd(cnt + e2, 1);
                lists[e1 * T_ + p1] = row; lists[e2 * T_ + p2] = row;
                toki[row * 8 + 0] = e1; toki[row * 8 + 1] = p1; toki[row * 8 + 2] = e2; toki[row * 8 + 3] = p2; toki[row * 8 + 4] = __float_as_int(w1); toki[row * 8 + 5] = __float_as_int(w2); }
        }
    }
}

__device__ void gather_phase(const Params& P) {
    const int tid = threadIdx.x, wid = tid >> 6, lane = tid & 63;
    const int* cnt = (const int*)(P.ws + WS_CNT); const int* lists = (const int*)(P.ws + WS_LIST);
    const bf16_t* h16 = (const bf16_t*)(P.ws + WS_H16); bf16_t* ga = (bf16_t*)(P.ws + WS_GA);
    int base[9], c[8]; base[0] = 0;
#pragma unroll
    for (int e = 0; e < 8; ++e) { c[e] = cnt[e]; base[e + 1] = base[e] + (((c[e] + 255) >> 8) << 8); }
    for (int r = blockIdx.x * 8 + wid; r < base[8]; r += gridDim.x * 8) {
        int e = 0;
#pragma unroll
        for (int k = 1; k < 8; ++k) e += (r >= base[k]) ? 1 : 0;
        int be = 0, ce = 0;
#pragma unroll
        for (int k = 0; k < 8; ++k) { be = (e == k) ? base[k] : be; ce = (e == k) ? c[k] : ce; }
        const int pos = r - be; u32x4 a = {0u, 0u, 0u, 0u}, b = a;
        if (pos < ce) { const int tok = lists[e * T_ + pos]; a = *(const u32x4*)(h16 + (size_t)tok * 1024 + lane * 8); b = *(const u32x4*)(h16 + (size_t)tok * 1024 + 512 + lane * 8); }
        *(u32x4*)(ga + (size_t)r * 1024 + lane * 8) = a; *(u32x4*)(ga + (size_t)r * 1024 + 512 + lane * 8) = b;
    }
}

__device__ void attn_phase(const Params& P, unsigned char* lds) {
    const int tid = threadIdx.x, wid = tid >> 6, lane = tid & 63, n = lane & 31, hh = lane >> 5;
    bf16_t* Ks = (bf16_t*)lds;
    bf16_t* Vt = (bf16_t*)(lds + 256 * 144);
    const bf16_t* QB = (const bf16_t*)(P.ws + WS_BIG); const bf16_t* KB = (const bf16_t*)(P.ws + WS_BIG + 64 * MiB); const bf16_t* VB = (const bf16_t*)(P.ws + WS_BIG + 80 * MiB);
    bf16_t* OB = (bf16_t*)(P.ws + WS_BIG + 96 * MiB);
#ifdef DUP_ATT
    constexpr int NITEM = 2048;
#else
    constexpr int NITEM = 1024;
#endif
    for (int item = blockIdx.x; item < NITEM; item += gridDim.x) {
        const int kvh = item & 3, nb = (item >> 2) & 15, b = (item >> 6) & 15;
        const int tok0 = b * 2048 + nb * 128;
        __syncthreads();
#pragma unroll
        for (int i = 0; i < 4; ++i) { const int piece = tid + 512 * i, s = piece >> 3, pc = piece & 7; u32x4 v = {0u, 0u, 0u, 0u};
            if (nb > 0 || s >= 128) v = *(const u32x4*)(KB + (size_t)(tok0 - 128 + s) * 256 + kvh * 64 + pc * 8);
            *(u32x4*)(Ks + s * 72 + pc * 8) = v; }
#pragma unroll
        for (int i = 0; i < 2; ++i) { const int s = 2 * (tid & 127), pc = (tid >> 7) + 4 * i; u32x4 v0 = {0u, 0u, 0u, 0u}, v1 = v0;
            if (nb > 0 || s >= 128) { v0 = *(const u32x4*)(VB + (size_t)(tok0 - 128 + s) * 256 + kvh * 64 + pc * 8); v1 = *(const u32x4*)(VB + (size_t)(tok0 - 127 + s) * 256 + kvh * 64 + pc * 8); }
            unsigned* vt = (unsigned*)(Vt + (pc * 8) * 264 + s);
            vt[0 * 132] = (v0.x & 0xffffu) | (v1.x << 16); vt[1 * 132] = (v0.x >> 16) | (v1.x & 0xffff0000u);
            vt[2 * 132] = (v0.y & 0xffffu) | (v1.y << 16); vt[3 * 132] = (v0.y >> 16) | (v1.y & 0xffff0000u);
            vt[4 * 132] = (v0.z & 0xffffu) | (v1.z << 16); vt[5 * 132] = (v0.z >> 16) | (v1.z & 0xffff0000u);
            vt[6 * 132] = (v0.w & 0xffffu) | (v1.w << 16); vt[7 * 132] = (v0.w >> 16) | (v1.w & 0xffff0000u); }
        __syncthreads();
        const int hq = kvh * 4 + (wid >> 1);
        const float sink = P.sinks[hq] * 1.4426950408889634f;
#pragma unroll 1
        for (int qq = 0; qq < 2; ++qq) {
            const int kb0 = (wid & 1) * 2 + qq, i0 = 32 * kb0, qi = i0 + n;
            const bf16_t* qp = QB + (size_t)(tok0 + qi) * 1024 + hq * 64 + 8 * hh;
            bf16x8 qf[4];
#pragma unroll
            for (int ks = 0; ks < 4; ++ks) qf[ks] = *(const bf16x8*)(qp + 16 * ks);
            f32x16 sacc[5];
#pragma unroll
            for (int kb = 0; kb < 5; ++kb) {
#pragma unroll
                for (int i = 0; i < 16; ++i) sacc[kb][i] = 0.f;
                const bf16_t* kp = Ks + (32 * (kb0 + kb) + n) * 72 + 8 * hh;
#pragma unroll
                for (int ks = 0; ks < 4; ++ks) { const bf16x8 a = *(const bf16x8*)(kp + 16 * ks); sacc[kb] = __builtin_amdgcn_mfma_f32_32x32x16_bf16(a, qf[ks], sacc[kb], 0, 0, 0); }
                asm volatile("" ::: "memory"); }
            const int nn4 = n - 4 * hh;
#pragma unroll
            for (int i = 0; i < 16; ++i) { const int r = 8 * (i >> 2) + (i & 3);
                sacc[0][i] = (r > nn4) ? sacc[0][i] : -1.0e30f; sacc[4][i] = (r <= nn4) ? sacc[4][i] : -1.0e30f; }
            if (nb == 0) {
#pragma unroll
                for (int kb = 0; kb < 4; ++kb) if (kb0 + kb < 4) {
#pragma unroll
                    for (int i = 0; i < 16; ++i) sacc[kb][i] = -1.0e30f; } }
            float mx = sink;
#pragma unroll
            for (int kb = 0; kb < 5; ++kb)
#pragma unroll
                for (int i = 0; i < 16; ++i) mx = fmaxf(mx, sacc[kb][i]);
            mx = fmaxf(mx, __shfl_xor(mx, 32));
            float sum = 0.f;
#pragma unroll
            for (int kb = 0; kb < 5; ++kb)
#pragma unroll
                for (int i = 0; i < 16; ++i) { const float p = __builtin_amdgcn_exp2f(sacc[kb][i] - mx); sacc[kb][i] = p; sum += p; }
            sum += __shfl_xor(sum, 32); sum += __builtin_amdgcn_exp2f(sink - mx);
            f32x16 oacc[2];
#pragma unroll
            for (int i = 0; i < 16; ++i) { oacc[0][i] = 0.f; oacc[1][i] = 0.f; }
#pragma unroll
            for (int kb = 0; kb < 5; ++kb)
#pragma unroll
                for (int sl = 0; sl < 2; ++sl) {
                    union { u32x4 u; bf16x8 v; } pb;
                    pb.u.x = pk_bf16(sacc[kb][8 * sl + 0], sacc[kb][8 * sl + 1]); pb.u.y = pk_bf16(sacc[kb][8 * sl + 2], sacc[kb][8 * sl + 3]);
                    pb.u.z = pk_bf16(sacc[kb][8 * sl + 4], sacc[kb][8 * sl + 5]); pb.u.w = pk_bf16(sacc[kb][8 * sl + 6], sacc[kb][8 * sl + 7]);
#pragma unroll
                    for (int mb = 0; mb < 2; ++mb) { const bf16_t* vp = Vt + (32 * mb + n) * 264 + 32 * (kb0 + kb) + 16 * sl + 4 * hh;
                        union { u32x4 u; bf16x8 v; } va; const u32x2 lo = *(const u32x2*)vp, hi = *(const u32x2*)(vp + 8); va.u.x = lo.x; va.u.y = lo.y; va.u.z = hi.x; va.u.w = hi.y;
                        oacc[mb] = __builtin_amdgcn_mfma_f32_32x32x16_bf16(va.v, pb.v, oacc[mb], 0, 0, 0); }
                    asm volatile("" ::: "memory"); }
            const float inv = 1.0f / sum;
            bf16_t* op = OB + (size_t)(tok0 + qi) * 1024 + hq * 64 + 4 * hh;
#pragma unroll
            for (int mb = 0; mb < 2; ++mb)
#pragma unroll
                for (int g4 = 0; g4 < 4; ++g4) { u32x2 w; w.x = pk_bf16(oacc[mb][4 * g4 + 0] * inv, oacc[mb][4 * g4 + 1] * inv); w.y = pk_bf16(oacc[mb][4 * g4 + 2] * inv, oacc[mb][4 * g4 + 3] * inv);
                    *(u32x2*)(op + 32 * mb + 8 * g4) = w; }
        }
    }
}

#if defined(__HIP_DEVICE_COMPILE__)
typedef const Params __attribute__((address_space(4)))* KParams;
__device__ __forceinline__ Params load_params() { KParams p = (KParams)__builtin_amdgcn_kernarg_segment_ptr(); asm volatile("" : "+s"(p)); return *p; }
#else
__device__ __forceinline__ Params load_params() { return Params{}; }
#endif
#define LP const Params P = load_params(); unsigned char* const ws = P.ws; float* const H = P.out; (void)ws; (void)H
__global__ void __launch_bounds__(512, 2) yoco_fwd(Params P_arg) {
    extern __shared__ __attribute__((aligned(16))) unsigned char lds[];
    cg::grid_group grid = cg::this_grid();
    LAS unsigned char* ldsl = (LAS unsigned char*)lds;
    const int G = gridDim.x, c = blockIdx.x;
    if (threadIdx.x == 0) { ((LAS unsigned*)(ldsl + 131072))[0] = 0u; ((LAS unsigned*)(ldsl + 131072))[1] = 0u; }
    __syncthreads();
#define GSYNC() do { LP; xcd_barrier((unsigned*)(ws + WS_BAR), (volatile LAS unsigned*)(ldsl + 131072)); } while (0)

#ifdef PROF_A_HI
#define STAMP(k) do { LP; if (((k) == PROF_A_LO || (k) == PROF_A_HI || (k) == PROF_B_LO || (k) == PROF_B_HI) && blockIdx.x == 0 && threadIdx.x == 0) ((unsigned long long*)(P.ws + WS_CNT + 1024))[k] = __builtin_amdgcn_s_memrealtime(); } while (0)
#else
#define STAMP(k) do { } while (0)
#endif
    STAMP(0);
    { LP; p0_prep(P, lds); }
    grid.sync();
    { LP; if (threadIdx.x == 0) (void)xb_add(&((unsigned*)(ws + WS_BAR))[XB_XCNT(xb_xcc_id())], 1u); }
#ifdef DUP_SYNC
#pragma unroll 1
    for (int r = 0; r < 16; ++r) GSYNC();
#endif
#ifdef DUP_P0
    { LP; p0_prep(P, lds); }
    GSYNC();
#endif
    STAMP(1);
#if LEVEL >= 1
#pragma unroll 1
    for (int rep = 0; rep < NREP_S1; ++rep) {
    {   LP;
        pg8::SchedSsm S; S.init(256, 512, G, c); pg8::EpiS1 E{(float*)(ws + WS_SST)};
        pg8::gemm_phase(ldsl, (const char*)(ws + WS_XA), (const char*)(ws + WS_BT1), 512, S, E); }
    GSYNC(); } STAMP(2);
#pragma unroll 1
    for (int rep = 0; rep < NREP_SCAN; ++rep) {
    { LP; p2_scan(P); }
    GSYNC(); } STAMP(3);
#pragma unroll 1
    for (int rep = 0; rep < NREP_S2; ++rep) {
    {   LP;
        pg8::SchedSsm S; S.init(512, 640, G, c); pg8::EpiS2 E{(const bf16_t*)(ws + WS_XA), P.ssm_d, (bf16_t*)(ws + WS_BIG)};
        pg8::gemm_phase(ldsl, (const char*)(ws + WS_XA), (const char*)(ws + WS_BT2), 640, S, E); }
    GSYNC(); } STAMP(4);
#pragma unroll 1
    for (int rep = 0; rep < NREP_GLU; ++rep) {
    {   LP;
        pg8::SchedDense S; S.init(T_, 2048, 1024, 1024, G, c); pg8::EpiUp<1> E{(bf16_t*)(ws + WS_GA), 1024};
        pg8::gemm_phase(ldsl, (const char*)(ws + WS_BIG), (const char*)(ws + WS_WGLU), 1024, S, E); }
    GSYNC(); } STAMP(5);
#endif
    { LP; ln_phase<0>(P, (LEVEL >= 1) ? P.x : H, P.ln_g, P.ln_b, lds, H, (bf16_t*)(ws + WS_H16), (LEVEL >= 1) ? (const bf16_t*)(ws + WS_GA) : nullptr); }
    GSYNC(); STAMP(6);
#if LEVEL >= 2
#pragma unroll 1
    for (int rep = 0; rep < NREP_FUP; ++rep) {
    {   LP;
        pg8::SchedDense S; S.init(T_, 2 * FF_, 1024, 1024, G, c); pg8::EpiUp<0> E{(bf16_t*)(ws + WS_BIG), FF_};
        pg8::gemm_phase(ldsl, (const char*)(ws + WS_H16), (const char*)(ws + WS_WUP), 1024, S, E); }
    GSYNC(); } STAMP(7);
#pragma unroll 1
    for (int rep = 0; rep < NREP_FDN; ++rep) {
    {   LP;
#define NREP_CUR NREP_FDN
        pg8::SchedDense S; S.init(T_, 1024, FF_, FF_, G, c); pg8::EpiBf16 E{(bf16_t*)(ws + WS_GA), 1024};
        pg8::gemm_phase(ldsl, (const char*)(ws + WS_BIG), (const char*)(ws + WS_WDN), FF_, S, E); }
    GSYNC(); } STAMP(8);
#endif
    { LP; ln_phase<0>(P, H, P.ln_g + 1024, P.ln_b + 1024, lds, H, (bf16_t*)(ws + WS_H16), (LEVEL >= 2) ? (const bf16_t*)(ws + WS_GA) : nullptr); }
    GSYNC(); STAMP(9);
#if LEVEL >= 3
#pragma unroll 1
    for (int rep = 0; rep < NREP_QKV; ++rep) {
    {   LP;
        pg8::SchedDense S; S.init(T_, 1536, 1024, 1024, G, c);
        pg8::EpiQkv E{(bf16_t*)(ws + WS_BIG), (bf16_t*)(ws + WS_BIG + 64 * MiB), (bf16_t*)(ws + WS_BIG + 80 * MiB), (const float*)(ws + WS_ROPEC), (const float*)(ws + WS_ROPES)};
        pg8::gemm_phase(ldsl, (const char*)(ws + WS_H16), (const char*)(ws + WS_WQKV), 1024, S, E); }
    GSYNC(); } STAMP(10);
#ifndef SKIP_ATT
    { LP; attn_phase(P, lds); }
#endif
    GSYNC(); STAMP(11);
#pragma unroll 1
    for (int rep = 0; rep < NREP_OUT; ++rep) {
    {   LP;
#undef NREP_CUR
#define NREP_CUR NREP_OUT
        pg8::SchedDense S; S.init(T_, 1024, 1024, 1024, G, c);
        pg8::EpiBf16 E{(bf16_t*)(ws + WS_GA), 1024};
        pg8::gemm_phase(ldsl, (const char*)(ws + WS_BIG + 96 * MiB), (const char*)(ws + WS_WO), 1024, S, E); }
    GSYNC(); } STAMP(12);
#endif
#if LEVEL >= 4
    { LP; ln_phase<1>(P, H, P.ln_g + 2048, P.ln_b + 2048, lds, H, (bf16_t*)(ws + WS_H16), (const bf16_t*)(ws + WS_GA)); }
    GSYNC(); STAMP(13);
#pragma unroll 1
    for (int rep = 0; rep < NREP_GATH; ++rep) {
    { LP; gather_phase(P); }
    GSYNC(); } STAMP(14);
#pragma unroll 1
    for (int rep = 0; rep < NREP_MUP; ++rep) {
    {   LP;
        pg8::SchedMoe S; S.init((const int*)(ws + WS_CNT), 2048, 1024, (size_t)2048 * 1024 * 2, G, c); pg8::EpiUp<0> E{(bf16_t*)(ws + WS_BIG), 1024};
        pg8::gemm_phase(ldsl, (const char*)(ws + WS_GA), (const char*)(ws + WS_WMUP), 1024, S, E); }
    GSYNC(); } STAMP(15);
#pragma unroll 1
    for (int rep = 0; rep < NREP_MDN; ++rep) {
    {   LP;
        pg8::SchedMoe S; S.init((const int*)(ws + WS_CNT), 1024, 1024, (size_t)1024 * 1024 * 2, G, c); pg8::EpiBf16 E{(bf16_t*)(ws + WS_Y), 1024};
        pg8::gemm_phase(ldsl, (const char*)(ws + WS_BIG), (const char*)(ws + WS_WMDN), 1024, S, E); }
    GSYNC(); } STAMP(16);
    { LP; ln_phase<2>(P, H, P.ln_g + 3072, P.ln_b + 3072, lds, H, (bf16_t*)(ws + WS_H16), nullptr); }
#ifdef PROF_A_HI
    GSYNC(); STAMP(17);
    {   LP; const unsigned long long* stamps = (const unsigned long long*)(P.ws + WS_CNT + 1024);
        const float tA = (float)(stamps[PROF_A_HI] - stamps[PROF_A_LO]) * 0.01f, tB = (float)(stamps[PROF_B_HI] - stamps[PROF_B_LO]) * 0.01f;
        for (int i = blockIdx.x * 512 + threadIdx.x; i < (1 << 22); i += gridDim.x * 512) H[(size_t)i * 8 + 1] = tB;
        if (blockIdx.x == 0 && threadIdx.x == 0) H[0] = 64.0f * tA; }
#endif
#else
    { LP; ln_phase<0>(P, H, P.ln_g + 2048, P.ln_b + 2048, lds, H, (bf16_t*)(ws + WS_H16), (LEVEL >= 3) ? (const bf16_t*)(ws + WS_GA) : nullptr); }
    GSYNC(); STAMP(13);
    { LP; ln_phase<0>(P, H, P.ln_g + 3072, P.ln_b + 3072, lds, H, (bf16_t*)(ws + WS_H16), nullptr); }
#endif
}

extern "C" void kernel_launch(void* const* d_in, const int* in_sizes, int n_in, void* d_out, int out_size, void* d_ws, size_t ws_size, hipStream_t stream) {
    static int grid_blocks = 0;
    if (grid_blocks == 0) {
        if (n_in != 25 || out_size != T_ * D_ || ws_size < WS_END) { fprintf(stderr, "kernel_launch: unexpected shapes (n_in %d out %d ws %zu)\n", n_in, out_size, ws_size); grid_blocks = -1; return; }
        int dev = 0, cus = 0, per_cu = 0;
        hipGetDevice(&dev); hipDeviceGetAttribute(&cus, hipDeviceAttributeMultiprocessorCount, dev);
        if (hipFuncSetAttribute((const void*)yoco_fwd, hipFuncAttributeMaxDynamicSharedMemorySize, LDS_BYTES) != hipSuccess) { fprintf(stderr, "kernel_launch: hipFuncSetAttribute failed\n"); grid_blocks = -1; return; }
        if (hipOccupancyMaxActiveBlocksPerMultiprocessor(&per_cu, (const void*)yoco_fwd, 512, LDS_BYTES) != hipSuccess || per_cu < 1) { fprintf(stderr, "kernel_launch: occupancy query says %d\n", per_cu); per_cu = 1; (void)hipGetLastError(); }
        grid_blocks = cus * 1;
    }
    if (grid_blocks < 0) return;
    Params p{};
    p.x = (const float*)d_in[0]; p.pos = (const int*)d_in[1]; p.ln_g = (const float*)d_in[2]; p.ln_b = (const float*)d_in[3];
    p.lam_re = (const float*)d_in[4]; p.lam_im = (const float*)d_in[5]; p.log_step = (const float*)d_in[6]; p.b_re = (const float*)d_in[7]; p.b_im = (const float*)d_in[8];
    p.c_re = (const float*)d_in[9]; p.c_im = (const float*)d_in[10]; p.ssm_d = (const float*)d_in[11]; p.w_glu = (const float*)d_in[12]; p.kv_w = (const float*)d_in[13];
    p.w_q = (const float*)d_in[14]; p.sinks = (const float*)d_in[15]; p.w_out = (const float*)d_in[16]; p.ffn_g = (const float*)d_in[17]; p.ffn_u = (const float*)d_in[18]; p.ffn_d = (const float*)d_in[19];
    p.w_router = (const float*)d_in[20]; p.b_router = (const float*)d_in[21]; p.moe_g = (const float*)d_in[22]; p.moe_u = (const float*)d_in[23]; p.moe_d = (const float*)d_in[24];
    p.out = (float*)d_out; p.ws = (unsigned char*)d_ws;
    void* args[] = {&p};
    hipError_t e = hipLaunchCooperativeKernel((const void*)yoco_fwd, dim3(grid_blocks), dim3(512), args, LDS_BYTES, stream);
    if (e != hipSuccess) fprintf(stderr, "cooperative launch failed: %s (grid %d)\n", hipGetErrorString(e), grid_blocks);
}
```

```cpp
#include <hip/hip_runtime.h>
#include <hip/hip_cooperative_groups.h>
#include <cstdio>
namespace cg = cooperative_groups;

#ifndef LEVEL
#define LEVEL 4
#endif

#ifdef DUP_S1
#define NREP_S1 2
#else
#define NREP_S1 1
#endif
#ifdef DUP_S2
#define NREP_S2 2
#else
#define NREP_S2 1
#endif
#ifdef DUP_GLU
#define NREP_GLU 2
#else
#define NREP_GLU 1
#endif
#ifdef DUP_FUP
#define NREP_FUP 2
#else
#define NREP_FUP 1
#endif
#if defined(DUP_FDN) || defined(DUP_FDNNULL)
#define NREP_FDN 2
#else
#define NREP_FDN 1
#endif
#ifdef DUP_QKV
#define NREP_QKV 2
#else
#define NREP_QKV 1
#endif
#if defined(DUP_OUT) || defined(DUP_OUTNULL)
#define NREP_OUT 2
#else
#define NREP_OUT 1
#endif
#ifdef DUP_MUP
#define NREP_MUP 2
#else
#define NREP_MUP 1
#endif
#ifdef DUP_MDN
#define NREP_MDN 2
#else
#define NREP_MDN 1
#endif
#ifdef DUP_SCAN
#define NREP_SCAN 2
#else
#define NREP_SCAN 1
#endif
#ifdef DUP_GATH
#define NREP_GATH 2
#else
#define NREP_GATH 1
#endif
#ifdef DUP_OUTNULL
#define SKIP_EPI_OUT (rep == 0)
#else
#define SKIP_EPI_OUT false
#endif
#ifdef DUP_FDNNULL
#define SKIP_EPI_FDN (rep == 0)
#else
#define SKIP_EPI_FDN false
#endif
#define LAS __attribute__((address_space(3)))
typedef unsigned short bf16_t;
typedef short bf16x8 __attribute__((ext_vector_type(8)));
typedef float f32x4 __attribute__((ext_vector_type(4)));
typedef float f32x16 __attribute__((ext_vector_type(16)));
typedef unsigned u32x4 __attribute__((ext_vector_type(4)));
typedef unsigned u32x2 __attribute__((ext_vector_type(2)));

constexpr int T_ = 32768, D_ = 1024, FF_ = 2816;
constexpr float ALPHA = 1.41421356237309515f;
constexpr float LN_EPS = 1e-5f;
constexpr size_t MiB = 1ull << 20;
constexpr size_t WS_CNT = 0, WS_BAR = 4096, WS_A32 = 65536, WS_ROPEC = 1 * MiB, WS_ROPES = 2 * MiB, WS_LIST = 3 * MiB, WS_TOK = 4 * MiB;
constexpr size_t WS_WMUP = 8 * MiB, WS_WMDN = 40 * MiB, WS_WGLU = 56 * MiB, WS_WUP = 60 * MiB, WS_WDN = 71 * MiB, WS_WQKV = 77 * MiB, WS_WO = 80 * MiB;
constexpr size_t WS_H16 = 82 * MiB, WS_BT2 = 146 * MiB, WS_BT1 = 186 * MiB, WS_XA = 202 * MiB, WS_SST = 282 * MiB, WS_GA = 146 * MiB, WS_Y = 146 * MiB;
constexpr size_t WS_BIG = 314 * MiB, WS_END = 490 * MiB;
constexpr int LDS_BYTES = 131072 + 16;

struct Params {
    const float* x; const int* pos; const float* ln_g; const float* ln_b;
    const float* lam_re; const float* lam_im; const float* log_step; const float* b_re; const float* b_im; const float* c_re; const float* c_im;
    const float* ssm_d; const float* w_glu; const float* kv_w; const float* w_q; const float* sinks; const float* w_out;
    const float* ffn_g; const float* ffn_u; const float* ffn_d; const float* w_router; const float* b_router;
    const float* moe_g; const float* moe_u; const float* moe_d;
    float* out; unsigned char* ws;
};

__device__ __forceinline__ unsigned pk_bf16(float lo, float hi) { unsigned r; asm volatile("v_cvt_pk_bf16_f32 %0, %1, %2" : "=v"(r) : "v"(lo), "v"(hi)); return r; }
typedef _Float16 f16x8 __attribute__((ext_vector_type(8)));
typedef _Float16 f16x2 __attribute__((ext_vector_type(2)));
__device__ __forceinline__ unsigned pk_f16(float lo, float hi) { union { f16x2 h; unsigned u; } c; c.h = (f16x2){(_Float16)lo, (_Float16)hi}; return c.u; }
__device__ __forceinline__ float hf_lo(unsigned w) { union { unsigned u; f16x2 h; } c; c.u = w; return (float)c.h[0]; }
__device__ __forceinline__ float hf_hi(unsigned w) { union { unsigned u; f16x2 h; } c; c.u = w; return (float)c.h[1]; }
__device__ __forceinline__ float bf_lo(unsigned w) { return __uint_as_float(w << 16); }
__device__ __forceinline__ float bf_hi(unsigned w) { return __uint_as_float(w & 0xffff0000u); }
__device__ __forceinline__ float sigmoidf_(float x) { return __builtin_amdgcn_rcpf(1.0f + __expf(-x)); }
__device__ __forceinline__ float gelu_tanh(float y) { const float u = 1.5957691216057308f * (y + 0.044715f * y * y * y); return y * sigmoidf_(u); }
__device__ __forceinline__ float wave_sum(float v) {
    v += __shfl_xor(v, 32); v += __shfl_xor(v, 16); v += __shfl_xor(v, 8); v += __shfl_xor(v, 4); v += __shfl_xor(v, 2); v += __shfl_xor(v, 1); return v; }


#define XB_TMO      128
#define XB_XCNT(j)  (256  + 64 * (j))
#define XB_XSUB(j)  (1280 + 64 * (j))
#define XB_XGEN(j)  (2304 + 64 * (j))
#define XB_TOP      3328
#define XB_TOPGEN   3392
#define XCD_BAR_WORDS 3456
#define XB_SPIN_CAP (1u << 22)
__device__ __forceinline__ unsigned xb_ld(unsigned* p)              { return __hip_atomic_load(p, __ATOMIC_RELAXED, __HIP_MEMORY_SCOPE_AGENT); }
__device__ __forceinline__ unsigned xb_add(unsigned* p, unsigned v) { return __hip_atomic_fetch_add(p, v, __ATOMIC_RELAXED, __HIP_MEMORY_SCOPE_AGENT); }
__device__ __forceinline__ unsigned xb_xcc_id() { return (unsigned)__builtin_amdgcn_s_getreg((3 << 11) | 20) & 0xFu; }
#define XB_SPIN(cond, bar) do { unsigned _sp = 0; while (cond) { __builtin_amdgcn_s_sleep(1); \
    if ((++_sp & 255u) == 0u) { if (xb_ld(&(bar)[XB_TMO])) break; if (_sp > XB_SPIN_CAP) { atomicAdd(&(bar)[XB_TMO], 1u); break; } } } } while (0)
__device__ __forceinline__ void xcd_barrier_complete(unsigned* bar, unsigned x, unsigned& nloc, unsigned& nx) {
    const unsigned G = gridDim.x * gridDim.y * gridDim.z;
    unsigned sum, cnt, mine, sp = 0u;
    for (;;) {
        sum = 0u; cnt = 0u; mine = 0u;
#pragma unroll
        for (unsigned j = 0; j < 16; ++j) { const unsigned c = xb_ld(&bar[XB_XCNT(j)]); sum += c; cnt += (c > 0u) ? 1u : 0u; mine = (j == x) ? c : mine; }
        if (sum == G) break;
        __builtin_amdgcn_s_sleep(1);
        if ((++sp & 255u) == 0u) { if (xb_ld(&bar[XB_TMO])) break; if (sp > XB_SPIN_CAP) { atomicAdd(&bar[XB_TMO], 1u); break; } }
    }
    nloc = mine > 0u ? mine : 1u; nx = cnt > 0u ? cnt : 1u;
}
__device__ __forceinline__ void xcd_barrier(unsigned* bar, volatile LAS unsigned* st) {
    asm volatile("s_waitcnt vmcnt(0)" ::: "memory");
    __syncthreads();
    if (threadIdx.x == 0) {
        const unsigned x = xb_xcc_id();
        __builtin_amdgcn_s_waitcnt(0);
        unsigned nloc = st[0], nx = st[1];
        if (nloc == 0u) { xcd_barrier_complete(bar, x, nloc, nx); st[0] = nloc; st[1] = nx; }
        const unsigned old = xb_add(&bar[XB_XSUB(x)], 1u);
        const unsigned gen = old / nloc;
        if (old + 1u == (gen + 1u) * nloc) {
            __builtin_amdgcn_fence(__ATOMIC_RELEASE, "agent");
            asm volatile("s_waitcnt vmcnt(0)" ::: "memory");
            const unsigned og = xb_add(&bar[XB_TOP], 1u);
            const unsigned tg = og / nx;
            if (og + 1u == (tg + 1u) * nx) xb_add(&bar[XB_TOPGEN], 1u);
            else XB_SPIN(xb_ld(&bar[XB_TOPGEN]) == tg, bar);
            __builtin_amdgcn_fence(__ATOMIC_ACQUIRE, "agent");
            xb_add(&bar[XB_XGEN(x)], 1u);
            asm volatile("s_waitcnt vmcnt(0)" ::: "memory");
        } else {
            XB_SPIN(xb_ld(&bar[XB_XGEN(x)]) == gen, bar);
            __builtin_amdgcn_fence(__ATOMIC_ACQUIRE, "agent");
            asm volatile("s_waitcnt vmcnt(0)" ::: "memory");
        }
    }
    __syncthreads();
}

namespace pg8 {
constexpr int BM = 256, BK = 64, HALF = 128, HTB = HALF * BK * 2, NXCD = 8, WGM = 8;
__device__ __forceinline__ int lds_byte(int r, int c) { const int st = (r >> 4) * 2 + (c >> 5), rr = r & 15, cc = c & 31, ob = rr * 64 + cc * 2; return st * 1024 + (ob ^ (((ob >> 9) & 1) << 5)); }
__device__ __forceinline__ void stage_rc(int b, int& R, int& C) { const int st = b / 1024, sb = b % 1024, swz = sb ^ (((sb >> 9) & 1) << 5); R = (st >> 1) * 16 + swz / 64; C = (st & 1) * 32 + (swz % 64) / 2; }
__device__ __forceinline__ int perm32(int rho) { const int n = rho >> 4, i = rho & 15; return 8 * (i >> 2) + 4 * n + (i & 3); }
__device__ __forceinline__ int xcd_remap(int L, int nwg) { const int q = nwg / NXCD, r = nwg % NXCD, xcd = L % NXCD, off = L / NXCD; return (xcd < r ? xcd * (q + 1) : r * (q + 1) + (xcd - r) * q) + off; }

struct Unit { int pm, pn, aux, pad; size_t a_off, b_off; };

struct SchedDense {
    int nM, nN, nwg, G, c, lda, K;
    __device__ __forceinline__ void init(int M, int N, int K_, int lda_, int G_, int c_) { nM = M / BM; nN = N / BM; nwg = nM * nN; G = G_; c = c_; lda = lda_; K = K_; }
    __device__ __forceinline__ bool next(int i, Unit& u) const {
        const int L = i * G + c; if (L >= nwg) return false;
        const int wgid = xcd_remap(L, nwg);
        const int nig = WGM * nN, gid = wgid / nig, fm = gid * WGM, gsz = (nM - fm) < WGM ? (nM - fm) : WGM;
        u.pm = fm + ((wgid % nig) % gsz); u.pn = (wgid % nig) / gsz; u.aux = 0; u.pad = 0;
        u.a_off = (size_t)u.pm * BM * lda * 2; u.b_off = (size_t)u.pn * BM * K * 2; return true;
    }
    __device__ __forceinline__ unsigned voffA(int R, int C) const { return (unsigned)(R * lda + C) * 2u; }
    __device__ __forceinline__ size_t a_kstep() const { return BK * 2; }
    __device__ __forceinline__ size_t a_hstep() const { return (size_t)HALF * lda * 2; }
};
struct SchedMoe {
    int nM, nN, nwg, G, c, K; int tb[9]; size_t estride;
    __device__ __forceinline__ void init(const int* cnt, int N, int K_, size_t estride_, int G_, int c_) {
        tb[0] = 0;
#pragma unroll
        for (int e = 0; e < 8; ++e) tb[e + 1] = tb[e] + ((cnt[e] + 255) >> 8);
        nM = tb[8]; nN = N / BM; nwg = nM * nN; G = G_; c = c_; K = K_; estride = estride_; }
    __device__ __forceinline__ bool next(int i, Unit& u) const {
        const int L = i * G + c; if (L >= nwg) return false;
        const int wgid = xcd_remap(L, nwg);
        const int nig = WGM * nN, gid = wgid / nig, fm = gid * WGM, gsz = (nM - fm) < WGM ? (nM - fm) : WGM;
        u.pm = fm + ((wgid % nig) % gsz); u.pn = (wgid % nig) / gsz; int e = 0;
#pragma unroll
        for (int k = 1; k < 8; ++k) e += (u.pm >= tb[k]) ? 1 : 0;
        u.aux = e; u.pad = 0;
        u.a_off = (size_t)u.pm * BM * 1024 * 2; u.b_off = (size_t)e * estride + (size_t)u.pn * BM * K * 2; return true;
    }
    __device__ __forceinline__ unsigned voffA(int R, int C) const { return (unsigned)(R * 1024 + C) * 2u; }
    __device__ __forceinline__ size_t a_kstep() const { return BK * 2; }
    __device__ __forceinline__ size_t a_hstep() const { return (size_t)HALF * 1024 * 2; }
};
struct SchedSsm {
    int nN, nwg, G, c, K, N;
    __device__ __forceinline__ void init(int N_, int K_, int G_, int c_) { N = N_; nN = N_ / BM; nwg = 64 * 4 * nN; G = G_; c = c_; K = K_; }
    __device__ __forceinline__ bool next(int i, Unit& u) const {
        const int L = i * G + c; if (L >= nwg) return false;
        const int wgid = xcd_remap(L, nwg);
        const int per = 4 * nN, g = (wgid / (4 * per)) * 4 + (wgid & 3), rem = (wgid >> 2) % per;
        u.pm = rem & 3; u.pn = rem >> 2; u.aux = g; u.pad = 0;
        u.a_off = ((size_t)u.pm * BM * 40 * 1024 + (size_t)g * 16) * 2; u.b_off = (size_t)g * N * K * 2 + (size_t)u.pn * BM * K * 2; return true;
    }
    __device__ __forceinline__ unsigned voffA(int R, int C) const { return (unsigned)((R * 40 + (C >> 4)) * 1024 + (C & 15)) * 2u; }
    __device__ __forceinline__ size_t a_kstep() const { return 4 * 1024 * 2; }
    __device__ __forceinline__ size_t a_hstep() const { return (size_t)HALF * 40 * 1024 * 2; }
};

template <bool F16, class Epi, class Sched>
__device__ __forceinline__ void gemm_phase(LAS unsigned char* lds, const char* Ab, const char* Bb, const int K, const Sched& S, const Epi& E) {
    const int tid = threadIdx.x, wid = __builtin_amdgcn_readfirstlane(tid >> 6), lane = tid & 63, wr = wid >> 2, wc = wid & 3, fr = lane & 15, fq = lane >> 4;
    const int nt = K / BK;
    unsigned voffA[2], voffB[2];
#pragma unroll
    for (int i = 0; i < 2; ++i) { int R, C; stage_rc(tid * 16 + i * 8192, R, C); const int Rb = Epi::PERM ? ((R & ~31) + perm32(R & 31)) : R;
        voffA[i] = S.voffA(R, C); voffB[i] = (unsigned)(Rb * K + C) * 2u; }
    const size_t kstepA = S.a_kstep(), hstepA = S.a_hstep(), kstepB = (size_t)(BK * 2), hstepB = (size_t)HALF * K * 2;
    const unsigned ldsw = (unsigned)wid * 1024u;
    const int aoff = lds_byte(wr * 64 + fr, fq * 8), boff = lds_byte(wc * 32 + fr, fq * 8);
#define PG8_SA(b, h) (((b) * 2 + (h)) * HTB)
#define PG8_SB(b, h) ((4 + (b) * 2 + (h)) * HTB)
#define PG8_STAGE(bufoff, gbase, voff) do { _Pragma("unroll") for (int _i = 0; _i < 2; ++_i) \
        __builtin_amdgcn_global_load_lds((const unsigned*)((const char*)(gbase) + (voff)[_i]), (LAS unsigned*)(lds + (bufoff) + ldsw + _i * 8192), 16, 0, 0); } while (0)
#define PG8_LDA(dst, b, h) do { _Pragma("unroll") for (int m = 0; m < 4; ++m) _Pragma("unroll") for (int k = 0; k < 2; ++k) dst[m][k] = *(const LAS bf16x8*)(lds + PG8_SA(b, h) + aoff + m * 2048 + k * 1024); } while (0)
#define PG8_LDB(dst, b, h) do { _Pragma("unroll") for (int n = 0; n < 2; ++n) _Pragma("unroll") for (int k = 0; k < 2; ++k) dst[n][k] = *(const LAS bf16x8*)(lds + PG8_SB(b, h) + boff + n * 2048 + k * 1024); } while (0)
#define PG8_MMA(ai, bj, At, Bt) do { __builtin_amdgcn_s_setprio(1); _Pragma("unroll") for (int m = 0; m < 4; ++m) _Pragma("unroll") for (int n = 0; n < 2; ++n) _Pragma("unroll") for (int k = 0; k < 2; ++k) \
        acc[ai][bj][m][n] = F16 ? __builtin_amdgcn_mfma_f32_16x16x32_f16(__builtin_bit_cast(f16x8, Bt[n][k]), __builtin_bit_cast(f16x8, At[m][k]), acc[ai][bj][m][n], 0, 0, 0) : __builtin_amdgcn_mfma_f32_16x16x32_bf16(Bt[n][k], At[m][k], acc[ai][bj][m][n], 0, 0, 0); __builtin_amdgcn_s_setprio(0); } while (0)
#define PG8_WAIT_V(n) asm volatile("s_waitcnt vmcnt(" #n ")" ::: "memory")
#define PG8_WAIT_L(n) asm volatile("s_waitcnt lgkmcnt(" #n ")" ::: "memory")
#define PG8_BAR __builtin_amdgcn_s_barrier()
#define PG8_SCHED __builtin_amdgcn_sched_barrier(0)
    Unit cur, nxt; int ui = 0;
    if (!S.next(0, cur)) return;
    f32x4 acc[2][2][4][2];
#pragma unroll
    for (int a = 0; a < 2; ++a)
#pragma unroll
        for (int b = 0; b < 2; ++b)
#pragma unroll
            for (int m = 0; m < 4; ++m)
#pragma unroll
                for (int n = 0; n < 2; ++n) acc[a][b][m][n] = (f32x4){0.f, 0.f, 0.f, 0.f};
    bf16x8 At[4][2], B0[2][2], B1[2][2];
    const char* cA = Ab + cur.a_off; const char* cB = Bb + cur.b_off;
    PG8_STAGE(PG8_SB(0, 0), cB, voffB); PG8_STAGE(PG8_SA(0, 0), cA, voffA); PG8_STAGE(PG8_SB(0, 1), cB + hstepB, voffB); PG8_STAGE(PG8_SA(0, 1), cA + hstepA, voffA);
    if (wr == 1) PG8_BAR;
    PG8_WAIT_V(4); PG8_BAR;
    PG8_STAGE(PG8_SB(1, 0), cB + kstepB, voffB); PG8_STAGE(PG8_SA(1, 0), cA + kstepA, voffA); PG8_STAGE(PG8_SB(1, 1), cB + hstepB + kstepB, voffB);
    PG8_WAIT_V(6); PG8_BAR;
    for (;;) {
        const bool has_next = S.next(ui + 1, nxt);
        const char* nA = has_next ? Ab + nxt.a_off : cA; const char* nB = has_next ? Bb + nxt.b_off : cB;
        for (int t = 0; t < nt; t += 2) {
            const bool last = (t == nt - 2);
            const char* a1 = cA + (size_t)(t + 1) * kstepA;
            const char* a2 = last ? nA : cA + (size_t)(t + 2) * kstepA; const char* b2 = last ? nB : cB + (size_t)(t + 2) * kstepB;
            const char* a3 = a2 + kstepA; const char* b3 = b2 + kstepB;
            PG8_LDB(B0, 0, 0); PG8_SCHED; PG8_LDA(At, 0, 0); PG8_STAGE(PG8_SA(1, 1), a1 + hstepA, voffA);
            PG8_WAIT_L(8); PG8_BAR; PG8_WAIT_L(0); PG8_MMA(0, 0, At, B0); PG8_BAR; PG8_SCHED;
            PG8_LDB(B1, 0, 1); PG8_STAGE(PG8_SB(0, 0), b2, voffB);
            PG8_BAR; PG8_WAIT_L(0); PG8_MMA(0, 1, At, B1); PG8_BAR;
            PG8_LDA(At, 0, 1); PG8_STAGE(PG8_SA(0, 0), a2, voffA);
            PG8_BAR; PG8_WAIT_L(0); PG8_MMA(1, 0, At, B0); PG8_BAR; PG8_SCHED;
            PG8_STAGE(PG8_SB(0, 1), b2 + hstepB, voffB);
            PG8_WAIT_V(6); PG8_BAR; PG8_MMA(1, 1, At, B1); PG8_BAR;
            PG8_LDB(B0, 1, 0); PG8_SCHED; PG8_LDA(At, 1, 0); PG8_STAGE(PG8_SA(0, 1), a2 + hstepA, voffA);
            PG8_WAIT_L(8); PG8_BAR; PG8_WAIT_L(0); PG8_MMA(0, 0, At, B0); PG8_BAR; PG8_SCHED;
            PG8_LDB(B1, 1, 1); PG8_STAGE(PG8_SB(1, 0), b3, voffB);
            PG8_BAR; PG8_WAIT_L(0); PG8_MMA(0, 1, At, B1); PG8_BAR;
            PG8_LDA(At, 1, 1); PG8_STAGE(PG8_SA(1, 0), a3, voffA);
            PG8_BAR; PG8_WAIT_L(0); PG8_MMA(1, 0, At, B0); PG8_BAR; PG8_SCHED;
            PG8_STAGE(PG8_SB(1, 1), b3 + hstepB, voffB);
            PG8_WAIT_V(6); PG8_BAR; PG8_MMA(1, 1, At, B1); PG8_BAR;
        }
        E(acc, cur, wr, wc, fr, fq);
        if (!has_next) break;
#pragma unroll
        for (int a = 0; a < 2; ++a)
#pragma unroll
            for (int b = 0; b < 2; ++b)
#pragma unroll
                for (int m = 0; m < 4; ++m)
#pragma unroll
                    for (int n = 0; n < 2; ++n) acc[a][b][m][n] = (f32x4){0.f, 0.f, 0.f, 0.f};
        cur = nxt; cA = nA; cB = nB; ++ui;
    }
    PG8_WAIT_V(0);
    if (wr == 0) PG8_BAR;
    PG8_BAR;
#undef PG8_SA
#undef PG8_SB
#undef PG8_STAGE
#undef PG8_LDA
#undef PG8_LDB
#undef PG8_MMA
#undef PG8_WAIT_V
#undef PG8_WAIT_L
#undef PG8_BAR
#undef PG8_SCHED
}

typedef const f32x4 (&AccRef)[2][2][4][2];

struct EpiS1 {
    static constexpr bool PERM = false; float* sst;
    __device__ __forceinline__ void operator()(AccRef acc, const Unit& u, int wr, int wc, int fr, int fq) const {
#pragma unroll
        for (int ai = 0; ai < 2; ++ai)
#pragma unroll
            for (int m = 0; m < 4; ++m) { const int row = u.pm * BM + ai * HALF + wr * 64 + m * 16 + fr; float* rp = sst + ((size_t)row * 64 + u.aux) * 128 + wc * 32 + 4 * fq;
#pragma unroll
                for (int n = 0; n < 2; ++n) *(f32x4*)(rp + 16 * n) = acc[ai][0][m][n]; }
    }
};
struct EpiS2 {
    static constexpr bool PERM = true; const bf16_t* xa; const float* dsk; bf16_t* g16;
    __device__ __forceinline__ void operator()(AccRef acc, const Unit& u, int wr, int wc, int fr, int fq) const {
        const int ch = u.aux * 16 + 8 * (fq & 1);
        const f32x4 d0 = *(const f32x4*)(dsk + ch), d1 = *(const f32x4*)(dsk + ch + 4);
#pragma unroll
        for (int ai = 0; ai < 2; ++ai)
#pragma unroll
            for (int m = 0; m < 4; ++m) { const int row = u.pm * BM + ai * HALF + wr * 64 + m * 16 + fr;
#pragma unroll
                for (int bj = 0; bj < 2; ++bj) { const int t = 16 * u.pn + 8 * bj + 2 * wc + (fq >> 1);
                    const u32x4 xv = *(const u32x4*)(xa + ((size_t)row * 40 + t) * 1024 + ch);
                    const f32x4 x0 = {bf_lo(xv.x), bf_hi(xv.x), bf_lo(xv.y), bf_hi(xv.y)}, x1 = {bf_lo(xv.z), bf_hi(xv.z), bf_lo(xv.w), bf_hi(xv.w)};
                    const f32x4 y0 = acc[ai][bj][m][0] + d0 * x0, y1 = acc[ai][bj][m][1] + d1 * x1;
                    u32x4 w; w.x = pk_bf16(gelu_tanh(y0[0]), gelu_tanh(y0[1])); w.y = pk_bf16(gelu_tanh(y0[2]), gelu_tanh(y0[3]));
                    w.z = pk_bf16(gelu_tanh(y1[0]), gelu_tanh(y1[1])); w.w = pk_bf16(gelu_tanh(y1[2]), gelu_tanh(y1[3]));
                    *(u32x4*)(g16 + ((size_t)row * 32 + t) * 1024 + ch) = w; } }
    }
};
struct EpiGlu {
    static constexpr bool PERM = false; const float* x; float* out;
    __device__ __forceinline__ void operator()(AccRef acc, const Unit& u, int wr, int wc, int fr, int fq) const {
#pragma unroll
        for (int ai = 0; ai < 2; ++ai)
#pragma unroll
            for (int m = 0; m < 4; ++m) { const int row = u.pm * BM + ai * HALF + wr * 64 + m * 16 + fr; const size_t off = (size_t)row * 1024 + u.pn * 128 + wc * 32 + 4 * fq;
#pragma unroll
                for (int n = 0; n < 2; ++n) { const f32x4 xv = *(const f32x4*)(x + off + 16 * n); const f32x4 v = acc[ai][0][m][n], g = acc[ai][1][m][n]; f32x4 o;
#pragma unroll
                    for (int j = 0; j < 4; ++j) o[j] = ALPHA * xv[j] + v[j] * sigmoidf_(g[j]);
                    *(f32x4*)(out + off + 16 * n) = o; } }
    }
};
template <int ACT> struct EpiUp {
    static constexpr bool PERM = true; bf16_t* act; int ld;
    __device__ __forceinline__ void operator()(AccRef acc, const Unit& u, int wr, int wc, int fr, int fq) const {
#pragma unroll
        for (int ai = 0; ai < 2; ++ai)
#pragma unroll
            for (int m = 0; m < 4; ++m) { const int row = u.pm * BM + ai * HALF + wr * 64 + m * 16 + fr; float r[8];
#pragma unroll
                for (int n = 0; n < 2; ++n)
#pragma unroll
                    for (int j = 0; j < 4; ++j) { const float g = acc[ai][0][m][n][j], up = acc[ai][1][m][n][j]; r[4 * n + j] = (ACT == 0) ? g * sigmoidf_(g) * up : g * sigmoidf_(up); }
                u32x4 w; w.x = pk_bf16(r[0], r[1]); w.y = pk_bf16(r[2], r[3]); w.z = pk_bf16(r[4], r[5]); w.w = pk_bf16(r[6], r[7]);
                *(u32x4*)(act + (size_t)row * ld + u.pn * 128 + wc * 32 + 8 * fq) = w; }
    }
};
struct EpiRes {
    static constexpr bool PERM = false; const float* hin; float* h; bool skip;
    __device__ __forceinline__ void operator()(AccRef acc, const Unit& u, int wr, int wc, int fr, int fq) const {
        if (skip) return;
#pragma unroll
        for (int ai = 0; ai < 2; ++ai)
#pragma unroll
            for (int m = 0; m < 4; ++m) { const int row = u.pm * BM + ai * HALF + wr * 64 + m * 16 + fr; const size_t ro = (size_t)row * 1024 + u.pn * BM + wc * 32 + 4 * fq;
#pragma unroll
                for (int bj = 0; bj < 2; ++bj)
#pragma unroll
                    for (int n = 0; n < 2; ++n) { const size_t o = ro + bj * HALF + 16 * n; const f32x4 hv = *(const f32x4*)(hin + o); *(f32x4*)(h + o) = ALPHA * hv + acc[ai][bj][m][n]; } }
    }
};
struct EpiQkv {
    static constexpr bool PERM = true; bf16_t* q; bf16_t* k; bf16_t* v; const float* rc; const float* rs;
    __device__ __forceinline__ void operator()(AccRef acc, const Unit& u, int wr, int wc, int fr, int fq) const {
        const bool rope = (u.pn <= 4) && ((wc & 1) == 0);
        bf16_t* base; int ld, colt; float scale = 1.0f;
        if (u.pn < 4) { base = q; ld = 1024; colt = u.pn * BM; scale = 0.125f * 1.4426950408889634f; } else if (u.pn == 4) { base = k; ld = 256; colt = 0; } else { base = v; ld = 256; colt = 0; }
#pragma unroll
        for (int ai = 0; ai < 2; ++ai)
#pragma unroll
            for (int m = 0; m < 4; ++m) { const int row = u.pm * BM + ai * HALF + wr * 64 + m * 16 + fr;
                f32x4 c0 = {1.f, 1.f, 1.f, 1.f}, c1 = c0, s0 = {0.f, 0.f, 0.f, 0.f}, s1 = s0;
                if (rope && fq < 2) { c0 = *(const f32x4*)(rc + (size_t)row * 8); c1 = *(const f32x4*)(rc + (size_t)row * 8 + 4); s0 = *(const f32x4*)(rs + (size_t)row * 8); s1 = *(const f32x4*)(rs + (size_t)row * 8 + 4);
                    if (fq == 0) { s0 = -s0; s1 = -s1; } }
#pragma unroll
                for (int bj = 0; bj < 2; ++bj) { f32x4 v0 = acc[ai][bj][m][0], v1 = acc[ai][bj][m][1];
                    if (rope) { f32x4 p0, p1;
#pragma unroll
                        for (int j = 0; j < 4; ++j) { p0[j] = __shfl_xor(v0[j], 16); p1[j] = __shfl_xor(v1[j], 16); }
                        v0 = v0 * c0 + p0 * s0; v1 = v1 * c1 + p1 * s1; }
                    v0 = v0 * scale; v1 = v1 * scale;
                    u32x4 w; w.x = pk_bf16(v0[0], v0[1]); w.y = pk_bf16(v0[2], v0[3]); w.z = pk_bf16(v1[0], v1[1]); w.w = pk_bf16(v1[2], v1[3]);
                    *(u32x4*)(base + (size_t)row * ld + colt + bj * HALF + wc * 32 + 8 * fq) = w; } }
    }
};
struct EpiBf16 {
    static constexpr bool PERM = true; bf16_t* o; int ld;
    __device__ __forceinline__ void operator()(AccRef acc, const Unit& u, int wr, int wc, int fr, int fq) const {
#pragma unroll
        for (int ai = 0; ai < 2; ++ai)
#pragma unroll
            for (int m = 0; m < 4; ++m) { const int row = u.pm * BM + ai * HALF + wr * 64 + m * 16 + fr;
#pragma unroll
                for (int bj = 0; bj < 2; ++bj) { const f32x4 v0 = acc[ai][bj][m][0], v1 = acc[ai][bj][m][1];
                    u32x4 w; w.x = pk_bf16(v0[0], v0[1]); w.y = pk_bf16(v0[2], v0[3]); w.z = pk_bf16(v1[0], v1[1]); w.w = pk_bf16(v1[2], v1[3]);
                    *(u32x4*)(o + (size_t)row * ld + u.pn * BM + bj * HALF + wc * 32 + 8 * fq) = w; } }
    }
};
struct EpiNull {
    static constexpr bool PERM = false; float* h;
    __device__ __forceinline__ void operator()(AccRef acc, const Unit& u, int wr, int wc, int fr, int fq) const {
        if (u.pm < 0) {
#pragma unroll
            for (int ai = 0; ai < 2; ++ai)
#pragma unroll
                for (int m = 0; m < 4; ++m)
#pragma unroll
                    for (int bj = 0; bj < 2; ++bj)
#pragma unroll
                        for (int n = 0; n < 2; ++n) *(f32x4*)(h + ((ai * 4 + m) * 4 + bj * 2 + n) * 256 + fr * 16 + fq * 4) = acc[ai][bj][m][n]; }
    }
};
}

__device__ __forceinline__ void transpose_tile(const float* __restrict__ src0, const float* __restrict__ src1, int ld, int k0, int col0, int col1, bf16_t* __restrict__ dst, int Kd, int n0, float* tile, const bool f16 = false) {
    const int tid = threadIdx.x;
    { const int nn = (tid & 63) * 4, kb = tid >> 6;
      const float* sp = (nn < 128) ? (src0 + col0 + nn) : (src1 + col1 + (nn - 128));
      f32x4 v[8];
#pragma unroll
      for (int i = 0; i < 8; ++i) v[i] = *(const f32x4*)(sp + (size_t)(k0 + kb + 8 * i) * ld);
#pragma unroll
      for (int i = 0; i < 8; ++i) { float* t = tile + (kb + 8 * i) * 257 + nn; t[0] = v[i][0]; t[1] = v[i][1]; t[2] = v[i][2]; t[3] = v[i][3]; } }
    __syncthreads();
    { const int ks = (tid & 7) * 8;
#pragma unroll
      for (int i = 0; i < 4; ++i) { const int n = (tid >> 3) + 64 * i; float r[8];
#pragma unroll
          for (int j = 0; j < 8; ++j) r[j] = tile[(ks + j) * 257 + n];
          u32x4 w; if (f16) { w.x = pk_f16(r[0], r[1]); w.y = pk_f16(r[2], r[3]); w.z = pk_f16(r[4], r[5]); w.w = pk_f16(r[6], r[7]); } else { w.x = pk_bf16(r[0], r[1]); w.y = pk_bf16(r[2], r[3]); w.z = pk_bf16(r[4], r[5]); w.w = pk_bf16(r[6], r[7]); }
          *(u32x4*)(dst + (size_t)(n0 + n) * Kd + k0 + ks) = w; } }
    __syncthreads();
}

__device__ void ssm_tables(const Params& P, int g, int qtr, unsigned char* lds) {
    const int tid = threadIdx.x;
    float* apr = (float*)lds;
    float* api = apr + 33 * 64;
    float* bbr = api + 33 * 64;
    float* bbi = bbr + 1024;
    float* ccr = bbi + 1024;
    float* cci = ccr + 1024;
    float* kg = cci + 1024;
    const float dtf = expf(P.log_step[g]);
    for (int idx = tid; idx < 33 * 64; idx += 512) { const int tau = idx >> 6, p = idx & 63;
        const float lr = P.lam_re[g * 64 + p], li = P.lam_im[g * 64 + p];
        const double dt = (double)dtf; double rev = (double)li * dt * (double)tau * 0.15915494309189535; rev -= floor(rev);
        const float ang = (float)(rev * 6.283185307179586); float sn, cs; sincosf(ang, &sn, &cs);
        const float mag = expf((float)((double)lr * dt * (double)tau));
        apr[idx] = mag * cs; api[idx] = mag * sn; }
    for (int idx = tid; idx < 1024; idx += 512) { ccr[idx] = P.c_re[g * 1024 + idx]; cci[idx] = P.c_im[g * 1024 + idx]; }
    __syncthreads();
    for (int idx = tid; idx < 1024; idx += 512) { const int p = idx >> 4;
        const float lr = P.lam_re[g * 64 + p], li = P.lam_im[g * 64 + p], ar = apr[64 + p], ai = api[64 + p];
        const float nr = ar - 1.0f, den = lr * lr + li * li, kr = (nr * lr + ai * li) / den, ki = (ai * lr - nr * li) / den;
        const float br = P.b_re[g * 1024 + idx], bi = P.b_im[g * 1024 + idx];
        bbr[idx] = kr * br - ki * bi; bbi[idx] = kr * bi + ki * br; }
    __syncthreads();
    { const int cp = tid & 15, c = 4 * qtr + ((tid >> 4) & 3), t0 = tid >> 6;
      for (int i = 0; i < 4; ++i) { const int tau = t0 + 8 * i; float s = 0.f;
          for (int p = 0; p < 64; ++p) { const float cr = ccr[c * 64 + p], ci = cci[c * 64 + p], ar = apr[tau * 64 + p], ai = api[tau * 64 + p];
              const float zr = cr * ar - ci * ai, zi = cr * ai + ci * ar; s += zr * bbr[p * 16 + cp] - zi * bbi[p * 16 + cp]; }
          kg[(tau * 16 + c) * 16 + cp] = s; } }
    __syncthreads();
    bf16_t* bt2 = (bf16_t*)(P.ws + WS_BT2) + (size_t)g * 512 * 640;
    for (int pc = tid; pc < 128 * 80; pc += 512) { const int nq = pc / 80, k8 = (pc % 80) * 8, t = nq >> 2, c = 4 * qtr + (nq & 3), n = t * 16 + c; float r[8];
        if (k8 < 512) { const int s = k8 >> 4, c0 = k8 & 15;
#pragma unroll
            for (int j = 0; j < 8; ++j) r[j] = (t >= s) ? kg[((t - s) * 16 + c) * 16 + c0 + j] : 0.f;
        } else { const int q0 = k8 - 512;
#pragma unroll
            for (int j = 0; j < 8; j += 2) { const int p = (q0 + j) >> 1; const float cr = ccr[c * 64 + p], ci = cci[c * 64 + p], ar = apr[(t + 1) * 64 + p], ai = api[(t + 1) * 64 + p];
                r[j] = cr * ar - ci * ai; r[j + 1] = -(cr * ai + ci * ar); } }
        u32x4 w; w.x = pk_bf16(r[0], r[1]); w.y = pk_bf16(r[2], r[3]); w.z = pk_bf16(r[4], r[5]); w.w = pk_bf16(r[6], r[7]);
        *(u32x4*)(bt2 + (size_t)n * 640 + k8) = w; }
    bf16_t* bt1 = (bf16_t*)(P.ws + WS_BT1) + (size_t)g * 256 * 512;
    for (int pc = tid; pc < 64 * 64; pc += 512) { const int q = 64 * qtr + (pc >> 6), k8 = (pc & 63) * 8; float r[8];
        if (q < 128) { const int p = q >> 1, s = k8 >> 4, c0 = k8 & 15; const float ar = apr[(31 - s) * 64 + p], ai = api[(31 - s) * 64 + p];
#pragma unroll
            for (int j = 0; j < 8; ++j) { const float br = bbr[p * 16 + c0 + j], bi = bbi[p * 16 + c0 + j]; r[j] = (q & 1) ? (ar * bi + ai * br) : (ar * br - ai * bi); }
        } else {
#pragma unroll
            for (int j = 0; j < 8; ++j) r[j] = 0.f; }
        u32x4 w; w.x = pk_bf16(r[0], r[1]); w.y = pk_bf16(r[2], r[3]); w.z = pk_bf16(r[4], r[5]); w.w = pk_bf16(r[6], r[7]);
        *(u32x4*)(bt1 + (size_t)q * 512 + k8) = w; }
    float* a32 = (float*)(P.ws + WS_A32);
    if (qtr == 0 && tid < 64) { a32[(g * 64 + tid) * 2] = apr[32 * 64 + tid]; a32[(g * 64 + tid) * 2 + 1] = api[32 * 64 + tid]; }
    __syncthreads();
}

__device__ void p0_prep(const Params& P, unsigned char* lds, const int mask) {
    const int tid = threadIdx.x, G = gridDim.x;
    if ((mask & 16) && blockIdx.x == 0 && tid < 8) ((int*)(P.ws + WS_CNT))[tid] = 0;
    if ((mask & 16) && blockIdx.x == 0) for (int i = tid; i < XCD_BAR_WORDS; i += 512) ((unsigned*)(P.ws + WS_BAR))[i] = 0u;
    constexpr int J_SSM = 256, J_X = 512, J_ROPE = 512, J_T = 2352;
    constexpr int NJ = J_SSM + J_X + J_ROPE + J_T;
    for (int job = blockIdx.x; job < NJ; job += G) {
        if (job < J_SSM) {
#if LEVEL >= 1
            if (mask & 1) ssm_tables(P, job >> 2, job & 3, lds);
#endif
        }
        else if (job < J_SSM + J_X) { if (!(mask & 2)) continue;
            const int r0 = (job - J_SSM) * 64; bf16_t* xa = (bf16_t*)(P.ws + WS_XA);
#pragma unroll 4
            for (int i = 0; i < 16; ++i) { const int piece = tid + 512 * i, r = r0 + (piece >> 7), c8 = (piece & 127) * 8;
                const f32x4 a = *(const f32x4*)(P.x + (size_t)r * 1024 + c8), b = *(const f32x4*)(P.x + (size_t)r * 1024 + c8 + 4);
                u32x4 w; w.x = pk_bf16(a[0], a[1]); w.y = pk_bf16(a[2], a[3]); w.z = pk_bf16(b[0], b[1]); w.w = pk_bf16(b[2], b[3]);
                *(u32x4*)(xa + ((size_t)(r >> 5) * 40 + (r & 31)) * 1024 + c8) = w;
#if LEVEL < 1
                *(f32x4*)(P.out + (size_t)r * 1024 + c8) = a; *(f32x4*)(P.out + (size_t)r * 1024 + c8 + 4) = b;
#endif
            }
        }
        else if (job < J_SSM + J_X + J_ROPE) { if (!(mask & 4)) continue;
            const int tok = (job - J_SSM - J_X) * 64 + (tid >> 3), i = tid & 7;
            const float invf[8] = {1.0f, 0.19392274474868576f, 0.03760603093086393f, 0.007292664737217109f, 0.001414213562373095f, 0.0002742481756762073f, 5.318295896944988e-05f, 1.031338537721246e-05f};
            float f = invf[0];
#pragma unroll
            for (int k = 1; k < 8; ++k) f = (i == k) ? invf[k] : f;
            const float ang = (float)P.pos[tok] * f; float sn, cs; sincosf(ang, &sn, &cs);
            ((float*)(P.ws + WS_ROPEC))[tok * 8 + i] = cs; ((float*)(P.ws + WS_ROPES))[tok * 8 + i] = sn;
        }
        else {
            if (!(mask & 8)) continue;
            int jt = job - J_SSM - J_X - J_ROPE; float* tile = (float*)lds;
            if (jt < 128) { const int kt = jt & 15, pn = jt >> 4;
                transpose_tile(P.w_glu, P.w_glu, 2048, kt * 64, 128 * pn, 1024 + 128 * pn, (bf16_t*)(P.ws + WS_WGLU), 1024, 256 * pn, tile); }
            else if ((jt -= 128) < 352) { const int kt = jt & 15, pn = jt >> 4;
                transpose_tile(P.ffn_g, P.ffn_u, 2816, kt * 64, 128 * pn, 128 * pn, (bf16_t*)(P.ws + WS_WUP), 1024, 256 * pn, tile, true); }
            else if ((jt -= 352) < 176) { const int kt = jt % 44, pn = jt / 44;
                transpose_tile(P.ffn_d, P.ffn_d, 1024, kt * 64, 256 * pn, 256 * pn + 128, (bf16_t*)(P.ws + WS_WDN), 2816, 256 * pn, tile); }
            else if ((jt -= 176) < 64) { const int kt = jt & 15, pn = jt >> 4;
                transpose_tile(P.w_q, P.w_q, 1024, kt * 64, 256 * pn, 256 * pn + 128, (bf16_t*)(P.ws + WS_WQKV), 1024, 256 * pn, tile, true); }
            else if ((jt -= 64) < 32) { const int kt = jt & 15, pn = jt >> 4;
                transpose_tile(P.kv_w, P.kv_w, 512, kt * 64, 256 * pn, 256 * pn + 128, (bf16_t*)(P.ws + WS_WQKV), 1024, 1024 + 256 * pn, tile, true); }
            else if ((jt -= 32) < 64) { const int kt = jt & 15, pn = jt >> 4;
                transpose_tile(P.w_out, P.w_out, 1024, kt * 64, 256 * pn, 256 * pn + 128, (bf16_t*)(P.ws + WS_WO), 1024, 256 * pn, tile); }
            else if ((jt -= 64) < 1024) { const int e = jt >> 7, r = jt & 127, kt = r & 15, pn = r >> 4;
                transpose_tile(P.moe_g + (size_t)e * 1048576, P.moe_u + (size_t)e * 1048576, 1024, kt * 64, 128 * pn, 128 * pn, (bf16_t*)(P.ws + WS_WMUP) + (size_t)e * 2048 * 1024, 1024, 256 * pn, tile, true); }
            else { jt -= 1024; const int e = jt >> 6, r = jt & 63, kt = r & 15, pn = r >> 4;
                transpose_tile(P.moe_d + (size_t)e * 1048576, P.moe_d + (size_t)e * 1048576, 1024, kt * 64, 256 * pn, 256 * pn + 128, (bf16_t*)(P.ws + WS_WMDN) + (size_t)e * 1048576, 1024, 256 * pn, tile); }
        }
    }
}

__device__ void p2_scan(const Params& P) {
    const float* sst = (const float*)(P.ws + WS_SST); const float* a32 = (const float*)(P.ws + WS_A32); bf16_t* xa = (bf16_t*)(P.ws + WS_XA);
    for (int idx = blockIdx.x * 512 + threadIdx.x; idx < 16 * 64 * 64; idx += gridDim.x * 512) {
        const int p = idx & 63, g = (idx >> 6) & 63, b = idx >> 12;
        const float ar = a32[(g * 64 + p) * 2], ai = a32[(g * 64 + p) * 2 + 1];
        float hr = 0.f, hi = 0.f;
        const int q = 2 * p;
#pragma unroll 8
        for (int j = 0; j < 64; ++j) { const int row = b * 64 + j;
            *(unsigned*)(xa + ((size_t)row * 40 + 32 + (q >> 4)) * 1024 + g * 16 + (q & 15)) = pk_bf16(hr, hi);
            const float2 s = *(const float2*)(sst + ((size_t)row * 64 + g) * 128 + q);
            const float nr = ar * hr - ai * hi + s.x, ni = ar * hi + ai * hr + s.y; hr = nr; hi = ni; }
    }
}

template <int MODE, bool IN32>
__device__ void ln_phase(const Params& P, const float* h, const float* gam, const float* bet, unsigned char* lds, float* hout, bf16_t* h16, const bf16_t* d16) {
    const int tid = threadIdx.x, wid = tid >> 6, lane = tid & 63;
    float* wrt = (float*)lds;
    int* cnt = (int*)(P.ws + WS_CNT); int* lists = (int*)(P.ws + WS_LIST); int* toki = (int*)(P.ws + WS_TOK);
    const bf16_t* Y = (const bf16_t*)(P.ws + WS_Y);
    int base[8];
    if (MODE == 1) { for (int k = 0; k < 16; ++k) { const int idx = tid + 512 * k; wrt[(idx & 7) * 1024 + (idx >> 3)] = P.w_router[idx]; } __syncthreads(); }
    if (MODE == 2) { int acc = 0;
#pragma unroll
        for (int e = 0; e < 8; ++e) { base[e] = acc; acc += ((cnt[e] + 255) >> 8) << 8; } }
    f32x4 gv[4], bv[4];
#pragma unroll
    for (int i = 0; i < 4; ++i) { gv[i] = *(const f32x4*)(gam + 256 * i + lane * 4); bv[i] = *(const f32x4*)(bet + 256 * i + lane * 4); }
    for (int row = blockIdx.x * 8 + wid; row < T_; row += gridDim.x * 8) {
        f32x4 v[4];
        if (IN32) {
#pragma unroll
            for (int i = 0; i < 4; ++i) v[i] = *(const f32x4*)(h + (size_t)row * 1024 + 256 * i + lane * 4);
        } else {
#pragma unroll
            for (int i = 0; i < 4; ++i) { const u32x2 a = *(const u32x2*)(h16 + (size_t)row * 1024 + 256 * i + lane * 4); v[i] = (f32x4){hf_lo(a.x), hf_hi(a.x), hf_lo(a.y), hf_hi(a.y)}; }
        }
        if (MODE != 2 && d16 != nullptr) {
#pragma unroll
            for (int i = 0; i < 4; ++i) { const u32x2 a = *(const u32x2*)(d16 + (size_t)row * 1024 + 256 * i + lane * 4);
                v[i][0] = ALPHA * v[i][0] + bf_lo(a.x); v[i][1] = ALPHA * v[i][1] + bf_hi(a.x); v[i][2] = ALPHA * v[i][2] + bf_lo(a.y); v[i][3] = ALPHA * v[i][3] + bf_hi(a.y); }
        }
        if (MODE == 2) {
            const int e1 = toki[row * 8 + 0], p1 = toki[row * 8 + 1], e2 = toki[row * 8 + 2], p2 = toki[row * 8 + 3];
            const float w1 = __int_as_float(toki[row * 8 + 4]), w2 = __int_as_float(toki[row * 8 + 5]);
            int b1 = 0, b2 = 0;
#pragma unroll
            for (int e = 0; e < 8; ++e) { b1 = (e1 == e) ? base[e] : b1; b2 = (e2 == e) ? base[e] : b2; }
            const bf16_t* y1 = Y + (size_t)(b1 + p1) * 1024; const bf16_t* y2 = Y + (size_t)(b2 + p2) * 1024;
#pragma unroll
            for (int i = 0; i < 4; ++i) { const u32x2 a = *(const u32x2*)(y1 + 256 * i + lane * 4), b = *(const u32x2*)(y2 + 256 * i + lane * 4);
                v[i][0] = ALPHA * v[i][0] + (w1 * bf_lo(a.x) + w2 * bf_lo(b.x)); v[i][1] = ALPHA * v[i][1] + (w1 * bf_hi(a.x) + w2 * bf_hi(b.x));
                v[i][2] = ALPHA * v[i][2] + (w1 * bf_lo(a.y) + w2 * bf_lo(b.y)); v[i][3] = ALPHA * v[i][3] + (w1 * bf_hi(a.y) + w2 * bf_hi(b.y)); }
        }
        float s = 0.f;
#pragma unroll
        for (int i = 0; i < 4; ++i) s += (v[i][0] + v[i][1]) + (v[i][2] + v[i][3]);
        const float mu = wave_sum(s) * (1.0f / 1024.0f);
        float q = 0.f;
#pragma unroll
        for (int i = 0; i < 4; ++i) { v[i] = v[i] - mu; q += (v[i][0] * v[i][0] + v[i][1] * v[i][1]) + (v[i][2] * v[i][2] + v[i][3] * v[i][3]); }
        const float rstd = rsqrtf(wave_sum(q) * (1.0f / 1024.0f) + LN_EPS);
#pragma unroll
        for (int i = 0; i < 4; ++i) { v[i] = v[i] * rstd * gv[i] + bv[i]; if (MODE == 2) *(f32x4*)(hout + (size_t)row * 1024 + 256 * i + lane * 4) = v[i];
            if (MODE != 2) { u32x2 w; w.x = pk_f16(v[i][0], v[i][1]); w.y = pk_f16(v[i][2], v[i][3]); *(u32x2*)(h16 + (size_t)row * 1024 + 256 * i + lane * 4) = w; } }
        if (MODE == 1) {
            float lg[8];
#pragma unroll
            for (int e = 0; e < 8; ++e) { float a = 0.f;
#pragma unroll
                for (int i = 0; i < 4; ++i) { const f32x4 w = *(const f32x4*)(wrt + e * 1024 + 256 * i + lane * 4); a += (v[i][0] * w[0] + v[i][1] * w[1]) + (v[i][2] * w[2] + v[i][3] * w[3]); }
                lg[e] = wave_sum(a) + P.b_router[e]; }
            int e1 = 0; float v1 = lg[0];
#pragma unroll
            for (int e = 1; e < 8; ++e) if (lg[e] > v1) { v1 = lg[e]; e1 = e; }
            int e2 = -1; float v2 = -3.0e38f;
#pragma unroll
            for (int e = 0; e < 8; ++e) if (e != e1 && lg[e] > v2) { v2 = lg[e]; e2 = e; }
            const float ex = __expf(v2 - v1), w1 = 1.0f / (1.0f + ex), w2 = ex / (1.0f + ex);
            if (lane == 0) { const int p1 = atomicAdd(cnt + e1, 1), p2 = atomicAdd(cnt + e2, 1);
                lists[e1 * T_ + p1] = row; lists[e2 * T_ + p2] = row;
                toki[row * 8 + 0] = e1; toki[row * 8 + 1] = p1; toki[row * 8 + 2] = e2; toki[row * 8 + 3] = p2; toki[row * 8 + 4] = __float_as_int(w1); toki[row * 8 + 5] = __float_as_int(w2); }
        }
    }
}

__device__ void gather_phase(const Params& P) {
    const int tid = threadIdx.x, wid = tid >> 6, lane = tid & 63;
    const int* cnt = (const int*)(P.ws + WS_CNT); const int* lists = (const int*)(P.ws + WS_LIST);
    const bf16_t* h16 = (const bf16_t*)(P.ws + WS_H16); bf16_t* ga = (bf16_t*)(P.ws + WS_GA);
    int base[9], c[8]; base[0] = 0;
#pragma unroll
    for (int e = 0; e < 8; ++e) { c[e] = cnt[e]; base[e + 1] = base[e] + (((c[e] + 255) >> 8) << 8); }
    for (int r = blockIdx.x * 8 + wid; r < base[8]; r += gridDim.x * 8) {
        int e = 0;
#pragma unroll
        for (int k = 1; k < 8; ++k) e += (r >= base[k]) ? 1 : 0;
        int be = 0, ce = 0;
#pragma unroll
        for (int k = 0; k < 8; ++k) { be = (e == k) ? base[k] : be; ce = (e == k) ? c[k] : ce; }
        const int pos = r - be; u32x4 a = {0u, 0u, 0u, 0u}, b = a;
        if (pos < ce) { const int tok = lists[e * T_ + pos]; a = *(const u32x4*)(h16 + (size_t)tok * 1024 + lane * 8); b = *(const u32x4*)(h16 + (size_t)tok * 1024 + 512 + lane * 8); }
        *(u32x4*)(ga + (size_t)r * 1024 + lane * 8) = a; *(u32x4*)(ga + (size_t)r * 1024 + 512 + lane * 8) = b;
    }
}

__device__ void attn_phase(const Params& P, unsigned char* lds) {
    const int tid = threadIdx.x, wid = tid >> 6, lane = tid & 63, n = lane & 31, hh = lane >> 5;
    bf16_t* Ks = (bf16_t*)lds;
    bf16_t* Vt = (bf16_t*)(lds + 256 * 144);
    const bf16_t* QB = (const bf16_t*)(P.ws + WS_BIG); const bf16_t* KB = (const bf16_t*)(P.ws + WS_BIG + 64 * MiB); const bf16_t* VB = (const bf16_t*)(P.ws + WS_BIG + 80 * MiB);
    bf16_t* OB = (bf16_t*)(P.ws + WS_BIG + 96 * MiB);
#ifdef DUP_ATT
    constexpr int NITEM = 2048;
#else
    constexpr int NITEM = 1024;
#endif
    for (int item = blockIdx.x; item < NITEM; item += gridDim.x) {
        const int kvh = item & 3, nb = (item >> 2) & 15, b = (item >> 6) & 15;
        const int tok0 = b * 2048 + nb * 128;
        __syncthreads();
#pragma unroll
        for (int i = 0; i < 4; ++i) { const int piece = tid + 512 * i, s = piece >> 3, pc = piece & 7; u32x4 v = {0u, 0u, 0u, 0u};
            if (nb > 0 || s >= 128) v = *(const u32x4*)(KB + (size_t)(tok0 - 128 + s) * 256 + kvh * 64 + pc * 8);
            *(u32x4*)(Ks + s * 72 + pc * 8) = v; }
#pragma unroll
        for (int i = 0; i < 2; ++i) { const int s = 2 * (tid & 127), pc = (tid >> 7) + 4 * i; u32x4 v0 = {0u, 0u, 0u, 0u}, v1 = v0;
            if (nb > 0 || s >= 128) { v0 = *(const u32x4*)(VB + (size_t)(tok0 - 128 + s) * 256 + kvh * 64 + pc * 8); v1 = *(const u32x4*)(VB + (size_t)(tok0 - 127 + s) * 256 + kvh * 64 + pc * 8); }
            unsigned* vt = (unsigned*)(Vt + (pc * 8) * 264 + s);
            vt[0 * 132] = (v0.x & 0xffffu) | (v1.x << 16); vt[1 * 132] = (v0.x >> 16) | (v1.x & 0xffff0000u);
            vt[2 * 132] = (v0.y & 0xffffu) | (v1.y << 16); vt[3 * 132] = (v0.y >> 16) | (v1.y & 0xffff0000u);
            vt[4 * 132] = (v0.z & 0xffffu) | (v1.z << 16); vt[5 * 132] = (v0.z >> 16) | (v1.z & 0xffff0000u);
            vt[6 * 132] = (v0.w & 0xffffu) | (v1.w << 16); vt[7 * 132] = (v0.w >> 16) | (v1.w & 0xffff0000u); }
        __syncthreads();
        const int hq = kvh * 4 + (wid >> 1);
        const float sink = P.sinks[hq] * 1.4426950408889634f;
#pragma unroll 1
        for (int qq = 0; qq < 2; ++qq) {
            const int kb0 = (wid & 1) * 2 + qq, i0 = 32 * kb0, qi = i0 + n;
            const bf16_t* qp = QB + (size_t)(tok0 + qi) * 1024 + hq * 64 + 8 * hh;
            bf16x8 qf[4];
#pragma unroll
            for (int ks = 0; ks < 4; ++ks) qf[ks] = *(const bf16x8*)(qp + 16 * ks);
            f32x16 sacc[5];
#pragma unroll
            for (int kb = 0; kb < 5; ++kb) {
#pragma unroll
                for (int i = 0; i < 16; ++i) sacc[kb][i] = 0.f;
                const bf16_t* kp = Ks + (32 * (kb0 + kb) + n) * 72 + 8 * hh;
#pragma unroll
                for (int ks = 0; ks < 4; ++ks) { const bf16x8 a = *(const bf16x8*)(kp + 16 * ks); sacc[kb] = __builtin_amdgcn_mfma_f32_32x32x16_bf16(a, qf[ks], sacc[kb], 0, 0, 0); }
                asm volatile("" ::: "memory"); }
            const int nn4 = n - 4 * hh;
#pragma unroll
            for (int i = 0; i < 16; ++i) { const int r = 8 * (i >> 2) + (i & 3);
                sacc[0][i] = (r > nn4) ? sacc[0][i] : -1.0e30f; sacc[4][i] = (r <= nn4) ? sacc[4][i] : -1.0e30f; }
            if (nb == 0) {
#pragma unroll
                for (int kb = 0; kb < 4; ++kb) if (kb0 + kb < 4) {
#pragma unroll
                    for (int i = 0; i < 16; ++i) sacc[kb][i] = -1.0e30f; } }
            float mx = sink;
#pragma unroll
            for (int kb = 0; kb < 5; ++kb)
#pragma unroll
                for (int i = 0; i < 16; ++i) mx = fmaxf(mx, sacc[kb][i]);
            mx = fmaxf(mx, __shfl_xor(mx, 32));
            float sum = 0.f;
#pragma unroll
            for (int kb = 0; kb < 5; ++kb)
#pragma unroll
                for (int i = 0; i < 16; ++i) { const float p = __builtin_amdgcn_exp2f(sacc[kb][i] - mx); sacc[kb][i] = p; sum += p; }
            sum += __shfl_xor(sum, 32); sum += __builtin_amdgcn_exp2f(sink - mx);
            f32x16 oacc[2];
#pragma unroll
            for (int i = 0; i < 16; ++i) { oacc[0][i] = 0.f; oacc[1][i] = 0.f; }
#pragma unroll
            for (int kb = 0; kb < 5; ++kb)
#pragma unroll
                for (int sl = 0; sl < 2; ++sl) {
                    union { u32x4 u; bf16x8 v; } pb;
                    pb.u.x = pk_bf16(sacc[kb][8 * sl + 0], sacc[kb][8 * sl + 1]); pb.u.y = pk_bf16(sacc[kb][8 * sl + 2], sacc[kb][8 * sl + 3]);
                    pb.u.z = pk_bf16(sacc[kb][8 * sl + 4], sacc[kb][8 * sl + 5]); pb.u.w = pk_bf16(sacc[kb][8 * sl + 6], sacc[kb][8 * sl + 7]);
#pragma unroll
                    for (int mb = 0; mb < 2; ++mb) { const bf16_t* vp = Vt + (32 * mb + n) * 264 + 32 * (kb0 + kb) + 16 * sl + 4 * hh;
                        union { u32x4 u; bf16x8 v; } va; const u32x2 lo = *(const u32x2*)vp, hi = *(const u32x2*)(vp + 8); va.u.x = lo.x; va.u.y = lo.y; va.u.z = hi.x; va.u.w = hi.y;
                        oacc[mb] = __builtin_amdgcn_mfma_f32_32x32x16_bf16(va.v, pb.v, oacc[mb], 0, 0, 0); }
                    asm volatile("" ::: "memory"); }
            const float inv = 1.0f / sum;
            bf16_t* op = OB + (size_t)(tok0 + qi) * 1024 + hq * 64 + 4 * hh;
#pragma unroll
            for (int mb = 0; mb < 2; ++mb)
#pragma unroll
                for (int g4 = 0; g4 < 4; ++g4) { u32x2 w; w.x = pk_bf16(oacc[mb][4 * g4 + 0] * inv, oacc[mb][4 * g4 + 1] * inv); w.y = pk_bf16(oacc[mb][4 * g4 + 2] * inv, oacc[mb][4 * g4 + 3] * inv);
                    *(u32x2*)(op + 32 * mb + 8 * g4) = w; }
        }
    }
}

#if defined(__HIP_DEVICE_COMPILE__)
typedef const Params __attribute__((address_space(4)))* KParams;
__device__ __forceinline__ Params load_params() { KParams p = (KParams)__builtin_amdgcn_kernarg_segment_ptr(); asm volatile("" : "+s"(p)); return *p; }
#else
__device__ __forceinline__ Params load_params() { return Params{}; }
#endif
#define LP const Params P = load_params(); unsigned char* const ws = P.ws; float* const H = P.out; (void)ws; (void)H
__global__ void __launch_bounds__(512, 2) yoco_fwd(Params P_arg) {
    extern __shared__ __attribute__((aligned(16))) unsigned char lds[];
    cg::grid_group grid = cg::this_grid();
    LAS unsigned char* ldsl = (LAS unsigned char*)lds;
    const int G = gridDim.x, c = blockIdx.x;
    if (threadIdx.x == 0) { ((LAS unsigned*)(ldsl + 131072))[0] = 0u; ((LAS unsigned*)(ldsl + 131072))[1] = 0u; }
    __syncthreads();
#define GSYNC() do { LP; xcd_barrier((unsigned*)(ws + WS_BAR), (volatile LAS unsigned*)(ldsl + 131072)); } while (0)

#ifdef PROF_A_HI
#define STAMP(k) do { LP; if (((k) == PROF_A_LO || (k) == PROF_A_HI || (k) == PROF_B_LO || (k) == PROF_B_HI) && blockIdx.x == 0 && threadIdx.x == 0) ((unsigned long long*)(P.ws + WS_CNT + 1024))[k] = __builtin_amdgcn_s_memrealtime(); } while (0)
#else
#define STAMP(k) do { } while (0)
#endif
    STAMP(0);
    { LP; p0_prep(P, lds, 31); }
    grid.sync();
    { LP; if (threadIdx.x == 0) (void)xb_add(&((unsigned*)(ws + WS_BAR))[XB_XCNT(xb_xcc_id())], 1u); }
#ifdef DUP_SYNC
#pragma unroll 1
    for (int r = 0; r < 16; ++r) GSYNC();
#endif
#ifdef DUP_P0
    { LP; p0_prep(P, lds, DUP_P0); }
    GSYNC();
#endif
    STAMP(1);
#if LEVEL >= 1
#pragma unroll 1
    for (int rep = 0; rep < NREP_S1; ++rep) {
    {   LP;
        pg8::SchedSsm S; S.init(256, 512, G, c); pg8::EpiS1 E{(float*)(ws + WS_SST)};
        pg8::gemm_phase<false>(ldsl, (const char*)(ws + WS_XA), (const char*)(ws + WS_BT1), 512, S, E); }
    GSYNC(); } STAMP(2);
#pragma unroll 1
    for (int rep = 0; rep < NREP_SCAN; ++rep) {
    { LP; p2_scan(P); }
    GSYNC(); } STAMP(3);
#pragma unroll 1
    for (int rep = 0; rep < NREP_S2; ++rep) {
    {   LP;
        pg8::SchedSsm S; S.init(512, 640, G, c); pg8::EpiS2 E{(const bf16_t*)(ws + WS_XA), P.ssm_d, (bf16_t*)(ws + WS_BIG)};
        pg8::gemm_phase<false>(ldsl, (const char*)(ws + WS_XA), (const char*)(ws + WS_BT2), 640, S, E); }
    GSYNC(); } STAMP(4);
#pragma unroll 1
    for (int rep = 0; rep < NREP_GLU; ++rep) {
    {   LP;
        pg8::SchedDense S; S.init(T_, 2048, 1024, 1024, G, c); pg8::EpiUp<1> E{(bf16_t*)(ws + WS_GA), 1024};
        pg8::gemm_phase<false>(ldsl, (const char*)(ws + WS_BIG), (const char*)(ws + WS_WGLU), 1024, S, E); }
    GSYNC(); } STAMP(5);
#endif
    { LP; ln_phase<0, true>(P, (LEVEL >= 1) ? P.x : H, P.ln_g, P.ln_b, lds, H, (bf16_t*)(ws + WS_H16), (LEVEL >= 1) ? (const bf16_t*)(ws + WS_GA) : nullptr); }
    GSYNC(); STAMP(6);
#if LEVEL >= 2
#pragma unroll 1
    for (int rep = 0; rep < NREP_FUP; ++rep) {
    {   LP;
        pg8::SchedDense S; S.init(T_, 2 * FF_, 1024, 1024, G, c); pg8::EpiUp<0> E{(bf16_t*)(ws + WS_BIG), FF_};
        pg8::gemm_phase<true>(ldsl, (const char*)(ws + WS_H16), (const char*)(ws + WS_WUP), 1024, S, E); }
    GSYNC(); } STAMP(7);
#pragma unroll 1
    for (int rep = 0; rep < NREP_FDN; ++rep) {
    {   LP;
#define NREP_CUR NREP_FDN
        pg8::SchedDense S; S.init(T_, 1024, FF_, FF_, G, c); pg8::EpiBf16 E{(bf16_t*)(ws + WS_GA), 1024};
        pg8::gemm_phase<false>(ldsl, (const char*)(ws + WS_BIG), (const char*)(ws + WS_WDN), FF_, S, E); }
    GSYNC(); } STAMP(8);
#endif
    { LP; ln_phase<0, false>(P, H, P.ln_g + 1024, P.ln_b + 1024, lds, H, (bf16_t*)(ws + WS_H16), (LEVEL >= 2) ? (const bf16_t*)(ws + WS_GA) : nullptr); }
    GSYNC(); STAMP(9);
#if LEVEL >= 3
#pragma unroll 1
    for (int rep = 0; rep < NREP_QKV; ++rep) {
    {   LP;
        pg8::SchedDense S; S.init(T_, 1536, 1024, 1024, G, c);
        pg8::EpiQkv E{(bf16_t*)(ws + WS_BIG), (bf16_t*)(ws + WS_BIG + 64 * MiB), (bf16_t*)(ws + WS_BIG + 80 * MiB), (const float*)(ws + WS_ROPEC), (const float*)(ws + WS_ROPES)};
        pg8::gemm_phase<true>(ldsl, (const char*)(ws + WS_H16), (const char*)(ws + WS_WQKV), 1024, S, E); }
    GSYNC(); } STAMP(10);
#ifndef SKIP_ATT
    { LP; attn_phase(P, lds); }
#endif
    GSYNC(); STAMP(11);
#pragma unroll 1
    for (int rep = 0; rep < NREP_OUT; ++rep) {
    {   LP;
#undef NREP_CUR
#define NREP_CUR NREP_OUT
        pg8::SchedDense S; S.init(T_, 1024, 1024, 1024, G, c);
        pg8::EpiBf16 E{(bf16_t*)(ws + WS_GA), 1024};
        pg8::gemm_phase<false>(ldsl, (const char*)(ws + WS_BIG + 96 * MiB), (const char*)(ws + WS_WO), 1024, S, E); }
    GSYNC(); } STAMP(12);
#endif
#if LEVEL >= 4
    { LP; ln_phase<1, false>(P, H, P.ln_g + 2048, P.ln_b + 2048, lds, H, (bf16_t*)(ws + WS_H16), (const bf16_t*)(ws + WS_GA)); }
    GSYNC(); STAMP(13);
#pragma unroll 1
    for (int rep = 0; rep < NREP_GATH; ++rep) {
    { LP; gather_phase(P); }
    GSYNC(); } STAMP(14);
#pragma unroll 1
    for (int rep = 0; rep < NREP_MUP; ++rep) {
    {   LP;
        pg8::SchedMoe S; S.init((const int*)(ws + WS_CNT), 2048, 1024, (size_t)2048 * 1024 * 2, G, c); pg8::EpiUp<0> E{(bf16_t*)(ws + WS_BIG), 1024};
        pg8::gemm_phase<true>(ldsl, (const char*)(ws + WS_GA), (const char*)(ws + WS_WMUP), 1024, S, E); }
    GSYNC(); } STAMP(15);
#pragma unroll 1
    for (int rep = 0; rep < NREP_MDN; ++rep) {
    {   LP;
        pg8::SchedMoe S; S.init((const int*)(ws + WS_CNT), 1024, 1024, (size_t)1024 * 1024 * 2, G, c); pg8::EpiBf16 E{(bf16_t*)(ws + WS_Y), 1024};
        pg8::gemm_phase<false>(ldsl, (const char*)(ws + WS_BIG), (const char*)(ws + WS_WMDN), 1024, S, E); }
    GSYNC(); } STAMP(16);
    { LP; ln_phase<2, false>(P, H, P.ln_g + 3072, P.ln_b + 3072, lds, H, (bf16_t*)(ws + WS_H16), nullptr); }
#ifdef PROF_A_HI
    GSYNC(); STAMP(17);
    {   LP; const unsigned long long* stamps = (const unsigned long long*)(P.ws + WS_CNT + 1024);
        const float tA = (float)(stamps[PROF_A_HI] - stamps[PROF_A_LO]) * 0.01f, tB = (float)(stamps[PROF_B_HI] - stamps[PROF_B_LO]) * 0.01f;
        for (int i = blockIdx.x * 512 + threadIdx.x; i < (1 << 22); i += gridDim.x * 512) H[(size_t)i * 8 + 1] = tB;
        if (blockIdx.x == 0 && threadIdx.x == 0) H[0] = 64.0f * tA; }
#endif
#else
    { LP; ln_phase<0, false>(P, H, P.ln_g + 2048, P.ln_b + 2048, lds, H, (bf16_t*)(ws + WS_H16), (LEVEL >= 3) ? (const bf16_t*)(ws + WS_GA) : nullptr); }
    GSYNC(); STAMP(13);
    { LP; ln_phase<0, false>(P, H, P.ln_g + 3072, P.ln_b + 3072, lds, H, (bf16_t*)(ws + WS_H16), nullptr); }
#endif
}

extern "C" void kernel_launch(void* const* d_in, const int* in_sizes, int n_in, void* d_out, int out_size, void* d_ws, size_t ws_size, hipStream_t stream) {
    static int grid_blocks = 0;
    if (grid_blocks == 0) {
        if (n_in != 25 || out_size != T_ * D_ || ws_size < WS_END) { fprintf(stderr, "kernel_launch: unexpected shapes (n_in %d out %d ws %zu)\n", n_in, out_size, ws_size); grid_blocks = -1; return; }
        int dev = 0, cus = 0, per_cu = 0;
        hipGetDevice(&dev); hipDeviceGetAttribute(&cus, hipDeviceAttributeMultiprocessorCount, dev);
        if (hipFuncSetAttribute((const void*)yoco_fwd, hipFuncAttributeMaxDynamicSharedMemorySize, LDS_BYTES) != hipSuccess) { fprintf(stderr, "kernel_launch: hipFuncSetAttribute failed\n"); grid_blocks = -1; return; }
        if (hipOccupancyMaxActiveBlocksPerMultiprocessor(&per_cu, (const void*)yoco_fwd, 512, LDS_BYTES) != hipSuccess || per_cu < 1) { fprintf(stderr, "kernel_launch: occupancy query says %d\n", per_cu); per_cu = 1; (void)hipGetLastError(); }
        grid_blocks = cus * 1;
    }
    if (grid_blocks < 0) return;
    Params p{};
    p.x = (const float*)d_in[0]; p.pos = (const int*)d_in[1]; p.ln_g = (const float*)d_in[2]; p.ln_b = (const float*)d_in[3];
    p.lam_re = (const float*)d_in[4]; p.lam_im = (const float*)d_in[5]; p.log_step = (const float*)d_in[6]; p.b_re = (const float*)d_in[7]; p.b_im = (const float*)d_in[8];
    p.c_re = (const float*)d_in[9]; p.c_im = (const float*)d_in[10]; p.ssm_d = (const float*)d_in[11]; p.w_glu = (const float*)d_in[12]; p.kv_w = (const float*)d_in[13];
    p.w_q = (const float*)d_in[14]; p.sinks = (const float*)d_in[15]; p.w_out = (const float*)d_in[16]; p.ffn_g = (const float*)d_in[17]; p.ffn_u = (const float*)d_in[18]; p.ffn_d = (const float*)d_in[19];
    p.w_router = (const float*)d_in[20]; p.b_router = (const float*)d_in[21]; p.moe_g = (const float*)d_in[22]; p.moe_u = (const float*)d_in[23]; p.moe_d = (const float*)d_in[24];
    p.out = (float*)d_out; p.ws = (unsigned char*)d_ws;
    void* args[] = {&p};
    hipError_t e = hipLaunchCooperativeKernel((const void*)yoco_fwd, dim3(grid_blocks), dim3(512), args, LDS_BYTES, stream);
    if (e != hipSuccess) fprintf(stderr, "cooperative launch failed: %s (grid %d)\n", hipGetErrorString(e), grid_blocks);
}
```

```cpp
#include <hip/hip_runtime.h>
#include <hip/hip_cooperative_groups.h>
#include <cstdio>
namespace cg = cooperative_groups;

#ifndef LEVEL
#define LEVEL 4
#endif

#ifdef DUP_S1
#define NREP_S1 2
#else
#define NREP_S1 1
#endif
#ifdef DUP_S2
#define NREP_S2 2
#else
#define NREP_S2 1
#endif
#ifdef DUP_GLU
#define NREP_GLU 2
#else
#define NREP_GLU 1
#endif
#ifdef DUP_FUP
#define NREP_FUP 2
#else
#define NREP_FUP 1
#endif
#if defined(DUP_FDN) || defined(DUP_FDNNULL)
#define NREP_FDN 2
#else
#define NREP_FDN 1
#endif
#ifdef DUP_QKV
#define NREP_QKV 2
#else
#define NREP_QKV 1
#endif
#if defined(DUP_OUT) || defined(DUP_OUTNULL)
#define NREP_OUT 2
#else
#define NREP_OUT 1
#endif
#ifdef DUP_MUP
#define NREP_MUP 2
#else
#define NREP_MUP 1
#endif
#ifdef DUP_MDN
#define NREP_MDN 2
#else
#define NREP_MDN 1
#endif
#ifdef DUP_SCAN
#define NREP_SCAN 2
#else
#define NREP_SCAN 1
#endif
#ifdef DUP_GATH
#define NREP_GATH 2
#else
#define NREP_GATH 1
#endif
#ifdef DUP_OUTNULL
#define SKIP_EPI_OUT (rep == 0)
#else
#define SKIP_EPI_OUT false
#endif
#ifdef DUP_FDNNULL
#define SKIP_EPI_FDN (rep == 0)
#else
#define SKIP_EPI_FDN false
#endif
#define LAS __attribute__((address_space(3)))
typedef unsigned short bf16_t;
typedef short bf16x8 __attribute__((ext_vector_type(8)));
typedef float f32x4 __attribute__((ext_vector_type(4)));
typedef float f32x16 __attribute__((ext_vector_type(16)));
typedef unsigned u32x4 __attribute__((ext_vector_type(4)));
typedef unsigned u32x2 __attribute__((ext_vector_type(2)));

constexpr int T_ = 32768, D_ = 1024, FF_ = 2816;
constexpr float ALPHA = 1.41421356237309515f;
constexpr float LN_EPS = 1e-5f;
constexpr size_t MiB = 1ull << 20;
constexpr size_t WS_CNT = 0, WS_BAR = 4096, WS_A32 = 65536, WS_ROPEC = 1 * MiB, WS_ROPES = 2 * MiB, WS_LIST = 3 * MiB, WS_TOK = 4 * MiB;
constexpr size_t WS_WMUP = 8 * MiB, WS_WMDN = 40 * MiB, WS_WGLU = 56 * MiB, WS_WUP = 60 * MiB, WS_WDN = 71 * MiB, WS_WQKV = 77 * MiB, WS_WO = 80 * MiB;
constexpr size_t WS_H16 = 82 * MiB, WS_BT2 = 146 * MiB, WS_BT1 = 186 * MiB, WS_XA = 202 * MiB, WS_SST = 282 * MiB, WS_GA = 146 * MiB, WS_Y = 146 * MiB;
constexpr size_t WS_BIG = 314 * MiB, WS_END = 490 * MiB;
constexpr int LDS_BYTES = 131072 + 16;

struct Params {
    const float* x; const int* pos; const float* ln_g; const float* ln_b;
    const float* lam_re; const float* lam_im; const float* log_step; const float* b_re; const float* b_im; const float* c_re; const float* c_im;
    const float* ssm_d; const float* w_glu; const float* kv_w; const float* w_q; const float* sinks; const float* w_out;
    const float* ffn_g; const float* ffn_u; const float* ffn_d; const float* w_router; const float* b_router;
    const float* moe_g; const float* moe_u; const float* moe_d;
    float* out; unsigned char* ws;
};

__device__ __forceinline__ unsigned pk_bf16(float lo, float hi) { unsigned r; asm volatile("v_cvt_pk_bf16_f32 %0, %1, %2" : "=v"(r) : "v"(lo), "v"(hi)); return r; }
typedef _Float16 f16x8 __attribute__((ext_vector_type(8)));
typedef _Float16 f16x2 __attribute__((ext_vector_type(2)));
__device__ __forceinline__ unsigned pk_f16(float lo, float hi) { union { f16x2 h; unsigned u; } c; c.h = (f16x2){(_Float16)lo, (_Float16)hi}; return c.u; }
__device__ __forceinline__ float hf_lo(unsigned w) { union { unsigned u; f16x2 h; } c; c.u = w; return (float)c.h[0]; }
__device__ __forceinline__ float hf_hi(unsigned w) { union { unsigned u; f16x2 h; } c; c.u = w; return (float)c.h[1]; }
__device__ __forceinline__ float bf_lo(unsigned w) { return __uint_as_float(w << 16); }
__device__ __forceinline__ float bf_hi(unsigned w) { return __uint_as_float(w & 0xffff0000u); }
__device__ __forceinline__ float sigmoidf_(float x) { return __builtin_amdgcn_rcpf(1.0f + __expf(-x)); }
__device__ __forceinline__ float gelu_tanh(float y) { const float u = 1.5957691216057308f * (y + 0.044715f * y * y * y); return y * sigmoidf_(u); }
__device__ __forceinline__ float xor16(float v) { const unsigned u = __float_as_uint(v); const auto r = __builtin_amdgcn_permlane16_swap(u, u, false, false); return __uint_as_float(r[0] == u ? r[1] : r[0]); }
__device__ __forceinline__ float wave_sum(float v) {
    v += __shfl_xor(v, 32); v += __shfl_xor(v, 16); v += __shfl_xor(v, 8); v += __shfl_xor(v, 4); v += __shfl_xor(v, 2); v += __shfl_xor(v, 1); return v; }


#define XB_TMO      128
#define XB_XCNT(j)  (256  + 64 * (j))
#define XB_XSUB(j)  (1280 + 64 * (j))
#define XB_XGEN(j)  (2304 + 64 * (j))
#define XB_TOP      3328
#define XB_TOPGEN   3392
#define XCD_BAR_WORDS 3456
#define XB_SPIN_CAP (1u << 22)
__device__ __forceinline__ unsigned xb_ld(unsigned* p)              { return __hip_atomic_load(p, __ATOMIC_RELAXED, __HIP_MEMORY_SCOPE_AGENT); }
__device__ __forceinline__ unsigned xb_add(unsigned* p, unsigned v) { return __hip_atomic_fetch_add(p, v, __ATOMIC_RELAXED, __HIP_MEMORY_SCOPE_AGENT); }
__device__ __forceinline__ unsigned xb_xcc_id() { return (unsigned)__builtin_amdgcn_s_getreg((3 << 11) | 20) & 0xFu; }
#define XB_SPIN(cond, bar) do { unsigned _sp = 0; while (cond) { __builtin_amdgcn_s_sleep(1); \
    if ((++_sp & 255u) == 0u) { if (xb_ld(&(bar)[XB_TMO])) break; if (_sp > XB_SPIN_CAP) { atomicAdd(&(bar)[XB_TMO], 1u); break; } } } } while (0)
__device__ __forceinline__ void xcd_barrier_complete(unsigned* bar, unsigned x, unsigned& nloc, unsigned& nx) {
    const unsigned G = gridDim.x * gridDim.y * gridDim.z;
    unsigned sum, cnt, mine, sp = 0u;
    for (;;) {
        sum = 0u; cnt = 0u; mine = 0u;
#pragma unroll
        for (unsigned j = 0; j < 16; ++j) { const unsigned c = xb_ld(&bar[XB_XCNT(j)]); sum += c; cnt += (c > 0u) ? 1u : 0u; mine = (j == x) ? c : mine; }
        if (sum == G) break;
        __builtin_amdgcn_s_sleep(1);
        if ((++sp & 255u) == 0u) { if (xb_ld(&bar[XB_TMO])) break; if (sp > XB_SPIN_CAP) { atomicAdd(&bar[XB_TMO], 1u); break; } }
    }
    nloc = mine > 0u ? mine : 1u; nx = cnt > 0u ? cnt : 1u;
}
__device__ __forceinline__ void xcd_barrier(unsigned* bar, volatile LAS unsigned* st) {
    asm volatile("s_waitcnt vmcnt(0)" ::: "memory");
    __syncthreads();
    if (threadIdx.x == 0) {
        const unsigned x = xb_xcc_id();
        __builtin_amdgcn_s_waitcnt(0);
        unsigned nloc = st[0], nx = st[1];
        if (nloc == 0u) { xcd_barrier_complete(bar, x, nloc, nx); st[0] = nloc; st[1] = nx; }
        const unsigned old = xb_add(&bar[XB_XSUB(x)], 1u);
        const unsigned gen = old / nloc;
        if (old + 1u == (gen + 1u) * nloc) {
            __builtin_amdgcn_fence(__ATOMIC_RELEASE, "agent");
            asm volatile("s_waitcnt vmcnt(0)" ::: "memory");
            const unsigned og = xb_add(&bar[XB_TOP], 1u);
            const unsigned tg = og / nx;
            if (og + 1u == (tg + 1u) * nx) xb_add(&bar[XB_TOPGEN], 1u);
            else XB_SPIN(xb_ld(&bar[XB_TOPGEN]) == tg, bar);
            __builtin_amdgcn_fence(__ATOMIC_ACQUIRE, "agent");
            xb_add(&bar[XB_XGEN(x)], 1u);
            asm volatile("s_waitcnt vmcnt(0)" ::: "memory");
        } else {
            XB_SPIN(xb_ld(&bar[XB_XGEN(x)]) == gen, bar);
            __builtin_amdgcn_fence(__ATOMIC_ACQUIRE, "agent");
            asm volatile("s_waitcnt vmcnt(0)" ::: "memory");
        }
    }
    __syncthreads();
}

namespace pg8 {
constexpr int BM = 256, BK = 64, HALF = 128, HTB = HALF * BK * 2, NXCD = 8, WGM = 8;
__device__ __forceinline__ int lds_byte(int r, int c) { const int st = (r >> 4) * 2 + (c >> 5), rr = r & 15, cc = c & 31, ob = rr * 64 + cc * 2; return st * 1024 + (ob ^ (((ob >> 9) & 1) << 5)); }
__device__ __forceinline__ void stage_rc(int b, int& R, int& C) { const int st = b / 1024, sb = b % 1024, swz = sb ^ (((sb >> 9) & 1) << 5); R = (st >> 1) * 16 + swz / 64; C = (st & 1) * 32 + (swz % 64) / 2; }
__device__ __forceinline__ int perm32(int rho) { const int n = rho >> 4, i = rho & 15; return 8 * (i >> 2) + 4 * n + (i & 3); }
__device__ __forceinline__ int xcd_remap(int L, int nwg) { const int q = nwg / NXCD, r = nwg % NXCD, xcd = L % NXCD, off = L / NXCD; return (xcd < r ? xcd * (q + 1) : r * (q + 1) + (xcd - r) * q) + off; }

struct Unit { int pm, pn, aux, pad; size_t a_off, b_off; };

struct SchedDense {
    int nM, nN, nwg, G, c, lda, K;
    __device__ __forceinline__ void init(int M, int N, int K_, int lda_, int G_, int c_) { nM = M / BM; nN = N / BM; nwg = nM * nN; G = G_; c = c_; lda = lda_; K = K_; }
    __device__ __forceinline__ bool next(int i, Unit& u) const {
        const int L = i * G + c; if (L >= nwg) return false;
        const int wgid = xcd_remap(L, nwg);
        const int nig = WGM * nN, gid = wgid / nig, fm = gid * WGM, gsz = (nM - fm) < WGM ? (nM - fm) : WGM;
        u.pm = fm + ((wgid % nig) % gsz); u.pn = (wgid % nig) / gsz; u.aux = 0; u.pad = 0;
        u.a_off = (size_t)u.pm * BM * lda * 2; u.b_off = (size_t)u.pn * BM * K * 2; return true;
    }
    __device__ __forceinline__ unsigned voffA(int R, int C) const { return (unsigned)(R * lda + C) * 2u; }
    __device__ __forceinline__ size_t a_kstep() const { return BK * 2; }
    __device__ __forceinline__ size_t a_hstep() const { return (size_t)HALF * lda * 2; }
};
struct SchedMoe {
    int nM, nN, nwg, G, c, K; int tb[9]; size_t estride;
    __device__ __forceinline__ void init(const int* cnt, int N, int K_, size_t estride_, int G_, int c_) {
        tb[0] = 0;
#pragma unroll
        for (int e = 0; e < 8; ++e) tb[e + 1] = tb[e] + ((cnt[e] + 255) >> 8);
        nM = tb[8]; nN = N / BM; nwg = nM * nN; G = G_; c = c_; K = K_; estride = estride_; }
    __device__ __forceinline__ bool next(int i, Unit& u) const {
        const int L = i * G + c; if (L >= nwg) return false;
        const int wgid = xcd_remap(L, nwg);
        const int nig = WGM * nN, gid = wgid / nig, fm = gid * WGM, gsz = (nM - fm) < WGM ? (nM - fm) : WGM;
        u.pm = fm + ((wgid % nig) % gsz); u.pn = (wgid % nig) / gsz; int e = 0;
#pragma unroll
        for (int k = 1; k < 8; ++k) e += (u.pm >= tb[k]) ? 1 : 0;
        u.aux = e; u.pad = 0;
        u.a_off = (size_t)u.pm * BM * 1024 * 2; u.b_off = (size_t)e * estride + (size_t)u.pn * BM * K * 2; return true;
    }
    __device__ __forceinline__ unsigned voffA(int R, int C) const { return (unsigned)(R * 1024 + C) * 2u; }
    __device__ __forceinline__ size_t a_kstep() const { return BK * 2; }
    __device__ __forceinline__ size_t a_hstep() const { return (size_t)HALF * 1024 * 2; }
};
struct SchedSsm {
    int nN, nwg, G, c, K, N;
    __device__ __forceinline__ void init(int N_, int K_, int G_, int c_) { N = N_; nN = N_ / BM; nwg = 64 * 4 * nN; G = G_; c = c_; K = K_; }
    __device__ __forceinline__ bool next(int i, Unit& u) const {
        const int L = i * G + c; if (L >= nwg) return false;
        const int wgid = xcd_remap(L, nwg);
        const int per = 4 * nN, g = (wgid / (4 * per)) * 4 + (wgid & 3), rem = (wgid >> 2) % per;
        u.pm = rem & 3; u.pn = rem >> 2; u.aux = g; u.pad = 0;
        u.a_off = ((size_t)u.pm * BM * 40 * 1024 + (size_t)g * 16) * 2; u.b_off = (size_t)g * N * K * 2 + (size_t)u.pn * BM * K * 2; return true;
    }
    __device__ __forceinline__ unsigned voffA(int R, int C) const { return (unsigned)((R * 40 + (C >> 4)) * 1024 + (C & 15)) * 2u; }
    __device__ __forceinline__ size_t a_kstep() const { return 4 * 1024 * 2; }
    __device__ __forceinline__ size_t a_hstep() const { return (size_t)HALF * 40 * 1024 * 2; }
};

template <bool F16, class Epi, class Sched>
__device__ __forceinline__ void gemm_phase(LAS unsigned char* lds, const char* Ab, const char* Bb, const int K, const Sched& S, const Epi& E) {
    const int tid = threadIdx.x, wid = __builtin_amdgcn_readfirstlane(tid >> 6), lane = tid & 63, wr = wid >> 2, wc = wid & 3, fr = lane & 15, fq = lane >> 4;
    const int nt = K / BK;
    unsigned voffA[2], voffB[2];
#pragma unroll
    for (int i = 0; i < 2; ++i) { int R, C; stage_rc(tid * 16 + i * 8192, R, C); const int Rb = Epi::PERM ? ((R & ~31) + perm32(R & 31)) : R;
        voffA[i] = S.voffA(R, C); voffB[i] = (unsigned)(Rb * K + C) * 2u; }
    const size_t kstepA = S.a_kstep(), hstepA = S.a_hstep(), kstepB = (size_t)(BK * 2), hstepB = (size_t)HALF * K * 2;
    const unsigned ldsw = (unsigned)wid * 1024u;
    const int aoff = lds_byte(wr * 64 + fr, fq * 8), boff = lds_byte(wc * 32 + fr, fq * 8);
#define PG8_SA(b, h) (((b) * 2 + (h)) * HTB)
#define PG8_SB(b, h) ((4 + (b) * 2 + (h)) * HTB)
#define PG8_STAGE(bufoff, gbase, voff) do { _Pragma("unroll") for (int _i = 0; _i < 2; ++_i) \
        __builtin_amdgcn_global_load_lds((const unsigned*)((const char*)(gbase) + (voff)[_i]), (LAS unsigned*)(lds + (bufoff) + ldsw + _i * 8192), 16, 0, 0); } while (0)
#define PG8_LDA(dst, b, h) do { _Pragma("unroll") for (int m = 0; m < 4; ++m) _Pragma("unroll") for (int k = 0; k < 2; ++k) dst[m][k] = *(const LAS bf16x8*)(lds + PG8_SA(b, h) + aoff + m * 2048 + k * 1024); } while (0)
#define PG8_LDB(dst, b, h) do { _Pragma("unroll") for (int n = 0; n < 2; ++n) _Pragma("unroll") for (int k = 0; k < 2; ++k) dst[n][k] = *(const LAS bf16x8*)(lds + PG8_SB(b, h) + boff + n * 2048 + k * 1024); } while (0)
#define PG8_MMA(ai, bj, At, Bt) do { __builtin_amdgcn_s_setprio(1); _Pragma("unroll") for (int m = 0; m < 4; ++m) _Pragma("unroll") for (int n = 0; n < 2; ++n) _Pragma("unroll") for (int k = 0; k < 2; ++k) \
        acc[ai][bj][m][n] = F16 ? __builtin_amdgcn_mfma_f32_16x16x32_f16(__builtin_bit_cast(f16x8, Bt[n][k]), __builtin_bit_cast(f16x8, At[m][k]), acc[ai][bj][m][n], 0, 0, 0) : __builtin_amdgcn_mfma_f32_16x16x32_bf16(Bt[n][k], At[m][k], acc[ai][bj][m][n], 0, 0, 0); __builtin_amdgcn_s_setprio(0); } while (0)
#define PG8_WAIT_V(n) asm volatile("s_waitcnt vmcnt(" #n ")" ::: "memory")
#define PG8_WAIT_L(n) asm volatile("s_waitcnt lgkmcnt(" #n ")" ::: "memory")
#define PG8_BAR __builtin_amdgcn_s_barrier()
#define PG8_SCHED __builtin_amdgcn_sched_barrier(0)
    Unit cur, nxt; int ui = 0;
    if (!S.next(0, cur)) return;
    f32x4 acc[2][2][4][2];
#pragma unroll
    for (int a = 0; a < 2; ++a)
#pragma unroll
        for (int b = 0; b < 2; ++b)
#pragma unroll
            for (int m = 0; m < 4; ++m)
#pragma unroll
                for (int n = 0; n < 2; ++n) acc[a][b][m][n] = (f32x4){0.f, 0.f, 0.f, 0.f};
    bf16x8 At[4][2], B0[2][2], B1[2][2];
    const char* cA = Ab + cur.a_off; const char* cB = Bb + cur.b_off;
    PG8_STAGE(PG8_SB(0, 0), cB, voffB); PG8_STAGE(PG8_SA(0, 0), cA, voffA); PG8_STAGE(PG8_SB(0, 1), cB + hstepB, voffB); PG8_STAGE(PG8_SA(0, 1), cA + hstepA, voffA);
    if (wr == 1) PG8_BAR;
    PG8_WAIT_V(4); PG8_BAR;
    PG8_STAGE(PG8_SB(1, 0), cB + kstepB, voffB); PG8_STAGE(PG8_SA(1, 0), cA + kstepA, voffA); PG8_STAGE(PG8_SB(1, 1), cB + hstepB + kstepB, voffB);
    PG8_WAIT_V(6); PG8_BAR;
    for (;;) {
        const bool has_next = S.next(ui + 1, nxt);
        const char* nA = has_next ? Ab + nxt.a_off : cA; const char* nB = has_next ? Bb + nxt.b_off : cB;
        for (int t = 0; t < nt; t += 2) {
            const bool last = (t == nt - 2);
            const char* a1 = cA + (size_t)(t + 1) * kstepA;
            const char* a2 = last ? nA : cA + (size_t)(t + 2) * kstepA; const char* b2 = last ? nB : cB + (size_t)(t + 2) * kstepB;
            const char* a3 = a2 + kstepA; const char* b3 = b2 + kstepB;
            PG8_LDB(B0, 0, 0); PG8_SCHED; PG8_LDA(At, 0, 0); PG8_STAGE(PG8_SA(1, 1), a1 + hstepA, voffA);
            PG8_WAIT_L(8); PG8_BAR; PG8_WAIT_L(0); PG8_MMA(0, 0, At, B0); PG8_BAR; PG8_SCHED;
            PG8_LDB(B1, 0, 1); PG8_STAGE(PG8_SB(0, 0), b2, voffB);
            PG8_BAR; PG8_WAIT_L(0); PG8_MMA(0, 1, At, B1); PG8_BAR;
            PG8_LDA(At, 0, 1); PG8_STAGE(PG8_SA(0, 0), a2, voffA);
            PG8_BAR; PG8_WAIT_L(0); PG8_MMA(1, 0, At, B0); PG8_BAR; PG8_SCHED;
            PG8_STAGE(PG8_SB(0, 1), b2 + hstepB, voffB);
            PG8_WAIT_V(6); PG8_BAR; PG8_MMA(1, 1, At, B1); PG8_BAR;
            PG8_LDB(B0, 1, 0); PG8_SCHED; PG8_LDA(At, 1, 0); PG8_STAGE(PG8_SA(0, 1), a2 + hstepA, voffA);
            PG8_WAIT_L(8); PG8_BAR; PG8_WAIT_L(0); PG8_MMA(0, 0, At, B0); PG8_BAR; PG8_SCHED;
            PG8_LDB(B1, 1, 1); PG8_STAGE(PG8_SB(1, 0), b3, voffB);
            PG8_BAR; PG8_WAIT_L(0); PG8_MMA(0, 1, At, B1); PG8_BAR;
            PG8_LDA(At, 1, 1); PG8_STAGE(PG8_SA(1, 0), a3, voffA);
            PG8_BAR; PG8_WAIT_L(0); PG8_MMA(1, 0, At, B0); PG8_BAR; PG8_SCHED;
            PG8_STAGE(PG8_SB(1, 1), b3 + hstepB, voffB);
            PG8_WAIT_V(6); PG8_BAR; PG8_MMA(1, 1, At, B1); PG8_BAR;
        }
        E(acc, cur, wr, wc, fr, fq);
        if (!has_next) break;
#pragma unroll
        for (int a = 0; a < 2; ++a)
#pragma unroll
            for (int b = 0; b < 2; ++b)
#pragma unroll
                for (int m = 0; m < 4; ++m)
#pragma unroll
                    for (int n = 0; n < 2; ++n) acc[a][b][m][n] = (f32x4){0.f, 0.f, 0.f, 0.f};
        cur = nxt; cA = nA; cB = nB; ++ui;
    }
    PG8_WAIT_V(0);
    if (wr == 0) PG8_BAR;
    PG8_BAR;
#undef PG8_SA
#undef PG8_SB
#undef PG8_STAGE
#undef PG8_LDA
#undef PG8_LDB
#undef PG8_MMA
#undef PG8_WAIT_V
#undef PG8_WAIT_L
#undef PG8_BAR
#undef PG8_SCHED
}

typedef const f32x4 (&AccRef)[2][2][4][2];

struct EpiS1 {
    static constexpr bool PERM = false; float* sst;
    __device__ __forceinline__ void operator()(AccRef acc, const Unit& u, int wr, int wc, int fr, int fq) const {
#pragma unroll
        for (int ai = 0; ai < 2; ++ai)
#pragma unroll
            for (int m = 0; m < 4; ++m) { const int row = u.pm * BM + ai * HALF + wr * 64 + m * 16 + fr; float* rp = sst + ((size_t)row * 64 + u.aux) * 128 + wc * 32 + 4 * fq;
#pragma unroll
                for (int n = 0; n < 2; ++n) *(f32x4*)(rp + 16 * n) = acc[ai][0][m][n]; }
    }
};
struct EpiS2 {
    static constexpr bool PERM = true; const bf16_t* xa; const float* dsk; bf16_t* g16;
    __device__ __forceinline__ void operator()(AccRef acc, const Unit& u, int wr, int wc, int fr, int fq) const {
        const int ch = u.aux * 16 + 8 * (fq & 1);
        const f32x4 d0 = *(const f32x4*)(dsk + ch), d1 = *(const f32x4*)(dsk + ch + 4);
#pragma unroll
        for (int ai = 0; ai < 2; ++ai)
#pragma unroll
            for (int m = 0; m < 4; ++m) { const int row = u.pm * BM + ai * HALF + wr * 64 + m * 16 + fr;
#pragma unroll
                for (int bj = 0; bj < 2; ++bj) { const int t = 16 * u.pn + 8 * bj + 2 * wc + (fq >> 1);
                    const u32x4 xv = *(const u32x4*)(xa + ((size_t)row * 40 + t) * 1024 + ch);
                    const f32x4 x0 = {bf_lo(xv.x), bf_hi(xv.x), bf_lo(xv.y), bf_hi(xv.y)}, x1 = {bf_lo(xv.z), bf_hi(xv.z), bf_lo(xv.w), bf_hi(xv.w)};
                    const f32x4 y0 = acc[ai][bj][m][0] + d0 * x0, y1 = acc[ai][bj][m][1] + d1 * x1;
                    u32x4 w; w.x = pk_bf16(gelu_tanh(y0[0]), gelu_tanh(y0[1])); w.y = pk_bf16(gelu_tanh(y0[2]), gelu_tanh(y0[3]));
                    w.z = pk_bf16(gelu_tanh(y1[0]), gelu_tanh(y1[1])); w.w = pk_bf16(gelu_tanh(y1[2]), gelu_tanh(y1[3]));
                    *(u32x4*)(g16 + ((size_t)row * 32 + t) * 1024 + ch) = w; } }
    }
};
struct EpiGlu {
    static constexpr bool PERM = false; const float* x; float* out;
    __device__ __forceinline__ void operator()(AccRef acc, const Unit& u, int wr, int wc, int fr, int fq) const {
#pragma unroll
        for (int ai = 0; ai < 2; ++ai)
#pragma unroll
            for (int m = 0; m < 4; ++m) { const int row = u.pm * BM + ai * HALF + wr * 64 + m * 16 + fr; const size_t off = (size_t)row * 1024 + u.pn * 128 + wc * 32 + 4 * fq;
#pragma unroll
                for (int n = 0; n < 2; ++n) { const f32x4 xv = *(const f32x4*)(x + off + 16 * n); const f32x4 v = acc[ai][0][m][n], g = acc[ai][1][m][n]; f32x4 o;
#pragma unroll
                    for (int j = 0; j < 4; ++j) o[j] = ALPHA * xv[j] + v[j] * sigmoidf_(g[j]);
                    *(f32x4*)(out + off + 16 * n) = o; } }
    }
};
template <int ACT> struct EpiUp {
    static constexpr bool PERM = true; bf16_t* act; int ld;
    __device__ __forceinline__ void operator()(AccRef acc, const Unit& u, int wr, int wc, int fr, int fq) const {
#pragma unroll
        for (int ai = 0; ai < 2; ++ai)
#pragma unroll
            for (int m = 0; m < 4; ++m) { const int row = u.pm * BM + ai * HALF + wr * 64 + m * 16 + fr; float r[8];
#pragma unroll
                for (int n = 0; n < 2; ++n)
#pragma unroll
                    for (int j = 0; j < 4; ++j) { const float g = acc[ai][0][m][n][j], up = acc[ai][1][m][n][j]; r[4 * n + j] = (ACT == 0) ? g * sigmoidf_(g) * up : g * sigmoidf_(up); }
                u32x4 w; w.x = pk_bf16(r[0], r[1]); w.y = pk_bf16(r[2], r[3]); w.z = pk_bf16(r[4], r[5]); w.w = pk_bf16(r[6], r[7]);
                *(u32x4*)(act + (size_t)row * ld + u.pn * 128 + wc * 32 + 8 * fq) = w; }
    }
};
struct EpiRes {
    static constexpr bool PERM = false; const float* hin; float* h; bool skip;
    __device__ __forceinline__ void operator()(AccRef acc, const Unit& u, int wr, int wc, int fr, int fq) const {
        if (skip) return;
#pragma unroll
        for (int ai = 0; ai < 2; ++ai)
#pragma unroll
            for (int m = 0; m < 4; ++m) { const int row = u.pm * BM + ai * HALF + wr * 64 + m * 16 + fr; const size_t ro = (size_t)row * 1024 + u.pn * BM + wc * 32 + 4 * fq;
#pragma unroll
                for (int bj = 0; bj < 2; ++bj)
#pragma unroll
                    for (int n = 0; n < 2; ++n) { const size_t o = ro + bj * HALF + 16 * n; const f32x4 hv = *(const f32x4*)(hin + o); *(f32x4*)(h + o) = ALPHA * hv + acc[ai][bj][m][n]; } }
    }
};
struct EpiQkv {
    static constexpr bool PERM = true; bf16_t* q; bf16_t* k; bf16_t* v; const float* rc; const float* rs;
    __device__ __forceinline__ void operator()(AccRef acc, const Unit& u, int wr, int wc, int fr, int fq) const {
        const bool rope = (u.pn <= 4) && ((wc & 1) == 0);
        bf16_t* base; int ld, colt; float scale = 1.0f;
        if (u.pn < 4) { base = q; ld = 1024; colt = u.pn * BM; scale = 0.125f * 1.4426950408889634f; } else if (u.pn == 4) { base = k; ld = 256; colt = 0; } else { base = v; ld = 256; colt = 0; }
#pragma unroll
        for (int ai = 0; ai < 2; ++ai)
#pragma unroll
            for (int m = 0; m < 4; ++m) { const int row = u.pm * BM + ai * HALF + wr * 64 + m * 16 + fr;
                f32x4 c0 = {1.f, 1.f, 1.f, 1.f}, c1 = c0, s0 = {0.f, 0.f, 0.f, 0.f}, s1 = s0;
                if (rope && fq < 2) { c0 = *(const f32x4*)(rc + (size_t)row * 8); c1 = *(const f32x4*)(rc + (size_t)row * 8 + 4); s0 = *(const f32x4*)(rs + (size_t)row * 8); s1 = *(const f32x4*)(rs + (size_t)row * 8 + 4);
                    if (fq == 0) { s0 = -s0; s1 = -s1; } }
#pragma unroll
                for (int bj = 0; bj < 2; ++bj) { f32x4 v0 = acc[ai][bj][m][0], v1 = acc[ai][bj][m][1];
                    if (rope) { f32x4 p0, p1;
#pragma unroll
                        for (int j = 0; j < 4; ++j) { p0[j] = xor16(v0[j]); p1[j] = xor16(v1[j]); }
                        v0 = v0 * c0 + p0 * s0; v1 = v1 * c1 + p1 * s1; }
                    v0 = v0 * scale; v1 = v1 * scale;
                    u32x4 w; w.x = pk_bf16(v0[0], v0[1]); w.y = pk_bf16(v0[2], v0[3]); w.z = pk_bf16(v1[0], v1[1]); w.w = pk_bf16(v1[2], v1[3]);
                    *(u32x4*)(base + (size_t)row * ld + colt + bj * HALF + wc * 32 + 8 * fq) = w; } }
    }
};
struct EpiBf16 {
    static constexpr bool PERM = true; bf16_t* o; int ld;
    __device__ __forceinline__ void operator()(AccRef acc, const Unit& u, int wr, int wc, int fr, int fq) const {
#pragma unroll
        for (int ai = 0; ai < 2; ++ai)
#pragma unroll
            for (int m = 0; m < 4; ++m) { const int row = u.pm * BM + ai * HALF + wr * 64 + m * 16 + fr;
#pragma unroll
                for (int bj = 0; bj < 2; ++bj) { const f32x4 v0 = acc[ai][bj][m][0], v1 = acc[ai][bj][m][1];
                    u32x4 w; w.x = pk_bf16(v0[0], v0[1]); w.y = pk_bf16(v0[2], v0[3]); w.z = pk_bf16(v1[0], v1[1]); w.w = pk_bf16(v1[2], v1[3]);
                    *(u32x4*)(o + (size_t)row * ld + u.pn * BM + bj * HALF + wc * 32 + 8 * fq) = w; } }
    }
};
struct EpiNull {
    static constexpr bool PERM = false; float* h;
    __device__ __forceinline__ void operator()(AccRef acc, const Unit& u, int wr, int wc, int fr, int fq) const {
        if (u.pm < 0) {
#pragma unroll
            for (int ai = 0; ai < 2; ++ai)
#pragma unroll
                for (int m = 0; m < 4; ++m)
#pragma unroll
                    for (int bj = 0; bj < 2; ++bj)
#pragma unroll
                        for (int n = 0; n < 2; ++n) *(f32x4*)(h + ((ai * 4 + m) * 4 + bj * 2 + n) * 256 + fr * 16 + fq * 4) = acc[ai][bj][m][n]; }
    }
};
}

__device__ __forceinline__ void transpose_tile(const float* __restrict__ src0, const float* __restrict__ src1, int ld, int k0, int col0, int col1, bf16_t* __restrict__ dst, int Kd, int n0, float* tile, const bool f16 = false) {
    const int tid = threadIdx.x;
    { const int nn = (tid & 63) * 4, kb = tid >> 6;
      const float* sp = (nn < 128) ? (src0 + col0 + nn) : (src1 + col1 + (nn - 128));
      f32x4 v[8];
#pragma unroll
      for (int i = 0; i < 8; ++i) v[i] = *(const f32x4*)(sp + (size_t)(k0 + kb + 8 * i) * ld);
#pragma unroll
      for (int i = 0; i < 8; ++i) { float* t = tile + (kb + 8 * i) * 257 + nn; t[0] = v[i][0]; t[1] = v[i][1]; t[2] = v[i][2]; t[3] = v[i][3]; } }
    __syncthreads();
    { const int ks = (tid & 7) * 8;
#pragma unroll
      for (int i = 0; i < 4; ++i) { const int n = (tid >> 3) + 64 * i; float r[8];
#pragma unroll
          for (int j = 0; j < 8; ++j) r[j] = tile[(ks + j) * 257 + n];
          u32x4 w; if (f16) { w.x = pk_f16(r[0], r[1]); w.y = pk_f16(r[2], r[3]); w.z = pk_f16(r[4], r[5]); w.w = pk_f16(r[6], r[7]); } else { w.x = pk_bf16(r[0], r[1]); w.y = pk_bf16(r[2], r[3]); w.z = pk_bf16(r[4], r[5]); w.w = pk_bf16(r[6], r[7]); }
          *(u32x4*)(dst + (size_t)(n0 + n) * Kd + k0 + ks) = w; } }
    __syncthreads();
}

__device__ void ssm_tables(const Params& P, int g, int qtr, unsigned char* lds) {
    const int tid = threadIdx.x;
    float* apr = (float*)lds;
    float* api = apr + 33 * 64;
    float* bbr = api + 33 * 64;
    float* bbi = bbr + 1024;
    float* ccr = bbi + 1024;
    float* cci = ccr + 1024;
    float* kg = cci + 1024;
    const float dtf = expf(P.log_step[g]);
    for (int idx = tid; idx < 33 * 64; idx += 512) { const int tau = idx >> 6, p = idx & 63;
        const float lr = P.lam_re[g * 64 + p], li = P.lam_im[g * 64 + p];
        const double dt = (double)dtf; double rev = (double)li * dt * (double)tau * 0.15915494309189535; rev -= floor(rev);
        const float ang = (float)(rev * 6.283185307179586); float sn, cs; sincosf(ang, &sn, &cs);
        const float mag = expf((float)((double)lr * dt * (double)tau));
        apr[idx] = mag * cs; api[idx] = mag * sn; }
    for (int idx = tid; idx < 1024; idx += 512) { ccr[idx] = P.c_re[g * 1024 + idx]; cci[idx] = P.c_im[g * 1024 + idx]; }
    __syncthreads();
    for (int idx = tid; idx < 1024; idx += 512) { const int p = idx >> 4;
        const float lr = P.lam_re[g * 64 + p], li = P.lam_im[g * 64 + p], ar = apr[64 + p], ai = api[64 + p];
        const float nr = ar - 1.0f, den = lr * lr + li * li, kr = (nr * lr + ai * li) / den, ki = (ai * lr - nr * li) / den;
        const float br = P.b_re[g * 1024 + idx], bi = P.b_im[g * 1024 + idx];
        bbr[idx] = kr * br - ki * bi; bbi[idx] = kr * bi + ki * br; }
    __syncthreads();
    { const int cp = tid & 15, c = 4 * qtr + ((tid >> 4) & 3), t0 = tid >> 6;
      for (int i = 0; i < 4; ++i) { const int tau = t0 + 8 * i; float s = 0.f;
          for (int p = 0; p < 64; ++p) { const float cr = ccr[c * 64 + p], ci = cci[c * 64 + p], ar = apr[tau * 64 + p], ai = api[tau * 64 + p];
              const float zr = cr * ar - ci * ai, zi = cr * ai + ci * ar; s += zr * bbr[p * 16 + cp] - zi * bbi[p * 16 + cp]; }
          kg[(tau * 16 + c) * 16 + cp] = s; } }
    __syncthreads();
    bf16_t* bt2 = (bf16_t*)(P.ws + WS_BT2) + (size_t)g * 512 * 640;
    for (int pc = tid; pc < 128 * 80; pc += 512) { const int nq = pc / 80, k8 = (pc % 80) * 8, t = nq >> 2, c = 4 * qtr + (nq & 3), n = t * 16 + c; float r[8];
        if (k8 < 512) { const int s = k8 >> 4, c0 = k8 & 15;
#pragma unroll
            for (int j = 0; j < 8; ++j) r[j] = (t >= s) ? kg[((t - s) * 16 + c) * 16 + c0 + j] : 0.f;
        } else { const int q0 = k8 - 512;
#pragma unroll
            for (int j = 0; j < 8; j += 2) { const int p = (q0 + j) >> 1; const float cr = ccr[c * 64 + p], ci = cci[c * 64 + p], ar = apr[(t + 1) * 64 + p], ai = api[(t + 1) * 64 + p];
                r[j] = cr * ar - ci * ai; r[j + 1] = -(cr * ai + ci * ar); } }
        u32x4 w; w.x = pk_bf16(r[0], r[1]); w.y = pk_bf16(r[2], r[3]); w.z = pk_bf16(r[4], r[5]); w.w = pk_bf16(r[6], r[7]);
        *(u32x4*)(bt2 + (size_t)n * 640 + k8) = w; }
    bf16_t* bt1 = (bf16_t*)(P.ws + WS_BT1) + (size_t)g * 256 * 512;
    for (int pc = tid; pc < 64 * 64; pc += 512) { const int q = 64 * qtr + (pc >> 6), k8 = (pc & 63) * 8; float r[8];
        if (q < 128) { const int p = q >> 1, s = k8 >> 4, c0 = k8 & 15; const float ar = apr[(31 - s) * 64 + p], ai = api[(31 - s) * 64 + p];
#pragma unroll
            for (int j = 0; j < 8; ++j) { const float br = bbr[p * 16 + c0 + j], bi = bbi[p * 16 + c0 + j]; r[j] = (q & 1) ? (ar * bi + ai * br) : (ar * br - ai * bi); }
        } else {
#pragma unroll
            for (int j = 0; j < 8; ++j) r[j] = 0.f; }
        u32x4 w; w.x = pk_bf16(r[0], r[1]); w.y = pk_bf16(r[2], r[3]); w.z = pk_bf16(r[4], r[5]); w.w = pk_bf16(r[6], r[7]);
        *(u32x4*)(bt1 + (size_t)q * 512 + k8) = w; }
    float* a32 = (float*)(P.ws + WS_A32);
    if (qtr == 0 && tid < 64) { a32[(g * 64 + tid) * 2] = apr[32 * 64 + tid]; a32[(g * 64 + tid) * 2 + 1] = api[32 * 64 + tid]; }
    __syncthreads();
}

__device__ void p0_prep(const Params& P, unsigned char* lds, const int mask) {
    const int tid = threadIdx.x, G = gridDim.x;
    if (blockIdx.x == 0 && tid < 8) ((int*)(P.ws + WS_CNT))[tid] = 0;
    constexpr int J_SSM = 256, J_X = 512, J_ROPE = 512, J_T = 2352;
    constexpr int NJ = J_SSM + J_X + J_ROPE + J_T;
    for (int job = blockIdx.x; job < NJ; job += G) {
        if (job < J_SSM) {
#if LEVEL >= 1
            if (mask & 1) ssm_tables(P, job >> 2, job & 3, lds);
#endif
        }
        else if (job < J_SSM + J_X) { if (!(mask & 2)) continue;
            const int r0 = (job - J_SSM) * 64; bf16_t* xa = (bf16_t*)(P.ws + WS_XA);
#pragma unroll 4
            for (int i = 0; i < 16; ++i) { const int piece = tid + 512 * i, r = r0 + (piece >> 7), c8 = (piece & 127) * 8;
                const f32x4 a = *(const f32x4*)(P.x + (size_t)r * 1024 + c8), b = *(const f32x4*)(P.x + (size_t)r * 1024 + c8 + 4);
                u32x4 w; w.x = pk_bf16(a[0], a[1]); w.y = pk_bf16(a[2], a[3]); w.z = pk_bf16(b[0], b[1]); w.w = pk_bf16(b[2], b[3]);
                *(u32x4*)(xa + ((size_t)(r >> 5) * 40 + (r & 31)) * 1024 + c8) = w;
#if LEVEL < 1
                *(f32x4*)(P.out + (size_t)r * 1024 + c8) = a; *(f32x4*)(P.out + (size_t)r * 1024 + c8 + 4) = b;
#endif
            }
        }
        else if (job < J_SSM + J_X + J_ROPE) { if (!(mask & 4)) continue;
            const int tok = (job - J_SSM - J_X) * 64 + (tid >> 3), i = tid & 7;
            const float invf[8] = {1.0f, 0.19392274474868576f, 0.03760603093086393f, 0.007292664737217109f, 0.001414213562373095f, 0.0002742481756762073f, 5.318295896944988e-05f, 1.031338537721246e-05f};
            float f = invf[0];
#pragma unroll
            for (int k = 1; k < 8; ++k) f = (i == k) ? invf[k] : f;
            const float ang = (float)P.pos[tok] * f; float sn, cs; sincosf(ang, &sn, &cs);
            ((float*)(P.ws + WS_ROPEC))[tok * 8 + i] = cs; ((float*)(P.ws + WS_ROPES))[tok * 8 + i] = sn;
        }
        else {
            if (!(mask & 8)) continue;
            int jt = job - J_SSM - J_X - J_ROPE; float* tile = (float*)lds;
            if (jt < 128) { const int kt = jt & 15, pn = jt >> 4;
                transpose_tile(P.w_glu, P.w_glu, 2048, kt * 64, 128 * pn, 1024 + 128 * pn, (bf16_t*)(P.ws + WS_WGLU), 1024, 256 * pn, tile); }
            else if ((jt -= 128) < 352) { const int kt = jt & 15, pn = jt >> 4;
                transpose_tile(P.ffn_g, P.ffn_u, 2816, kt * 64, 128 * pn, 128 * pn, (bf16_t*)(P.ws + WS_WUP), 1024, 256 * pn, tile, true); }
            else if ((jt -= 352) < 176) { const int kt = jt % 44, pn = jt / 44;
                transpose_tile(P.ffn_d, P.ffn_d, 1024, kt * 64, 256 * pn, 256 * pn + 128, (bf16_t*)(P.ws + WS_WDN), 2816, 256 * pn, tile); }
            else if ((jt -= 176) < 64) { const int kt = jt & 15, pn = jt >> 4;
                transpose_tile(P.w_q, P.w_q, 1024, kt * 64, 256 * pn, 256 * pn + 128, (bf16_t*)(P.ws + WS_WQKV), 1024, 256 * pn, tile, true); }
            else if ((jt -= 64) < 32) { const int kt = jt & 15, pn = jt >> 4;
                transpose_tile(P.kv_w, P.kv_w, 512, kt * 64, 256 * pn, 256 * pn + 128, (bf16_t*)(P.ws + WS_WQKV), 1024, 1024 + 256 * pn, tile, true); }
            else if ((jt -= 32) < 64) { const int kt = jt & 15, pn = jt >> 4;
                transpose_tile(P.w_out, P.w_out, 1024, kt * 64, 256 * pn, 256 * pn + 128, (bf16_t*)(P.ws + WS_WO), 1024, 256 * pn, tile); }
            else if ((jt -= 64) < 1024) { const int e = jt >> 7, r = jt & 127, kt = r & 15, pn = r >> 4;
                transpose_tile(P.moe_g + (size_t)e * 1048576, P.moe_u + (size_t)e * 1048576, 1024, kt * 64, 128 * pn, 128 * pn, (bf16_t*)(P.ws + WS_WMUP) + (size_t)e * 2048 * 1024, 1024, 256 * pn, tile, true); }
            else { jt -= 1024; const int e = jt >> 6, r = jt & 63, kt = r & 15, pn = r >> 4;
                transpose_tile(P.moe_d + (size_t)e * 1048576, P.moe_d + (size_t)e * 1048576, 1024, kt * 64, 256 * pn, 256 * pn + 128, (bf16_t*)(P.ws + WS_WMDN) + (size_t)e * 1048576, 1024, 256 * pn, tile); }
        }
    }
}

__device__ void scan_unit(const Params& P, int g, int pm) {
    const float* sst = (const float*)(P.ws + WS_SST); const float* a32 = (const float*)(P.ws + WS_A32); bf16_t* xa = (bf16_t*)(P.ws + WS_XA);
    const int tid = threadIdx.x;
    if (tid < 256) {
        const int p = tid & 63, b = pm * 4 + (tid >> 6), q = 2 * p;
        const float ar = a32[(g * 64 + p) * 2], ai = a32[(g * 64 + p) * 2 + 1];
        float hr = 0.f, hi = 0.f;
#pragma unroll 1
        for (int jb = 0; jb < 64; jb += 16) {
            float2 s[16];
#pragma unroll
            for (int j = 0; j < 16; ++j) s[j] = *(const float2*)(sst + ((size_t)(b * 64 + jb + j) * 64 + g) * 128 + q);
#pragma unroll
            for (int j = 0; j < 16; ++j) { const int row = b * 64 + jb + j;
                *(unsigned*)(xa + ((size_t)row * 40 + 32 + (q >> 4)) * 1024 + g * 16 + (q & 15)) = pk_bf16(hr, hi);
                const float nr = ar * hr - ai * hi + s[j].x, ni = ar * hi + ai * hr + s[j].y; hr = nr; hi = ni; }
        }
    }
}

template <int MODE, bool IN32>
__device__ void ln_phase(const Params& P, const float* h, const float* gam, const float* bet, unsigned char* lds, float* hout, bf16_t* h16, const bf16_t* d16) {
    const int tid = threadIdx.x, wid = tid >> 6, lane = tid & 63;
    float* wrt = (float*)lds;
    int* cnt = (int*)(P.ws + WS_CNT); int* lists = (int*)(P.ws + WS_LIST); int* toki = (int*)(P.ws + WS_TOK);
    const bf16_t* Y = (const bf16_t*)(P.ws + WS_Y);
    int base[8];
    if (MODE == 1) { for (int k = 0; k < 16; ++k) { const int idx = tid + 512 * k; wrt[(idx & 7) * 1024 + (idx >> 3)] = P.w_router[idx]; } __syncthreads(); }
    if (MODE == 2) { int acc = 0;
#pragma unroll
        for (int e = 0; e < 8; ++e) { base[e] = acc; acc += ((cnt[e] + 255) >> 8) << 8; } }
    f32x4 gv[4], bv[4];
#pragma unroll
    for (int i = 0; i < 4; ++i) { gv[i] = *(const f32x4*)(gam + 256 * i + lane * 4); bv[i] = *(const f32x4*)(bet + 256 * i + lane * 4); }
    for (int row = blockIdx.x * 8 + wid; row < T_; row += gridDim.x * 8) {
        f32x4 v[4];
        if (IN32) {
#pragma unroll
            for (int i = 0; i < 4; ++i) v[i] = *(const f32x4*)(h + (size_t)row * 1024 + 256 * i + lane * 4);
        } else {
#pragma unroll
            for (int i = 0; i < 4; ++i) { const u32x2 a = *(const u32x2*)(h16 + (size_t)row * 1024 + 256 * i + lane * 4); v[i] = (f32x4){hf_lo(a.x), hf_hi(a.x), hf_lo(a.y), hf_hi(a.y)}; }
        }
        if (MODE != 2 && d16 != nullptr) {
#pragma unroll
            for (int i = 0; i < 4; ++i) { const u32x2 a = *(const u32x2*)(d16 + (size_t)row * 1024 + 256 * i + lane * 4);
                v[i][0] = ALPHA * v[i][0] + bf_lo(a.x); v[i][1] = ALPHA * v[i][1] + bf_hi(a.x); v[i][2] = ALPHA * v[i][2] + bf_lo(a.y); v[i][3] = ALPHA * v[i][3] + bf_hi(a.y); }
        }
        if (MODE == 2) {
            const int e1 = toki[row * 8 + 0], p1 = toki[row * 8 + 1], e2 = toki[row * 8 + 2], p2 = toki[row * 8 + 3];
            const float w1 = __int_as_float(toki[row * 8 + 4]), w2 = __int_as_float(toki[row * 8 + 5]);
            int b1 = 0, b2 = 0;
#pragma unroll
            for (int e = 0; e < 8; ++e) { b1 = (e1 == e) ? base[e] : b1; b2 = (e2 == e) ? base[e] : b2; }
            const bf16_t* y1 = Y + (size_t)(b1 + p1) * 1024; const bf16_t* y2 = Y + (size_t)(b2 + p2) * 1024;
#pragma unroll
            for (int i = 0; i < 4; ++i) { const u32x2 a = *(const u32x2*)(y1 + 256 * i + lane * 4), b = *(const u32x2*)(y2 + 256 * i + lane * 4);
                v[i][0] = ALPHA * v[i][0] + (w1 * bf_lo(a.x) + w2 * bf_lo(b.x)); v[i][1] = ALPHA * v[i][1] + (w1 * bf_hi(a.x) + w2 * bf_hi(b.x));
                v[i][2] = ALPHA * v[i][2] + (w1 * bf_lo(a.y) + w2 * bf_lo(b.y)); v[i][3] = ALPHA * v[i][3] + (w1 * bf_hi(a.y) + w2 * bf_hi(b.y)); }
        }
        float s = 0.f;
#pragma unroll
        for (int i = 0; i < 4; ++i) s += (v[i][0] + v[i][1]) + (v[i][2] + v[i][3]);
        const float mu = wave_sum(s) * (1.0f / 1024.0f);
        float q = 0.f;
#pragma unroll
        for (int i = 0; i < 4; ++i) { v[i] = v[i] - mu; q += (v[i][0] * v[i][0] + v[i][1] * v[i][1]) + (v[i][2] * v[i][2] + v[i][3] * v[i][3]); }
        const float rstd = rsqrtf(wave_sum(q) * (1.0f / 1024.0f) + LN_EPS);
#pragma unroll
        for (int i = 0; i < 4; ++i) { v[i] = v[i] * rstd * gv[i] + bv[i]; if (MODE == 2) *(f32x4*)(hout + (size_t)row * 1024 + 256 * i + lane * 4) = v[i];
            if (MODE != 2) { u32x2 w; w.x = pk_f16(v[i][0], v[i][1]); w.y = pk_f16(v[i][2], v[i][3]); *(u32x2*)(h16 + (size_t)row * 1024 + 256 * i + lane * 4) = w; } }
        if (MODE == 1) {
            float lg[8];
#pragma unroll
            for (int e = 0; e < 8; ++e) { float a = 0.f;
#pragma unroll
                for (int i = 0; i < 4; ++i) { const f32x4 w = *(const f32x4*)(wrt + e * 1024 + 256 * i + lane * 4); a += (v[i][0] * w[0] + v[i][1] * w[1]) + (v[i][2] * w[2] + v[i][3] * w[3]); }
                lg[e] = wave_sum(a) + P.b_router[e]; }
            int e1 = 0; float v1 = lg[0];
#pragma unroll
            for (int e = 1; e < 8; ++e) if (lg[e] > v1) { v1 = lg[e]; e1 = e; }
            int e2 = -1; float v2 = -3.0e38f;
#pragma unroll
            for (int e = 0; e < 8; ++e) if (e != e1 && lg[e] > v2) { v2 = lg[e]; e2 = e; }
            const float ex = __expf(v2 - v1), w1 = 1.0f / (1.0f + ex), w2 = ex / (1.0f + ex);
            if (lane == 0) { const int p1 = atomicAdd(cnt + e1, 1), p2 = atomicAdd(cnt + e2, 1);
                lists[e1 * T_ + p1] = row; lists[e2 * T_ + p2] = row;
                toki[row * 8 + 0] = e1; toki[row * 8 + 1] = p1; toki[row * 8 + 2] = e2; toki[row * 8 + 3] = p2; toki[row * 8 + 4] = __float_as_int(w1); toki[row * 8 + 5] = __float_as_int(w2); }
        }
    }
}

__device__ void gather_phase(const Params& P) {
    const int tid = threadIdx.x, wid = tid >> 6, lane = tid & 63;
    const int* cnt = (const int*)(P.ws + WS_CNT); const int* lists = (const int*)(P.ws + WS_LIST);
    const bf16_t* h16 = (const bf16_t*)(P.ws + WS_H16); bf16_t* ga = (bf16_t*)(P.ws + WS_GA);
    int base[9], c[8]; base[0] = 0;
#pragma unroll
    for (int e = 0; e < 8; ++e) { c[e] = cnt[e]; base[e + 1] = base[e] + (((c[e] + 255) >> 8) << 8); }
    for (int r = blockIdx.x * 8 + wid; r < base[8]; r += gridDim.x * 8) {
        int e = 0;
#pragma unroll
        for (int k = 1; k < 8; ++k) e += (r >= base[k]) ? 1 : 0;
        int be = 0, ce = 0;
#pragma unroll
        for (int k = 0; k < 8; ++k) { be = (e == k) ? base[k] : be; ce = (e == k) ? c[k] : ce; }
        const int pos = r - be; u32x4 a = {0u, 0u, 0u, 0u}, b = a;
        if (pos < ce) { const int tok = lists[e * T_ + pos]; a = *(const u32x4*)(h16 + (size_t)tok * 1024 + lane * 8); b = *(const u32x4*)(h16 + (size_t)tok * 1024 + 512 + lane * 8); }
        *(u32x4*)(ga + (size_t)r * 1024 + lane * 8) = a; *(u32x4*)(ga + (size_t)r * 1024 + 512 + lane * 8) = b;
    }
}

__device__ void attn_phase(const Params& P, unsigned char* lds) {
    const int tid = threadIdx.x, wid = tid >> 6, lane = tid & 63, n = lane & 31, hh = lane >> 5;
    bf16_t* Ks = (bf16_t*)lds;
    bf16_t* Vt = (bf16_t*)(lds + 256 * 144);
    const bf16_t* QB = (const bf16_t*)(P.ws + WS_BIG); const bf16_t* KB = (const bf16_t*)(P.ws + WS_BIG + 64 * MiB); const bf16_t* VB = (const bf16_t*)(P.ws + WS_BIG + 80 * MiB);
    bf16_t* OB = (bf16_t*)(P.ws + WS_BIG + 96 * MiB);
#ifdef DUP_ATT
    constexpr int NITEM = 2048;
#else
    constexpr int NITEM = 1024;
#endif
    for (int item = blockIdx.x; item < NITEM; item += gridDim.x) {
        const int kvh = item & 3, nb = (item >> 2) & 15, b = (item >> 6) & 15;
        const int tok0 = b * 2048 + nb * 128;
        __syncthreads();
#pragma unroll
        for (int i = 0; i < 4; ++i) { const int piece = tid + 512 * i, s = piece >> 3, pc = piece & 7; u32x4 v = {0u, 0u, 0u, 0u};
            if (nb > 0 || s >= 128) v = *(const u32x4*)(KB + (size_t)(tok0 - 128 + s) * 256 + kvh * 64 + pc * 8);
            *(u32x4*)(Ks + s * 72 + pc * 8) = v; }
#pragma unroll
        for (int i = 0; i < 2; ++i) { const int s = 2 * (tid & 127), pc = (tid >> 7) + 4 * i; u32x4 v0 = {0u, 0u, 0u, 0u}, v1 = v0;
            if (nb > 0 || s >= 128) { v0 = *(const u32x4*)(VB + (size_t)(tok0 - 128 + s) * 256 + kvh * 64 + pc * 8); v1 = *(const u32x4*)(VB + (size_t)(tok0 - 127 + s) * 256 + kvh * 64 + pc * 8); }
            unsigned* vt = (unsigned*)(Vt + (pc * 8) * 264 + s);
            vt[0 * 132] = (v0.x & 0xffffu) | (v1.x << 16); vt[1 * 132] = (v0.x >> 16) | (v1.x & 0xffff0000u);
            vt[2 * 132] = (v0.y & 0xffffu) | (v1.y << 16); vt[3 * 132] = (v0.y >> 16) | (v1.y & 0xffff0000u);
            vt[4 * 132] = (v0.z & 0xffffu) | (v1.z << 16); vt[5 * 132] = (v0.z >> 16) | (v1.z & 0xffff0000u);
            vt[6 * 132] = (v0.w & 0xffffu) | (v1.w << 16); vt[7 * 132] = (v0.w >> 16) | (v1.w & 0xffff0000u); }
        __syncthreads();
        const int hq = kvh * 4 + (wid >> 1);
        const float sink = P.sinks[hq] * 1.4426950408889634f;
#pragma unroll 1
        for (int qq = 0; qq < 2; ++qq) {
            const int kb0 = (wid & 1) * 2 + qq, i0 = 32 * kb0, qi = i0 + n;
            const bf16_t* qp = QB + (size_t)(tok0 + qi) * 1024 + hq * 64 + 8 * hh;
            bf16x8 qf[4];
#pragma unroll
            for (int ks = 0; ks < 4; ++ks) qf[ks] = *(const bf16x8*)(qp + 16 * ks);
            f32x16 sacc[5];
#pragma unroll
            for (int kb = 0; kb < 5; ++kb) {
#pragma unroll
                for (int i = 0; i < 16; ++i) sacc[kb][i] = 0.f;
                const bf16_t* kp = Ks + (32 * (kb0 + kb) + n) * 72 + 8 * hh;
#pragma unroll
                for (int ks = 0; ks < 4; ++ks) { const bf16x8 a = *(const bf16x8*)(kp + 16 * ks); sacc[kb] = __builtin_amdgcn_mfma_f32_32x32x16_bf16(a, qf[ks], sacc[kb], 0, 0, 0); }
                asm volatile("" ::: "memory"); }
            const int nn4 = n - 4 * hh;
#pragma unroll
            for (int i = 0; i < 16; ++i) { const int r = 8 * (i >> 2) + (i & 3);
                sacc[0][i] = (r > nn4) ? sacc[0][i] : -1.0e30f; sacc[4][i] = (r <= nn4) ? sacc[4][i] : -1.0e30f; }
            if (nb == 0) {
#pragma unroll
                for (int kb = 0; kb < 4; ++kb) if (kb0 + kb < 4) {
#pragma unroll
                    for (int i = 0; i < 16; ++i) sacc[kb][i] = -1.0e30f; } }
            float mx = sink;
#pragma unroll
            for (int kb = 0; kb < 5; ++kb)
#pragma unroll
                for (int i = 0; i < 16; ++i) mx = fmaxf(mx, sacc[kb][i]);
            mx = fmaxf(mx, __shfl_xor(mx, 32));
            float sum = 0.f;
#pragma unroll
            for (int kb = 0; kb < 5; ++kb)
#pragma unroll
                for (int i = 0; i < 16; ++i) { const float p = __builtin_amdgcn_exp2f(sacc[kb][i] - mx); sacc[kb][i] = p; sum += p; }
            sum += __shfl_xor(sum, 32); sum += __builtin_amdgcn_exp2f(sink - mx);
            f32x16 oacc[2];
#pragma unroll
            for (int i = 0; i < 16; ++i) { oacc[0][i] = 0.f; oacc[1][i] = 0.f; }
#pragma unroll
            for (int kb = 0; kb < 5; ++kb)
#pragma unroll
                for (int sl = 0; sl < 2; ++sl) {
                    union { u32x4 u; bf16x8 v; } pb;
                    pb.u.x = pk_bf16(sacc[kb][8 * sl + 0], sacc[kb][8 * sl + 1]); pb.u.y = pk_bf16(sacc[kb][8 * sl + 2], sacc[kb][8 * sl + 3]);
                    pb.u.z = pk_bf16(sacc[kb][8 * sl + 4], sacc[kb][8 * sl + 5]); pb.u.w = pk_bf16(sacc[kb][8 * sl + 6], sacc[kb][8 * sl + 7]);
#pragma unroll
                    for (int mb = 0; mb < 2; ++mb) { const bf16_t* vp = Vt + (32 * mb + n) * 264 + 32 * (kb0 + kb) + 16 * sl + 4 * hh;
                        union { u32x4 u; bf16x8 v; } va; const u32x2 lo = *(const u32x2*)vp, hi = *(const u32x2*)(vp + 8); va.u.x = lo.x; va.u.y = lo.y; va.u.z = hi.x; va.u.w = hi.y;
                        oacc[mb] = __builtin_amdgcn_mfma_f32_32x32x16_bf16(va.v, pb.v, oacc[mb], 0, 0, 0); }
                    asm volatile("" ::: "memory"); }
            const float inv = 1.0f / sum;
            bf16_t* op = OB + (size_t)(tok0 + qi) * 1024 + hq * 64 + 4 * hh;
#pragma unroll
            for (int mb = 0; mb < 2; ++mb)
#pragma unroll
                for (int g4 = 0; g4 < 4; ++g4) { u32x2 w; w.x = pk_bf16(oacc[mb][4 * g4 + 0] * inv, oacc[mb][4 * g4 + 1] * inv); w.y = pk_bf16(oacc[mb][4 * g4 + 2] * inv, oacc[mb][4 * g4 + 3] * inv);
                    *(u32x2*)(op + 32 * mb + 8 * g4) = w; }
        }
    }
}

#if defined(__HIP_DEVICE_COMPILE__)
typedef const Params __attribute__((address_space(4)))* KParams;
__device__ __forceinline__ Params load_params() { KParams p = (KParams)__builtin_amdgcn_kernarg_segment_ptr(); asm volatile("" : "+s"(p)); return *p; }
#else
__device__ __forceinline__ Params load_params() { return Params{}; }
#endif
#define LP const Params P = load_params(); unsigned char* const ws = P.ws; float* const H = P.out; (void)ws; (void)H
__global__ void __launch_bounds__(512, 2) yoco_fwd(Params P_arg) {
    extern __shared__ __attribute__((aligned(16))) unsigned char lds[];
    cg::grid_group grid = cg::this_grid();
    LAS unsigned char* ldsl = (LAS unsigned char*)lds;
    const int G = gridDim.x, c = blockIdx.x;
    if (threadIdx.x == 0) { ((LAS unsigned*)(ldsl + 131072))[0] = 0u; ((LAS unsigned*)(ldsl + 131072))[1] = 0u; }
    __syncthreads();
#define GSYNC() do { LP; xcd_barrier((unsigned*)(ws + WS_BAR), (volatile LAS unsigned*)(ldsl + 131072)); } while (0)

#ifdef PROF_A_HI
#define STAMP(k) do { LP; if (((k) == PROF_A_LO || (k) == PROF_A_HI || (k) == PROF_B_LO || (k) == PROF_B_HI) && blockIdx.x == 0 && threadIdx.x == 0) ((unsigned long long*)(P.ws + WS_CNT + 1024))[k] = __builtin_amdgcn_s_memrealtime(); } while (0)
#else
#define STAMP(k) do { } while (0)
#endif
    STAMP(0);
    { LP; p0_prep(P, lds, 15); if (blockIdx.x == 0) for (int i = threadIdx.x; i < XCD_BAR_WORDS; i += 512) ((unsigned*)(ws + WS_BAR))[i] = 0u; }
    grid.sync();
    { LP; if (threadIdx.x == 0) (void)xb_add(&((unsigned*)(ws + WS_BAR))[XB_XCNT(xb_xcc_id())], 1u); }
#ifdef DUP_SYNC
#pragma unroll 1
    for (int r = 0; r < 16; ++r) GSYNC();
#endif
#ifdef DUP_P0
    { LP; p0_prep(P, lds, DUP_P0); }
    GSYNC();
#endif
    STAMP(1);
#if LEVEL >= 1
#pragma unroll 1
    for (int rep = 0; rep < NREP_S1; ++rep) {
    {   LP;
        pg8::SchedSsm S; S.init(256, 512, G, c); pg8::EpiS1 E{(float*)(ws + WS_SST)};
        pg8::gemm_phase<false>(ldsl, (const char*)(ws + WS_XA), (const char*)(ws + WS_BT1), 512, S, E);
        asm volatile("s_waitcnt vmcnt(0)" ::: "memory"); __syncthreads();
        pg8::Unit u; for (int i = 0; S.next(i, u); ++i) scan_unit(P, u.aux, u.pm); }
    GSYNC(); } STAMP(2);
#pragma unroll 1
    for (int rep = 0; rep < NREP_S2; ++rep) {
    {   LP;
        pg8::SchedSsm S; S.init(512, 640, G, c); pg8::EpiS2 E{(const bf16_t*)(ws + WS_XA), P.ssm_d, (bf16_t*)(ws + WS_BIG)};
        pg8::gemm_phase<false>(ldsl, (const char*)(ws + WS_XA), (const char*)(ws + WS_BT2), 640, S, E); }
    GSYNC(); } STAMP(4);
#pragma unroll 1
    for (int rep = 0; rep < NREP_GLU; ++rep) {
    {   LP;
        pg8::SchedDense S; S.init(T_, 2048, 1024, 1024, G, c); pg8::EpiUp<1> E{(bf16_t*)(ws + WS_GA), 1024};
        pg8::gemm_phase<false>(ldsl, (const char*)(ws + WS_BIG), (const char*)(ws + WS_WGLU), 1024, S, E); }
    GSYNC(); } STAMP(5);
#endif
    { LP; ln_phase<0, true>(P, (LEVEL >= 1) ? P.x : H, P.ln_g, P.ln_b, lds, H, (bf16_t*)(ws + WS_H16), (LEVEL >= 1) ? (const bf16_t*)(ws + WS_GA) : nullptr); }
    GSYNC(); STAMP(6);
#if LEVEL >= 2
#pragma unroll 1
    for (int rep = 0; rep < NREP_FUP; ++rep) {
    {   LP;
        pg8::SchedDense S; S.init(T_, 2 * FF_, 1024, 1024, G, c); pg8::EpiUp<0> E{(bf16_t*)(ws + WS_BIG), FF_};
        pg8::gemm_phase<true>(ldsl, (const char*)(ws + WS_H16), (const char*)(ws + WS_WUP), 1024, S, E); }
    GSYNC(); } STAMP(7);
#pragma unroll 1
    for (int rep = 0; rep < NREP_FDN; ++rep) {
    {   LP;
#define NREP_CUR NREP_FDN
        pg8::SchedDense S; S.init(T_, 1024, FF_, FF_, G, c); pg8::EpiBf16 E{(bf16_t*)(ws + WS_GA), 1024};
        pg8::gemm_phase<false>(ldsl, (const char*)(ws + WS_BIG), (const char*)(ws + WS_WDN), FF_, S, E); }
    GSYNC(); } STAMP(8);
#endif
    { LP; ln_phase<0, false>(P, H, P.ln_g + 1024, P.ln_b + 1024, lds, H, (bf16_t*)(ws + WS_H16), (LEVEL >= 2) ? (const bf16_t*)(ws + WS_GA) : nullptr); }
    GSYNC(); STAMP(9);
#if LEVEL >= 3
#pragma unroll 1
    for (int rep = 0; rep < NREP_QKV; ++rep) {
    {   LP;
        pg8::SchedDense S; S.init(T_, 1536, 1024, 1024, G, c);
        pg8::EpiQkv E{(bf16_t*)(ws + WS_BIG), (bf16_t*)(ws + WS_BIG + 64 * MiB), (bf16_t*)(ws + WS_BIG + 80 * MiB), (const float*)(ws + WS_ROPEC), (const float*)(ws + WS_ROPES)};
        pg8::gemm_phase<true>(ldsl, (const char*)(ws + WS_H16), (const char*)(ws + WS_WQKV), 1024, S, E); }
    GSYNC(); } STAMP(10);
#ifndef SKIP_ATT
    { LP; attn_phase(P, lds); }
#endif
    GSYNC(); STAMP(11);
#pragma unroll 1
    for (int rep = 0; rep < NREP_OUT; ++rep) {
    {   LP;
#undef NREP_CUR
#define NREP_CUR NREP_OUT
        pg8::SchedDense S; S.init(T_, 1024, 1024, 1024, G, c);
        pg8::EpiBf16 E{(bf16_t*)(ws + WS_GA), 1024};
        pg8::gemm_phase<false>(ldsl, (const char*)(ws + WS_BIG + 96 * MiB), (const char*)(ws + WS_WO), 1024, S, E); }
    GSYNC(); } STAMP(12);
#endif
#if LEVEL >= 4
    { LP; ln_phase<1, false>(P, H, P.ln_g + 2048, P.ln_b + 2048, lds, H, (bf16_t*)(ws + WS_H16), (const bf16_t*)(ws + WS_GA)); }
    GSYNC(); STAMP(13);
#pragma unroll 1
    for (int rep = 0; rep < NREP_GATH; ++rep) {
    { LP; gather_phase(P); }
    GSYNC(); } STAMP(14);
#pragma unroll 1
    for (int rep = 0; rep < NREP_MUP; ++rep) {
    {   LP;
        pg8::SchedMoe S; S.init((const int*)(ws + WS_CNT), 2048, 1024, (size_t)2048 * 1024 * 2, G, c); pg8::EpiUp<0> E{(bf16_t*)(ws + WS_BIG), 1024};
        pg8::gemm_phase<true>(ldsl, (const char*)(ws + WS_GA), (const char*)(ws + WS_WMUP), 1024, S, E); }
    GSYNC(); } STAMP(15);
#pragma unroll 1
    for (int rep = 0; rep < NREP_MDN; ++rep) {
    {   LP;
        pg8::SchedMoe S; S.init((const int*)(ws + WS_CNT), 1024, 1024, (size_t)1024 * 1024 * 2, G, c); pg8::EpiBf16 E{(bf16_t*)(ws + WS_Y), 1024};
        pg8::gemm_phase<false>(ldsl, (const char*)(ws + WS_BIG), (const char*)(ws + WS_WMDN), 1024, S, E); }
    GSYNC(); } STAMP(16);
    { LP; ln_phase<2, false>(P, H, P.ln_g + 3072, P.ln_b + 3072, lds, H, (bf16_t*)(ws + WS_H16), nullptr); }
#ifdef PROF_A_HI
    GSYNC(); STAMP(17);
    {   LP; const unsigned long long* stamps = (const unsigned long long*)(P.ws + WS_CNT + 1024);
        const float tA = (float)(stamps[PROF_A_HI] - stamps[PROF_A_LO]) * 0.01f, tB = (float)(stamps[PROF_B_HI] - stamps[PROF_B_LO]) * 0.01f;
        for (int i = blockIdx.x * 512 + threadIdx.x; i < (1 << 22); i += gridDim.x * 512) H[(size_t)i * 8 + 1] = tB;
        if (blockIdx.x == 0 && threadIdx.x == 0) H[0] = 64.0f * tA; }
#endif
#else
    { LP; ln_phase<0, false>(P, H, P.ln_g + 2048, P.ln_b + 2048, lds, H, (bf16_t*)(ws + WS_H16), (LEVEL >= 3) ? (const bf16_t*)(ws + WS_GA) : nullptr); }
    GSYNC(); STAMP(13);
    { LP; ln_phase<0, false>(P, H, P.ln_g + 3072, P.ln_b + 3072, lds, H, (bf16_t*)(ws + WS_H16), nullptr); }
#endif
}

extern "C" void kernel_launch(void* const* d_in, const int* in_sizes, int n_in, void* d_out, int out_size, void* d_ws, size_t ws_size, hipStream_t stream) {
    static int grid_blocks = 0;
    if (grid_blocks == 0) {
        if (n_in != 25 || out_size != T_ * D_ || ws_size < WS_END) { fprintf(stderr, "kernel_launch: unexpected shapes (n_in %d out %d ws %zu)\n", n_in, out_size, ws_size); grid_blocks = -1; return; }
        int dev = 0, cus = 0, per_cu = 0;
        hipGetDevice(&dev); hipDeviceGetAttribute(&cus, hipDeviceAttributeMultiprocessorCount, dev);
        if (hipFuncSetAttribute((const void*)yoco_fwd, hipFuncAttributeMaxDynamicSharedMemorySize, LDS_BYTES) != hipSuccess) { fprintf(stderr, "kernel_launch: hipFuncSetAttribute failed\n"); grid_blocks = -1; return; }
        if (hipOccupancyMaxActiveBlocksPerMultiprocessor(&per_cu, (const void*)yoco_fwd, 512, LDS_BYTES) != hipSuccess || per_cu < 1) { fprintf(stderr, "kernel_launch: occupancy query says %d\n", per_cu); per_cu = 1; (void)hipGetLastError(); }
        grid_blocks = cus * 1;
    }
    if (grid_blocks < 0) return;
    Params p{};
    p.x = (const float*)d_in[0]; p.pos = (const int*)d_in[1]; p.ln_g = (const float*)d_in[2]; p.ln_b = (const float*)d_in[3];
    p.lam_re = (const float*)d_in[4]; p.lam_im = (const float*)d_in[5]; p.log_step = (const float*)d_in[6]; p.b_re = (const float*)d_in[7]; p.b_im = (const float*)d_in[8];
    p.c_re = (const float*)d_in[9]; p.c_im = (const float*)d_in[10]; p.ssm_d = (const float*)d_in[11]; p.w_glu = (const float*)d_in[12]; p.kv_w = (const float*)d_in[13];
    p.w_q = (const float*)d_in[14]; p.sinks = (const float*)d_in[15]; p.w_out = (const float*)d_in[16]; p.ffn_g = (const float*)d_in[17]; p.ffn_u = (const float*)d_in[18]; p.ffn_d = (const float*)d_in[19];
    p.w_router = (const float*)d_in[20]; p.b_router = (const float*)d_in[21]; p.moe_g = (const float*)d_in[22]; p.moe_u = (const float*)d_in[23]; p.moe_d = (const float*)d_in[24];
    p.out = (float*)d_out; p.ws = (unsigned char*)d_ws;
    void* args[] = {&p};
    hipError_t e = hipLaunchCooperativeKernel((const void*)yoco_fwd, dim3(grid_blocks), dim3(512), args, LDS_BYTES, stream);
    if (e != hipSuccess) fprintf(stderr, "cooperative launch failed: %s (grid %d)\n", hipGetErrorString(e), grid_blocks);
}
```

```cpp
#include <hip/hip_runtime.h>
#include <hip/hip_cooperative_groups.h>
#include <cstdio>
namespace cg = cooperative_groups;

#ifndef LEVEL
#define LEVEL 4
#endif

#ifdef DUP_S1
#define NREP_S1 2
#else
#define NREP_S1 1
#endif
#ifdef DUP_S2
#define NREP_S2 2
#else
#define NREP_S2 1
#endif
#ifdef DUP_GLU
#define NREP_GLU 2
#else
#define NREP_GLU 1
#endif
#ifdef DUP_FUP
#define NREP_FUP 2
#else
#define NREP_FUP 1
#endif
#if defined(DUP_FDN) || defined(DUP_FDNNULL)
#define NREP_FDN 2
#else
#define NREP_FDN 1
#endif
#ifdef DUP_QKV
#define NREP_QKV 2
#else
#define NREP_QKV 1
#endif
#if defined(DUP_OUT) || defined(DUP_OUTNULL)
#define NREP_OUT 2
#else
#define NREP_OUT 1
#endif
#ifdef DUP_MUP
#define NREP_MUP 2
#else
#define NREP_MUP 1
#endif
#ifdef DUP_MDN
#define NREP_MDN 2
#else
#define NREP_MDN 1
#endif
#ifdef DUP_SCAN
#define NREP_SCAN 2
#else
#define NREP_SCAN 1
#endif
#ifdef DUP_GATH
#define NREP_GATH 2
#else
#define NREP_GATH 1
#endif
#ifdef DUP_OUTNULL
#define SKIP_EPI_OUT (rep == 0)
#else
#define SKIP_EPI_OUT false
#endif
#ifdef DUP_FDNNULL
#define SKIP_EPI_FDN (rep == 0)
#else
#define SKIP_EPI_FDN false
#endif
#define LAS __attribute__((address_space(3)))
typedef unsigned short bf16_t;
typedef short bf16x8 __attribute__((ext_vector_type(8)));
typedef float f32x4 __attribute__((ext_vector_type(4)));
typedef float f32x16 __attribute__((ext_vector_type(16)));
typedef unsigned u32x4 __attribute__((ext_vector_type(4)));
typedef unsigned u32x2 __attribute__((ext_vector_type(2)));

constexpr int T_ = 32768, D_ = 1024, FF_ = 2816;
constexpr float ALPHA = 1.41421356237309515f;
constexpr float LN_EPS = 1e-5f;
constexpr size_t MiB = 1ull << 20;
constexpr size_t WS_CNT = 0, WS_BAR = 4096, WS_A32 = 65536, WS_ROPEC = 1 * MiB, WS_ROPES = 2 * MiB, WS_LIST = 3 * MiB, WS_TOK = 4 * MiB;
constexpr size_t WS_WMUP = 8 * MiB, WS_WMDN = 40 * MiB, WS_WGLU = 56 * MiB, WS_WUP = 60 * MiB, WS_WDN = 71 * MiB, WS_WQKV = 77 * MiB, WS_WO = 80 * MiB;
constexpr size_t WS_H16 = 82 * MiB, WS_BT2 = 146 * MiB, WS_BT1 = 186 * MiB, WS_XA = 202 * MiB, WS_SST = 282 * MiB, WS_GA = 146 * MiB, WS_Y = 146 * MiB;
constexpr size_t WS_BIG = 314 * MiB, WS_END = 490 * MiB;
constexpr int LDS_BYTES = 131072 + 16;

struct Params {
    const float* x; const int* pos; const float* ln_g; const float* ln_b;
    const float* lam_re; const float* lam_im; const float* log_step; const float* b_re; const float* b_im; const float* c_re; const float* c_im;
    const float* ssm_d; const float* w_glu; const float* kv_w; const float* w_q; const float* sinks; const float* w_out;
    const float* ffn_g; const float* ffn_u; const float* ffn_d; const float* w_router; const float* b_router;
    const float* moe_g; const float* moe_u; const float* moe_d;
    float* out; unsigned char* ws; int skip; int pad;
};

__device__ __forceinline__ unsigned pk_bf16(float lo, float hi) { unsigned r; asm volatile("v_cvt_pk_bf16_f32 %0, %1, %2" : "=v"(r) : "v"(lo), "v"(hi)); return r; }
typedef _Float16 f16x8 __attribute__((ext_vector_type(8)));
typedef _Float16 f16x2 __attribute__((ext_vector_type(2)));
__device__ __forceinline__ unsigned pk_f16(float lo, float hi) { union { f16x2 h; unsigned u; } c; c.h = (f16x2){(_Float16)lo, (_Float16)hi}; return c.u; }
__device__ __forceinline__ float hf_lo(unsigned w) { union { unsigned u; f16x2 h; } c; c.u = w; return (float)c.h[0]; }
__device__ __forceinline__ float hf_hi(unsigned w) { union { unsigned u; f16x2 h; } c; c.u = w; return (float)c.h[1]; }
__device__ __forceinline__ float bf_lo(unsigned w) { return __uint_as_float(w << 16); }
__device__ __forceinline__ float bf_hi(unsigned w) { return __uint_as_float(w & 0xffff0000u); }
__device__ __forceinline__ float sigmoidf_(float x) { return __builtin_amdgcn_rcpf(1.0f + __expf(-x)); }
__device__ __forceinline__ float gelu_tanh(float y) { const float u = 1.5957691216057308f * (y + 0.044715f * y * y * y); return y * sigmoidf_(u); }
__device__ __forceinline__ float xor16(float v) { const unsigned u = __float_as_uint(v); const auto r = __builtin_amdgcn_permlane16_swap(u, u, false, false); return __uint_as_float(r[0] == u ? r[1] : r[0]); }
__device__ __forceinline__ float wave_sum(float v) {
    v += __shfl_xor(v, 32); v += __shfl_xor(v, 16); v += __shfl_xor(v, 8); v += __shfl_xor(v, 4); v += __shfl_xor(v, 2); v += __shfl_xor(v, 1); return v; }


#define XB_TMO      128
#define XB_XCNT(j)  (256  + 64 * (j))
#define XB_XSUB(j)  (1280 + 64 * (j))
#define XB_XGEN(j)  (2304 + 64 * (j))
#define XB_TOP      3328
#define XB_TOPGEN   3392
#define XCD_BAR_WORDS 3456
#define XB_SPIN_CAP (1u << 22)
__device__ __forceinline__ unsigned xb_ld(unsigned* p)              { return __hip_atomic_load(p, __ATOMIC_RELAXED, __HIP_MEMORY_SCOPE_AGENT); }
__device__ __forceinline__ unsigned xb_add(unsigned* p, unsigned v) { return __hip_atomic_fetch_add(p, v, __ATOMIC_RELAXED, __HIP_MEMORY_SCOPE_AGENT); }
__device__ __forceinline__ unsigned xb_xcc_id() { return (unsigned)__builtin_amdgcn_s_getreg((3 << 11) | 20) & 0xFu; }
#define XB_SPIN(cond, bar) do { unsigned _sp = 0; while (cond) { __builtin_amdgcn_s_sleep(1); \
    if ((++_sp & 255u) == 0u) { if (xb_ld(&(bar)[XB_TMO])) break; if (_sp > XB_SPIN_CAP) { atomicAdd(&(bar)[XB_TMO], 1u); break; } } } } while (0)
__device__ __forceinline__ void xcd_barrier_complete(unsigned* bar, unsigned x, unsigned& nloc, unsigned& nx) {
    const unsigned G = gridDim.x * gridDim.y * gridDim.z;
    unsigned sum, cnt, mine, sp = 0u;
    for (;;) {
        sum = 0u; cnt = 0u; mine = 0u;
#pragma unroll
        for (unsigned j = 0; j < 16; ++j) { const unsigned c = xb_ld(&bar[XB_XCNT(j)]); sum += c; cnt += (c > 0u) ? 1u : 0u; mine = (j == x) ? c : mine; }
        if (sum == G) break;
        __builtin_amdgcn_s_sleep(1);
        if ((++sp & 255u) == 0u) { if (xb_ld(&bar[XB_TMO])) break; if (sp > XB_SPIN_CAP) { atomicAdd(&bar[XB_TMO], 1u); break; } }
    }
    nloc = mine > 0u ? mine : 1u; nx = cnt > 0u ? cnt : 1u;
}
__device__ __forceinline__ void xcd_barrier(unsigned* bar, volatile LAS unsigned* st) {
    asm volatile("s_waitcnt vmcnt(0)" ::: "memory");
    __syncthreads();
    if (threadIdx.x == 0) {
        const unsigned x = xb_xcc_id();
        __builtin_amdgcn_s_waitcnt(0);
        unsigned nloc = st[0], nx = st[1];
        if (nloc == 0u) { xcd_barrier_complete(bar, x, nloc, nx); st[0] = nloc; st[1] = nx; }
        const unsigned old = xb_add(&bar[XB_XSUB(x)], 1u);
        const unsigned gen = old / nloc;
        if (old + 1u == (gen + 1u) * nloc) {
            __builtin_amdgcn_fence(__ATOMIC_RELEASE, "agent");
            asm volatile("s_waitcnt vmcnt(0)" ::: "memory");
            const unsigned og = xb_add(&bar[XB_TOP], 1u);
            const unsigned tg = og / nx;
            if (og + 1u == (tg + 1u) * nx) xb_add(&bar[XB_TOPGEN], 1u);
            else XB_SPIN(xb_ld(&bar[XB_TOPGEN]) == tg, bar);
            __builtin_amdgcn_fence(__ATOMIC_ACQUIRE, "agent");
            xb_add(&bar[XB_XGEN(x)], 1u);
            asm volatile("s_waitcnt vmcnt(0)" ::: "memory");
        } else {
            XB_SPIN(xb_ld(&bar[XB_XGEN(x)]) == gen, bar);
            __builtin_amdgcn_fence(__ATOMIC_ACQUIRE, "agent");
            asm volatile("s_waitcnt vmcnt(0)" ::: "memory");
        }
    }
    __syncthreads();
}

namespace pg8 {
constexpr int BM = 256, BK = 64, HALF = 128, HTB = HALF * BK * 2, NXCD = 8, WGM = 8;
__device__ __forceinline__ int lds_byte(int r, int c) { const int st = (r >> 4) * 2 + (c >> 5), rr = r & 15, cc = c & 31, ob = rr * 64 + cc * 2; return st * 1024 + (ob ^ (((ob >> 9) & 1) << 5)); }
__device__ __forceinline__ void stage_rc(int b, int& R, int& C) { const int st = b / 1024, sb = b % 1024, swz = sb ^ (((sb >> 9) & 1) << 5); R = (st >> 1) * 16 + swz / 64; C = (st & 1) * 32 + (swz % 64) / 2; }
__device__ __forceinline__ int perm32(int rho) { const int n = rho >> 4, i = rho & 15; return 8 * (i >> 2) + 4 * n + (i & 3); }
__device__ __forceinline__ int xcd_remap(int L, int nwg) { const int q = nwg / NXCD, r = nwg % NXCD, xcd = L % NXCD, off = L / NXCD; return (xcd < r ? xcd * (q + 1) : r * (q + 1) + (xcd - r) * q) + off; }

struct Unit { int pm, pn, aux, pad; size_t a_off, b_off; };

struct SchedDense {
    int nM, nN, nwg, G, c, lda, K;
    __device__ __forceinline__ void init(int M, int N, int K_, int lda_, int G_, int c_) { nM = M / BM; nN = N / BM; nwg = nM * nN; G = G_; c = c_; lda = lda_; K = K_; }
    __device__ __forceinline__ bool next(int i, Unit& u) const {
        const int L = i * G + c; if (L >= nwg) return false;
        const int wgid = xcd_remap(L, nwg);
        const int nig = WGM * nN, gid = wgid / nig, fm = gid * WGM, gsz = (nM - fm) < WGM ? (nM - fm) : WGM;
        u.pm = fm + ((wgid % nig) % gsz); u.pn = (wgid % nig) / gsz; u.aux = 0; u.pad = 0;
        u.a_off = (size_t)u.pm * BM * lda * 2; u.b_off = (size_t)u.pn * BM * K * 2; return true;
    }
    __device__ __forceinline__ unsigned voffA(int R, int C) const { return (unsigned)(R * lda + C) * 2u; }
    __device__ __forceinline__ size_t a_kstep() const { return BK * 2; }
    __device__ __forceinline__ size_t a_hstep() const { return (size_t)HALF * lda * 2; }
};
struct SchedMoe {
    int nM, nN, nwg, G, c, K; int tb[9]; size_t estride;
    __device__ __forceinline__ void init(const int* cnt, int N, int K_, size_t estride_, int G_, int c_) {
        tb[0] = 0;
#pragma unroll
        for (int e = 0; e < 8; ++e) tb[e + 1] = tb[e] + ((cnt[e] + 255) >> 8);
        nM = tb[8]; nN = N / BM; nwg = nM * nN; G = G_; c = c_; K = K_; estride = estride_; }
    __device__ __forceinline__ bool next(int i, Unit& u) const {
        const int L = i * G + c; if (L >= nwg) return false;
        const int wgid = xcd_remap(L, nwg);
        const int nig = WGM * nN, gid = wgid / nig, fm = gid * WGM, gsz = (nM - fm) < WGM ? (nM - fm) : WGM;
        u.pm = fm + ((wgid % nig) % gsz); u.pn = (wgid % nig) / gsz; int e = 0;
#pragma unroll
        for (int k = 1; k < 8; ++k) e += (u.pm >= tb[k]) ? 1 : 0;
        u.aux = e; u.pad = 0;
        u.a_off = (size_t)u.pm * BM * 1024 * 2; u.b_off = (size_t)e * estride + (size_t)u.pn * BM * K * 2; return true;
    }
    __device__ __forceinline__ unsigned voffA(int R, int C) const { return (unsigned)(R * 1024 + C) * 2u; }
    __device__ __forceinline__ size_t a_kstep() const { return BK * 2; }
    __device__ __forceinline__ size_t a_hstep() const { return (size_t)HALF * 1024 * 2; }
};
struct SchedSsm {
    int nN, nwg, G, c, K, N;
    __device__ __forceinline__ void init(int N_, int K_, int G_, int c_) { N = N_; nN = N_ / BM; nwg = 64 * 4 * nN; G = G_; c = c_; K = K_; }
    __device__ __forceinline__ bool next(int i, Unit& u) const {
        const int L = i * G + c; if (L >= nwg) return false;
        const int wgid = xcd_remap(L, nwg);
        const int per = 4 * nN, g = (wgid / (4 * per)) * 4 + (wgid & 3), rem = (wgid >> 2) % per;
        u.pm = rem & 3; u.pn = rem >> 2; u.aux = g; u.pad = 0;
        u.a_off = ((size_t)u.pm * BM * 40 * 1024 + (size_t)g * 16) * 2; u.b_off = (size_t)g * N * K * 2 + (size_t)u.pn * BM * K * 2; return true;
    }
    __device__ __forceinline__ unsigned voffA(int R, int C) const { return (unsigned)((R * 40 + (C >> 4)) * 1024 + (C & 15)) * 2u; }
    __device__ __forceinline__ size_t a_kstep() const { return 4 * 1024 * 2; }
    __device__ __forceinline__ size_t a_hstep() const { return (size_t)HALF * 40 * 1024 * 2; }
};

template <bool F16, class Epi, class Sched>
__device__ __forceinline__ void gemm_phase(LAS unsigned char* lds, const char* Ab, const char* Bb, const int K, const Sched& S, const Epi& E) {
    const int tid = threadIdx.x, wid = __builtin_amdgcn_readfirstlane(tid >> 6), lane = tid & 63, wr = wid >> 2, wc = wid & 3, fr = lane & 15, fq = lane >> 4;
    const int nt = K / BK;
    unsigned voffA[2], voffB[2];
#pragma unroll
    for (int i = 0; i < 2; ++i) { int R, C; stage_rc(tid * 16 + i * 8192, R, C); const int Rb = Epi::PERM ? ((R & ~31) + perm32(R & 31)) : R;
        voffA[i] = S.voffA(R, C); voffB[i] = (unsigned)(Rb * K + C) * 2u; }
    const size_t kstepA = S.a_kstep(), hstepA = S.a_hstep(), kstepB = (size_t)(BK * 2), hstepB = (size_t)HALF * K * 2;
    const unsigned ldsw = (unsigned)wid * 1024u;
    const int aoff = lds_byte(wr * 64 + fr, fq * 8), boff = lds_byte(wc * 32 + fr, fq * 8);
#define PG8_SA(b, h) (((b) * 2 + (h)) * HTB)
#define PG8_SB(b, h) ((4 + (b) * 2 + (h)) * HTB)
#define PG8_STAGE(bufoff, gbase, voff) do { _Pragma("unroll") for (int _i = 0; _i < 2; ++_i) \
        __builtin_amdgcn_global_load_lds((const unsigned*)((const char*)(gbase) + (voff)[_i]), (LAS unsigned*)(lds + (bufoff) + ldsw + _i * 8192), 16, 0, 0); } while (0)
#define PG8_LDA(dst, b, h) do { _Pragma("unroll") for (int m = 0; m < 4; ++m) _Pragma("unroll") for (int k = 0; k < 2; ++k) dst[m][k] = *(const LAS bf16x8*)(lds + PG8_SA(b, h) + aoff + m * 2048 + k * 1024); } while (0)
#define PG8_LDB(dst, b, h) do { _Pragma("unroll") for (int n = 0; n < 2; ++n) _Pragma("unroll") for (int k = 0; k < 2; ++k) dst[n][k] = *(const LAS bf16x8*)(lds + PG8_SB(b, h) + boff + n * 2048 + k * 1024); } while (0)
#define PG8_MMA(ai, bj, At, Bt) do { __builtin_amdgcn_s_setprio(1); _Pragma("unroll") for (int m = 0; m < 4; ++m) _Pragma("unroll") for (int n = 0; n < 2; ++n) _Pragma("unroll") for (int k = 0; k < 2; ++k) \
        acc[ai][bj][m][n] = F16 ? __builtin_amdgcn_mfma_f32_16x16x32_f16(__builtin_bit_cast(f16x8, Bt[n][k]), __builtin_bit_cast(f16x8, At[m][k]), acc[ai][bj][m][n], 0, 0, 0) : __builtin_amdgcn_mfma_f32_16x16x32_bf16(Bt[n][k], At[m][k], acc[ai][bj][m][n], 0, 0, 0); __builtin_amdgcn_s_setprio(0); } while (0)
#define PG8_WAIT_V(n) asm volatile("s_waitcnt vmcnt(" #n ")" ::: "memory")
#define PG8_WAIT_L(n) asm volatile("s_waitcnt lgkmcnt(" #n ")" ::: "memory")
#define PG8_BAR __builtin_amdgcn_s_barrier()
#define PG8_SCHED __builtin_amdgcn_sched_barrier(0)
    Unit cur, nxt; int ui = 0;
    if (!S.next(0, cur)) return;
    f32x4 acc[2][2][4][2];
#pragma unroll
    for (int a = 0; a < 2; ++a)
#pragma unroll
        for (int b = 0; b < 2; ++b)
#pragma unroll
            for (int m = 0; m < 4; ++m)
#pragma unroll
                for (int n = 0; n < 2; ++n) acc[a][b][m][n] = (f32x4){0.f, 0.f, 0.f, 0.f};
    bf16x8 At[4][2], B0[2][2], B1[2][2];
    const char* cA = Ab + cur.a_off; const char* cB = Bb + cur.b_off;
    PG8_STAGE(PG8_SB(0, 0), cB, voffB); PG8_STAGE(PG8_SA(0, 0), cA, voffA); PG8_STAGE(PG8_SB(0, 1), cB + hstepB, voffB); PG8_STAGE(PG8_SA(0, 1), cA + hstepA, voffA);
    if (wr == 1) PG8_BAR;
    PG8_WAIT_V(4); PG8_BAR;
    PG8_STAGE(PG8_SB(1, 0), cB + kstepB, voffB); PG8_STAGE(PG8_SA(1, 0), cA + kstepA, voffA); PG8_STAGE(PG8_SB(1, 1), cB + hstepB + kstepB, voffB);
    PG8_WAIT_V(6); PG8_BAR;
    for (;;) {
        const bool has_next = S.next(ui + 1, nxt);
        const char* nA = has_next ? Ab + nxt.a_off : cA; const char* nB = has_next ? Bb + nxt.b_off : cB;
        for (int t = 0; t < nt; t += 2) {
            const bool last = (t == nt - 2);
            const char* a1 = cA + (size_t)(t + 1) * kstepA;
            const char* a2 = last ? nA : cA + (size_t)(t + 2) * kstepA; const char* b2 = last ? nB : cB + (size_t)(t + 2) * kstepB;
            const char* a3 = a2 + kstepA; const char* b3 = b2 + kstepB;
            PG8_LDB(B0, 0, 0); PG8_SCHED; PG8_LDA(At, 0, 0); PG8_STAGE(PG8_SA(1, 1), a1 + hstepA, voffA);
            PG8_WAIT_L(8); PG8_BAR; PG8_WAIT_L(0); PG8_MMA(0, 0, At, B0); PG8_BAR; PG8_SCHED;
            PG8_LDB(B1, 0, 1); PG8_STAGE(PG8_SB(0, 0), b2, voffB);
            PG8_BAR; PG8_WAIT_L(0); PG8_MMA(0, 1, At, B1); PG8_BAR;
            PG8_LDA(At, 0, 1); PG8_STAGE(PG8_SA(0, 0), a2, voffA);
            PG8_BAR; PG8_WAIT_L(0); PG8_MMA(1, 0, At, B0); PG8_BAR; PG8_SCHED;
            PG8_STAGE(PG8_SB(0, 1), b2 + hstepB, voffB);
            PG8_WAIT_V(6); PG8_BAR; PG8_MMA(1, 1, At, B1); PG8_BAR;
            PG8_LDB(B0, 1, 0); PG8_SCHED; PG8_LDA(At, 1, 0); PG8_STAGE(PG8_SA(0, 1), a2 + hstepA, voffA);
            PG8_WAIT_L(8); PG8_BAR; PG8_WAIT_L(0); PG8_MMA(0, 0, At, B0); PG8_BAR; PG8_SCHED;
            PG8_LDB(B1, 1, 1); PG8_STAGE(PG8_SB(1, 0), b3, voffB);
            PG8_BAR; PG8_WAIT_L(0); PG8_MMA(0, 1, At, B1); PG8_BAR;
            PG8_LDA(At, 1, 1); PG8_STAGE(PG8_SA(1, 0), a3, voffA);
            PG8_BAR; PG8_WAIT_L(0); PG8_MMA(1, 0, At, B0); PG8_BAR; PG8_SCHED;
            PG8_STAGE(PG8_SB(1, 1), b3 + hstepB, voffB);
            PG8_WAIT_V(6); PG8_BAR; PG8_MMA(1, 1, At, B1); PG8_BAR;
        }
        E(acc, cur, wr, wc, fr, fq);
        if (!has_next) break;
#pragma unroll
        for (int a = 0; a < 2; ++a)
#pragma unroll
            for (int b = 0; b < 2; ++b)
#pragma unroll
                for (int m = 0; m < 4; ++m)
#pragma unroll
                    for (int n = 0; n < 2; ++n) acc[a][b][m][n] = (f32x4){0.f, 0.f, 0.f, 0.f};
        cur = nxt; cA = nA; cB = nB; ++ui;
    }
    PG8_WAIT_V(0);
    if (wr == 0) PG8_BAR;
    PG8_BAR;
#undef PG8_SA
#undef PG8_SB
#undef PG8_STAGE
#undef PG8_LDA
#undef PG8_LDB
#undef PG8_MMA
#undef PG8_WAIT_V
#undef PG8_WAIT_L
#undef PG8_BAR
#undef PG8_SCHED
}

typedef const f32x4 (&AccRef)[2][2][4][2];

struct EpiS1 {
    static constexpr bool PERM = false; float* sst;
    __device__ __forceinline__ void operator()(AccRef acc, const Unit& u, int wr, int wc, int fr, int fq) const {
#pragma unroll
        for (int ai = 0; ai < 2; ++ai)
#pragma unroll
            for (int m = 0; m < 4; ++m) { const int row = u.pm * BM + ai * HALF + wr * 64 + m * 16 + fr; float* rp = sst + ((size_t)row * 64 + u.aux) * 128 + wc * 32 + 4 * fq;
#pragma unroll
                for (int n = 0; n < 2; ++n) *(f32x4*)(rp + 16 * n) = acc[ai][0][m][n]; }
    }
};
struct EpiS2 {
    static constexpr bool PERM = true; const bf16_t* xa; const float* dsk; bf16_t* g16;
    __device__ __forceinline__ void operator()(AccRef acc, const Unit& u, int wr, int wc, int fr, int fq) const {
        const int ch = u.aux * 16 + 8 * (fq & 1);
        const f32x4 d0 = *(const f32x4*)(dsk + ch), d1 = *(const f32x4*)(dsk + ch + 4);
#pragma unroll
        for (int ai = 0; ai < 2; ++ai)
#pragma unroll
            for (int m = 0; m < 4; ++m) { const int row = u.pm * BM + ai * HALF + wr * 64 + m * 16 + fr;
#pragma unroll
                for (int bj = 0; bj < 2; ++bj) { const int t = 16 * u.pn + 8 * bj + 2 * wc + (fq >> 1);
                    const u32x4 xv = *(const u32x4*)(xa + ((size_t)row * 40 + t) * 1024 + ch);
                    const f32x4 x0 = {bf_lo(xv.x), bf_hi(xv.x), bf_lo(xv.y), bf_hi(xv.y)}, x1 = {bf_lo(xv.z), bf_hi(xv.z), bf_lo(xv.w), bf_hi(xv.w)};
                    const f32x4 y0 = acc[ai][bj][m][0] + d0 * x0, y1 = acc[ai][bj][m][1] + d1 * x1;
                    u32x4 w; w.x = pk_bf16(gelu_tanh(y0[0]), gelu_tanh(y0[1])); w.y = pk_bf16(gelu_tanh(y0[2]), gelu_tanh(y0[3]));
                    w.z = pk_bf16(gelu_tanh(y1[0]), gelu_tanh(y1[1])); w.w = pk_bf16(gelu_tanh(y1[2]), gelu_tanh(y1[3]));
                    *(u32x4*)(g16 + ((size_t)row * 32 + t) * 1024 + ch) = w; } }
    }
};
struct EpiGlu {
    static constexpr bool PERM = false; const float* x; float* out;
    __device__ __forceinline__ void operator()(AccRef acc, const Unit& u, int wr, int wc, int fr, int fq) const {
#pragma unroll
        for (int ai = 0; ai < 2; ++ai)
#pragma unroll
            for (int m = 0; m < 4; ++m) { const int row = u.pm * BM + ai * HALF + wr * 64 + m * 16 + fr; const size_t off = (size_t)row * 1024 + u.pn * 128 + wc * 32 + 4 * fq;
#pragma unroll
                for (int n = 0; n < 2; ++n) { const f32x4 xv = *(const f32x4*)(x + off + 16 * n); const f32x4 v = acc[ai][0][m][n], g = acc[ai][1][m][n]; f32x4 o;
#pragma unroll
                    for (int j = 0; j < 4; ++j) o[j] = ALPHA * xv[j] + v[j] * sigmoidf_(g[j]);
                    *(f32x4*)(out + off + 16 * n) = o; } }
    }
};
template <int ACT> struct EpiUp {
    static constexpr bool PERM = true; bf16_t* act; int ld;
    __device__ __forceinline__ void operator()(AccRef acc, const Unit& u, int wr, int wc, int fr, int fq) const {
#pragma unroll
        for (int ai = 0; ai < 2; ++ai)
#pragma unroll
            for (int m = 0; m < 4; ++m) { const int row = u.pm * BM + ai * HALF + wr * 64 + m * 16 + fr; float r[8];
#pragma unroll
                for (int n = 0; n < 2; ++n)
#pragma unroll
                    for (int j = 0; j < 4; ++j) { const float g = acc[ai][0][m][n][j], up = acc[ai][1][m][n][j]; r[4 * n + j] = (ACT == 0) ? g * sigmoidf_(g) * up : g * sigmoidf_(up); }
                u32x4 w; w.x = pk_bf16(r[0], r[1]); w.y = pk_bf16(r[2], r[3]); w.z = pk_bf16(r[4], r[5]); w.w = pk_bf16(r[6], r[7]);
                *(u32x4*)(act + (size_t)row * ld + u.pn * 128 + wc * 32 + 8 * fq) = w; }
    }
};
struct EpiRes {
    static constexpr bool PERM = false; const float* hin; float* h; bool skip;
    __device__ __forceinline__ void operator()(AccRef acc, const Unit& u, int wr, int wc, int fr, int fq) const {
        if (skip) return;
#pragma unroll
        for (int ai = 0; ai < 2; ++ai)
#pragma unroll
            for (int m = 0; m < 4; ++m) { const int row = u.pm * BM + ai * HALF + wr * 64 + m * 16 + fr; const size_t ro = (size_t)row * 1024 + u.pn * BM + wc * 32 + 4 * fq;
#pragma unroll
                for (int bj = 0; bj < 2; ++bj)
#pragma unroll
                    for (int n = 0; n < 2; ++n) { const size_t o = ro + bj * HALF + 16 * n; const f32x4 hv = *(const f32x4*)(hin + o); *(f32x4*)(h + o) = ALPHA * hv + acc[ai][bj][m][n]; } }
    }
};
struct EpiQkv {
    static constexpr bool PERM = true; bf16_t* q; bf16_t* k; bf16_t* v; const float* rc; const float* rs;
    __device__ __forceinline__ void operator()(AccRef acc, const Unit& u, int wr, int wc, int fr, int fq) const {
        const bool rope = (u.pn <= 4) && ((wc & 1) == 0);
        bf16_t* base; int ld, colt; float scale = 1.0f;
        if (u.pn < 4) { base = q; ld = 1024; colt = u.pn * BM; scale = 0.125f * 1.4426950408889634f; } else if (u.pn == 4) { base = k; ld = 256; colt = 0; } else { base = v; ld = 256; colt = 0; }
#pragma unroll
        for (int ai = 0; ai < 2; ++ai)
#pragma unroll
            for (int m = 0; m < 4; ++m) { const int row = u.pm * BM + ai * HALF + wr * 64 + m * 16 + fr;
                f32x4 c0 = {1.f, 1.f, 1.f, 1.f}, c1 = c0, s0 = {0.f, 0.f, 0.f, 0.f}, s1 = s0;
                if (rope && fq < 2) { c0 = *(const f32x4*)(rc + (size_t)row * 8); c1 = *(const f32x4*)(rc + (size_t)row * 8 + 4); s0 = *(const f32x4*)(rs + (size_t)row * 8); s1 = *(const f32x4*)(rs + (size_t)row * 8 + 4);
                    if (fq == 0) { s0 = -s0; s1 = -s1; } }
#pragma unroll
                for (int bj = 0; bj < 2; ++bj) { f32x4 v0 = acc[ai][bj][m][0], v1 = acc[ai][bj][m][1];
                    if (rope) { f32x4 p0, p1;
#pragma unroll
                        for (int j = 0; j < 4; ++j) { p0[j] = xor16(v0[j]); p1[j] = xor16(v1[j]); }
                        v0 = v0 * c0 + p0 * s0; v1 = v1 * c1 + p1 * s1; }
                    v0 = v0 * scale; v1 = v1 * scale;
                    u32x4 w; w.x = pk_bf16(v0[0], v0[1]); w.y = pk_bf16(v0[2], v0[3]); w.z = pk_bf16(v1[0], v1[1]); w.w = pk_bf16(v1[2], v1[3]);
                    *(u32x4*)(base + (size_t)row * ld + colt + bj * HALF + wc * 32 + 8 * fq) = w; } }
    }
};
struct EpiBf16 {
    static constexpr bool PERM = true; bf16_t* o; int ld;
    __device__ __forceinline__ void operator()(AccRef acc, const Unit& u, int wr, int wc, int fr, int fq) const {
#pragma unroll
        for (int ai = 0; ai < 2; ++ai)
#pragma unroll
            for (int m = 0; m < 4; ++m) { const int row = u.pm * BM + ai * HALF + wr * 64 + m * 16 + fr;
#pragma unroll
                for (int bj = 0; bj < 2; ++bj) { const f32x4 v0 = acc[ai][bj][m][0], v1 = acc[ai][bj][m][1];
                    u32x4 w; w.x = pk_bf16(v0[0], v0[1]); w.y = pk_bf16(v0[2], v0[3]); w.z = pk_bf16(v1[0], v1[1]); w.w = pk_bf16(v1[2], v1[3]);
                    *(u32x4*)(o + (size_t)row * ld + u.pn * BM + bj * HALF + wc * 32 + 8 * fq) = w; } }
    }
};
struct EpiNull {
    static constexpr bool PERM = false; float* h;
    __device__ __forceinline__ void operator()(AccRef acc, const Unit& u, int wr, int wc, int fr, int fq) const {
        if (u.pm < 0) {
#pragma unroll
            for (int ai = 0; ai < 2; ++ai)
#pragma unroll
                for (int m = 0; m < 4; ++m)
#pragma unroll
                    for (int bj = 0; bj < 2; ++bj)
#pragma unroll
                        for (int n = 0; n < 2; ++n) *(f32x4*)(h + ((ai * 4 + m) * 4 + bj * 2 + n) * 256 + fr * 16 + fq * 4) = acc[ai][bj][m][n]; }
    }
};
}

__device__ __forceinline__ void transpose_tile(const float* __restrict__ src0, const float* __restrict__ src1, int ld, int k0, int col0, int col1, bf16_t* __restrict__ dst, int Kd, int n0, float* tile, const bool f16 = false) {
    const int tid = threadIdx.x;
    { const int nn = (tid & 63) * 4, kb = tid >> 6;
      const float* sp = (nn < 128) ? (src0 + col0 + nn) : (src1 + col1 + (nn - 128));
      f32x4 v[8];
#pragma unroll
      for (int i = 0; i < 8; ++i) v[i] = *(const f32x4*)(sp + (size_t)(k0 + kb + 8 * i) * ld);
#pragma unroll
      for (int i = 0; i < 8; ++i) { float* t = tile + (kb + 8 * i) * 257 + nn; t[0] = v[i][0]; t[1] = v[i][1]; t[2] = v[i][2]; t[3] = v[i][3]; } }
    __syncthreads();
    { const int ks = (tid & 7) * 8;
#pragma unroll
      for (int i = 0; i < 4; ++i) { const int n = (tid >> 3) + 64 * i; float r[8];
#pragma unroll
          for (int j = 0; j < 8; ++j) r[j] = tile[(ks + j) * 257 + n];
          u32x4 w; if (f16) { w.x = pk_f16(r[0], r[1]); w.y = pk_f16(r[2], r[3]); w.z = pk_f16(r[4], r[5]); w.w = pk_f16(r[6], r[7]); } else { w.x = pk_bf16(r[0], r[1]); w.y = pk_bf16(r[2], r[3]); w.z = pk_bf16(r[4], r[5]); w.w = pk_bf16(r[6], r[7]); }
          *(u32x4*)(dst + (size_t)(n0 + n) * Kd + k0 + ks) = w; } }
    __syncthreads();
}

__device__ void ssm_tables(const Params& P, int g, int qtr, unsigned char* lds) {
    const int tid = threadIdx.x;
    float* apr = (float*)lds;
    float* api = apr + 33 * 64;
    float* bbr = api + 33 * 64;
    float* bbi = bbr + 1024;
    float* ccr = bbi + 1024;
    float* cci = ccr + 1024;
    float* kg = cci + 1024;
    const float dtf = expf(P.log_step[g]);
    for (int idx = tid; idx < 33 * 64; idx += 512) { const int tau = idx >> 6, p = idx & 63;
        const float lr = P.lam_re[g * 64 + p], li = P.lam_im[g * 64 + p];
        const double dt = (double)dtf; double rev = (double)li * dt * (double)tau * 0.15915494309189535; rev -= floor(rev);
        const float ang = (float)(rev * 6.283185307179586); float sn, cs; sincosf(ang, &sn, &cs);
        const float mag = expf((float)((double)lr * dt * (double)tau));
        apr[idx] = mag * cs; api[idx] = mag * sn; }
    for (int idx = tid; idx < 1024; idx += 512) { ccr[idx] = P.c_re[g * 1024 + idx]; cci[idx] = P.c_im[g * 1024 + idx]; }
    __syncthreads();
    for (int idx = tid; idx < 1024; idx += 512) { const int p = idx >> 4;
        const float lr = P.lam_re[g * 64 + p], li = P.lam_im[g * 64 + p], ar = apr[64 + p], ai = api[64 + p];
        const float nr = ar - 1.0f, den = lr * lr + li * li, kr = (nr * lr + ai * li) / den, ki = (ai * lr - nr * li) / den;
        const float br = P.b_re[g * 1024 + idx], bi = P.b_im[g * 1024 + idx];
        bbr[idx] = kr * br - ki * bi; bbi[idx] = kr * bi + ki * br; }
    __syncthreads();
    { const int cp = tid & 15, c = 4 * qtr + ((tid >> 4) & 3), t0 = tid >> 6;
      for (int i = 0; i < 4; ++i) { const int tau = t0 + 8 * i; float s = 0.f;
          for (int p = 0; p < 64; ++p) { const float cr = ccr[c * 64 + p], ci = cci[c * 64 + p], ar = apr[tau * 64 + p], ai = api[tau * 64 + p];
              const float zr = cr * ar - ci * ai, zi = cr * ai + ci * ar; s += zr * bbr[p * 16 + cp] - zi * bbi[p * 16 + cp]; }
          kg[(tau * 16 + c) * 16 + cp] = s; } }
    __syncthreads();
    bf16_t* bt2 = (bf16_t*)(P.ws + WS_BT2) + (size_t)g * 512 * 640;
    for (int pc = tid; pc < 128 * 80; pc += 512) { const int nq = pc / 80, k8 = (pc % 80) * 8, t = nq >> 2, c = 4 * qtr + (nq & 3), n = t * 16 + c; float r[8];
        if (k8 < 512) { const int s = k8 >> 4, c0 = k8 & 15;
#pragma unroll
            for (int j = 0; j < 8; ++j) r[j] = (t >= s) ? kg[((t - s) * 16 + c) * 16 + c0 + j] : 0.f;
        } else { const int q0 = k8 - 512;
#pragma unroll
            for (int j = 0; j < 8; j += 2) { const int p = (q0 + j) >> 1; const float cr = ccr[c * 64 + p], ci = cci[c * 64 + p], ar = apr[(t + 1) * 64 + p], ai = api[(t + 1) * 64 + p];
                r[j] = cr * ar - ci * ai; r[j + 1] = -(cr * ai + ci * ar); } }
        u32x4 w; w.x = pk_bf16(r[0], r[1]); w.y = pk_bf16(r[2], r[3]); w.z = pk_bf16(r[4], r[5]); w.w = pk_bf16(r[6], r[7]);
        *(u32x4*)(bt2 + (size_t)n * 640 + k8) = w; }
    bf16_t* bt1 = (bf16_t*)(P.ws + WS_BT1) + (size_t)g * 256 * 512;
    for (int pc = tid; pc < 64 * 64; pc += 512) { const int q = 64 * qtr + (pc >> 6), k8 = (pc & 63) * 8; float r[8];
        if (q < 128) { const int p = q >> 1, s = k8 >> 4, c0 = k8 & 15; const float ar = apr[(31 - s) * 64 + p], ai = api[(31 - s) * 64 + p];
#pragma unroll
            for (int j = 0; j < 8; ++j) { const float br = bbr[p * 16 + c0 + j], bi = bbi[p * 16 + c0 + j]; r[j] = (q & 1) ? (ar * bi + ai * br) : (ar * br - ai * bi); }
        } else {
#pragma unroll
            for (int j = 0; j < 8; ++j) r[j] = 0.f; }
        u32x4 w; w.x = pk_bf16(r[0], r[1]); w.y = pk_bf16(r[2], r[3]); w.z = pk_bf16(r[4], r[5]); w.w = pk_bf16(r[6], r[7]);
        *(u32x4*)(bt1 + (size_t)q * 512 + k8) = w; }
    float* a32 = (float*)(P.ws + WS_A32);
    if (qtr == 0 && tid < 64) { a32[(g * 64 + tid) * 2] = apr[32 * 64 + tid]; a32[(g * 64 + tid) * 2 + 1] = api[32 * 64 + tid]; }
    __syncthreads();
}

__device__ void p0_prep(const Params& P, unsigned char* lds, const int mask) {
    const int tid = threadIdx.x, G = gridDim.x;
    if (blockIdx.x == 0 && tid < 8) ((int*)(P.ws + WS_CNT))[tid] = 0;
    constexpr int J_SSM = 256, J_X = 512, J_ROPE = 512, J_T = 2352;
    constexpr int NJ = J_SSM + J_X + J_ROPE + J_T;
    for (int job = blockIdx.x; job < NJ; job += G) {
        if (job < J_SSM) {
#if LEVEL >= 1
            if (mask & 1) ssm_tables(P, job >> 2, job & 3, lds);
#endif
        }
        else if (job < J_SSM + J_X) { if (!(mask & 2)) continue;
            const int r0 = (job - J_SSM) * 64; bf16_t* xa = (bf16_t*)(P.ws + WS_XA);
#pragma unroll 4
            for (int i = 0; i < 16; ++i) { const int piece = tid + 512 * i, r = r0 + (piece >> 7), c8 = (piece & 127) * 8;
                const f32x4 a = *(const f32x4*)(P.x + (size_t)r * 1024 + c8), b = *(const f32x4*)(P.x + (size_t)r * 1024 + c8 + 4);
                u32x4 w; w.x = pk_bf16(a[0], a[1]); w.y = pk_bf16(a[2], a[3]); w.z = pk_bf16(b[0], b[1]); w.w = pk_bf16(b[2], b[3]);
                *(u32x4*)(xa + ((size_t)(r >> 5) * 40 + (r & 31)) * 1024 + c8) = w;
#if LEVEL < 1
                *(f32x4*)(P.out + (size_t)r * 1024 + c8) = a; *(f32x4*)(P.out + (size_t)r * 1024 + c8 + 4) = b;
#endif
            }
        }
        else if (job < J_SSM + J_X + J_ROPE) { if (!(mask & 4)) continue;
            const int tok = (job - J_SSM - J_X) * 64 + (tid >> 3), i = tid & 7;
            const float invf[8] = {1.0f, 0.19392274474868576f, 0.03760603093086393f, 0.007292664737217109f, 0.001414213562373095f, 0.0002742481756762073f, 5.318295896944988e-05f, 1.031338537721246e-05f};
            float f = invf[0];
#pragma unroll
            for (int k = 1; k < 8; ++k) f = (i == k) ? invf[k] : f;
            const float ang = (float)P.pos[tok] * f; float sn, cs; sincosf(ang, &sn, &cs);
            ((float*)(P.ws + WS_ROPEC))[tok * 8 + i] = cs; ((float*)(P.ws + WS_ROPES))[tok * 8 + i] = sn;
        }
        else {
            if (!(mask & 8)) continue;
            int jt = job - J_SSM - J_X - J_ROPE; float* tile = (float*)lds;
            if (jt < 128) { const int kt = jt & 15, pn = jt >> 4;
                transpose_tile(P.w_glu, P.w_glu, 2048, kt * 64, 128 * pn, 1024 + 128 * pn, (bf16_t*)(P.ws + WS_WGLU), 1024, 256 * pn, tile); }
            else if ((jt -= 128) < 352) { const int kt = jt & 15, pn = jt >> 4;
                transpose_tile(P.ffn_g, P.ffn_u, 2816, kt * 64, 128 * pn, 128 * pn, (bf16_t*)(P.ws + WS_WUP), 1024, 256 * pn, tile, true); }
            else if ((jt -= 352) < 176) { const int kt = jt % 44, pn = jt / 44;
                transpose_tile(P.ffn_d, P.ffn_d, 1024, kt * 64, 256 * pn, 256 * pn + 128, (bf16_t*)(P.ws + WS_WDN), 2816, 256 * pn, tile); }
            else if ((jt -= 176) < 64) { const int kt = jt & 15, pn = jt >> 4;
                transpose_tile(P.w_q, P.w_q, 1024, kt * 64, 256 * pn, 256 * pn + 128, (bf16_t*)(P.ws + WS_WQKV), 1024, 256 * pn, tile, true); }
            else if ((jt -= 64) < 32) { const int kt = jt & 15, pn = jt >> 4;
                transpose_tile(P.kv_w, P.kv_w, 512, kt * 64, 256 * pn, 256 * pn + 128, (bf16_t*)(P.ws + WS_WQKV), 1024, 1024 + 256 * pn, tile, true); }
            else if ((jt -= 32) < 64) { const int kt = jt & 15, pn = jt >> 4;
                transpose_tile(P.w_out, P.w_out, 1024, kt * 64, 256 * pn, 256 * pn + 128, (bf16_t*)(P.ws + WS_WO), 1024, 256 * pn, tile); }
            else if ((jt -= 64) < 1024) { const int e = jt >> 7, r = jt & 127, kt = r & 15, pn = r >> 4;
                transpose_tile(P.moe_g + (size_t)e * 1048576, P.moe_u + (size_t)e * 1048576, 1024, kt * 64, 128 * pn, 128 * pn, (bf16_t*)(P.ws + WS_WMUP) + (size_t)e * 2048 * 1024, 1024, 256 * pn, tile, true); }
            else { jt -= 1024; const int e = jt >> 6, r = jt & 63, kt = r & 15, pn = r >> 4;
                transpose_tile(P.moe_d + (size_t)e * 1048576, P.moe_d + (size_t)e * 1048576, 1024, kt * 64, 256 * pn, 256 * pn + 128, (bf16_t*)(P.ws + WS_WMDN) + (size_t)e * 1048576, 1024, 256 * pn, tile); }
        }
    }
}

__device__ void scan_unit(const Params& P, int g, int pm) {
    const float* sst = (const float*)(P.ws + WS_SST); const float* a32 = (const float*)(P.ws + WS_A32); bf16_t* xa = (bf16_t*)(P.ws + WS_XA);
    const int tid = threadIdx.x;
    if (tid < 256) {
        const int p = tid & 63, b = pm * 4 + (tid >> 6), q = 2 * p;
        const float ar = a32[(g * 64 + p) * 2], ai = a32[(g * 64 + p) * 2 + 1];
        float hr = 0.f, hi = 0.f;
#pragma unroll 1
        for (int jb = 0; jb < 64; jb += 16) {
            float2 s[16];
#pragma unroll
            for (int j = 0; j < 16; ++j) s[j] = *(const float2*)(sst + ((size_t)(b * 64 + jb + j) * 64 + g) * 128 + q);
#pragma unroll
            for (int j = 0; j < 16; ++j) { const int row = b * 64 + jb + j;
                *(unsigned*)(xa + ((size_t)row * 40 + 32 + (q >> 4)) * 1024 + g * 16 + (q & 15)) = pk_bf16(hr, hi);
                const float nr = ar * hr - ai * hi + s[j].x, ni = ar * hi + ai * hr + s[j].y; hr = nr; hi = ni; }
        }
    }
}

template <int MODE, bool IN32>
__device__ void ln_phase(const Params& P, const float* h, const float* gam, const float* bet, unsigned char* lds, float* hout, bf16_t* h16, const bf16_t* d16) {
    const int tid = threadIdx.x, wid = tid >> 6, lane = tid & 63;
    float* wrt = (float*)lds;
    int* cnt = (int*)(P.ws + WS_CNT); int* lists = (int*)(P.ws + WS_LIST); int* toki = (int*)(P.ws + WS_TOK);
    const bf16_t* Y = (const bf16_t*)(P.ws + WS_Y);
    int base[8];
    int* lcnt = (int*)(lds + 32768);
    int* rinfo = (int*)(lds + 32768 + 64);
    if (MODE == 1) { for (int k = 0; k < 16; ++k) { const int idx = tid + 512 * k; wrt[(idx & 7) * 1024 + (idx >> 3)] = P.w_router[idx]; } if (tid < 8) lcnt[tid] = 0; __syncthreads(); }
    int kiter = 0;
    if (MODE == 2) { int acc = 0;
#pragma unroll
        for (int e = 0; e < 8; ++e) { base[e] = acc; acc += ((cnt[e] + 255) >> 8) << 8; } }
    f32x4 gv[4], bv[4];
#pragma unroll
    for (int i = 0; i < 4; ++i) { gv[i] = *(const f32x4*)(gam + 256 * i + lane * 4); bv[i] = *(const f32x4*)(bet + 256 * i + lane * 4); }
    for (int row = blockIdx.x * 8 + wid; row < T_; row += gridDim.x * 8, ++kiter) {
        f32x4 v[4];
        if (IN32) {
#pragma unroll
            for (int i = 0; i < 4; ++i) v[i] = *(const f32x4*)(h + (size_t)row * 1024 + 256 * i + lane * 4);
        } else {
#pragma unroll
            for (int i = 0; i < 4; ++i) { const u32x2 a = *(const u32x2*)(h16 + (size_t)row * 1024 + 256 * i + lane * 4); v[i] = (f32x4){hf_lo(a.x), hf_hi(a.x), hf_lo(a.y), hf_hi(a.y)}; }
        }
        if (MODE != 2 && d16 != nullptr) {
#pragma unroll
            for (int i = 0; i < 4; ++i) { const u32x2 a = *(const u32x2*)(d16 + (size_t)row * 1024 + 256 * i + lane * 4);
                v[i][0] = ALPHA * v[i][0] + bf_lo(a.x); v[i][1] = ALPHA * v[i][1] + bf_hi(a.x); v[i][2] = ALPHA * v[i][2] + bf_lo(a.y); v[i][3] = ALPHA * v[i][3] + bf_hi(a.y); }
        }
        if (MODE == 2) {
            const int e1 = toki[row * 8 + 0], p1 = toki[row * 8 + 1], e2 = toki[row * 8 + 2], p2 = toki[row * 8 + 3];
            const float w1 = __int_as_float(toki[row * 8 + 4]), w2 = __int_as_float(toki[row * 8 + 5]);
            int b1 = 0, b2 = 0;
#pragma unroll
            for (int e = 0; e < 8; ++e) { b1 = (e1 == e) ? base[e] : b1; b2 = (e2 == e) ? base[e] : b2; }
            const bf16_t* y1 = Y + (size_t)(b1 + p1) * 1024; const bf16_t* y2 = Y + (size_t)(b2 + p2) * 1024;
#pragma unroll
            for (int i = 0; i < 4; ++i) { const u32x2 a = *(const u32x2*)(y1 + 256 * i + lane * 4), b = *(const u32x2*)(y2 + 256 * i + lane * 4);
                v[i][0] = ALPHA * v[i][0] + (w1 * bf_lo(a.x) + w2 * bf_lo(b.x)); v[i][1] = ALPHA * v[i][1] + (w1 * bf_hi(a.x) + w2 * bf_hi(b.x));
                v[i][2] = ALPHA * v[i][2] + (w1 * bf_lo(a.y) + w2 * bf_lo(b.y)); v[i][3] = ALPHA * v[i][3] + (w1 * bf_hi(a.y) + w2 * bf_hi(b.y)); }
        }
        float s = 0.f;
#pragma unroll
        for (int i = 0; i < 4; ++i) s += (v[i][0] + v[i][1]) + (v[i][2] + v[i][3]);
        const float mu = wave_sum(s) * (1.0f / 1024.0f);
        float q = 0.f;
#pragma unroll
        for (int i = 0; i < 4; ++i) { v[i] = v[i] - mu; q += (v[i][0] * v[i][0] + v[i][1] * v[i][1]) + (v[i][2] * v[i][2] + v[i][3] * v[i][3]); }
        const float rstd = rsqrtf(wave_sum(q) * (1.0f / 1024.0f) + LN_EPS);
#pragma unroll
        for (int i = 0; i < 4; ++i) { v[i] = v[i] * rstd * gv[i] + bv[i]; if (MODE == 2) *(f32x4*)(hout + (size_t)row * 1024 + 256 * i + lane * 4) = v[i];
            if (MODE != 2) { u32x2 w; w.x = pk_f16(v[i][0], v[i][1]); w.y = pk_f16(v[i][2], v[i][3]); *(u32x2*)(h16 + (size_t)row * 1024 + 256 * i + lane * 4) = w; } }
        if (MODE == 1) {
            float lg[8];
#pragma unroll
            for (int e = 0; e < 8; ++e) { float a = 0.f;
#pragma unroll
                for (int i = 0; i < 4; ++i) { const f32x4 w = *(const f32x4*)(wrt + e * 1024 + 256 * i + lane * 4); a += (v[i][0] * w[0] + v[i][1] * w[1]) + (v[i][2] * w[2] + v[i][3] * w[3]); }
                lg[e] = wave_sum(a) + P.b_router[e]; }
            int e1 = 0; float v1 = lg[0];
#pragma unroll
            for (int e = 1; e < 8; ++e) if (lg[e] > v1) { v1 = lg[e]; e1 = e; }
            int e2 = -1; float v2 = -3.0e38f;
#pragma unroll
            for (int e = 0; e < 8; ++e) if (e != e1 && lg[e] > v2) { v2 = lg[e]; e2 = e; }
            const float ex = __expf(v2 - v1), w1 = 1.0f / (1.0f + ex), w2 = ex / (1.0f + ex);
            if (lane == 0) { const int p1 = atomicAdd(lcnt + e1, 1), p2 = atomicAdd(lcnt + e2, 1); int* ri = rinfo + (kiter * 8 + wid) * 6;
                ri[0] = e1; ri[1] = p1; ri[2] = e2; ri[3] = p2; ri[4] = __float_as_int(w1); ri[5] = __float_as_int(w2); }
        }
    }
    if (MODE == 1) {
        __syncthreads();
        if (tid < 8) lcnt[8 + tid] = atomicAdd(cnt + tid, lcnt[tid]);
        __syncthreads();
        for (int lr = tid; lr < 512; lr += 512) { const int row = blockIdx.x * 8 + (lr & 7) + (lr >> 3) * gridDim.x * 8;
            if (row < T_) { const int* ri = rinfo + lr * 6; const int e1 = ri[0], e2 = ri[2], p1 = lcnt[8 + e1] + ri[1], p2 = lcnt[8 + e2] + ri[3];
                lists[e1 * T_ + p1] = row; lists[e2 * T_ + p2] = row;
                toki[row * 8 + 0] = e1; toki[row * 8 + 1] = p1; toki[row * 8 + 2] = e2; toki[row * 8 + 3] = p2; toki[row * 8 + 4] = ri[4]; toki[row * 8 + 5] = ri[5]; } }
    }
}

__device__ void gather_phase(const Params& P) {
    const int tid = threadIdx.x, wid = tid >> 6, lane = tid & 63;
    const int* cnt = (const int*)(P.ws + WS_CNT); const int* lists = (const int*)(P.ws + WS_LIST);
    const bf16_t* h16 = (const bf16_t*)(P.ws + WS_H16); bf16_t* ga = (bf16_t*)(P.ws + WS_GA);
    int base[9], c[8]; base[0] = 0;
#pragma unroll
    for (int e = 0; e < 8; ++e) { c[e] = cnt[e]; base[e + 1] = base[e] + (((c[e] + 255) >> 8) << 8); }
    for (int r = blockIdx.x * 8 + wid; r < base[8]; r += gridDim.x * 8) {
        int e = 0;
#pragma unroll
        for (int k = 1; k < 8; ++k) e += (r >= base[k]) ? 1 : 0;
        int be = 0, ce = 0;
#pragma unroll
        for (int k = 0; k < 8; ++k) { be = (e == k) ? base[k] : be; ce = (e == k) ? c[k] : ce; }
        const int pos = r - be; u32x4 a = {0u, 0u, 0u, 0u}, b = a;
        if (pos < ce) { const int tok = lists[e * T_ + pos]; a = *(const u32x4*)(h16 + (size_t)tok * 1024 + lane * 8); b = *(const u32x4*)(h16 + (size_t)tok * 1024 + 512 + lane * 8); }
        *(u32x4*)(ga + (size_t)r * 1024 + lane * 8) = a; *(u32x4*)(ga + (size_t)r * 1024 + 512 + lane * 8) = b;
    }
}

__device__ void attn_phase(const Params& P, unsigned char* lds) {
    const int tid = threadIdx.x, wid = tid >> 6, lane = tid & 63, n = lane & 31, hh = lane >> 5;
    bf16_t* Ks = (bf16_t*)lds;
    bf16_t* Vt = (bf16_t*)(lds + 256 * 144);
    const bf16_t* QB = (const bf16_t*)(P.ws + WS_BIG); const bf16_t* KB = (const bf16_t*)(P.ws + WS_BIG + 64 * MiB); const bf16_t* VB = (const bf16_t*)(P.ws + WS_BIG + 80 * MiB);
    bf16_t* OB = (bf16_t*)(P.ws + WS_BIG + 96 * MiB);
#ifdef DUP_ATT
    constexpr int NITEM = 2048;
#else
    constexpr int NITEM = 1024;
#endif
    u32x4 kreg[4], vreg0[2], vreg1[2];
#define ATT_LOAD(it) do { const int kvh_ = (it) & 3, nb_ = ((it) >> 2) & 15, b_ = ((it) >> 6) & 15, tok_ = b_ * 2048 + nb_ * 128; \
        _Pragma("unroll") for (int i = 0; i < 4; ++i) { const int piece = tid + 512 * i, s = piece >> 3, pc = piece & 7; kreg[i] = (u32x4){0u, 0u, 0u, 0u}; \
            if (nb_ > 0 || s >= 128) kreg[i] = *(const u32x4*)(KB + (size_t)(tok_ - 128 + s) * 256 + kvh_ * 64 + pc * 8); } \
        _Pragma("unroll") for (int i = 0; i < 2; ++i) { const int s = 2 * (tid & 127), pc = (tid >> 7) + 4 * i; vreg0[i] = (u32x4){0u, 0u, 0u, 0u}; vreg1[i] = vreg0[i]; \
            if (nb_ > 0 || s >= 128) { vreg0[i] = *(const u32x4*)(VB + (size_t)(tok_ - 128 + s) * 256 + kvh_ * 64 + pc * 8); vreg1[i] = *(const u32x4*)(VB + (size_t)(tok_ - 127 + s) * 256 + kvh_ * 64 + pc * 8); } } } while (0)
    if ((int)blockIdx.x < NITEM) ATT_LOAD((int)blockIdx.x);
    for (int item = blockIdx.x; item < NITEM; item += gridDim.x) {
        const int kvh = item & 3, nb = (item >> 2) & 15, b = (item >> 6) & 15;
        const int tok0 = b * 2048 + nb * 128;
        __syncthreads();
#pragma unroll
        for (int i = 0; i < 4; ++i) { const int piece = tid + 512 * i, s = piece >> 3, pc = piece & 7; *(u32x4*)(Ks + s * 72 + pc * 8) = kreg[i]; }
#pragma unroll
        for (int i = 0; i < 2; ++i) { const int s = 2 * (tid & 127), pc = (tid >> 7) + 4 * i; const u32x4 v0 = vreg0[i], v1 = vreg1[i];
            unsigned* vt = (unsigned*)(Vt + (pc * 8) * 264 + s);
            vt[0 * 132] = (v0.x & 0xffffu) | (v1.x << 16); vt[1 * 132] = (v0.x >> 16) | (v1.x & 0xffff0000u);
            vt[2 * 132] = (v0.y & 0xffffu) | (v1.y << 16); vt[3 * 132] = (v0.y >> 16) | (v1.y & 0xffff0000u);
            vt[4 * 132] = (v0.z & 0xffffu) | (v1.z << 16); vt[5 * 132] = (v0.z >> 16) | (v1.z & 0xffff0000u);
            vt[6 * 132] = (v0.w & 0xffffu) | (v1.w << 16); vt[7 * 132] = (v0.w >> 16) | (v1.w & 0xffff0000u); }
        __syncthreads();
        if (item + (int)gridDim.x < NITEM) ATT_LOAD(item + (int)gridDim.x);
        const int hq = kvh * 4 + (wid >> 1);
        const float sink = P.sinks[hq] * 1.4426950408889634f;
#pragma unroll 1
        for (int qq = 0; qq < 2; ++qq) {
            const int kb0 = (wid & 1) * 2 + qq, i0 = 32 * kb0, qi = i0 + n;
            const bf16_t* qp = QB + (size_t)(tok0 + qi) * 1024 + hq * 64 + 8 * hh;
            bf16x8 qf[4];
#pragma unroll
            for (int ks = 0; ks < 4; ++ks) qf[ks] = *(const bf16x8*)(qp + 16 * ks);
            f32x16 sacc[5];
#pragma unroll
            for (int kb = 0; kb < 5; ++kb) {
#pragma unroll
                for (int i = 0; i < 16; ++i) sacc[kb][i] = 0.f;
                const bf16_t* kp = Ks + (32 * (kb0 + kb) + n) * 72 + 8 * hh;
#pragma unroll
                for (int ks = 0; ks < 4; ++ks) { const bf16x8 a = *(const bf16x8*)(kp + 16 * ks); sacc[kb] = __builtin_amdgcn_mfma_f32_32x32x16_bf16(a, qf[ks], sacc[kb], 0, 0, 0); }
                asm volatile("" ::: "memory"); }
            const int nn4 = n - 4 * hh;
#pragma unroll
            for (int i = 0; i < 16; ++i) { const int r = 8 * (i >> 2) + (i & 3);
                sacc[0][i] = (r > nn4) ? sacc[0][i] : -1.0e30f; sacc[4][i] = (r <= nn4) ? sacc[4][i] : -1.0e30f; }
            if (nb == 0) {
#pragma unroll
                for (int kb = 0; kb < 4; ++kb) if (kb0 + kb < 4) {
#pragma unroll
                    for (int i = 0; i < 16; ++i) sacc[kb][i] = -1.0e30f; } }
            float mx = sink;
#pragma unroll
            for (int kb = 0; kb < 5; ++kb)
#pragma unroll
                for (int i = 0; i < 16; ++i) mx = fmaxf(mx, sacc[kb][i]);
            mx = fmaxf(mx, __shfl_xor(mx, 32));
            float sum = 0.f;
#pragma unroll
            for (int kb = 0; kb < 5; ++kb)
#pragma unroll
                for (int i = 0; i < 16; ++i) { const float p = __builtin_amdgcn_exp2f(sacc[kb][i] - mx); sacc[kb][i] = p; sum += p; }
            sum += __shfl_xor(sum, 32); sum += __builtin_amdgcn_exp2f(sink - mx);
            f32x16 oacc[2];
#pragma unroll
            for (int i = 0; i < 16; ++i) { oacc[0][i] = 0.f; oacc[1][i] = 0.f; }
#pragma unroll
            for (int kb = 0; kb < 5; ++kb)
#pragma unroll
                for (int sl = 0; sl < 2; ++sl) {
                    union { u32x4 u; bf16x8 v; } pb;
                    pb.u.x = pk_bf16(sacc[kb][8 * sl + 0], sacc[kb][8 * sl + 1]); pb.u.y = pk_bf16(sacc[kb][8 * sl + 2], sacc[kb][8 * sl + 3]);
                    pb.u.z = pk_bf16(sacc[kb][8 * sl + 4], sacc[kb][8 * sl + 5]); pb.u.w = pk_bf16(sacc[kb][8 * sl + 6], sacc[kb][8 * sl + 7]);
#pragma unroll
                    for (int mb = 0; mb < 2; ++mb) { const bf16_t* vp = Vt + (32 * mb + n) * 264 + 32 * (kb0 + kb) + 16 * sl + 4 * hh;
                        union { u32x4 u; bf16x8 v; } va; const u32x2 lo = *(const u32x2*)vp, hi = *(const u32x2*)(vp + 8); va.u.x = lo.x; va.u.y = lo.y; va.u.z = hi.x; va.u.w = hi.y;
                        oacc[mb] = __builtin_amdgcn_mfma_f32_32x32x16_bf16(va.v, pb.v, oacc[mb], 0, 0, 0); }
                    asm volatile("" ::: "memory"); }
            const float inv = 1.0f / sum;
            bf16_t* op = OB + (size_t)(tok0 + qi) * 1024 + hq * 64 + 4 * hh;
#pragma unroll
            for (int mb = 0; mb < 2; ++mb)
#pragma unroll
                for (int g4 = 0; g4 < 4; ++g4) { u32x2 w; w.x = pk_bf16(oacc[mb][4 * g4 + 0] * inv, oacc[mb][4 * g4 + 1] * inv); w.y = pk_bf16(oacc[mb][4 * g4 + 2] * inv, oacc[mb][4 * g4 + 3] * inv);
                    *(u32x2*)(op + 32 * mb + 8 * g4) = w; }
        }
    }
}

#if defined(__HIP_DEVICE_COMPILE__)
typedef const Params __attribute__((address_space(4)))* KParams;
__device__ __forceinline__ Params load_params() { KParams p = (KParams)__builtin_amdgcn_kernarg_segment_ptr(); asm volatile("" : "+s"(p)); return *p; }
#else
__device__ __forceinline__ Params load_params() { return Params{}; }
#endif
#define LP const Params P = load_params(); unsigned char* const ws = P.ws; float* const H = P.out; (void)ws; (void)H
__global__ void __launch_bounds__(512, 2) yoco_fwd(Params P_arg) {
    extern __shared__ __attribute__((aligned(16))) unsigned char lds[];
    cg::grid_group grid = cg::this_grid();
    LAS unsigned char* ldsl = (LAS unsigned char*)lds;
    const int G = gridDim.x, c = blockIdx.x;
    if (threadIdx.x == 0) { ((LAS unsigned*)(ldsl + 131072))[0] = 0u; ((LAS unsigned*)(ldsl + 131072))[1] = 0u; }
    __syncthreads();
#define GSYNC() do { LP; xcd_barrier((unsigned*)(ws + WS_BAR), (volatile LAS unsigned*)(ldsl + 131072)); } while (0)

#ifdef PROF_A_HI
#define STAMP(k) do { LP; if (((k) == PROF_A_LO || (k) == PROF_A_HI || (k) == PROF_B_LO || (k) == PROF_B_HI) && blockIdx.x == 0 && threadIdx.x == 0) ((unsigned long long*)(P.ws + WS_CNT + 1024))[k] = __builtin_amdgcn_s_memrealtime(); } while (0)
#else
#define STAMP(k) do { } while (0)
#endif
#ifdef DUP_ALL
#pragma unroll 1
    for (int pass = 0; pass < 2; ++pass) {
#else
    { const int pass = 0;
#endif
    STAMP(0);
    if (pass != 0) GSYNC();
    { LP; p0_prep(P, lds, (P.skip & 1) ? 0 : (15 & ~(P.skip >> 16))); if (pass == 0 && blockIdx.x == 0) for (int i = threadIdx.x; i < XCD_BAR_WORDS; i += 512) ((unsigned*)(ws + WS_BAR))[i] = 0u; }
    if (pass == 0) { grid.sync();
        { LP; if (threadIdx.x == 0) (void)xb_add(&((unsigned*)(ws + WS_BAR))[XB_XCNT(xb_xcc_id())], 1u); } }
    else GSYNC();
#ifdef DUP_SYNC
#pragma unroll 1
    for (int r = 0; r < 16; ++r) GSYNC();
#endif
#ifdef DUP_P0
    { LP; p0_prep(P, lds, DUP_P0); }
    GSYNC();
#endif
    STAMP(1);
#if LEVEL >= 1
#pragma unroll 1
    for (int rep = 0; rep < NREP_S1; ++rep) {
    {   LP; if (!((P.skip >> 1) & 1)) {
        pg8::SchedSsm S; S.init(256, 512, G, c); pg8::EpiS1 E{(float*)(ws + WS_SST)};
        pg8::gemm_phase<false>(ldsl, (const char*)(ws + WS_XA), (const char*)(ws + WS_BT1), 512, S, E);
        asm volatile("s_waitcnt vmcnt(0)" ::: "memory"); __syncthreads();
        pg8::Unit u; for (int i = 0; S.next(i, u); ++i) scan_unit(P, u.aux, u.pm); } }
    GSYNC(); } STAMP(2);
#pragma unroll 1
    for (int rep = 0; rep < NREP_S2; ++rep) {
    {   LP; if (!((P.skip >> 2) & 1)) {
        pg8::SchedSsm S; S.init(512, 640, G, c); pg8::EpiS2 E{(const bf16_t*)(ws + WS_XA), P.ssm_d, (bf16_t*)(ws + WS_BIG)};
        pg8::gemm_phase<false>(ldsl, (const char*)(ws + WS_XA), (const char*)(ws + WS_BT2), 640, S, E); } }
    GSYNC(); } STAMP(4);
#pragma unroll 1
    for (int rep = 0; rep < NREP_GLU; ++rep) {
    {   LP; if (!((P.skip >> 3) & 1)) {
        pg8::SchedDense S; S.init(T_, 2048, 1024, 1024, G, c); pg8::EpiUp<1> E{(bf16_t*)(ws + WS_GA), 1024};
        pg8::gemm_phase<false>(ldsl, (const char*)(ws + WS_BIG), (const char*)(ws + WS_WGLU), 1024, S, E); } }
    GSYNC(); } STAMP(5);
#endif
    { LP; if (!((P.skip >> 4) & 1)) ln_phase<0, true>(P, (LEVEL >= 1) ? P.x : H, P.ln_g, P.ln_b, lds, H, (bf16_t*)(ws + WS_H16), (LEVEL >= 1) ? (const bf16_t*)(ws + WS_GA) : nullptr); }
    GSYNC(); STAMP(6);
#if LEVEL >= 2
#pragma unroll 1
    for (int rep = 0; rep < NREP_FUP; ++rep) {
    {   LP; if (!((P.skip >> 5) & 1)) {
        pg8::SchedDense S; S.init(T_, 2 * FF_, 1024, 1024, G, c); pg8::EpiUp<0> E{(bf16_t*)(ws + WS_BIG), FF_};
        pg8::gemm_phase<true>(ldsl, (const char*)(ws + WS_H16), (const char*)(ws + WS_WUP), 1024, S, E); } }
    GSYNC(); } STAMP(7);
#pragma unroll 1
    for (int rep = 0; rep < NREP_FDN; ++rep) {
    {   LP; if (!((P.skip >> 6) & 1)) {
#define NREP_CUR NREP_FDN
        pg8::SchedDense S; S.init(T_, 1024, FF_, FF_, G, c); pg8::EpiBf16 E{(bf16_t*)(ws + WS_GA), 1024};
        pg8::gemm_phase<false>(ldsl, (const char*)(ws + WS_BIG), (const char*)(ws + WS_WDN), FF_, S, E); } }
    GSYNC(); } STAMP(8);
#endif
    { LP; if (!((P.skip >> 7) & 1)) ln_phase<0, false>(P, H, P.ln_g + 1024, P.ln_b + 1024, lds, H, (bf16_t*)(ws + WS_H16), (LEVEL >= 2) ? (const bf16_t*)(ws + WS_GA) : nullptr); }
    GSYNC(); STAMP(9);
#if LEVEL >= 3
#pragma unroll 1
    for (int rep = 0; rep < NREP_QKV; ++rep) {
    {   LP; if (!((P.skip >> 8) & 1)) {
        pg8::SchedDense S; S.init(T_, 1536, 1024, 1024, G, c);
        pg8::EpiQkv E{(bf16_t*)(ws + WS_BIG), (bf16_t*)(ws + WS_BIG + 64 * MiB), (bf16_t*)(ws + WS_BIG + 80 * MiB), (const float*)(ws + WS_ROPEC), (const float*)(ws + WS_ROPES)};
        pg8::gemm_phase<true>(ldsl, (const char*)(ws + WS_H16), (const char*)(ws + WS_WQKV), 1024, S, E); } }
    GSYNC(); } STAMP(10);
#ifndef SKIP_ATT
    { LP; if (!((P.skip >> 9) & 1)) attn_phase(P, lds); }
#endif
    GSYNC(); STAMP(11);
#pragma unroll 1
    for (int rep = 0; rep < NREP_OUT; ++rep) {
    {   LP; if (!((P.skip >> 10) & 1)) {
#undef NREP_CUR
#define NREP_CUR NREP_OUT
        pg8::SchedDense S; S.init(T_, 1024, 1024, 1024, G, c);
        pg8::EpiBf16 E{(bf16_t*)(ws + WS_GA), 1024};
        pg8::gemm_phase<false>(ldsl, (const char*)(ws + WS_BIG + 96 * MiB), (const char*)(ws + WS_WO), 1024, S, E); } }
    GSYNC(); } STAMP(12);
#endif
#if LEVEL >= 4
    { LP; if (!((P.skip >> 11) & 1)) ln_phase<1, false>(P, H, P.ln_g + 2048, P.ln_b + 2048, lds, H, (bf16_t*)(ws + WS_H16), (const bf16_t*)(ws + WS_GA)); }
    GSYNC(); STAMP(13);
#pragma unroll 1
    for (int rep = 0; rep < NREP_GATH; ++rep) {
    { LP; if (!((P.skip >> 12) & 1)) gather_phase(P); }
    GSYNC(); } STAMP(14);
#pragma unroll 1
    for (int rep = 0; rep < NREP_MUP; ++rep) {
    {   LP; if (!((P.skip >> 13) & 1)) {
        pg8::SchedMoe S; S.init((const int*)(ws + WS_CNT), 2048, 1024, (size_t)2048 * 1024 * 2, G, c); pg8::EpiUp<0> E{(bf16_t*)(ws + WS_BIG), 1024};
        pg8::gemm_phase<true>(ldsl, (const char*)(ws + WS_GA), (const char*)(ws + WS_WMUP), 1024, S, E); } }
    GSYNC(); } STAMP(15);
#pragma unroll 1
    for (int rep = 0; rep < NREP_MDN; ++rep) {
    {   LP; if (!((P.skip >> 14) & 1)) {
        pg8::SchedMoe S; S.init((const int*)(ws + WS_CNT), 1024, 1024, (size_t)1024 * 1024 * 2, G, c); pg8::EpiBf16 E{(bf16_t*)(ws + WS_Y), 1024};
        pg8::gemm_phase<false>(ldsl, (const char*)(ws + WS_BIG), (const char*)(ws + WS_WMDN), 1024, S, E); } }
    GSYNC(); } STAMP(16);
    { LP; if (!((P.skip >> 15) & 1)) ln_phase<2, false>(P, H, P.ln_g + 3072, P.ln_b + 3072, lds, H, (bf16_t*)(ws + WS_H16), nullptr); }
#ifdef PROF_A_HI
    GSYNC(); STAMP(17);
    {   LP; const unsigned long long* stamps = (const unsigned long long*)(P.ws + WS_CNT + 1024);
        const float tA = (float)(stamps[PROF_A_HI] - stamps[PROF_A_LO]) * 0.01f, tB = (float)(stamps[PROF_B_HI] - stamps[PROF_B_LO]) * 0.01f;
        for (int i = blockIdx.x * 512 + threadIdx.x; i < (1 << 22); i += gridDim.x * 512) H[(size_t)i * 8 + 1] = tB;
        if (blockIdx.x == 0 && threadIdx.x == 0) H[0] = 64.0f * tA; }
#endif
#ifdef PROF_A_HI
#endif
    }
#else
    { LP; ln_phase<0, false>(P, H, P.ln_g + 2048, P.ln_b + 2048, lds, H, (bf16_t*)(ws + WS_H16), (LEVEL >= 3) ? (const bf16_t*)(ws + WS_GA) : nullptr); }
    GSYNC(); STAMP(13);
    { LP; ln_phase<0, false>(P, H, P.ln_g + 3072, P.ln_b + 3072, lds, H, (bf16_t*)(ws + WS_H16), nullptr); }
#endif
}

extern "C" void kernel_launch(void* const* d_in, const int* in_sizes, int n_in, void* d_out, int out_size, void* d_ws, size_t ws_size, hipStream_t stream) {
    static int grid_blocks = 0;
    if (grid_blocks == 0) {
        if (n_in != 25 || out_size != T_ * D_ || ws_size < WS_END) { fprintf(stderr, "kernel_launch: unexpected shapes (n_in %d out %d ws %zu)\n", n_in, out_size, ws_size); grid_blocks = -1; return; }
        int dev = 0, cus = 0, per_cu = 0;
        hipGetDevice(&dev); hipDeviceGetAttribute(&cus, hipDeviceAttributeMultiprocessorCount, dev);
        if (hipFuncSetAttribute((const void*)yoco_fwd, hipFuncAttributeMaxDynamicSharedMemorySize, LDS_BYTES) != hipSuccess) { fprintf(stderr, "kernel_launch: hipFuncSetAttribute failed\n"); grid_blocks = -1; return; }
        if (hipOccupancyMaxActiveBlocksPerMultiprocessor(&per_cu, (const void*)yoco_fwd, 512, LDS_BYTES) != hipSuccess || per_cu < 1) { fprintf(stderr, "kernel_launch: occupancy query says %d\n", per_cu); per_cu = 1; (void)hipGetLastError(); }
        grid_blocks = cus * 1;
    }
    if (grid_blocks < 0) return;
    Params p{};
    p.x = (const float*)d_in[0]; p.pos = (const int*)d_in[1]; p.ln_g = (const float*)d_in[2]; p.ln_b = (const float*)d_in[3];
    p.lam_re = (const float*)d_in[4]; p.lam_im = (const float*)d_in[5]; p.log_step = (const float*)d_in[6]; p.b_re = (const float*)d_in[7]; p.b_im = (const float*)d_in[8];
    p.c_re = (const float*)d_in[9]; p.c_im = (const float*)d_in[10]; p.ssm_d = (const float*)d_in[11]; p.w_glu = (const float*)d_in[12]; p.kv_w = (const float*)d_in[13];
    p.w_q = (const float*)d_in[14]; p.sinks = (const float*)d_in[15]; p.w_out = (const float*)d_in[16]; p.ffn_g = (const float*)d_in[17]; p.ffn_u = (const float*)d_in[18]; p.ffn_d = (const float*)d_in[19];
    p.w_router = (const float*)d_in[20]; p.b_router = (const float*)d_in[21]; p.moe_g = (const float*)d_in[22]; p.moe_u = (const float*)d_in[23]; p.moe_d = (const float*)d_in[24];
    p.out = (float*)d_out; p.ws = (unsigned char*)d_ws;
    void* args[] = {&p};
#ifdef SKIP_PROBE
    p.skip = SKIP_PROBE; (void)hipLaunchCooperativeKernel((const void*)yoco_fwd, dim3(grid_blocks), dim3(512), args, LDS_BYTES, stream); p.skip = 0;
#endif
    hipError_t e = hipLaunchCooperativeKernel((const void*)yoco_fwd, dim3(grid_blocks), dim3(512), args, LDS_BYTES, stream);
    if (e != hipSuccess) fprintf(stderr, "cooperative launch failed: %s (grid %d)\n", hipGetErrorString(e), grid_blocks);
}
```

```cpp
#include <hip/hip_runtime.h>
#include <hip/hip_cooperative_groups.h>
#include <cstdio>
namespace cg = cooperative_groups;

#ifndef LEVEL
#define LEVEL 4
#endif

#ifdef DUP_S1
#define NREP_S1 2
#else
#define NREP_S1 1
#endif
#ifdef DUP_S2
#define NREP_S2 2
#else
#define NREP_S2 1
#endif
#ifdef DUP_GLU
#define NREP_GLU 2
#else
#define NREP_GLU 1
#endif
#ifdef DUP_FUP
#define NREP_FUP 2
#else
#define NREP_FUP 1
#endif
#if defined(DUP_FDN) || defined(DUP_FDNNULL)
#define NREP_FDN 2
#else
#define NREP_FDN 1
#endif
#ifdef DUP_QKV
#define NREP_QKV 2
#else
#define NREP_QKV 1
#endif
#if defined(DUP_OUT) || defined(DUP_OUTNULL)
#define NREP_OUT 2
#else
#define NREP_OUT 1
#endif
#ifdef DUP_MUP
#define NREP_MUP 2
#else
#define NREP_MUP 1
#endif
#ifdef DUP_MDN
#define NREP_MDN 2
#else
#define NREP_MDN 1
#endif
#ifdef DUP_SCAN
#define NREP_SCAN 2
#else
#define NREP_SCAN 1
#endif
#ifdef DUP_GATH
#define NREP_GATH 2
#else
#define NREP_GATH 1
#endif
#ifdef DUP_OUTNULL
#define SKIP_EPI_OUT (rep == 0)
#else
#define SKIP_EPI_OUT false
#endif
#ifdef DUP_FDNNULL
#define SKIP_EPI_FDN (rep == 0)
#else
#define SKIP_EPI_FDN false
#endif
#define LAS __attribute__((address_space(3)))
typedef unsigned short bf16_t;
typedef short bf16x8 __attribute__((ext_vector_type(8)));
typedef float f32x4 __attribute__((ext_vector_type(4)));
typedef float f32x16 __attribute__((ext_vector_type(16)));
typedef unsigned u32x4 __attribute__((ext_vector_type(4)));
typedef unsigned u32x2 __attribute__((ext_vector_type(2)));

constexpr int T_ = 32768, D_ = 1024, FF_ = 2816;
constexpr float ALPHA = 1.41421356237309515f;
constexpr float LN_EPS = 1e-5f;
constexpr size_t MiB = 1ull << 20;
constexpr size_t WS_CNT = 0, WS_BAR = 4096, WS_A32 = 65536, WS_ROPEC = 1 * MiB, WS_ROPES = 2 * MiB, WS_LIST = 3 * MiB, WS_TOK = 4 * MiB;
constexpr size_t WS_WMUP = 8 * MiB, WS_WMDN = 40 * MiB, WS_WGLU = 56 * MiB, WS_WUP = 60 * MiB, WS_WDN = 71 * MiB, WS_WQKV = 77 * MiB, WS_WO = 80 * MiB;
constexpr size_t WS_H16 = 82 * MiB, WS_BT2 = 146 * MiB, WS_BT1 = 186 * MiB, WS_XA = 202 * MiB, WS_SST = 282 * MiB, WS_GA = 146 * MiB, WS_Y = 146 * MiB;
constexpr size_t WS_BIG = 314 * MiB, WS_END = 490 * MiB;
constexpr int LDS_BYTES = 131072 + 16;

struct Params {
    const float* x; const int* pos; const float* ln_g; const float* ln_b;
    const float* lam_re; const float* lam_im; const float* log_step; const float* b_re; const float* b_im; const float* c_re; const float* c_im;
    const float* ssm_d; const float* w_glu; const float* kv_w; const float* w_q; const float* sinks; const float* w_out;
    const float* ffn_g; const float* ffn_u; const float* ffn_d; const float* w_router; const float* b_router;
    const float* moe_g; const float* moe_u; const float* moe_d;
    float* out; unsigned char* ws; int skip; int pad;
};

__device__ __forceinline__ unsigned pk_bf16(float lo, float hi) { unsigned r; asm volatile("v_cvt_pk_bf16_f32 %0, %1, %2" : "=v"(r) : "v"(lo), "v"(hi)); return r; }
typedef _Float16 f16x8 __attribute__((ext_vector_type(8)));
typedef _Float16 f16x2 __attribute__((ext_vector_type(2)));
__device__ __forceinline__ unsigned pk_f16(float lo, float hi) { union { f16x2 h; unsigned u; } c; c.h = (f16x2){(_Float16)lo, (_Float16)hi}; return c.u; }
__device__ __forceinline__ float hf_lo(unsigned w) { union { unsigned u; f16x2 h; } c; c.u = w; return (float)c.h[0]; }
__device__ __forceinline__ float hf_hi(unsigned w) { union { unsigned u; f16x2 h; } c; c.u = w; return (float)c.h[1]; }
__device__ __forceinline__ float bf_lo(unsigned w) { return __uint_as_float(w << 16); }
__device__ __forceinline__ float bf_hi(unsigned w) { return __uint_as_float(w & 0xffff0000u); }
__device__ __forceinline__ float sigmoidf_(float x) { return __builtin_amdgcn_rcpf(1.0f + __expf(-x)); }
__device__ __forceinline__ float gelu_tanh(float y) { const float u = 1.5957691216057308f * (y + 0.044715f * y * y * y); return y * sigmoidf_(u); }
__device__ __forceinline__ float xor16(float v) { const unsigned u = __float_as_uint(v); const auto r = __builtin_amdgcn_permlane16_swap(u, u, false, false); return __uint_as_float(r[0] == u ? r[1] : r[0]); }
__device__ __forceinline__ float wave_sum(float v) {
    v += __shfl_xor(v, 32); v += __shfl_xor(v, 16); v += __shfl_xor(v, 8); v += __shfl_xor(v, 4); v += __shfl_xor(v, 2); v += __shfl_xor(v, 1); return v; }


#define XB_TMO      128
#define XB_XCNT(j)  (256  + 64 * (j))
#define XB_XSUB(j)  (1280 + 64 * (j))
#define XB_XGEN(j)  (2304 + 64 * (j))
#define XB_TOP      3328
#define XB_TOPGEN   3392
#define XCD_BAR_WORDS 3456
#define XB_SPIN_CAP (1u << 22)
__device__ __forceinline__ unsigned xb_ld(unsigned* p)              { return __hip_atomic_load(p, __ATOMIC_RELAXED, __HIP_MEMORY_SCOPE_AGENT); }
__device__ __forceinline__ unsigned xb_add(unsigned* p, unsigned v) { return __hip_atomic_fetch_add(p, v, __ATOMIC_RELAXED, __HIP_MEMORY_SCOPE_AGENT); }
__device__ __forceinline__ unsigned xb_xcc_id() { return (unsigned)__builtin_amdgcn_s_getreg((3 << 11) | 20) & 0xFu; }
#define XB_SPIN(cond, bar) do { unsigned _sp = 0; while (cond) { __builtin_amdgcn_s_sleep(1); \
    if ((++_sp & 255u) == 0u) { if (xb_ld(&(bar)[XB_TMO])) break; if (_sp > XB_SPIN_CAP) { atomicAdd(&(bar)[XB_TMO], 1u); break; } } } } while (0)
__device__ __forceinline__ void xcd_barrier_complete(unsigned* bar, unsigned x, unsigned& nloc, unsigned& nx) {
    const unsigned G = gridDim.x * gridDim.y * gridDim.z;
    unsigned sum, cnt, mine, sp = 0u;
    for (;;) {
        sum = 0u; cnt = 0u; mine = 0u;
#pragma unroll
        for (unsigned j = 0; j < 16; ++j) { const unsigned c = xb_ld(&bar[XB_XCNT(j)]); sum += c; cnt += (c > 0u) ? 1u : 0u; mine = (j == x) ? c : mine; }
        if (sum == G) break;
        __builtin_amdgcn_s_sleep(1);
        if ((++sp & 255u) == 0u) { if (xb_ld(&bar[XB_TMO])) break; if (sp > XB_SPIN_CAP) { atomicAdd(&bar[XB_TMO], 1u); break; } }
    }
    nloc = mine > 0u ? mine : 1u; nx = cnt > 0u ? cnt : 1u;
}
__device__ __forceinline__ void xcd_barrier(unsigned* bar, volatile LAS unsigned* st) {
    asm volatile("s_waitcnt vmcnt(0)" ::: "memory");
    __syncthreads();
    if (threadIdx.x == 0) {
        const unsigned x = xb_xcc_id();
        __builtin_amdgcn_s_waitcnt(0);
        unsigned nloc = st[0], nx = st[1];
        if (nloc == 0u) { xcd_barrier_complete(bar, x, nloc, nx); st[0] = nloc; st[1] = nx; }
        const unsigned old = xb_add(&bar[XB_XSUB(x)], 1u);
        const unsigned gen = old / nloc;
        if (old + 1u == (gen + 1u) * nloc) {
            __builtin_amdgcn_fence(__ATOMIC_RELEASE, "agent");
            asm volatile("s_waitcnt vmcnt(0)" ::: "memory");
            const unsigned og = xb_add(&bar[XB_TOP], 1u);
            const unsigned tg = og / nx;
            if (og + 1u == (tg + 1u) * nx) xb_add(&bar[XB_TOPGEN], 1u);
            else XB_SPIN(xb_ld(&bar[XB_TOPGEN]) == tg, bar);
            __builtin_amdgcn_fence(__ATOMIC_ACQUIRE, "agent");
            xb_add(&bar[XB_XGEN(x)], 1u);
            asm volatile("s_waitcnt vmcnt(0)" ::: "memory");
        } else {
            XB_SPIN(xb_ld(&bar[XB_XGEN(x)]) == gen, bar);
            __builtin_amdgcn_fence(__ATOMIC_ACQUIRE, "agent");
            asm volatile("s_waitcnt vmcnt(0)" ::: "memory");
        }
    }
    __syncthreads();
}

namespace pg8 {
constexpr int BM = 256, BK = 64, HALF = 128, HTB = HALF * BK * 2, NXCD = 8, WGM = 8;
__device__ __forceinline__ int lds_byte(int r, int c) { const int st = (r >> 4) * 2 + (c >> 5), rr = r & 15, cc = c & 31, ob = rr * 64 + cc * 2; return st * 1024 + (ob ^ (((ob >> 9) & 1) << 5)); }
__device__ __forceinline__ void stage_rc(int b, int& R, int& C) { const int st = b / 1024, sb = b % 1024, swz = sb ^ (((sb >> 9) & 1) << 5); R = (st >> 1) * 16 + swz / 64; C = (st & 1) * 32 + (swz % 64) / 2; }
__device__ __forceinline__ int perm32(int rho) { const int n = rho >> 4, i = rho & 15; return 8 * (i >> 2) + 4 * n + (i & 3); }
__device__ __forceinline__ int xcd_remap(int L, int nwg) { const int q = nwg / NXCD, r = nwg % NXCD, xcd = L % NXCD, off = L / NXCD; return (xcd < r ? xcd * (q + 1) : r * (q + 1) + (xcd - r) * q) + off; }

struct Unit { int pm, pn, aux, pad; size_t a_off, b_off; };

struct SchedDense {
    int nM, nN, nwg, G, c, lda, K;
    __device__ __forceinline__ void init(int M, int N, int K_, int lda_, int G_, int c_) { nM = M / BM; nN = N / BM; nwg = nM * nN; G = G_; c = c_; lda = lda_; K = K_; }
    __device__ __forceinline__ bool next(int i, Unit& u) const {
        const int L = i * G + c; if (L >= nwg) return false;
        const int wgid = xcd_remap(L, nwg);
        const int nig = WGM * nN, gid = wgid / nig, fm = gid * WGM, gsz = (nM - fm) < WGM ? (nM - fm) : WGM;
        u.pm = fm + ((wgid % nig) % gsz); u.pn = (wgid % nig) / gsz; u.aux = 0; u.pad = 0;
        u.a_off = (size_t)u.pm * BM * lda * 2; u.b_off = (size_t)u.pn * BM * K * 2; return true;
    }
    __device__ __forceinline__ unsigned voffA(int R, int C) const { return (unsigned)(R * lda + C) * 2u; }
    __device__ __forceinline__ size_t a_kstep() const { return BK * 2; }
    __device__ __forceinline__ size_t a_hstep() const { return (size_t)HALF * lda * 2; }
};
struct SchedMoe {
    int nM, nN, nwg, G, c, K; int tb[9]; size_t estride;
    __device__ __forceinline__ void init(const int* cnt, int N, int K_, size_t estride_, int G_, int c_) {
        tb[0] = 0;
#pragma unroll
        for (int e = 0; e < 8; ++e) tb[e + 1] = tb[e] + ((cnt[e] + 255) >> 8);
        nM = tb[8]; nN = N / BM; nwg = nM * nN; G = G_; c = c_; K = K_; estride = estride_; }
    __device__ __forceinline__ bool next(int i, Unit& u) const {
        const int L = i * G + c; if (L >= nwg) return false;
        const int wgid = xcd_remap(L, nwg);
        const int nig = WGM * nN, gid = wgid / nig, fm = gid * WGM, gsz = (nM - fm) < WGM ? (nM - fm) : WGM;
        u.pm = fm + ((wgid % nig) % gsz); u.pn = (wgid % nig) / gsz; int e = 0;
#pragma unroll
        for (int k = 1; k < 8; ++k) e += (u.pm >= tb[k]) ? 1 : 0;
        u.aux = e; u.pad = 0;
        u.a_off = (size_t)u.pm * BM * 1024 * 2; u.b_off = (size_t)e * estride + (size_t)u.pn * BM * K * 2; return true;
    }
    __device__ __forceinline__ unsigned voffA(int R, int C) const { return (unsigned)(R * 1024 + C) * 2u; }
    __device__ __forceinline__ size_t a_kstep() const { return BK * 2; }
    __device__ __forceinline__ size_t a_hstep() const { return (size_t)HALF * 1024 * 2; }
};
struct SchedSsm {
    int nN, nwg, G, c, K, N;
    __device__ __forceinline__ void init(int N_, int K_, int G_, int c_) { N = N_; nN = N_ / BM; nwg = 64 * 4 * nN; G = G_; c = c_; K = K_; }
    __device__ __forceinline__ bool next(int i, Unit& u) const {
        const int L = i * G + c; if (L >= nwg) return false;
        const int wgid = xcd_remap(L, nwg);
        const int per = 4 * nN, g = (wgid / (4 * per)) * 4 + (wgid & 3), rem = (wgid >> 2) % per;
        u.pm = rem & 3; u.pn = rem >> 2; u.aux = g; u.pad = 0;
        u.a_off = ((size_t)u.pm * BM * 40 * 1024 + (size_t)g * 16) * 2; u.b_off = (size_t)g * N * K * 2 + (size_t)u.pn * BM * K * 2; return true;
    }
    __device__ __forceinline__ unsigned voffA(int R, int C) const { return (unsigned)((R * 40 + (C >> 4)) * 1024 + (C & 15)) * 2u; }
    __device__ __forceinline__ size_t a_kstep() const { return 4 * 1024 * 2; }
    __device__ __forceinline__ size_t a_hstep() const { return (size_t)HALF * 40 * 1024 * 2; }
};

template <bool F16, class Epi, class Sched>
__device__ __forceinline__ void gemm_phase(LAS unsigned char* lds, const char* Ab, const char* Bb, const int K, const Sched& S, const Epi& E) {
    const int tid = threadIdx.x, wid = __builtin_amdgcn_readfirstlane(tid >> 6), lane = tid & 63, wr = wid >> 2, wc = wid & 3, fr = lane & 15, fq = lane >> 4;
    const int nt = K / BK;
    unsigned voffA[2], voffB[2];
#pragma unroll
    for (int i = 0; i < 2; ++i) { int R, C; stage_rc(tid * 16 + i * 8192, R, C); const int Rb = Epi::PERM ? ((R & ~31) + perm32(R & 31)) : R;
        voffA[i] = S.voffA(R, C); voffB[i] = (unsigned)(Rb * K + C) * 2u; }
    const size_t kstepA = S.a_kstep(), hstepA = S.a_hstep(), kstepB = (size_t)(BK * 2), hstepB = (size_t)HALF * K * 2;
    const unsigned ldsw = (unsigned)wid * 1024u;
    const int aoff = lds_byte(wr * 64 + fr, fq * 8), boff = lds_byte(wc * 32 + fr, fq * 8);
#define PG8_SA(b, h) (((b) * 2 + (h)) * HTB)
#define PG8_SB(b, h) ((4 + (b) * 2 + (h)) * HTB)
#define PG8_STAGE(bufoff, gbase, voff) do { _Pragma("unroll") for (int _i = 0; _i < 2; ++_i) \
        __builtin_amdgcn_global_load_lds((const unsigned*)((const char*)(gbase) + (voff)[_i]), (LAS unsigned*)(lds + (bufoff) + ldsw + _i * 8192), 16, 0, 0); } while (0)
#define PG8_LDA(dst, b, h) do { _Pragma("unroll") for (int m = 0; m < 4; ++m) _Pragma("unroll") for (int k = 0; k < 2; ++k) dst[m][k] = *(const LAS bf16x8*)(lds + PG8_SA(b, h) + aoff + m * 2048 + k * 1024); } while (0)
#define PG8_LDB(dst, b, h) do { _Pragma("unroll") for (int n = 0; n < 2; ++n) _Pragma("unroll") for (int k = 0; k < 2; ++k) dst[n][k] = *(const LAS bf16x8*)(lds + PG8_SB(b, h) + boff + n * 2048 + k * 1024); } while (0)
#define PG8_MMA(ai, bj, At, Bt) do { __builtin_amdgcn_s_setprio(1); _Pragma("unroll") for (int m = 0; m < 4; ++m) _Pragma("unroll") for (int n = 0; n < 2; ++n) _Pragma("unroll") for (int k = 0; k < 2; ++k) \
        acc[ai][bj][m][n] = F16 ? __builtin_amdgcn_mfma_f32_16x16x32_f16(__builtin_bit_cast(f16x8, Bt[n][k]), __builtin_bit_cast(f16x8, At[m][k]), acc[ai][bj][m][n], 0, 0, 0) : __builtin_amdgcn_mfma_f32_16x16x32_bf16(Bt[n][k], At[m][k], acc[ai][bj][m][n], 0, 0, 0); __builtin_amdgcn_s_setprio(0); } while (0)
#define PG8_WAIT_V(n) asm volatile("s_waitcnt vmcnt(" #n ")" ::: "memory")
#define PG8_WAIT_L(n) asm volatile("s_waitcnt lgkmcnt(" #n ")" ::: "memory")
#define PG8_BAR __builtin_amdgcn_s_barrier()
#define PG8_SCHED __builtin_amdgcn_sched_barrier(0)
    Unit cur, nxt; int ui = 0;
    if (!S.next(0, cur)) return;
    f32x4 acc[2][2][4][2];
#pragma unroll
    for (int a = 0; a < 2; ++a)
#pragma unroll
        for (int b = 0; b < 2; ++b)
#pragma unroll
            for (int m = 0; m < 4; ++m)
#pragma unroll
                for (int n = 0; n < 2; ++n) acc[a][b][m][n] = (f32x4){0.f, 0.f, 0.f, 0.f};
    bf16x8 At[4][2], B0[2][2], B1[2][2];
    const char* cA = Ab + cur.a_off; const char* cB = Bb + cur.b_off;
    PG8_STAGE(PG8_SB(0, 0), cB, voffB); PG8_STAGE(PG8_SA(0, 0), cA, voffA); PG8_STAGE(PG8_SB(0, 1), cB + hstepB, voffB); PG8_STAGE(PG8_SA(0, 1), cA + hstepA, voffA);
    if (wr == 1) PG8_BAR;
    PG8_WAIT_V(4); PG8_BAR;
    PG8_STAGE(PG8_SB(1, 0), cB + kstepB, voffB); PG8_STAGE(PG8_SA(1, 0), cA + kstepA, voffA); PG8_STAGE(PG8_SB(1, 1), cB + hstepB + kstepB, voffB);
    PG8_WAIT_V(6); PG8_BAR;
    for (;;) {
        const bool has_next = S.next(ui + 1, nxt);
        const char* nA = has_next ? Ab + nxt.a_off : cA; const char* nB = has_next ? Bb + nxt.b_off : cB;
        for (int t = 0; t < nt; t += 2) {
            const bool last = (t == nt - 2);
            const char* a1 = cA + (size_t)(t + 1) * kstepA;
            const char* a2 = last ? nA : cA + (size_t)(t + 2) * kstepA; const char* b2 = last ? nB : cB + (size_t)(t + 2) * kstepB;
            const char* a3 = a2 + kstepA; const char* b3 = b2 + kstepB;
            PG8_LDB(B0, 0, 0); PG8_SCHED; PG8_LDA(At, 0, 0); PG8_STAGE(PG8_SA(1, 1), a1 + hstepA, voffA);
            PG8_WAIT_L(8); PG8_BAR; PG8_WAIT_L(0); PG8_MMA(0, 0, At, B0); PG8_BAR; PG8_SCHED;
            PG8_LDB(B1, 0, 1); PG8_STAGE(PG8_SB(0, 0), b2, voffB);
            PG8_BAR; PG8_WAIT_L(0); PG8_MMA(0, 1, At, B1); PG8_BAR;
            PG8_LDA(At, 0, 1); PG8_STAGE(PG8_SA(0, 0), a2, voffA);
            PG8_BAR; PG8_WAIT_L(0); PG8_MMA(1, 0, At, B0); PG8_BAR; PG8_SCHED;
            PG8_STAGE(PG8_SB(0, 1), b2 + hstepB, voffB);
            PG8_WAIT_V(6); PG8_BAR; PG8_MMA(1, 1, At, B1); PG8_BAR;
            PG8_LDB(B0, 1, 0); PG8_SCHED; PG8_LDA(At, 1, 0); PG8_STAGE(PG8_SA(0, 1), a2 + hstepA, voffA);
            PG8_WAIT_L(8); PG8_BAR; PG8_WAIT_L(0); PG8_MMA(0, 0, At, B0); PG8_BAR; PG8_SCHED;
            PG8_LDB(B1, 1, 1); PG8_STAGE(PG8_SB(1, 0), b3, voffB);
            PG8_BAR; PG8_WAIT_L(0); PG8_MMA(0, 1, At, B1); PG8_BAR;
            PG8_LDA(At, 1, 1); PG8_STAGE(PG8_SA(1, 0), a3, voffA);
            PG8_BAR; PG8_WAIT_L(0); PG8_MMA(1, 0, At, B0); PG8_BAR; PG8_SCHED;
            PG8_STAGE(PG8_SB(1, 1), b3 + hstepB, voffB);
            PG8_WAIT_V(6); PG8_BAR; PG8_MMA(1, 1, At, B1); PG8_BAR;
        }
        E(acc, cur, wr, wc, fr, fq);
        if (!has_next) break;
#pragma unroll
        for (int a = 0; a < 2; ++a)
#pragma unroll
            for (int b = 0; b < 2; ++b)
#pragma unroll
                for (int m = 0; m < 4; ++m)
#pragma unroll
                    for (int n = 0; n < 2; ++n) acc[a][b][m][n] = (f32x4){0.f, 0.f, 0.f, 0.f};
        cur = nxt; cA = nA; cB = nB; ++ui;
    }
    PG8_WAIT_V(0);
    if (wr == 0) PG8_BAR;
    PG8_BAR;
#undef PG8_SA
#undef PG8_SB
#undef PG8_STAGE
#undef PG8_LDA
#undef PG8_LDB
#undef PG8_MMA
#undef PG8_WAIT_V
#undef PG8_WAIT_L
#undef PG8_BAR
#undef PG8_SCHED
}

typedef const f32x4 (&AccRef)[2][2][4][2];

struct EpiS1 {
    static constexpr bool PERM = false; float* sst;
    __device__ __forceinline__ void operator()(AccRef acc, const Unit& u, int wr, int wc, int fr, int fq) const {
#pragma unroll
        for (int ai = 0; ai < 2; ++ai)
#pragma unroll
            for (int m = 0; m < 4; ++m) { const int row = u.pm * BM + ai * HALF + wr * 64 + m * 16 + fr; float* rp = sst + ((size_t)row * 64 + u.aux) * 128 + wc * 32 + 4 * fq;
#pragma unroll
                for (int n = 0; n < 2; ++n) *(f32x4*)(rp + 16 * n) = acc[ai][0][m][n]; }
    }
};
struct EpiS2 {
    static constexpr bool PERM = true; const bf16_t* xa; const float* dsk; bf16_t* g16;
    __device__ __forceinline__ void operator()(AccRef acc, const Unit& u, int wr, int wc, int fr, int fq) const {
        const int ch = u.aux * 16 + 8 * (fq & 1);
        const f32x4 d0 = *(const f32x4*)(dsk + ch), d1 = *(const f32x4*)(dsk + ch + 4);
#pragma unroll
        for (int ai = 0; ai < 2; ++ai)
#pragma unroll
            for (int m = 0; m < 4; ++m) { const int row = u.pm * BM + ai * HALF + wr * 64 + m * 16 + fr;
#pragma unroll
                for (int bj = 0; bj < 2; ++bj) { const int t = 16 * u.pn + 8 * bj + 2 * wc + (fq >> 1);
                    const u32x4 xv = *(const u32x4*)(xa + ((size_t)row * 40 + t) * 1024 + ch);
                    const f32x4 x0 = {bf_lo(xv.x), bf_hi(xv.x), bf_lo(xv.y), bf_hi(xv.y)}, x1 = {bf_lo(xv.z), bf_hi(xv.z), bf_lo(xv.w), bf_hi(xv.w)};
                    const f32x4 y0 = acc[ai][bj][m][0] + d0 * x0, y1 = acc[ai][bj][m][1] + d1 * x1;
                    u32x4 w; w.x = pk_bf16(gelu_tanh(y0[0]), gelu_tanh(y0[1])); w.y = pk_bf16(gelu_tanh(y0[2]), gelu_tanh(y0[3]));
                    w.z = pk_bf16(gelu_tanh(y1[0]), gelu_tanh(y1[1])); w.w = pk_bf16(gelu_tanh(y1[2]), gelu_tanh(y1[3]));
                    *(u32x4*)(g16 + ((size_t)row * 32 + t) * 1024 + ch) = w; } }
    }
};
struct EpiGlu {
    static constexpr bool PERM = false; const float* x; float* out;
    __device__ __forceinline__ void operator()(AccRef acc, const Unit& u, int wr, int wc, int fr, int fq) const {
#pragma unroll
        for (int ai = 0; ai < 2; ++ai)
#pragma unroll
            for (int m = 0; m < 4; ++m) { const int row = u.pm * BM + ai * HALF + wr * 64 + m * 16 + fr; const size_t off = (size_t)row * 1024 + u.pn * 128 + wc * 32 + 4 * fq;
#pragma unroll
                for (int n = 0; n < 2; ++n) { const f32x4 xv = *(const f32x4*)(x + off + 16 * n); const f32x4 v = acc[ai][0][m][n], g = acc[ai][1][m][n]; f32x4 o;
#pragma unroll
                    for (int j = 0; j < 4; ++j) o[j] = ALPHA * xv[j] + v[j] * sigmoidf_(g[j]);
                    *(f32x4*)(out + off + 16 * n) = o; } }
    }
};
template <int ACT> struct EpiUp {
    static constexpr bool PERM = true; bf16_t* act; int ld;
    __device__ __forceinline__ void operator()(AccRef acc, const Unit& u, int wr, int wc, int fr, int fq) const {
#pragma unroll
        for (int ai = 0; ai < 2; ++ai)
#pragma unroll
            for (int m = 0; m < 4; ++m) { const int row = u.pm * BM + ai * HALF + wr * 64 + m * 16 + fr; float r[8];
#pragma unroll
                for (int n = 0; n < 2; ++n)
#pragma unroll
                    for (int j = 0; j < 4; ++j) { const float g = acc[ai][0][m][n][j], up = acc[ai][1][m][n][j]; r[4 * n + j] = (ACT == 0) ? g * sigmoidf_(g) * up : g * sigmoidf_(up); }
                u32x4 w; w.x = pk_bf16(r[0], r[1]); w.y = pk_bf16(r[2], r[3]); w.z = pk_bf16(r[4], r[5]); w.w = pk_bf16(r[6], r[7]);
                *(u32x4*)(act + (size_t)row * ld + u.pn * 128 + wc * 32 + 8 * fq) = w; }
    }
};
struct EpiRes {
    static constexpr bool PERM = false; const float* hin; float* h; bool skip;
    __device__ __forceinline__ void operator()(AccRef acc, const Unit& u, int wr, int wc, int fr, int fq) const {
        if (skip) return;
#pragma unroll
        for (int ai = 0; ai < 2; ++ai)
#pragma unroll
            for (int m = 0; m < 4; ++m) { const int row = u.pm * BM + ai * HALF + wr * 64 + m * 16 + fr; const size_t ro = (size_t)row * 1024 + u.pn * BM + wc * 32 + 4 * fq;
#pragma unroll
                for (int bj = 0; bj < 2; ++bj)
#pragma unroll
                    for (int n = 0; n < 2; ++n) { const size_t o = ro + bj * HALF + 16 * n; const f32x4 hv = *(const f32x4*)(hin + o); *(f32x4*)(h + o) = ALPHA * hv + acc[ai][bj][m][n]; } }
    }
};
struct EpiQkv {
    static constexpr bool PERM = true; bf16_t* q; bf16_t* k; bf16_t* v; const float* rc; const float* rs;
    __device__ __forceinline__ void operator()(AccRef acc, const Unit& u, int wr, int wc, int fr, int fq) const {
        const bool rope = (u.pn <= 4) && ((wc & 1) == 0);
        bf16_t* base; int ld, colt; float scale = 1.0f;
        if (u.pn < 4) { base = q; ld = 1024; colt = u.pn * BM; scale = 0.125f * 1.4426950408889634f; } else if (u.pn == 4) { base = k; ld = 256; colt = 0; } else { base = v; ld = 256; colt = 0; }
#pragma unroll
        for (int ai = 0; ai < 2; ++ai)
#pragma unroll
            for (int m = 0; m < 4; ++m) { const int row = u.pm * BM + ai * HALF + wr * 64 + m * 16 + fr;
                f32x4 c0 = {1.f, 1.f, 1.f, 1.f}, c1 = c0, s0 = {0.f, 0.f, 0.f, 0.f}, s1 = s0;
                if (rope && fq < 2) { c0 = *(const f32x4*)(rc + (size_t)row * 8); c1 = *(const f32x4*)(rc + (size_t)row * 8 + 4); s0 = *(const f32x4*)(rs + (size_t)row * 8); s1 = *(const f32x4*)(rs + (size_t)row * 8 + 4);
                    if (fq == 0) { s0 = -s0; s1 = -s1; } }
#pragma unroll
                for (int bj = 0; bj < 2; ++bj) { f32x4 v0 = acc[ai][bj][m][0], v1 = acc[ai][bj][m][1];
                    if (rope) { f32x4 p0, p1;
#pragma unroll
                        for (int j = 0; j < 4; ++j) { p0[j] = xor16(v0[j]); p1[j] = xor16(v1[j]); }
                        v0 = v0 * c0 + p0 * s0; v1 = v1 * c1 + p1 * s1; }
                    v0 = v0 * scale; v1 = v1 * scale;
                    u32x4 w; w.x = pk_bf16(v0[0], v0[1]); w.y = pk_bf16(v0[2], v0[3]); w.z = pk_bf16(v1[0], v1[1]); w.w = pk_bf16(v1[2], v1[3]);
                    *(u32x4*)(base + (size_t)row * ld + colt + bj * HALF + wc * 32 + 8 * fq) = w; } }
    }
};
struct EpiBf16 {
    static constexpr bool PERM = true; bf16_t* o; int ld;
    __device__ __forceinline__ void operator()(AccRef acc, const Unit& u, int wr, int wc, int fr, int fq) const {
#pragma unroll
        for (int ai = 0; ai < 2; ++ai)
#pragma unroll
            for (int m = 0; m < 4; ++m) { const int row = u.pm * BM + ai * HALF + wr * 64 + m * 16 + fr;
#pragma unroll
                for (int bj = 0; bj < 2; ++bj) { const f32x4 v0 = acc[ai][bj][m][0], v1 = acc[ai][bj][m][1];
                    u32x4 w; w.x = pk_bf16(v0[0], v0[1]); w.y = pk_bf16(v0[2], v0[3]); w.z = pk_bf16(v1[0], v1[1]); w.w = pk_bf16(v1[2], v1[3]);
                    *(u32x4*)(o + (size_t)row * ld + u.pn * BM + bj * HALF + wc * 32 + 8 * fq) = w; } }
    }
};
struct EpiNull {
    static constexpr bool PERM = false; float* h;
    __device__ __forceinline__ void operator()(AccRef acc, const Unit& u, int wr, int wc, int fr, int fq) const {
        if (u.pm < 0) {
#pragma unroll
            for (int ai = 0; ai < 2; ++ai)
#pragma unroll
                for (int m = 0; m < 4; ++m)
#pragma unroll
                    for (int bj = 0; bj < 2; ++bj)
#pragma unroll
                        for (int n = 0; n < 2; ++n) *(f32x4*)(h + ((ai * 4 + m) * 4 + bj * 2 + n) * 256 + fr * 16 + fq * 4) = acc[ai][bj][m][n]; }
    }
};
}

struct TJob { const float* s0; const float* s1; bf16_t* dst; int ld, k0, Kd, n0, f16; };
__device__ __forceinline__ void tjob_decode(const Params& P, int jt, TJob& j) {
    if (jt < 128) { const int pn = jt & 7, kt = jt >> 3;
        j.s0 = P.w_glu + 128 * pn; j.s1 = P.w_glu + 1024 + 128 * pn; j.ld = 2048; j.k0 = kt * 64; j.dst = (bf16_t*)(P.ws + WS_WGLU); j.Kd = 1024; j.n0 = 256 * pn; j.f16 = 0; }
    else if ((jt -= 128) < 352) { const int pn = jt % 22, kt = jt / 22;
        j.s0 = P.ffn_g + 128 * pn; j.s1 = P.ffn_u + 128 * pn; j.ld = 2816; j.k0 = kt * 64; j.dst = (bf16_t*)(P.ws + WS_WUP); j.Kd = 1024; j.n0 = 256 * pn; j.f16 = 1; }
    else if ((jt -= 352) < 176) { const int pn = jt & 3, kt = jt >> 2;
        j.s0 = P.ffn_d + 256 * pn; j.s1 = j.s0 + 128; j.ld = 1024; j.k0 = kt * 64; j.dst = (bf16_t*)(P.ws + WS_WDN); j.Kd = 2816; j.n0 = 256 * pn; j.f16 = 0; }
    else if ((jt -= 176) < 64) { const int pn = jt & 3, kt = jt >> 2;
        j.s0 = P.w_q + 256 * pn; j.s1 = j.s0 + 128; j.ld = 1024; j.k0 = kt * 64; j.dst = (bf16_t*)(P.ws + WS_WQKV); j.Kd = 1024; j.n0 = 256 * pn; j.f16 = 1; }
    else if ((jt -= 64) < 32) { const int pn = jt & 1, kt = jt >> 1;
        j.s0 = P.kv_w + 256 * pn; j.s1 = j.s0 + 128; j.ld = 512; j.k0 = kt * 64; j.dst = (bf16_t*)(P.ws + WS_WQKV); j.Kd = 1024; j.n0 = 1024 + 256 * pn; j.f16 = 1; }
    else if ((jt -= 32) < 64) { const int pn = jt & 3, kt = jt >> 2;
        j.s0 = P.w_out + 256 * pn; j.s1 = j.s0 + 128; j.ld = 1024; j.k0 = kt * 64; j.dst = (bf16_t*)(P.ws + WS_WO); j.Kd = 1024; j.n0 = 256 * pn; j.f16 = 0; }
    else if ((jt -= 64) < 1024) { const int e = jt & 7, r = jt >> 3, pn = r & 7, kt = r >> 3;
        j.s0 = P.moe_g + (size_t)e * 1048576 + 128 * pn; j.s1 = P.moe_u + (size_t)e * 1048576 + 128 * pn; j.ld = 1024; j.k0 = kt * 64; j.dst = (bf16_t*)(P.ws + WS_WMUP) + (size_t)e * 2048 * 1024; j.Kd = 1024; j.n0 = 256 * pn; j.f16 = 1; }
    else { jt -= 1024; const int e = jt & 7, r = jt >> 3, pn = r & 3, kt = r >> 2;
        j.s0 = P.moe_d + (size_t)e * 1048576 + 256 * pn; j.s1 = j.s0 + 128; j.ld = 1024; j.k0 = kt * 64; j.dst = (bf16_t*)(P.ws + WS_WMDN) + (size_t)e * 1048576; j.Kd = 1024; j.n0 = 256 * pn; j.f16 = 0; }
}
#define TJ_LOAD(J, V) do { const int nn_ = (tid & 63) * 4, kb_ = tid >> 6; const float* sp_ = (nn_ < 128) ? ((J).s0 + nn_) : ((J).s1 + (nn_ - 128)); \
    _Pragma("unroll") for (int i = 0; i < 8; ++i) (V)[i] = *(const f32x4*)(sp_ + (size_t)((J).k0 + kb_ + 8 * i) * (J).ld); } while (0)
__device__ void transposes_phase(const Params& P, float* tile) {
    constexpr int J_T = 2352;
    const int tid = threadIdx.x, G = gridDim.x;
    int jt = blockIdx.x; TJob cur, nxt; f32x4 v[8], vn[8];
    if (jt < J_T) { tjob_decode(P, jt, cur); TJ_LOAD(cur, v); }
    while (jt < J_T) {
        { const int nn = (tid & 63) * 4, kb = tid >> 6;
#pragma unroll
          for (int i = 0; i < 8; ++i) { float* t = tile + (kb + 8 * i) * 257 + nn; t[0] = v[i][0]; t[1] = v[i][1]; t[2] = v[i][2]; t[3] = v[i][3]; } }
        __syncthreads();
        const int jn = jt + G;
        if (jn < J_T) { tjob_decode(P, jn, nxt); TJ_LOAD(nxt, vn); }
        { const int ks = (tid & 7) * 8;
#pragma unroll
          for (int i = 0; i < 4; ++i) { const int n = (tid >> 3) + 64 * i; float r[8];
#pragma unroll
              for (int j = 0; j < 8; ++j) r[j] = tile[(ks + j) * 257 + n];
              u32x4 w; if (cur.f16) { w.x = pk_f16(r[0], r[1]); w.y = pk_f16(r[2], r[3]); w.z = pk_f16(r[4], r[5]); w.w = pk_f16(r[6], r[7]); } else { w.x = pk_bf16(r[0], r[1]); w.y = pk_bf16(r[2], r[3]); w.z = pk_bf16(r[4], r[5]); w.w = pk_bf16(r[6], r[7]); }
              *(u32x4*)(cur.dst + (size_t)(cur.n0 + n) * cur.Kd + cur.k0 + ks) = w; } }
        __syncthreads();
        cur = nxt; jt = jn;
#pragma unroll
        for (int i = 0; i < 8; ++i) v[i] = vn[i];
    }
}

__device__ void ssm_tables(const Params& P, int g, int qtr, unsigned char* lds) {
    const int tid = threadIdx.x;
    float* apr = (float*)lds;
    float* api = apr + 33 * 64;
    float* bbr = api + 33 * 64;
    float* bbi = bbr + 1024;
    float* ccr = bbi + 1024;
    float* cci = ccr + 1024;
    float* kg = cci + 1024;
    const float dtf = expf(P.log_step[g]);
    for (int idx = tid; idx < 33 * 64; idx += 512) { const int tau = idx >> 6, p = idx & 63;
        const float lr = P.lam_re[g * 64 + p], li = P.lam_im[g * 64 + p];
        const double dt = (double)dtf; double rev = (double)li * dt * (double)tau * 0.15915494309189535; rev -= floor(rev);
        const float ang = (float)(rev * 6.283185307179586); float sn, cs; sincosf(ang, &sn, &cs);
        const float mag = expf((float)((double)lr * dt * (double)tau));
        apr[idx] = mag * cs; api[idx] = mag * sn; }
    for (int idx = tid; idx < 1024; idx += 512) { ccr[idx] = P.c_re[g * 1024 + idx]; cci[idx] = P.c_im[g * 1024 + idx]; }
    __syncthreads();
    for (int idx = tid; idx < 1024; idx += 512) { const int p = idx >> 4;
        const float lr = P.lam_re[g * 64 + p], li = P.lam_im[g * 64 + p], ar = apr[64 + p], ai = api[64 + p];
        const float nr = ar - 1.0f, den = lr * lr + li * li, kr = (nr * lr + ai * li) / den, ki = (ai * lr - nr * li) / den;
        const float br = P.b_re[g * 1024 + idx], bi = P.b_im[g * 1024 + idx];
        bbr[idx] = kr * br - ki * bi; bbi[idx] = kr * bi + ki * br; }
    __syncthreads();
    { const int cp = tid & 15, c = 4 * qtr + ((tid >> 4) & 3), t0 = tid >> 6;
      for (int i = 0; i < 4; ++i) { const int tau = t0 + 8 * i; float s = 0.f;
          for (int p = 0; p < 64; ++p) { const float cr = ccr[c * 64 + p], ci = cci[c * 64 + p], ar = apr[tau * 64 + p], ai = api[tau * 64 + p];
              const float zr = cr * ar - ci * ai, zi = cr * ai + ci * ar; s += zr * bbr[p * 16 + cp] - zi * bbi[p * 16 + cp]; }
          kg[(tau * 16 + c) * 16 + cp] = s; } }
    __syncthreads();
    bf16_t* bt2 = (bf16_t*)(P.ws + WS_BT2) + (size_t)g * 512 * 640;
    for (int pc = tid; pc < 128 * 80; pc += 512) { const int nq = pc / 80, k8 = (pc % 80) * 8, t = nq >> 2, c = 4 * qtr + (nq & 3), n = t * 16 + c; float r[8];
        if (k8 < 512) { const int s = k8 >> 4, c0 = k8 & 15;
#pragma unroll
            for (int j = 0; j < 8; ++j) r[j] = (t >= s) ? kg[((t - s) * 16 + c) * 16 + c0 + j] : 0.f;
        } else { const int q0 = k8 - 512;
#pragma unroll
            for (int j = 0; j < 8; j += 2) { const int p = (q0 + j) >> 1; const float cr = ccr[c * 64 + p], ci = cci[c * 64 + p], ar = apr[(t + 1) * 64 + p], ai = api[(t + 1) * 64 + p];
                r[j] = cr * ar - ci * ai; r[j + 1] = -(cr * ai + ci * ar); } }
        u32x4 w; w.x = pk_bf16(r[0], r[1]); w.y = pk_bf16(r[2], r[3]); w.z = pk_bf16(r[4], r[5]); w.w = pk_bf16(r[6], r[7]);
        *(u32x4*)(bt2 + (size_t)n * 640 + k8) = w; }
    bf16_t* bt1 = (bf16_t*)(P.ws + WS_BT1) + (size_t)g * 256 * 512;
    for (int pc = tid; pc < 64 * 64; pc += 512) { const int q = 64 * qtr + (pc >> 6), k8 = (pc & 63) * 8; float r[8];
        if (q < 128) { const int p = q >> 1, s = k8 >> 4, c0 = k8 & 15; const float ar = apr[(31 - s) * 64 + p], ai = api[(31 - s) * 64 + p];
#pragma unroll
            for (int j = 0; j < 8; ++j) { const float br = bbr[p * 16 + c0 + j], bi = bbi[p * 16 + c0 + j]; r[j] = (q & 1) ? (ar * bi + ai * br) : (ar * br - ai * bi); }
        } else {
#pragma unroll
            for (int j = 0; j < 8; ++j) r[j] = 0.f; }
        u32x4 w; w.x = pk_bf16(r[0], r[1]); w.y = pk_bf16(r[2], r[3]); w.z = pk_bf16(r[4], r[5]); w.w = pk_bf16(r[6], r[7]);
        *(u32x4*)(bt1 + (size_t)q * 512 + k8) = w; }
    float* a32 = (float*)(P.ws + WS_A32);
    if (qtr == 0 && tid < 64) { a32[(g * 64 + tid) * 2] = apr[32 * 64 + tid]; a32[(g * 64 + tid) * 2 + 1] = api[32 * 64 + tid]; }
    __syncthreads();
}

__device__ void p0_prep(const Params& P, unsigned char* lds, const int mask) {
    const int tid = threadIdx.x, G = gridDim.x;
    if (blockIdx.x == 0 && tid < 8) ((int*)(P.ws + WS_CNT))[tid] = 0;
    constexpr int J_SSM = 256, J_X = 512, J_ROPE = 512;
    constexpr int NJ = J_SSM + J_X + J_ROPE;
    const bool tfirst = (blockIdx.x & 1) != 0;
    if (tfirst && (mask & 8)) { transposes_phase(P, (float*)lds); __syncthreads(); }
    for (int job = blockIdx.x; job < NJ; job += G) {
        if (job < J_SSM) {
#if LEVEL >= 1
            if (mask & 1) ssm_tables(P, job >> 2, job & 3, lds);
#endif
        }
        else if (job < J_SSM + J_X) { if (!(mask & 2)) continue;
            const int r0 = (job - J_SSM) * 64; bf16_t* xa = (bf16_t*)(P.ws + WS_XA);
#pragma unroll 4
            for (int i = 0; i < 16; ++i) { const int piece = tid + 512 * i, r = r0 + (piece >> 7), c8 = (piece & 127) * 8;
                const f32x4 a = *(const f32x4*)(P.x + (size_t)r * 1024 + c8), b = *(const f32x4*)(P.x + (size_t)r * 1024 + c8 + 4);
                u32x4 w; w.x = pk_bf16(a[0], a[1]); w.y = pk_bf16(a[2], a[3]); w.z = pk_bf16(b[0], b[1]); w.w = pk_bf16(b[2], b[3]);
                *(u32x4*)(xa + ((size_t)(r >> 5) * 40 + (r & 31)) * 1024 + c8) = w;
#if LEVEL < 1
                *(f32x4*)(P.out + (size_t)r * 1024 + c8) = a; *(f32x4*)(P.out + (size_t)r * 1024 + c8 + 4) = b;
#endif
            }
        }
        else if (job < J_SSM + J_X + J_ROPE) { if (!(mask & 4)) continue;
            const int tok = (job - J_SSM - J_X) * 64 + (tid >> 3), i = tid & 7;
            const float invf[8] = {1.0f, 0.19392274474868576f, 0.03760603093086393f, 0.007292664737217109f, 0.001414213562373095f, 0.0002742481756762073f, 5.318295896944988e-05f, 1.031338537721246e-05f};
            float f = invf[0];
#pragma unroll
            for (int k = 1; k < 8; ++k) f = (i == k) ? invf[k] : f;
            const float ang = (float)P.pos[tok] * f; float sn, cs; sincosf(ang, &sn, &cs);
            ((float*)(P.ws + WS_ROPEC))[tok * 8 + i] = cs; ((float*)(P.ws + WS_ROPES))[tok * 8 + i] = sn;
        }
    }
    if (!tfirst && (mask & 8)) { __syncthreads(); transposes_phase(P, (float*)lds); }
}

__device__ void scan_unit(const Params& P, int g, int pm) {
    const float* sst = (const float*)(P.ws + WS_SST); const float* a32 = (const float*)(P.ws + WS_A32); bf16_t* xa = (bf16_t*)(P.ws + WS_XA);
    const int tid = threadIdx.x;
    if (tid < 256) {
        const int p = tid & 63, b = pm * 4 + (tid >> 6), q = 2 * p;
        const float ar = a32[(g * 64 + p) * 2], ai = a32[(g * 64 + p) * 2 + 1];
        float hr = 0.f, hi = 0.f;
#pragma unroll 1
        for (int jb = 0; jb < 64; jb += 16) {
            float2 s[16];
#pragma unroll
            for (int j = 0; j < 16; ++j) s[j] = *(const float2*)(sst + ((size_t)(b * 64 + jb + j) * 64 + g) * 128 + q);
#pragma unroll
            for (int j = 0; j < 16; ++j) { const int row = b * 64 + jb + j;
                *(unsigned*)(xa + ((size_t)row * 40 + 32 + (q >> 4)) * 1024 + g * 16 + (q & 15)) = pk_bf16(hr, hi);
                const float nr = ar * hr - ai * hi + s[j].x, ni = ar * hi + ai * hr + s[j].y; hr = nr; hi = ni; }
        }
    }
}

template <int MODE, bool IN32>
__device__ void ln_phase(const Params& P, const float* h, const float* gam, const float* bet, unsigned char* lds, float* hout, bf16_t* h16, const bf16_t* d16) {
    const int tid = threadIdx.x, wid = tid >> 6, lane = tid & 63;
    float* wrt = (float*)lds;
    int* cnt = (int*)(P.ws + WS_CNT); int* lists = (int*)(P.ws + WS_LIST); int* toki = (int*)(P.ws + WS_TOK);
    const bf16_t* Y = (const bf16_t*)(P.ws + WS_Y);
    int base[8];
    int* lcnt = (int*)(lds + 32768);
    int* rinfo = (int*)(lds + 32768 + 64);
    if (MODE == 1) { for (int k = 0; k < 16; ++k) { const int idx = tid + 512 * k; wrt[(idx & 7) * 1024 + (idx >> 3)] = P.w_router[idx]; } if (tid < 8) lcnt[tid] = 0; __syncthreads(); }
    int kiter = 0;
    if (MODE == 2) { int acc = 0;
#pragma unroll
        for (int e = 0; e < 8; ++e) { base[e] = acc; acc += ((cnt[e] + 255) >> 8) << 8; } }
    f32x4 gv[4], bv[4];
#pragma unroll
    for (int i = 0; i < 4; ++i) { gv[i] = *(const f32x4*)(gam + 256 * i + lane * 4); bv[i] = *(const f32x4*)(bet + 256 * i + lane * 4); }
    for (int row = blockIdx.x * 8 + wid; row < T_; row += gridDim.x * 8, ++kiter) {
        f32x4 v[4];
        if (IN32) {
#pragma unroll
            for (int i = 0; i < 4; ++i) v[i] = *(const f32x4*)(h + (size_t)row * 1024 + 256 * i + lane * 4);
        } else {
#pragma unroll
            for (int i = 0; i < 4; ++i) { const u32x2 a = *(const u32x2*)(h16 + (size_t)row * 1024 + 256 * i + lane * 4); v[i] = (f32x4){hf_lo(a.x), hf_hi(a.x), hf_lo(a.y), hf_hi(a.y)}; }
        }
        if (MODE != 2 && d16 != nullptr) {
#pragma unroll
            for (int i = 0; i < 4; ++i) { const u32x2 a = *(const u32x2*)(d16 + (size_t)row * 1024 + 256 * i + lane * 4);
                v[i][0] = ALPHA * v[i][0] + bf_lo(a.x); v[i][1] = ALPHA * v[i][1] + bf_hi(a.x); v[i][2] = ALPHA * v[i][2] + bf_lo(a.y); v[i][3] = ALPHA * v[i][3] + bf_hi(a.y); }
        }
        if (MODE == 2) {
            const int e1 = toki[row * 8 + 0], p1 = toki[row * 8 + 1], e2 = toki[row * 8 + 2], p2 = toki[row * 8 + 3];
            const float w1 = __int_as_float(toki[row * 8 + 4]), w2 = __int_as_float(toki[row * 8 + 5]);
            int b1 = 0, b2 = 0;
#pragma unroll
            for (int e = 0; e < 8; ++e) { b1 = (e1 == e) ? base[e] : b1; b2 = (e2 == e) ? base[e] : b2; }
            const bf16_t* y1 = Y + (size_t)(b1 + p1) * 1024; const bf16_t* y2 = Y + (size_t)(b2 + p2) * 1024;
#pragma unroll
            for (int i = 0; i < 4; ++i) { const u32x2 a = *(const u32x2*)(y1 + 256 * i + lane * 4), b = *(const u32x2*)(y2 + 256 * i + lane * 4);
                v[i][0] = ALPHA * v[i][0] + (w1 * bf_lo(a.x) + w2 * bf_lo(b.x)); v[i][1] = ALPHA * v[i][1] + (w1 * bf_hi(a.x) + w2 * bf_hi(b.x));
                v[i][2] = ALPHA * v[i][2] + (w1 * bf_lo(a.y) + w2 * bf_lo(b.y)); v[i][3] = ALPHA * v[i][3] + (w1 * bf_hi(a.y) + w2 * bf_hi(b.y)); }
        }
        float s = 0.f;
#pragma unroll
        for (int i = 0; i < 4; ++i) s += (v[i][0] + v[i][1]) + (v[i][2] + v[i][3]);
        const float mu = wave_sum(s) * (1.0f / 1024.0f);
        float q = 0.f;
#pragma unroll
        for (int i = 0; i < 4; ++i) { v[i] = v[i] - mu; q += (v[i][0] * v[i][0] + v[i][1] * v[i][1]) + (v[i][2] * v[i][2] + v[i][3] * v[i][3]); }
        const float rstd = rsqrtf(wave_sum(q) * (1.0f / 1024.0f) + LN_EPS);
#pragma unroll
        for (int i = 0; i < 4; ++i) { v[i] = v[i] * rstd * gv[i] + bv[i]; if (MODE == 2) *(f32x4*)(hout + (size_t)row * 1024 + 256 * i + lane * 4) = v[i];
            if (MODE != 2) { u32x2 w; w.x = pk_f16(v[i][0], v[i][1]); w.y = pk_f16(v[i][2], v[i][3]); *(u32x2*)(h16 + (size_t)row * 1024 + 256 * i + lane * 4) = w; } }
        if (MODE == 1) {
            float lg[8];
#pragma unroll
            for (int e = 0; e < 8; ++e) { float a = 0.f;
#pragma unroll
                for (int i = 0; i < 4; ++i) { const f32x4 w = *(const f32x4*)(wrt + e * 1024 + 256 * i + lane * 4); a += (v[i][0] * w[0] + v[i][1] * w[1]) + (v[i][2] * w[2] + v[i][3] * w[3]); }
                lg[e] = wave_sum(a) + P.b_router[e]; }
            int e1 = 0; float v1 = lg[0];
#pragma unroll
            for (int e = 1; e < 8; ++e) if (lg[e] > v1) { v1 = lg[e]; e1 = e; }
            int e2 = -1; float v2 = -3.0e38f;
#pragma unroll
            for (int e = 0; e < 8; ++e) if (e != e1 && lg[e] > v2) { v2 = lg[e]; e2 = e; }
            const float ex = __expf(v2 - v1), w1 = 1.0f / (1.0f + ex), w2 = ex / (1.0f + ex);
            if (lane == 0) { const int p1 = atomicAdd(lcnt + e1, 1), p2 = atomicAdd(lcnt + e2, 1); int* ri = rinfo + (kiter * 8 + wid) * 6;
                ri[0] = e1; ri[1] = p1; ri[2] = e2; ri[3] = p2; ri[4] = __float_as_int(w1); ri[5] = __float_as_int(w2); }
        }
    }
    if (MODE == 1) {
        __syncthreads();
        if (tid < 8) lcnt[8 + tid] = atomicAdd(cnt + tid, lcnt[tid]);
        __syncthreads();
        for (int lr = tid; lr < 512; lr += 512) { const int row = blockIdx.x * 8 + (lr & 7) + (lr >> 3) * gridDim.x * 8;
            if (row < T_) { const int* ri = rinfo + lr * 6; const int e1 = ri[0], e2 = ri[2], p1 = lcnt[8 + e1] + ri[1], p2 = lcnt[8 + e2] + ri[3];
                lists[e1 * T_ + p1] = row; lists[e2 * T_ + p2] = row;
                toki[row * 8 + 0] = e1; toki[row * 8 + 1] = p1; toki[row * 8 + 2] = e2; toki[row * 8 + 3] = p2; toki[row * 8 + 4] = ri[4]; toki[row * 8 + 5] = ri[5]; } }
    }
}

__device__ void gather_phase(const Params& P) {
    const int tid = threadIdx.x, wid = tid >> 6, lane = tid & 63;
    const int* cnt = (const int*)(P.ws + WS_CNT); const int* lists = (const int*)(P.ws + WS_LIST);
    const bf16_t* h16 = (const bf16_t*)(P.ws + WS_H16); bf16_t* ga = (bf16_t*)(P.ws + WS_GA);
    int base[9], c[8]; base[0] = 0;
#pragma unroll
    for (int e = 0; e < 8; ++e) { c[e] = cnt[e]; base[e + 1] = base[e] + (((c[e] + 255) >> 8) << 8); }
    for (int r = blockIdx.x * 8 + wid; r < base[8]; r += gridDim.x * 8) {
        int e = 0;
#pragma unroll
        for (int k = 1; k < 8; ++k) e += (r >= base[k]) ? 1 : 0;
        int be = 0, ce = 0;
#pragma unroll
        for (int k = 0; k < 8; ++k) { be = (e == k) ? base[k] : be; ce = (e == k) ? c[k] : ce; }
        const int pos = r - be; u32x4 a = {0u, 0u, 0u, 0u}, b = a;
        if (pos < ce) { const int tok = lists[e * T_ + pos]; a = *(const u32x4*)(h16 + (size_t)tok * 1024 + lane * 8); b = *(const u32x4*)(h16 + (size_t)tok * 1024 + 512 + lane * 8); }
        *(u32x4*)(ga + (size_t)r * 1024 + lane * 8) = a; *(u32x4*)(ga + (size_t)r * 1024 + 512 + lane * 8) = b;
    }
}

__device__ void attn_phase(const Params& P, unsigned char* lds) {
    const int tid = threadIdx.x, wid = tid >> 6, lane = tid & 63, n = lane & 31, hh = lane >> 5;
    bf16_t* Ks = (bf16_t*)lds;
    bf16_t* Vt = (bf16_t*)(lds + 256 * 144);
    const bf16_t* QB = (const bf16_t*)(P.ws + WS_BIG); const bf16_t* KB = (const bf16_t*)(P.ws + WS_BIG + 64 * MiB); const bf16_t* VB = (const bf16_t*)(P.ws + WS_BIG + 80 * MiB);
    bf16_t* OB = (bf16_t*)(P.ws + WS_BIG + 96 * MiB);
#ifdef DUP_ATT
    constexpr int NITEM = 2048;
#else
    constexpr int NITEM = 1024;
#endif
    u32x4 kreg[4], vreg0[2], vreg1[2];
#define ATT_LOAD(it) do { const int kvh_ = (it) & 3, nb_ = ((it) >> 2) & 15, b_ = ((it) >> 6) & 15, tok_ = b_ * 2048 + nb_ * 128; \
        _Pragma("unroll") for (int i = 0; i < 4; ++i) { const int piece = tid + 512 * i, s = piece >> 3, pc = piece & 7; kreg[i] = (u32x4){0u, 0u, 0u, 0u}; \
            if (nb_ > 0 || s >= 128) kreg[i] = *(const u32x4*)(KB + (size_t)(tok_ - 128 + s) * 256 + kvh_ * 64 + pc * 8); } \
        _Pragma("unroll") for (int i = 0; i < 2; ++i) { const int s = 2 * (tid & 127), pc = (tid >> 7) + 4 * i; vreg0[i] = (u32x4){0u, 0u, 0u, 0u}; vreg1[i] = vreg0[i]; \
            if (nb_ > 0 || s >= 128) { vreg0[i] = *(const u32x4*)(VB + (size_t)(tok_ - 128 + s) * 256 + kvh_ * 64 + pc * 8); vreg1[i] = *(const u32x4*)(VB + (size_t)(tok_ - 127 + s) * 256 + kvh_ * 64 + pc * 8); } } } while (0)
    if ((int)blockIdx.x < NITEM) ATT_LOAD((int)blockIdx.x);
    for (int item = blockIdx.x; item < NITEM; item += gridDim.x) {
        const int kvh = item & 3, nb = (item >> 2) & 15, b = (item >> 6) & 15;
        const int tok0 = b * 2048 + nb * 128;
        __syncthreads();
#pragma unroll
        for (int i = 0; i < 4; ++i) { const int piece = tid + 512 * i, s = piece >> 3, pc = piece & 7; *(u32x4*)(Ks + s * 72 + pc * 8) = kreg[i]; }
#pragma unroll
        for (int i = 0; i < 2; ++i) { const int s = 2 * (tid & 127), pc = (tid >> 7) + 4 * i; const u32x4 v0 = vreg0[i], v1 = vreg1[i];
            unsigned* vt = (unsigned*)(Vt + (pc * 8) * 264 + s);
            vt[0 * 132] = (v0.x & 0xffffu) | (v1.x << 16); vt[1 * 132] = (v0.x >> 16) | (v1.x & 0xffff0000u);
            vt[2 * 132] = (v0.y & 0xffffu) | (v1.y << 16); vt[3 * 132] = (v0.y >> 16) | (v1.y & 0xffff0000u);
            vt[4 * 132] = (v0.z & 0xffffu) | (v1.z << 16); vt[5 * 132] = (v0.z >> 16) | (v1.z & 0xffff0000u);
            vt[6 * 132] = (v0.w & 0xffffu) | (v1.w << 16); vt[7 * 132] = (v0.w >> 16) | (v1.w & 0xffff0000u); }
        __syncthreads();
        if (item + (int)gridDim.x < NITEM) ATT_LOAD(item + (int)gridDim.x);
        const int hq = kvh * 4 + (wid >> 1);
        const float sink = P.sinks[hq] * 1.4426950408889634f;
#pragma unroll 1
        for (int qq = 0; qq < 2; ++qq) {
            const int kb0 = (wid & 1) * 2 + qq, i0 = 32 * kb0, qi = i0 + n;
            const bf16_t* qp = QB + (size_t)(tok0 + qi) * 1024 + hq * 64 + 8 * hh;
            bf16x8 qf[4];
#pragma unroll
            for (int ks = 0; ks < 4; ++ks) qf[ks] = *(const bf16x8*)(qp + 16 * ks);
            f32x16 sacc[5];
#pragma unroll
            for (int kb = 0; kb < 5; ++kb) {
#pragma unroll
                for (int i = 0; i < 16; ++i) sacc[kb][i] = 0.f;
                const bf16_t* kp = Ks + (32 * (kb0 + kb) + n) * 72 + 8 * hh;
#pragma unroll
                for (int ks = 0; ks < 4; ++ks) { const bf16x8 a = *(const bf16x8*)(kp + 16 * ks); sacc[kb] = __builtin_amdgcn_mfma_f32_32x32x16_bf16(a, qf[ks], sacc[kb], 0, 0, 0); }
                asm volatile("" ::: "memory"); }
            const int nn4 = n - 4 * hh;
#pragma unroll
            for (int i = 0; i < 16; ++i) { const int r = 8 * (i >> 2) + (i & 3);
                sacc[0][i] = (r > nn4) ? sacc[0][i] : -1.0e30f; sacc[4][i] = (r <= nn4) ? sacc[4][i] : -1.0e30f; }
            if (nb == 0) {
#pragma unroll
                for (int kb = 0; kb < 4; ++kb) if (kb0 + kb < 4) {
#pragma unroll
                    for (int i = 0; i < 16; ++i) sacc[kb][i] = -1.0e30f; } }
            float mx = sink;
#pragma unroll
            for (int kb = 0; kb < 5; ++kb)
#pragma unroll
                for (int i = 0; i < 16; ++i) mx = fmaxf(mx, sacc[kb][i]);
            mx = fmaxf(mx, __shfl_xor(mx, 32));
            float sum = 0.f;
#pragma unroll
            for (int kb = 0; kb < 5; ++kb)
#pragma unroll
                for (int i = 0; i < 16; ++i) { const float p = __builtin_amdgcn_exp2f(sacc[kb][i] - mx); sacc[kb][i] = p; sum += p; }
            sum += __shfl_xor(sum, 32); sum += __builtin_amdgcn_exp2f(sink - mx);
            f32x16 oacc[2];
#pragma unroll
            for (int i = 0; i < 16; ++i) { oacc[0][i] = 0.f; oacc[1][i] = 0.f; }
#pragma unroll
            for (int kb = 0; kb < 5; ++kb)
#pragma unroll
                for (int sl = 0; sl < 2; ++sl) {
                    union { u32x4 u; bf16x8 v; } pb;
                    pb.u.x = pk_bf16(sacc[kb][8 * sl + 0], sacc[kb][8 * sl + 1]); pb.u.y = pk_bf16(sacc[kb][8 * sl + 2], sacc[kb][8 * sl + 3]);
                    pb.u.z = pk_bf16(sacc[kb][8 * sl + 4], sacc[kb][8 * sl + 5]); pb.u.w = pk_bf16(sacc[kb][8 * sl + 6], sacc[kb][8 * sl + 7]);
#pragma unroll
                    for (int mb = 0; mb < 2; ++mb) { const bf16_t* vp = Vt + (32 * mb + n) * 264 + 32 * (kb0 + kb) + 16 * sl + 4 * hh;
                        union { u32x4 u; bf16x8 v; } va; const u32x2 lo = *(const u32x2*)vp, hi = *(const u32x2*)(vp + 8); va.u.x = lo.x; va.u.y = lo.y; va.u.z = hi.x; va.u.w = hi.y;
                        oacc[mb] = __builtin_amdgcn_mfma_f32_32x32x16_bf16(va.v, pb.v, oacc[mb], 0, 0, 0); }
                    asm volatile("" ::: "memory"); }
            const float inv = 1.0f / sum;
            bf16_t* op = OB + (size_t)(tok0 + qi) * 1024 + hq * 64 + 4 * hh;
#pragma unroll
            for (int mb = 0; mb < 2; ++mb)
#pragma unroll
                for (int g4 = 0; g4 < 4; ++g4) { u32x2 w; w.x = pk_bf16(oacc[mb][4 * g4 + 0] * inv, oacc[mb][4 * g4 + 1] * inv); w.y = pk_bf16(oacc[mb][4 * g4 + 2] * inv, oacc[mb][4 * g4 + 3] * inv);
                    *(u32x2*)(op + 32 * mb + 8 * g4) = w; }
        }
    }
}

#if defined(__HIP_DEVICE_COMPILE__)
typedef const Params __attribute__((address_space(4)))* KParams;
__device__ __forceinline__ Params load_params() { KParams p = (KParams)__builtin_amdgcn_kernarg_segment_ptr(); asm volatile("" : "+s"(p)); return *p; }
#else
__device__ __forceinline__ Params load_params() { return Params{}; }
#endif
#define LP const Params P = load_params(); unsigned char* const ws = P.ws; float* const H = P.out; (void)ws; (void)H
__global__ void __launch_bounds__(512, 2) yoco_fwd(Params P_arg) {
    extern __shared__ __attribute__((aligned(16))) unsigned char lds[];
    cg::grid_group grid = cg::this_grid();
    LAS unsigned char* ldsl = (LAS unsigned char*)lds;
    const int G = gridDim.x, c = blockIdx.x;
    if (threadIdx.x == 0) { ((LAS unsigned*)(ldsl + 131072))[0] = 0u; ((LAS unsigned*)(ldsl + 131072))[1] = 0u; }
    __syncthreads();
#define GSYNC() do { LP; xcd_barrier((unsigned*)(ws + WS_BAR), (volatile LAS unsigned*)(ldsl + 131072)); } while (0)

#ifdef PROF_A_HI
#define STAMP(k) do { LP; if (((k) == PROF_A_LO || (k) == PROF_A_HI || (k) == PROF_B_LO || (k) == PROF_B_HI) && blockIdx.x == 0 && threadIdx.x == 0) ((unsigned long long*)(P.ws + WS_CNT + 1024))[k] = __builtin_amdgcn_s_memrealtime(); } while (0)
#else
#define STAMP(k) do { } while (0)
#endif
#ifdef DUP_ALL
#pragma unroll 1
    for (int pass = 0; pass < 2; ++pass) {
#else
    { const int pass = 0;
#endif
    STAMP(0);
    if (pass != 0) GSYNC();
    { LP; p0_prep(P, lds, (P.skip & 1) ? 0 : (15 & ~(P.skip >> 16))); if (pass == 0 && blockIdx.x == 0) for (int i = threadIdx.x; i < XCD_BAR_WORDS; i += 512) ((unsigned*)(ws + WS_BAR))[i] = 0u; }
    if (pass == 0) { grid.sync();
        { LP; if (threadIdx.x == 0) (void)xb_add(&((unsigned*)(ws + WS_BAR))[XB_XCNT(xb_xcc_id())], 1u); } }
    else GSYNC();
#ifdef DUP_SYNC
#pragma unroll 1
    for (int r = 0; r < 16; ++r) GSYNC();
#endif
#ifdef DUP_P0
    { LP; p0_prep(P, lds, DUP_P0); }
    GSYNC();
#endif
    STAMP(1);
#if LEVEL >= 1
#pragma unroll 1
    for (int rep = 0; rep < NREP_S1; ++rep) {
    {   LP; if (!((P.skip >> 1) & 1)) {
        pg8::SchedSsm S; S.init(256, 512, G, c); pg8::EpiS1 E{(float*)(ws + WS_SST)};
        pg8::gemm_phase<false>(ldsl, (const char*)(ws + WS_XA), (const char*)(ws + WS_BT1), 512, S, E);
        asm volatile("s_waitcnt vmcnt(0)" ::: "memory"); __syncthreads();
        pg8::Unit u; for (int i = 0; S.next(i, u); ++i) scan_unit(P, u.aux, u.pm); } }
    GSYNC(); } STAMP(2);
#pragma unroll 1
    for (int rep = 0; rep < NREP_S2; ++rep) {
    {   LP; if (!((P.skip >> 2) & 1)) {
        pg8::SchedSsm S; S.init(512, 640, G, c); pg8::EpiS2 E{(const bf16_t*)(ws + WS_XA), P.ssm_d, (bf16_t*)(ws + WS_BIG)};
        pg8::gemm_phase<false>(ldsl, (const char*)(ws + WS_XA), (const char*)(ws + WS_BT2), 640, S, E); } }
    GSYNC(); } STAMP(4);
#pragma unroll 1
    for (int rep = 0; rep < NREP_GLU; ++rep) {
    {   LP; if (!((P.skip >> 3) & 1)) {
        pg8::SchedDense S; S.init(T_, 2048, 1024, 1024, G, c); pg8::EpiUp<1> E{(bf16_t*)(ws + WS_GA), 1024};
        pg8::gemm_phase<false>(ldsl, (const char*)(ws + WS_BIG), (const char*)(ws + WS_WGLU), 1024, S, E); } }
    GSYNC(); } STAMP(5);
#endif
    { LP; if (!((P.skip >> 4) & 1)) ln_phase<0, true>(P, (LEVEL >= 1) ? P.x : H, P.ln_g, P.ln_b, lds, H, (bf16_t*)(ws + WS_H16), (LEVEL >= 1) ? (const bf16_t*)(ws + WS_GA) : nullptr); }
    GSYNC(); STAMP(6);
#if LEVEL >= 2
#pragma unroll 1
    for (int rep = 0; rep < NREP_FUP; ++rep) {
    {   LP; if (!((P.skip >> 5) & 1)) {
        pg8::SchedDense S; S.init(T_, 2 * FF_, 1024, 1024, G, c); pg8::EpiUp<0> E{(bf16_t*)(ws + WS_BIG), FF_};
        pg8::gemm_phase<true>(ldsl, (const char*)(ws + WS_H16), (const char*)(ws + WS_WUP), 1024, S, E); } }
    GSYNC(); } STAMP(7);
#pragma unroll 1
    for (int rep = 0; rep < NREP_FDN; ++rep) {
    {   LP; if (!((P.skip >> 6) & 1)) {
#define NREP_CUR NREP_FDN
        pg8::SchedDense S; S.init(T_, 1024, FF_, FF_, G, c); pg8::EpiBf16 E{(bf16_t*)(ws + WS_GA), 1024};
        pg8::gemm_phase<false>(ldsl, (const char*)(ws + WS_BIG), (const char*)(ws + WS_WDN), FF_, S, E); } }
    GSYNC(); } STAMP(8);
#endif
    { LP; if (!((P.skip >> 7) & 1)) ln_phase<0, false>(P, H, P.ln_g + 1024, P.ln_b + 1024, lds, H, (bf16_t*)(ws + WS_H16), (LEVEL >= 2) ? (const bf16_t*)(ws + WS_GA) : nullptr); }
    GSYNC(); STAMP(9);
#if LEVEL >= 3
#pragma unroll 1
    for (int rep = 0; rep < NREP_QKV; ++rep) {
    {   LP; if (!((P.skip >> 8) & 1)) {
        pg8::SchedDense S; S.init(T_, 1536, 1024, 1024, G, c);
        pg8::EpiQkv E{(bf16_t*)(ws + WS_BIG), (bf16_t*)(ws + WS_BIG + 64 * MiB), (bf16_t*)(ws + WS_BIG + 80 * MiB), (const float*)(ws + WS_ROPEC), (const float*)(ws + WS_ROPES)};
        pg8::gemm_phase<true>(ldsl, (const char*)(ws + WS_H16), (const char*)(ws + WS_WQKV), 1024, S, E); } }
    GSYNC(); } STAMP(10);
#ifndef SKIP_ATT
    { LP; if (!((P.skip >> 9) & 1)) attn_phase(P, lds); }
#endif
    GSYNC(); STAMP(11);
#pragma unroll 1
    for (int rep = 0; rep < NREP_OUT; ++rep) {
    {   LP; if (!((P.skip >> 10) & 1)) {
#undef NREP_CUR
#define NREP_CUR NREP_OUT
        pg8::SchedDense S; S.init(T_, 1024, 1024, 1024, G, c);
        pg8::EpiBf16 E{(bf16_t*)(ws + WS_GA), 1024};
        pg8::gemm_phase<false>(ldsl, (const char*)(ws + WS_BIG + 96 * MiB), (const char*)(ws + WS_WO), 1024, S, E); } }
    GSYNC(); } STAMP(12);
#endif
#if LEVEL >= 4
    { LP; if (!((P.skip >> 11) & 1)) ln_phase<1, false>(P, H, P.ln_g + 2048, P.ln_b + 2048, lds, H, (bf16_t*)(ws + WS_H16), (const bf16_t*)(ws + WS_GA)); }
    GSYNC(); STAMP(13);
#pragma unroll 1
    for (int rep = 0; rep < NREP_GATH; ++rep) {
    { LP; if (!((P.skip >> 12) & 1)) gather_phase(P); }
    GSYNC(); } STAMP(14);
#pragma unroll 1
    for (int rep = 0; rep < NREP_MUP; ++rep) {
    {   LP; if (!((P.skip >> 13) & 1)) {
        pg8::SchedMoe S; S.init((const int*)(ws + WS_CNT), 2048, 1024, (size_t)2048 * 1024 * 2, G, c); pg8::EpiUp<0> E{(bf16_t*)(ws + WS_BIG), 1024};
        pg8::gemm_phase<true>(ldsl, (const char*)(ws + WS_GA), (const char*)(ws + WS_WMUP), 1024, S, E); } }
    GSYNC(); } STAMP(15);
#pragma unroll 1
    for (int rep = 0; rep < NREP_MDN; ++rep) {
    {   LP; if (!((P.skip >> 14) & 1)) {
        pg8::SchedMoe S; S.init((const int*)(ws + WS_CNT), 1024, 1024, (size_t)1024 * 1024 * 2, G, c); pg8::EpiBf16 E{(bf16_t*)(ws + WS_Y), 1024};
        pg8::gemm_phase<false>(ldsl, (const char*)(ws + WS_BIG), (const char*)(ws + WS_WMDN), 1024, S, E); } }
    GSYNC(); } STAMP(16);
    { LP; if (!((P.skip >> 15) & 1)) ln_phase<2, false>(P, H, P.ln_g + 3072, P.ln_b + 3072, lds, H, (bf16_t*)(ws + WS_H16), nullptr); }
#ifdef PROF_A_HI
    GSYNC(); STAMP(17);
    {   LP; const unsigned long long* stamps = (const unsigned long long*)(P.ws + WS_CNT + 1024);
        const float tA = (float)(stamps[PROF_A_HI] - stamps[PROF_A_LO]) * 0.01f, tB = (float)(stamps[PROF_B_HI] - stamps[PROF_B_LO]) * 0.01f;
        for (int i = blockIdx.x * 512 + threadIdx.x; i < (1 << 22); i += gridDim.x * 512) H[(size_t)i * 8 + 1] = tB;
        if (blockIdx.x == 0 && threadIdx.x == 0) H[0] = 64.0f * tA; }
#endif
#ifdef PROF_A_HI
#endif
    }
#else
    { LP; ln_phase<0, false>(P, H, P.ln_g + 2048, P.ln_b + 2048, lds, H, (bf16_t*)(ws + WS_H16), (LEVEL >= 3) ? (const bf16_t*)(ws + WS_GA) : nullptr); }
    GSYNC(); STAMP(13);
    { LP; ln_phase<0, false>(P, H, P.ln_g + 3072, P.ln_b + 3072, lds, H, (bf16_t*)(ws + WS_H16), nullptr); }
#endif
}

extern "C" void kernel_launch(void* const* d_in, const int* in_sizes, int n_in, void* d_out, int out_size, void* d_ws, size_t ws_size, hipStream_t stream) {
    static int grid_blocks = 0;
    if (grid_blocks == 0) {
        if (n_in != 25 || out_size != T_ * D_ || ws_size < WS_END) { fprintf(stderr, "kernel_launch: unexpected shapes (n_in %d out %d ws %zu)\n", n_in, out_size, ws_size); grid_blocks = -1; return; }
        int dev = 0, cus = 0, per_cu = 0;
        hipGetDevice(&dev); hipDeviceGetAttribute(&cus, hipDeviceAttributeMultiprocessorCount, dev);
        if (hipFuncSetAttribute((const void*)yoco_fwd, hipFuncAttributeMaxDynamicSharedMemorySize, LDS_BYTES) != hipSuccess) { fprintf(stderr, "kernel_launch: hipFuncSetAttribute failed\n"); grid_blocks = -1; return; }
        if (hipOccupancyMaxActiveBlocksPerMultiprocessor(&per_cu, (const void*)yoco_fwd, 512, LDS_BYTES) != hipSuccess || per_cu < 1) { fprintf(stderr, "kernel_launch: occupancy query says %d\n", per_cu); per_cu = 1; (void)hipGetLastError(); }
        grid_blocks = cus * 1;
    }
    if (grid_blocks < 0) return;
    Params p{};
    p.x = (const float*)d_in[0]; p.pos = (const int*)d_in[1]; p.ln_g = (const float*)d_in[2]; p.ln_b = (const float*)d_in[3];
    p.lam_re = (const float*)d_in[4]; p.lam_im = (const float*)d_in[5]; p.log_step = (const float*)d_in[6]; p.b_re = (const float*)d_in[7]; p.b_im = (const float*)d_in[8];
    p.c_re = (const float*)d_in[9]; p.c_im = (const float*)d_in[10]; p.ssm_d = (const float*)d_in[11]; p.w_glu = (const float*)d_in[12]; p.kv_w = (const float*)d_in[13];
    p.w_q = (const float*)d_in[14]; p.sinks = (const float*)d_in[15]; p.w_out = (const float*)d_in[16]; p.ffn_g = (const float*)d_in[17]; p.ffn_u = (const float*)d_in[18]; p.ffn_d = (const float*)d_in[19];
    p.w_router = (const float*)d_in[20]; p.b_router = (const float*)d_in[21]; p.moe_g = (const float*)d_in[22]; p.moe_u = (const float*)d_in[23]; p.moe_d = (const float*)d_in[24];
    p.out = (float*)d_out; p.ws = (unsigned char*)d_ws;
    void* args[] = {&p};
#ifdef SKIP_PROBE
    p.skip = SKIP_PROBE; (void)hipLaunchCooperativeKernel((const void*)yoco_fwd, dim3(grid_blocks), dim3(512), args, LDS_BYTES, stream); p.skip = 0;
#endif
    hipError_t e = hipLaunchCooperativeKernel((const void*)yoco_fwd, dim3(grid_blocks), dim3(512), args, LDS_BYTES, stream);
    if (e != hipSuccess) fprintf(stderr, "cooperative launch failed: %s (grid %d)\n", hipGetErrorString(e), grid_blocks);
}
```

```cpp
#include <hip/hip_runtime.h>
#include <hip/hip_cooperative_groups.h>
#include <cstdio>
namespace cg = cooperative_groups;

#ifndef LEVEL
#define LEVEL 4
#endif

#ifdef DUP_S1
#define NREP_S1 2
#else
#define NREP_S1 1
#endif
#ifdef DUP_S2
#define NREP_S2 2
#else
#define NREP_S2 1
#endif
#ifdef DUP_GLU
#define NREP_GLU 2
#else
#define NREP_GLU 1
#endif
#ifdef DUP_FUP
#define NREP_FUP 2
#else
#define NREP_FUP 1
#endif
#if defined(DUP_FDN) || defined(DUP_FDNNULL)
#define NREP_FDN 2
#else
#define NREP_FDN 1
#endif
#ifdef DUP_QKV
#define NREP_QKV 2
#else
#define NREP_QKV 1
#endif
#if defined(DUP_OUT) || defined(DUP_OUTNULL)
#define NREP_OUT 2
#else
#define NREP_OUT 1
#endif
#ifdef DUP_MUP
#define NREP_MUP 2
#else
#define NREP_MUP 1
#endif
#ifdef DUP_MDN
#define NREP_MDN 2
#else
#define NREP_MDN 1
#endif
#ifdef DUP_SCAN
#define NREP_SCAN 2
#else
#define NREP_SCAN 1
#endif
#ifdef DUP_GATH
#define NREP_GATH 2
#else
#define NREP_GATH 1
#endif
#ifdef DUP_OUTNULL
#define SKIP_EPI_OUT (rep == 0)
#else
#define SKIP_EPI_OUT false
#endif
#ifdef DUP_FDNNULL
#define SKIP_EPI_FDN (rep == 0)
#else
#define SKIP_EPI_FDN false
#endif
#define LAS __attribute__((address_space(3)))
typedef unsigned short bf16_t;
typedef short bf16x8 __attribute__((ext_vector_type(8)));
typedef float f32x4 __attribute__((ext_vector_type(4)));
typedef float f32x16 __attribute__((ext_vector_type(16)));
typedef unsigned u32x4 __attribute__((ext_vector_type(4)));
typedef unsigned u32x2 __attribute__((ext_vector_type(2)));

constexpr int T_ = 32768, D_ = 1024, FF_ = 2816;
constexpr float ALPHA = 1.41421356237309515f;
constexpr float LN_EPS = 1e-5f;
constexpr size_t MiB = 1ull << 20;
constexpr size_t WS_CNT = 0, WS_BAR = 4096, WS_A32 = 65536, WS_ROPEC = 1 * MiB, WS_ROPES = 2 * MiB, WS_LIST = 3 * MiB, WS_TOK = 4 * MiB;
constexpr size_t WS_WMUP = 8 * MiB, WS_WMDN = 40 * MiB, WS_WGLU = 56 * MiB, WS_WUP = 60 * MiB, WS_WDN = 71 * MiB, WS_WQKV = 77 * MiB, WS_WO = 80 * MiB;
constexpr size_t WS_H16 = 82 * MiB, WS_BT2 = 146 * MiB, WS_BT1 = 186 * MiB, WS_XA = 202 * MiB, WS_SST = 282 * MiB, WS_GA = 146 * MiB, WS_Y = 146 * MiB;
constexpr size_t WS_BIG = 314 * MiB, WS_END = 490 * MiB;
constexpr int LDS_BYTES = 131072 + 16;

struct Params {
    const float* x; const int* pos; const float* ln_g; const float* ln_b;
    const float* lam_re; const float* lam_im; const float* log_step; const float* b_re; const float* b_im; const float* c_re; const float* c_im;
    const float* ssm_d; const float* w_glu; const float* kv_w; const float* w_q; const float* sinks; const float* w_out;
    const float* ffn_g; const float* ffn_u; const float* ffn_d; const float* w_router; const float* b_router;
    const float* moe_g; const float* moe_u; const float* moe_d;
    float* out; unsigned char* ws; int skip; int pad;
};

__device__ __forceinline__ unsigned pk_bf16(float lo, float hi) { unsigned r; asm volatile("v_cvt_pk_bf16_f32 %0, %1, %2" : "=v"(r) : "v"(lo), "v"(hi)); return r; }
typedef _Float16 f16x8 __attribute__((ext_vector_type(8)));
typedef _Float16 f16x2 __attribute__((ext_vector_type(2)));
__device__ __forceinline__ unsigned pk_f16(float lo, float hi) { union { f16x2 h; unsigned u; } c; c.h = (f16x2){(_Float16)lo, (_Float16)hi}; return c.u; }
__device__ __forceinline__ float hf_lo(unsigned w) { union { unsigned u; f16x2 h; } c; c.u = w; return (float)c.h[0]; }
__device__ __forceinline__ float hf_hi(unsigned w) { union { unsigned u; f16x2 h; } c; c.u = w; return (float)c.h[1]; }
__device__ __forceinline__ float bf_lo(unsigned w) { return __uint_as_float(w << 16); }
__device__ __forceinline__ float bf_hi(unsigned w) { return __uint_as_float(w & 0xffff0000u); }
__device__ __forceinline__ float sigmoidf_(float x) { return __builtin_amdgcn_rcpf(1.0f + __expf(-x)); }
__device__ __forceinline__ float gelu_tanh(float y) { const float u = 1.5957691216057308f * (y + 0.044715f * y * y * y); return y * sigmoidf_(u); }
__device__ __forceinline__ float xor16(float v) { const unsigned u = __float_as_uint(v); const auto r = __builtin_amdgcn_permlane16_swap(u, u, false, false); return __uint_as_float(r[0] == u ? r[1] : r[0]); }
__device__ __forceinline__ float wave_sum(float v) {
    v += __shfl_xor(v, 32); v += __shfl_xor(v, 16); v += __shfl_xor(v, 8); v += __shfl_xor(v, 4); v += __shfl_xor(v, 2); v += __shfl_xor(v, 1); return v; }


#define XB_TMO      128
#define XB_XCNT(j)  (256  + 64 * (j))
#define XB_XSUB(j)  (1280 + 64 * (j))
#define XB_XGEN(j)  (2304 + 64 * (j))
#define XB_TOP      3328
#define XB_TOPGEN   3392
#define XCD_BAR_WORDS 3456
#define XB_SPIN_CAP (1u << 22)
__device__ __forceinline__ unsigned xb_ld(unsigned* p)              { return __hip_atomic_load(p, __ATOMIC_RELAXED, __HIP_MEMORY_SCOPE_AGENT); }
__device__ __forceinline__ unsigned xb_add(unsigned* p, unsigned v) { return __hip_atomic_fetch_add(p, v, __ATOMIC_RELAXED, __HIP_MEMORY_SCOPE_AGENT); }
__device__ __forceinline__ unsigned xb_xcc_id() { return (unsigned)__builtin_amdgcn_s_getreg((3 << 11) | 20) & 0xFu; }
#define XB_SPIN(cond, bar) do { unsigned _sp = 0; while (cond) { __builtin_amdgcn_s_sleep(1); \
    if ((++_sp & 255u) == 0u) { if (xb_ld(&(bar)[XB_TMO])) break; if (_sp > XB_SPIN_CAP) { atomicAdd(&(bar)[XB_TMO], 1u); break; } } } } while (0)
__device__ __forceinline__ void xcd_barrier_complete(unsigned* bar, unsigned x, unsigned& nloc, unsigned& nx) {
    const unsigned G = gridDim.x * gridDim.y * gridDim.z;
    unsigned sum, cnt, mine, sp = 0u;
    for (;;) {
        sum = 0u; cnt = 0u; mine = 0u;
#pragma unroll
        for (unsigned j = 0; j < 16; ++j) { const unsigned c = xb_ld(&bar[XB_XCNT(j)]); sum += c; cnt += (c > 0u) ? 1u : 0u; mine = (j == x) ? c : mine; }
        if (sum == G) break;
        __builtin_amdgcn_s_sleep(1);
        if ((++sp & 255u) == 0u) { if (xb_ld(&bar[XB_TMO])) break; if (sp > XB_SPIN_CAP) { atomicAdd(&bar[XB_TMO], 1u); break; } }
    }
    nloc = mine > 0u ? mine : 1u; nx = cnt > 0u ? cnt : 1u;
}
__device__ __forceinline__ void xcd_barrier(unsigned* bar, volatile LAS unsigned* st) {
    asm volatile("s_waitcnt vmcnt(0)" ::: "memory");
    __syncthreads();
    if (threadIdx.x == 0) {
        const unsigned x = xb_xcc_id();
        __builtin_amdgcn_s_waitcnt(0);
        unsigned nloc = st[0], nx = st[1];
        if (nloc == 0u) { xcd_barrier_complete(bar, x, nloc, nx); st[0] = nloc; st[1] = nx; }
        const unsigned old = xb_add(&bar[XB_XSUB(x)], 1u);
        const unsigned gen = old / nloc;
        if (old + 1u == (gen + 1u) * nloc) {
            __builtin_amdgcn_fence(__ATOMIC_RELEASE, "agent");
            asm volatile("s_waitcnt vmcnt(0)" ::: "memory");
            const unsigned og = xb_add(&bar[XB_TOP], 1u);
            const unsigned tg = og / nx;
            if (og + 1u == (tg + 1u) * nx) xb_add(&bar[XB_TOPGEN], 1u);
            else XB_SPIN(xb_ld(&bar[XB_TOPGEN]) == tg, bar);
            __builtin_amdgcn_fence(__ATOMIC_ACQUIRE, "agent");
            xb_add(&bar[XB_XGEN(x)], 1u);
            asm volatile("s_waitcnt vmcnt(0)" ::: "memory");
        } else {
            XB_SPIN(xb_ld(&bar[XB_XGEN(x)]) == gen, bar);
            __builtin_amdgcn_fence(__ATOMIC_ACQUIRE, "agent");
            asm volatile("s_waitcnt vmcnt(0)" ::: "memory");
        }
    }
    __syncthreads();
}

namespace pg8 {
constexpr int BM = 256, BK = 64, HALF = 128, HTB = HALF * BK * 2, NXCD = 8, WGM = 8;
__device__ __forceinline__ int lds_byte(int r, int c) { const int st = (r >> 4) * 2 + (c >> 5), rr = r & 15, cc = c & 31, ob = rr * 64 + cc * 2; return st * 1024 + (ob ^ (((ob >> 9) & 1) << 5)); }
__device__ __forceinline__ void stage_rc(int b, int& R, int& C) { const int st = b / 1024, sb = b % 1024, swz = sb ^ (((sb >> 9) & 1) << 5); R = (st >> 1) * 16 + swz / 64; C = (st & 1) * 32 + (swz % 64) / 2; }
__device__ __forceinline__ int perm32(int rho) { const int n = rho >> 4, i = rho & 15; return 8 * (i >> 2) + 4 * n + (i & 3); }
__device__ __forceinline__ int xcd_remap(int L, int nwg) { const int q = nwg / NXCD, r = nwg % NXCD, xcd = L % NXCD, off = L / NXCD; return (xcd < r ? xcd * (q + 1) : r * (q + 1) + (xcd - r) * q) + off; }

struct Unit { int pm, pn, aux, pad; size_t a_off, b_off; };

struct SchedDense {
    int nM, nN, nwg, G, c, lda, K;
    __device__ __forceinline__ void init(int M, int N, int K_, int lda_, int G_, int c_) { nM = M / BM; nN = N / BM; nwg = nM * nN; G = G_; c = c_; lda = lda_; K = K_; }
    __device__ __forceinline__ bool next(int i, Unit& u) const {
        const int L = i * G + c; if (L >= nwg) return false;
        const int wgid = xcd_remap(L, nwg);
        const int nig = WGM * nN, gid = wgid / nig, fm = gid * WGM, gsz = (nM - fm) < WGM ? (nM - fm) : WGM;
        u.pm = fm + ((wgid % nig) % gsz); u.pn = (wgid % nig) / gsz; u.aux = 0; u.pad = 0;
        u.a_off = (size_t)u.pm * BM * lda * 2; u.b_off = (size_t)u.pn * BM * K * 2; return true;
    }
    __device__ __forceinline__ unsigned voffA(int R, int C) const { return (unsigned)(R * lda + C) * 2u; }
    __device__ __forceinline__ size_t a_kstep() const { return BK * 2; }
    __device__ __forceinline__ size_t a_hstep() const { return (size_t)HALF * lda * 2; }
};
struct SchedMoe {
    int nM, nN, nwg, G, c, K; int tb[9]; size_t estride;
    __device__ __forceinline__ void init(const int* cnt, int N, int K_, size_t estride_, int G_, int c_) {
        tb[0] = 0;
#pragma unroll
        for (int e = 0; e < 8; ++e) tb[e + 1] = tb[e] + ((cnt[e] + 255) >> 8);
        nM = tb[8]; nN = N / BM; nwg = nM * nN; G = G_; c = c_; K = K_; estride = estride_; }
    __device__ __forceinline__ bool next(int i, Unit& u) const {
        const int L = i * G + c; if (L >= nwg) return false;
        const int wgid = xcd_remap(L, nwg);
        const int nig = WGM * nN, gid = wgid / nig, fm = gid * WGM, gsz = (nM - fm) < WGM ? (nM - fm) : WGM;
        u.pm = fm + ((wgid % nig) % gsz); u.pn = (wgid % nig) / gsz; int e = 0;
#pragma unroll
        for (int k = 1; k < 8; ++k) e += (u.pm >= tb[k]) ? 1 : 0;
        u.aux = e; u.pad = 0;
        u.a_off = (size_t)u.pm * BM * 1024 * 2; u.b_off = (size_t)e * estride + (size_t)u.pn * BM * K * 2; return true;
    }
    __device__ __forceinline__ unsigned voffA(int R, int C) const { return (unsigned)(R * 1024 + C) * 2u; }
    __device__ __forceinline__ size_t a_kstep() const { return BK * 2; }
    __device__ __forceinline__ size_t a_hstep() const { return (size_t)HALF * 1024 * 2; }
};
struct SchedSsm {
    int nN, nwg, G, c, K, N;
    __device__ __forceinline__ void init(int N_, int K_, int G_, int c_) { N = N_; nN = N_ / BM; nwg = 64 * 4 * nN; G = G_; c = c_; K = K_; }
    __device__ __forceinline__ bool next(int i, Unit& u) const {
        const int L = i * G + c; if (L >= nwg) return false;
        const int wgid = xcd_remap(L, nwg);
        const int per = 4 * nN, g = (wgid / (4 * per)) * 4 + (wgid & 3), rem = (wgid >> 2) % per;
        u.pm = rem & 3; u.pn = rem >> 2; u.aux = g; u.pad = 0;
        u.a_off = ((size_t)u.pm * BM * 40 * 1024 + (size_t)g * 16) * 2; u.b_off = (size_t)g * N * K * 2 + (size_t)u.pn * BM * K * 2; return true;
    }
    __device__ __forceinline__ unsigned voffA(int R, int C) const { return (unsigned)((R * 40 + (C >> 4)) * 1024 + (C & 15)) * 2u; }
    __device__ __forceinline__ size_t a_kstep() const { return 4 * 1024 * 2; }
    __device__ __forceinline__ size_t a_hstep() const { return (size_t)HALF * 40 * 1024 * 2; }
};

template <bool F16, class Epi, class Sched>
__device__ __forceinline__ void gemm_phase(LAS unsigned char* lds, const char* Ab, const char* Bb, const int K, const Sched& S, const Epi& E) {
    const int tid = threadIdx.x, wid = __builtin_amdgcn_readfirstlane(tid >> 6), lane = tid & 63, wr = wid >> 2, wc = wid & 3, fr = lane & 15, fq = lane >> 4;
    const int nt = K / BK;
    unsigned voffA[2], voffB[2];
#pragma unroll
    for (int i = 0; i < 2; ++i) { int R, C; stage_rc(tid * 16 + i * 8192, R, C); const int Rb = Epi::PERM ? ((R & ~31) + perm32(R & 31)) : R;
        voffA[i] = S.voffA(R, C); voffB[i] = (unsigned)(Rb * K + C) * 2u; }
    const size_t kstepA = S.a_kstep(), hstepA = S.a_hstep(), kstepB = (size_t)(BK * 2), hstepB = (size_t)HALF * K * 2;
    const unsigned ldsw = (unsigned)wid * 1024u;
    const int aoff = lds_byte(wr * 64 + fr, fq * 8), boff = lds_byte(wc * 32 + fr, fq * 8);
#define PG8_SA(b, h) (((b) * 2 + (h)) * HTB)
#define PG8_SB(b, h) ((4 + (b) * 2 + (h)) * HTB)
#define PG8_STAGE(bufoff, gbase, voff) do { _Pragma("unroll") for (int _i = 0; _i < 2; ++_i) \
        __builtin_amdgcn_global_load_lds((const unsigned*)((const char*)(gbase) + (voff)[_i]), (LAS unsigned*)(lds + (bufoff) + ldsw + _i * 8192), 16, 0, 0); } while (0)
#define PG8_LDA(dst, b, h) do { _Pragma("unroll") for (int m = 0; m < 4; ++m) _Pragma("unroll") for (int k = 0; k < 2; ++k) dst[m][k] = *(const LAS bf16x8*)(lds + PG8_SA(b, h) + aoff + m * 2048 + k * 1024); } while (0)
#define PG8_LDB(dst, b, h) do { _Pragma("unroll") for (int n = 0; n < 2; ++n) _Pragma("unroll") for (int k = 0; k < 2; ++k) dst[n][k] = *(const LAS bf16x8*)(lds + PG8_SB(b, h) + boff + n * 2048 + k * 1024); } while (0)
#define PG8_MMA(ai, bj, At, Bt) do { __builtin_amdgcn_s_setprio(1); _Pragma("unroll") for (int m = 0; m < 4; ++m) _Pragma("unroll") for (int n = 0; n < 2; ++n) _Pragma("unroll") for (int k = 0; k < 2; ++k) \
        acc[ai][bj][m][n] = F16 ? __builtin_amdgcn_mfma_f32_16x16x32_f16(__builtin_bit_cast(f16x8, Bt[n][k]), __builtin_bit_cast(f16x8, At[m][k]), acc[ai][bj][m][n], 0, 0, 0) : __builtin_amdgcn_mfma_f32_16x16x32_bf16(Bt[n][k], At[m][k], acc[ai][bj][m][n], 0, 0, 0); __builtin_amdgcn_s_setprio(0); } while (0)
#define PG8_WAIT_V(n) asm volatile("s_waitcnt vmcnt(" #n ")" ::: "memory")
#define PG8_WAIT_L(n) asm volatile("s_waitcnt lgkmcnt(" #n ")" ::: "memory")
#define PG8_BAR __builtin_amdgcn_s_barrier()
#define PG8_SCHED __builtin_amdgcn_sched_barrier(0)
    Unit cur, nxt; int ui = 0;
    if (!S.next(0, cur)) return;
    f32x4 acc[2][2][4][2];
#pragma unroll
    for (int a = 0; a < 2; ++a)
#pragma unroll
        for (int b = 0; b < 2; ++b)
#pragma unroll
            for (int m = 0; m < 4; ++m)
#pragma unroll
                for (int n = 0; n < 2; ++n) acc[a][b][m][n] = (f32x4){0.f, 0.f, 0.f, 0.f};
    bf16x8 At[4][2], B0[2][2], B1[2][2];
    const char* cA = Ab + cur.a_off; const char* cB = Bb + cur.b_off;
    PG8_STAGE(PG8_SB(0, 0), cB, voffB); PG8_STAGE(PG8_SA(0, 0), cA, voffA); PG8_STAGE(PG8_SB(0, 1), cB + hstepB, voffB); PG8_STAGE(PG8_SA(0, 1), cA + hstepA, voffA);
    if (wr == 1) PG8_BAR;
    PG8_WAIT_V(4); PG8_BAR;
    PG8_STAGE(PG8_SB(1, 0), cB + kstepB, voffB); PG8_STAGE(PG8_SA(1, 0), cA + kstepA, voffA); PG8_STAGE(PG8_SB(1, 1), cB + hstepB + kstepB, voffB);
    PG8_WAIT_V(6); PG8_BAR;
    for (;;) {
        const bool has_next = S.next(ui + 1, nxt);
        const char* nA = has_next ? Ab + nxt.a_off : cA; const char* nB = has_next ? Bb + nxt.b_off : cB;
        for (int t = 0; t < nt; t += 2) {
            const bool last = (t == nt - 2);
            const char* a1 = cA + (size_t)(t + 1) * kstepA;
            const char* a2 = last ? nA : cA + (size_t)(t + 2) * kstepA; const char* b2 = last ? nB : cB + (size_t)(t + 2) * kstepB;
            const char* a3 = a2 + kstepA; const char* b3 = b2 + kstepB;
            PG8_LDB(B0, 0, 0); PG8_SCHED; PG8_LDA(At, 0, 0); PG8_STAGE(PG8_SA(1, 1), a1 + hstepA, voffA);
            PG8_WAIT_L(8); PG8_BAR; PG8_WAIT_L(0); PG8_MMA(0, 0, At, B0); PG8_BAR; PG8_SCHED;
            PG8_LDB(B1, 0, 1); PG8_STAGE(PG8_SB(0, 0), b2, voffB);
            PG8_BAR; PG8_WAIT_L(0); PG8_MMA(0, 1, At, B1); PG8_BAR;
            PG8_LDA(At, 0, 1); PG8_STAGE(PG8_SA(0, 0), a2, voffA);
            PG8_BAR; PG8_WAIT_L(0); PG8_MMA(1, 0, At, B0); PG8_BAR; PG8_SCHED;
            PG8_STAGE(PG8_SB(0, 1), b2 + hstepB, voffB);
            PG8_WAIT_V(6); PG8_BAR; PG8_MMA(1, 1, At, B1); PG8_BAR;
            PG8_LDB(B0, 1, 0); PG8_SCHED; PG8_LDA(At, 1, 0); PG8_STAGE(PG8_SA(0, 1), a2 + hstepA, voffA);
            PG8_WAIT_L(8); PG8_BAR; PG8_WAIT_L(0); PG8_MMA(0, 0, At, B0); PG8_BAR; PG8_SCHED;
            PG8_LDB(B1, 1, 1); PG8_STAGE(PG8_SB(1, 0), b3, voffB);
            PG8_BAR; PG8_WAIT_L(0); PG8_MMA(0, 1, At, B1); PG8_BAR;
            PG8_LDA(At, 1, 1); PG8_STAGE(PG8_SA(1, 0), a3, voffA);
            PG8_BAR; PG8_WAIT_L(0); PG8_MMA(1, 0, At, B0); PG8_BAR; PG8_SCHED;
            PG8_STAGE(PG8_SB(1, 1), b3 + hstepB, voffB);
            PG8_WAIT_V(6); PG8_BAR; PG8_MMA(1, 1, At, B1); PG8_BAR;
        }
        E(acc, cur, wr, wc, fr, fq);
        if (!has_next) break;
#pragma unroll
        for (int a = 0; a < 2; ++a)
#pragma unroll
            for (int b = 0; b < 2; ++b)
#pragma unroll
                for (int m = 0; m < 4; ++m)
#pragma unroll
                    for (int n = 0; n < 2; ++n) acc[a][b][m][n] = (f32x4){0.f, 0.f, 0.f, 0.f};
        cur = nxt; cA = nA; cB = nB; ++ui;
    }
    PG8_WAIT_V(0);
    if (wr == 0) PG8_BAR;
    PG8_BAR;
#undef PG8_SA
#undef PG8_SB
#undef PG8_STAGE
#undef PG8_LDA
#undef PG8_LDB
#undef PG8_MMA
#undef PG8_WAIT_V
#undef PG8_WAIT_L
#undef PG8_BAR
#undef PG8_SCHED
}

typedef const f32x4 (&AccRef)[2][2][4][2];

struct EpiS1 {
    static constexpr bool PERM = false; float* sst;
    __device__ __forceinline__ void operator()(AccRef acc, const Unit& u, int wr, int wc, int fr, int fq) const {
#pragma unroll
        for (int ai = 0; ai < 2; ++ai)
#pragma unroll
            for (int m = 0; m < 4; ++m) { const int row = u.pm * BM + ai * HALF + wr * 64 + m * 16 + fr; float* rp = sst + ((size_t)row * 64 + u.aux) * 128 + wc * 32 + 4 * fq;
#pragma unroll
                for (int n = 0; n < 2; ++n) *(f32x4*)(rp + 16 * n) = acc[ai][0][m][n]; }
    }
};
struct EpiS2 {
    static constexpr bool PERM = true; const bf16_t* xa; const float* dsk; bf16_t* g16;
    __device__ __forceinline__ void operator()(AccRef acc, const Unit& u, int wr, int wc, int fr, int fq) const {
        const int ch = u.aux * 16 + 8 * (fq & 1);
        const f32x4 d0 = *(const f32x4*)(dsk + ch), d1 = *(const f32x4*)(dsk + ch + 4);
#pragma unroll
        for (int ai = 0; ai < 2; ++ai)
#pragma unroll
            for (int m = 0; m < 4; ++m) { const int row = u.pm * BM + ai * HALF + wr * 64 + m * 16 + fr;
#pragma unroll
                for (int bj = 0; bj < 2; ++bj) { const int t = 16 * u.pn + 8 * bj + 2 * wc + (fq >> 1);
                    const u32x4 xv = *(const u32x4*)(xa + ((size_t)row * 40 + t) * 1024 + ch);
                    const f32x4 x0 = {bf_lo(xv.x), bf_hi(xv.x), bf_lo(xv.y), bf_hi(xv.y)}, x1 = {bf_lo(xv.z), bf_hi(xv.z), bf_lo(xv.w), bf_hi(xv.w)};
                    const f32x4 y0 = acc[ai][bj][m][0] + d0 * x0, y1 = acc[ai][bj][m][1] + d1 * x1;
                    u32x4 w; w.x = pk_bf16(gelu_tanh(y0[0]), gelu_tanh(y0[1])); w.y = pk_bf16(gelu_tanh(y0[2]), gelu_tanh(y0[3]));
                    w.z = pk_bf16(gelu_tanh(y1[0]), gelu_tanh(y1[1])); w.w = pk_bf16(gelu_tanh(y1[2]), gelu_tanh(y1[3]));
                    *(u32x4*)(g16 + ((size_t)row * 32 + t) * 1024 + ch) = w; } }
    }
};
struct EpiGlu {
    static constexpr bool PERM = false; const float* x; float* out;
    __device__ __forceinline__ void operator()(AccRef acc, const Unit& u, int wr, int wc, int fr, int fq) const {
#pragma unroll
        for (int ai = 0; ai < 2; ++ai)
#pragma unroll
            for (int m = 0; m < 4; ++m) { const int row = u.pm * BM + ai * HALF + wr * 64 + m * 16 + fr; const size_t off = (size_t)row * 1024 + u.pn * 128 + wc * 32 + 4 * fq;
#pragma unroll
                for (int n = 0; n < 2; ++n) { const f32x4 xv = *(const f32x4*)(x + off + 16 * n); const f32x4 v = acc[ai][0][m][n], g = acc[ai][1][m][n]; f32x4 o;
#pragma unroll
                    for (int j = 0; j < 4; ++j) o[j] = ALPHA * xv[j] + v[j] * sigmoidf_(g[j]);
                    *(f32x4*)(out + off + 16 * n) = o; } }
    }
};
template <int ACT> struct EpiUp {
    static constexpr bool PERM = true; bf16_t* act; int ld;
    __device__ __forceinline__ void operator()(AccRef acc, const Unit& u, int wr, int wc, int fr, int fq) const {
#pragma unroll
        for (int ai = 0; ai < 2; ++ai)
#pragma unroll
            for (int m = 0; m < 4; ++m) { const int row = u.pm * BM + ai * HALF + wr * 64 + m * 16 + fr; float r[8];
#pragma unroll
                for (int n = 0; n < 2; ++n)
#pragma unroll
                    for (int j = 0; j < 4; ++j) { const float g = acc[ai][0][m][n][j], up = acc[ai][1][m][n][j]; r[4 * n + j] = (ACT == 0) ? g * sigmoidf_(g) * up : g * sigmoidf_(up); }
                u32x4 w; w.x = pk_bf16(r[0], r[1]); w.y = pk_bf16(r[2], r[3]); w.z = pk_bf16(r[4], r[5]); w.w = pk_bf16(r[6], r[7]);
                *(u32x4*)(act + (size_t)row * ld + u.pn * 128 + wc * 32 + 8 * fq) = w; }
    }
};
struct EpiRes {
    static constexpr bool PERM = false; const float* hin; float* h; bool skip;
    __device__ __forceinline__ void operator()(AccRef acc, const Unit& u, int wr, int wc, int fr, int fq) const {
        if (skip) return;
#pragma unroll
        for (int ai = 0; ai < 2; ++ai)
#pragma unroll
            for (int m = 0; m < 4; ++m) { const int row = u.pm * BM + ai * HALF + wr * 64 + m * 16 + fr; const size_t ro = (size_t)row * 1024 + u.pn * BM + wc * 32 + 4 * fq;
#pragma unroll
                for (int bj = 0; bj < 2; ++bj)
#pragma unroll
                    for (int n = 0; n < 2; ++n) { const size_t o = ro + bj * HALF + 16 * n; const f32x4 hv = *(const f32x4*)(hin + o); *(f32x4*)(h + o) = ALPHA * hv + acc[ai][bj][m][n]; } }
    }
};
struct EpiQkv {
    static constexpr bool PERM = true; bf16_t* q; bf16_t* k; bf16_t* v; const float* rc; const float* rs;
    __device__ __forceinline__ void operator()(AccRef acc, const Unit& u, int wr, int wc, int fr, int fq) const {
        const bool rope = (u.pn <= 4) && ((wc & 1) == 0);
        bf16_t* base; int ld, colt; float scale = 1.0f;
        if (u.pn < 4) { base = q; ld = 1024; colt = u.pn * BM; scale = 0.125f * 1.4426950408889634f; } else if (u.pn == 4) { base = k; ld = 256; colt = 0; } else { base = v; ld = 256; colt = 0; }
#pragma unroll
        for (int ai = 0; ai < 2; ++ai)
#pragma unroll
            for (int m = 0; m < 4; ++m) { const int row = u.pm * BM + ai * HALF + wr * 64 + m * 16 + fr;
                f32x4 c0 = {1.f, 1.f, 1.f, 1.f}, c1 = c0, s0 = {0.f, 0.f, 0.f, 0.f}, s1 = s0;
                if (rope && fq < 2) { c0 = *(const f32x4*)(rc + (size_t)row * 8); c1 = *(const f32x4*)(rc + (size_t)row * 8 + 4); s0 = *(const f32x4*)(rs + (size_t)row * 8); s1 = *(const f32x4*)(rs + (size_t)row * 8 + 4);
                    if (fq == 0) { s0 = -s0; s1 = -s1; } }
#pragma unroll
                for (int bj = 0; bj < 2; ++bj) { f32x4 v0 = acc[ai][bj][m][0], v1 = acc[ai][bj][m][1];
                    if (rope) { f32x4 p0, p1;
#pragma unroll
                        for (int j = 0; j < 4; ++j) { p0[j] = xor16(v0[j]); p1[j] = xor16(v1[j]); }
                        v0 = v0 * c0 + p0 * s0; v1 = v1 * c1 + p1 * s1; }
                    v0 = v0 * scale; v1 = v1 * scale;
                    u32x4 w; w.x = pk_bf16(v0[0], v0[1]); w.y = pk_bf16(v0[2], v0[3]); w.z = pk_bf16(v1[0], v1[1]); w.w = pk_bf16(v1[2], v1[3]);
                    *(u32x4*)(base + (size_t)row * ld + colt + bj * HALF + wc * 32 + 8 * fq) = w; } }
    }
};
struct EpiBf16 {
    static constexpr bool PERM = true; bf16_t* o; int ld;
    __device__ __forceinline__ void operator()(AccRef acc, const Unit& u, int wr, int wc, int fr, int fq) const {
#pragma unroll
        for (int ai = 0; ai < 2; ++ai)
#pragma unroll
            for (int m = 0; m < 4; ++m) { const int row = u.pm * BM + ai * HALF + wr * 64 + m * 16 + fr;
#pragma unroll
                for (int bj = 0; bj < 2; ++bj) { const f32x4 v0 = acc[ai][bj][m][0], v1 = acc[ai][bj][m][1];
                    u32x4 w; w.x = pk_bf16(v0[0], v0[1]); w.y = pk_bf16(v0[2], v0[3]); w.z = pk_bf16(v1[0], v1[1]); w.w = pk_bf16(v1[2], v1[3]);
                    *(u32x4*)(o + (size_t)row * ld + u.pn * BM + bj * HALF + wc * 32 + 8 * fq) = w; } }
    }
};
struct EpiNull {
    static constexpr bool PERM = false; float* h;
    __device__ __forceinline__ void operator()(AccRef acc, const Unit& u, int wr, int wc, int fr, int fq) const {
        if (u.pm < 0) {
#pragma unroll
            for (int ai = 0; ai < 2; ++ai)
#pragma unroll
                for (int m = 0; m < 4; ++m)
#pragma unroll
                    for (int bj = 0; bj < 2; ++bj)
#pragma unroll
                        for (int n = 0; n < 2; ++n) *(f32x4*)(h + ((ai * 4 + m) * 4 + bj * 2 + n) * 256 + fr * 16 + fq * 4) = acc[ai][bj][m][n]; }
    }
};
}

struct TJob { const float* s0; const float* s1; bf16_t* dst; int ld, k0, Kd, n0, f16; };
__device__ __forceinline__ void tjob_decode(const Params& P, int jt, TJob& j) {
    if (jt < 128) { const int pn = jt & 7, kt = jt >> 3;
        j.s0 = P.w_glu + 128 * pn; j.s1 = P.w_glu + 1024 + 128 * pn; j.ld = 2048; j.k0 = kt * 64; j.dst = (bf16_t*)(P.ws + WS_WGLU); j.Kd = 1024; j.n0 = 256 * pn; j.f16 = 0; }
    else if ((jt -= 128) < 352) { const int pn = jt % 22, kt = jt / 22;
        j.s0 = P.ffn_g + 128 * pn; j.s1 = P.ffn_u + 128 * pn; j.ld = 2816; j.k0 = kt * 64; j.dst = (bf16_t*)(P.ws + WS_WUP); j.Kd = 1024; j.n0 = 256 * pn; j.f16 = 1; }
    else if ((jt -= 352) < 176) { const int pn = jt & 3, kt = jt >> 2;
        j.s0 = P.ffn_d + 256 * pn; j.s1 = j.s0 + 128; j.ld = 1024; j.k0 = kt * 64; j.dst = (bf16_t*)(P.ws + WS_WDN); j.Kd = 2816; j.n0 = 256 * pn; j.f16 = 0; }
    else if ((jt -= 176) < 64) { const int pn = jt & 3, kt = jt >> 2;
        j.s0 = P.w_q + 256 * pn; j.s1 = j.s0 + 128; j.ld = 1024; j.k0 = kt * 64; j.dst = (bf16_t*)(P.ws + WS_WQKV); j.Kd = 1024; j.n0 = 256 * pn; j.f16 = 1; }
    else if ((jt -= 64) < 32) { const int pn = jt & 1, kt = jt >> 1;
        j.s0 = P.kv_w + 256 * pn; j.s1 = j.s0 + 128; j.ld = 512; j.k0 = kt * 64; j.dst = (bf16_t*)(P.ws + WS_WQKV); j.Kd = 1024; j.n0 = 1024 + 256 * pn; j.f16 = 1; }
    else if ((jt -= 32) < 64) { const int pn = jt & 3, kt = jt >> 2;
        j.s0 = P.w_out + 256 * pn; j.s1 = j.s0 + 128; j.ld = 1024; j.k0 = kt * 64; j.dst = (bf16_t*)(P.ws + WS_WO); j.Kd = 1024; j.n0 = 256 * pn; j.f16 = 0; }
    else if ((jt -= 64) < 1024) { const int e = jt & 7, r = jt >> 3, pn = r & 7, kt = r >> 3;
        j.s0 = P.moe_g + (size_t)e * 1048576 + 128 * pn; j.s1 = P.moe_u + (size_t)e * 1048576 + 128 * pn; j.ld = 1024; j.k0 = kt * 64; j.dst = (bf16_t*)(P.ws + WS_WMUP) + (size_t)e * 2048 * 1024; j.Kd = 1024; j.n0 = 256 * pn; j.f16 = 1; }
    else { jt -= 1024; const int e = jt & 7, r = jt >> 3, pn = r & 3, kt = r >> 2;
        j.s0 = P.moe_d + (size_t)e * 1048576 + 256 * pn; j.s1 = j.s0 + 128; j.ld = 1024; j.k0 = kt * 64; j.dst = (bf16_t*)(P.ws + WS_WMDN) + (size_t)e * 1048576; j.Kd = 1024; j.n0 = 256 * pn; j.f16 = 0; }
}
#define TJ_LOAD(J, V) do { const int nn_ = (tid & 63) * 4, kb_ = tid >> 6; const float* sp_ = (nn_ < 128) ? ((J).s0 + nn_) : ((J).s1 + (nn_ - 128)); \
    _Pragma("unroll") for (int i = 0; i < 8; ++i) (V)[i] = *(const f32x4*)(sp_ + (size_t)((J).k0 + kb_ + 8 * i) * (J).ld); } while (0)
__device__ void transposes_phase(const Params& P, float* tile) {
    constexpr int J_T = 2352;
    const int tid = threadIdx.x, G = gridDim.x;
    int jt = blockIdx.x; TJob cur, nxt; f32x4 v[8], vn[8];
    if (jt < J_T) { tjob_decode(P, jt, cur); TJ_LOAD(cur, v); }
    while (jt < J_T) {
        { const int nn = (tid & 63) * 4, kb = tid >> 6;
#pragma unroll
          for (int i = 0; i < 8; ++i) { float* t = tile + (kb + 8 * i) * 257 + nn; t[0] = v[i][0]; t[1] = v[i][1]; t[2] = v[i][2]; t[3] = v[i][3]; } }
        __syncthreads();
        const int jn = jt + G;
        if (jn < J_T) { tjob_decode(P, jn, nxt); TJ_LOAD(nxt, vn); }
        { const int ks = (tid & 7) * 8;
#pragma unroll
          for (int i = 0; i < 4; ++i) { const int n = (tid >> 3) + 64 * i; float r[8];
#pragma unroll
              for (int j = 0; j < 8; ++j) r[j] = tile[(ks + j) * 257 + n];
              u32x4 w; if (cur.f16) { w.x = pk_f16(r[0], r[1]); w.y = pk_f16(r[2], r[3]); w.z = pk_f16(r[4], r[5]); w.w = pk_f16(r[6], r[7]); } else { w.x = pk_bf16(r[0], r[1]); w.y = pk_bf16(r[2], r[3]); w.z = pk_bf16(r[4], r[5]); w.w = pk_bf16(r[6], r[7]); }
              *(u32x4*)(cur.dst + (size_t)(cur.n0 + n) * cur.Kd + cur.k0 + ks) = w; } }
        __syncthreads();
        cur = nxt; jt = jn;
#pragma unroll
        for (int i = 0; i < 8; ++i) v[i] = vn[i];
    }
}

__device__ void ssm_tables(const Params& P, int g, int qtr, unsigned char* lds) {
    const int tid = threadIdx.x;
    float* apr = (float*)lds;
    float* api = apr + 33 * 64;
    float* bbr = api + 33 * 64;
    float* bbi = bbr + 1024;
    float* ccr = bbi + 1024;
    float* cci = ccr + 1024;
    float* kg = cci + 1024;
    const float dtf = expf(P.log_step[g]);
    for (int idx = tid; idx < 33 * 64; idx += 512) { const int tau = idx >> 6, p = idx & 63;
        const float lr = P.lam_re[g * 64 + p], li = P.lam_im[g * 64 + p];
        const double dt = (double)dtf; double rev = (double)li * dt * (double)tau * 0.15915494309189535; rev -= floor(rev);
        const float ang = (float)(rev * 6.283185307179586); float sn, cs; sincosf(ang, &sn, &cs);
        const float mag = expf((float)((double)lr * dt * (double)tau));
        apr[idx] = mag * cs; api[idx] = mag * sn; }
    for (int idx = tid; idx < 1024; idx += 512) { ccr[idx] = P.c_re[g * 1024 + idx]; cci[idx] = P.c_im[g * 1024 + idx]; }
    __syncthreads();
    for (int idx = tid; idx < 1024; idx += 512) { const int p = idx >> 4;
        const float lr = P.lam_re[g * 64 + p], li = P.lam_im[g * 64 + p], ar = apr[64 + p], ai = api[64 + p];
        const float nr = ar - 1.0f, den = lr * lr + li * li, kr = (nr * lr + ai * li) / den, ki = (ai * lr - nr * li) / den;
        const float br = P.b_re[g * 1024 + idx], bi = P.b_im[g * 1024 + idx];
        bbr[idx] = kr * br - ki * bi; bbi[idx] = kr * bi + ki * br; }
    __syncthreads();
    { const int cp = tid & 15, c = 4 * qtr + ((tid >> 4) & 3), t0 = tid >> 6;
      for (int i = 0; i < 4; ++i) { const int tau = t0 + 8 * i; float s = 0.f;
          for (int p = 0; p < 64; ++p) { const float cr = ccr[c * 64 + p], ci = cci[c * 64 + p], ar = apr[tau * 64 + p], ai = api[tau * 64 + p];
              const float zr = cr * ar - ci * ai, zi = cr * ai + ci * ar; s += zr * bbr[p * 16 + cp] - zi * bbi[p * 16 + cp]; }
          kg[(tau * 16 + c) * 16 + cp] = s; } }
    __syncthreads();
    bf16_t* bt2 = (bf16_t*)(P.ws + WS_BT2) + (size_t)g * 512 * 640;
    for (int pc = tid; pc < 128 * 80; pc += 512) { const int nq = pc / 80, k8 = (pc % 80) * 8, t = nq >> 2, c = 4 * qtr + (nq & 3), n = t * 16 + c; float r[8];
        if (k8 < 512) { const int s = k8 >> 4, c0 = k8 & 15;
#pragma unroll
            for (int j = 0; j < 8; ++j) r[j] = (t >= s) ? kg[((t - s) * 16 + c) * 16 + c0 + j] : 0.f;
        } else { const int q0 = k8 - 512;
#pragma unroll
            for (int j = 0; j < 8; j += 2) { const int p = (q0 + j) >> 1; const float cr = ccr[c * 64 + p], ci = cci[c * 64 + p], ar = apr[(t + 1) * 64 + p], ai = api[(t + 1) * 64 + p];
                r[j] = cr * ar - ci * ai; r[j + 1] = -(cr * ai + ci * ar); } }
        u32x4 w; w.x = pk_bf16(r[0], r[1]); w.y = pk_bf16(r[2], r[3]); w.z = pk_bf16(r[4], r[5]); w.w = pk_bf16(r[6], r[7]);
        *(u32x4*)(bt2 + (size_t)n * 640 + k8) = w; }
    bf16_t* bt1 = (bf16_t*)(P.ws + WS_BT1) + (size_t)g * 256 * 512;
    for (int pc = tid; pc < 64 * 64; pc += 512) { const int q = 64 * qtr + (pc >> 6), k8 = (pc & 63) * 8; float r[8];
        if (q < 128) { const int p = q >> 1, s = k8 >> 4, c0 = k8 & 15; const float ar = apr[(31 - s) * 64 + p], ai = api[(31 - s) * 64 + p];
#pragma unroll
            for (int j = 0; j < 8; ++j) { const float br = bbr[p * 16 + c0 + j], bi = bbi[p * 16 + c0 + j]; r[j] = (q & 1) ? (ar * bi + ai * br) : (ar * br - ai * bi); }
        } else {
#pragma unroll
            for (int j = 0; j < 8; ++j) r[j] = 0.f; }
        u32x4 w; w.x = pk_bf16(r[0], r[1]); w.y = pk_bf16(r[2], r[3]); w.z = pk_bf16(r[4], r[5]); w.w = pk_bf16(r[6], r[7]);
        *(u32x4*)(bt1 + (size_t)q * 512 + k8) = w; }
    float* a32 = (float*)(P.ws + WS_A32);
    if (qtr == 0 && tid < 64) { a32[(g * 64 + tid) * 2] = apr[32 * 64 + tid]; a32[(g * 64 + tid) * 2 + 1] = api[32 * 64 + tid]; }
    __syncthreads();
}

__device__ void p0_prep(const Params& P, unsigned char* lds, const int mask) {
    const int tid = threadIdx.x, G = gridDim.x;
    if (blockIdx.x == 0 && tid < 8) ((int*)(P.ws + WS_CNT))[tid] = 0;
    constexpr int J_SSM = 256, J_X = 512, J_ROPE = 512;
    constexpr int NJ = J_SSM + J_X + J_ROPE;
    const bool tfirst = (blockIdx.x & 1) != 0;
    if (tfirst && (mask & 8)) { transposes_phase(P, (float*)lds); __syncthreads(); }
    for (int job = blockIdx.x; job < NJ; job += G) {
        if (job < J_SSM) {
#if LEVEL >= 1
            if (mask & 1) ssm_tables(P, job >> 2, job & 3, lds);
#endif
        }
        else if (job < J_SSM + J_X) { if (!(mask & 2)) continue;
            const int r0 = (job - J_SSM) * 64; bf16_t* xa = (bf16_t*)(P.ws + WS_XA);
#pragma unroll 4
            for (int i = 0; i < 16; ++i) { const int piece = tid + 512 * i, r = r0 + (piece >> 7), c8 = (piece & 127) * 8;
                const f32x4 a = *(const f32x4*)(P.x + (size_t)r * 1024 + c8), b = *(const f32x4*)(P.x + (size_t)r * 1024 + c8 + 4);
                u32x4 w; w.x = pk_bf16(a[0], a[1]); w.y = pk_bf16(a[2], a[3]); w.z = pk_bf16(b[0], b[1]); w.w = pk_bf16(b[2], b[3]);
                *(u32x4*)(xa + ((size_t)(r >> 5) * 40 + (r & 31)) * 1024 + c8) = w;
#if LEVEL < 1
                *(f32x4*)(P.out + (size_t)r * 1024 + c8) = a; *(f32x4*)(P.out + (size_t)r * 1024 + c8 + 4) = b;
#endif
            }
        }
        else if (job < J_SSM + J_X + J_ROPE) { if (!(mask & 4)) continue;
            const int tok = (job - J_SSM - J_X) * 64 + (tid >> 3), i = tid & 7;
            const float invf[8] = {1.0f, 0.19392274474868576f, 0.03760603093086393f, 0.007292664737217109f, 0.001414213562373095f, 0.0002742481756762073f, 5.318295896944988e-05f, 1.031338537721246e-05f};
            float f = invf[0];
#pragma unroll
            for (int k = 1; k < 8; ++k) f = (i == k) ? invf[k] : f;
            const float ang = (float)P.pos[tok] * f; float sn, cs; sincosf(ang, &sn, &cs);
            ((float*)(P.ws + WS_ROPEC))[tok * 8 + i] = cs; ((float*)(P.ws + WS_ROPES))[tok * 8 + i] = sn;
        }
    }
    if (!tfirst && (mask & 8)) { __syncthreads(); transposes_phase(P, (float*)lds); }
}

__device__ void scan_unit(const Params& P, int g, int pm) {
    const float* sst = (const float*)(P.ws + WS_SST); const float* a32 = (const float*)(P.ws + WS_A32); bf16_t* xa = (bf16_t*)(P.ws + WS_XA);
    const int tid = threadIdx.x;
    if (tid < 256) {
        const int p = tid & 63, b = pm * 4 + (tid >> 6), q = 2 * p;
        const float ar = a32[(g * 64 + p) * 2], ai = a32[(g * 64 + p) * 2 + 1];
        float hr = 0.f, hi = 0.f;
#pragma unroll 1
        for (int jb = 0; jb < 64; jb += 16) {
            float2 s[16];
#pragma unroll
            for (int j = 0; j < 16; ++j) s[j] = *(const float2*)(sst + ((size_t)(b * 64 + jb + j) * 64 + g) * 128 + q);
#pragma unroll
            for (int j = 0; j < 16; ++j) { const int row = b * 64 + jb + j;
                *(unsigned*)(xa + ((size_t)row * 40 + 32 + (q >> 4)) * 1024 + g * 16 + (q & 15)) = pk_bf16(hr, hi);
                const float nr = ar * hr - ai * hi + s[j].x, ni = ar * hi + ai * hr + s[j].y; hr = nr; hi = ni; }
        }
    }
}

template <int MODE, bool IN32>
__device__ void ln_phase(const Params& P, const float* h, const float* gam, const float* bet, unsigned char* lds, float* hout, bf16_t* h16, const bf16_t* d16) {
    const int tid = threadIdx.x, wid = tid >> 6, lane = tid & 63;
    float* wrt = (float*)lds;
    int* cnt = (int*)(P.ws + WS_CNT); int* lists = (int*)(P.ws + WS_LIST); int* toki = (int*)(P.ws + WS_TOK);
    const bf16_t* Y = (const bf16_t*)(P.ws + WS_Y);
    int base[8];
    int* lcnt = (int*)(lds + 32768);
    int* rinfo = (int*)(lds + 32768 + 64);
    if (MODE == 1) { for (int k = 0; k < 16; ++k) { const int idx = tid + 512 * k; wrt[(idx & 7) * 1024 + (idx >> 3)] = P.w_router[idx]; } if (tid < 8) lcnt[tid] = 0; __syncthreads(); }
    int kiter = 0;
    if (MODE == 2) { int acc = 0;
#pragma unroll
        for (int e = 0; e < 8; ++e) { base[e] = acc; acc += ((cnt[e] + 255) >> 8) << 8; } }
    f32x4 gv[4], bv[4];
#pragma unroll
    for (int i = 0; i < 4; ++i) { gv[i] = *(const f32x4*)(gam + 256 * i + lane * 4); bv[i] = *(const f32x4*)(bet + 256 * i + lane * 4); }
    f32x4 nf[4]; u32x2 nh[4], nd[4], na[4], nb2[4]; float nw1 = 0.f, nw2 = 0.f;
#pragma unroll
    for (int i = 0; i < 4; ++i) { nf[i] = (f32x4){0.f, 0.f, 0.f, 0.f}; nh[i] = (u32x2){0u, 0u}; nd[i] = nh[i]; na[i] = nh[i]; nb2[i] = nh[i]; }
#define LN_FETCH(R) do { const size_t ro_ = (size_t)(R) * 1024 + lane * 4; \
        if (IN32) { _Pragma("unroll") for (int i = 0; i < 4; ++i) nf[i] = *(const f32x4*)(h + ro_ + 256 * i); } \
        else { _Pragma("unroll") for (int i = 0; i < 4; ++i) nh[i] = *(const u32x2*)(h16 + ro_ + 256 * i); } \
        if (MODE != 2 && d16 != nullptr) { _Pragma("unroll") for (int i = 0; i < 4; ++i) nd[i] = *(const u32x2*)(d16 + ro_ + 256 * i); } \
        if (MODE == 2) { const int e1_ = toki[(R) * 8 + 0], p1_ = toki[(R) * 8 + 1], e2_ = toki[(R) * 8 + 2], p2_ = toki[(R) * 8 + 3]; \
            nw1 = __int_as_float(toki[(R) * 8 + 4]); nw2 = __int_as_float(toki[(R) * 8 + 5]); int b1_ = 0, b2_ = 0; \
            _Pragma("unroll") for (int e = 0; e < 8; ++e) { b1_ = (e1_ == e) ? base[e] : b1_; b2_ = (e2_ == e) ? base[e] : b2_; } \
            const bf16_t* y1_ = Y + (size_t)(b1_ + p1_) * 1024 + lane * 4; const bf16_t* y2_ = Y + (size_t)(b2_ + p2_) * 1024 + lane * 4; \
            _Pragma("unroll") for (int i = 0; i < 4; ++i) { na[i] = *(const u32x2*)(y1_ + 256 * i); nb2[i] = *(const u32x2*)(y2_ + 256 * i); } } } while (0)
    const int rstride = gridDim.x * 8;
    int row = blockIdx.x * 8 + wid;
    if (row < T_) LN_FETCH(row);
    for (; row < T_; row += rstride, ++kiter) {
        f32x4 v[4];
        if (IN32) {
#pragma unroll
            for (int i = 0; i < 4; ++i) v[i] = nf[i];
        } else {
#pragma unroll
            for (int i = 0; i < 4; ++i) v[i] = (f32x4){hf_lo(nh[i].x), hf_hi(nh[i].x), hf_lo(nh[i].y), hf_hi(nh[i].y)};
        }
        if (MODE != 2 && d16 != nullptr) {
#pragma unroll
            for (int i = 0; i < 4; ++i) { const u32x2 a = nd[i];
                v[i][0] = ALPHA * v[i][0] + bf_lo(a.x); v[i][1] = ALPHA * v[i][1] + bf_hi(a.x); v[i][2] = ALPHA * v[i][2] + bf_lo(a.y); v[i][3] = ALPHA * v[i][3] + bf_hi(a.y); }
        }
        if (MODE == 2) { const float w1 = nw1, w2 = nw2;
#pragma unroll
            for (int i = 0; i < 4; ++i) { const u32x2 a = na[i], b = nb2[i];
                v[i][0] = ALPHA * v[i][0] + (w1 * bf_lo(a.x) + w2 * bf_lo(b.x)); v[i][1] = ALPHA * v[i][1] + (w1 * bf_hi(a.x) + w2 * bf_hi(b.x));
                v[i][2] = ALPHA * v[i][2] + (w1 * bf_lo(a.y) + w2 * bf_lo(b.y)); v[i][3] = ALPHA * v[i][3] + (w1 * bf_hi(a.y) + w2 * bf_hi(b.y)); }
        }
        { const int nrow = row + rstride; if (nrow < T_) LN_FETCH(nrow); }
        float s = 0.f;
#pragma unroll
        for (int i = 0; i < 4; ++i) s += (v[i][0] + v[i][1]) + (v[i][2] + v[i][3]);
        const float mu = wave_sum(s) * (1.0f / 1024.0f);
        float q = 0.f;
#pragma unroll
        for (int i = 0; i < 4; ++i) { v[i] = v[i] - mu; q += (v[i][0] * v[i][0] + v[i][1] * v[i][1]) + (v[i][2] * v[i][2] + v[i][3] * v[i][3]); }
        const float rstd = rsqrtf(wave_sum(q) * (1.0f / 1024.0f) + LN_EPS);
#pragma unroll
        for (int i = 0; i < 4; ++i) { v[i] = v[i] * rstd * gv[i] + bv[i]; if (MODE == 2) *(f32x4*)(hout + (size_t)row * 1024 + 256 * i + lane * 4) = v[i];
            if (MODE != 2) { u32x2 w; w.x = pk_f16(v[i][0], v[i][1]); w.y = pk_f16(v[i][2], v[i][3]); *(u32x2*)(h16 + (size_t)row * 1024 + 256 * i + lane * 4) = w; } }
        if (MODE == 1) {
            float lg[8];
#pragma unroll
            for (int e = 0; e < 8; ++e) { float a = 0.f;
#pragma unroll
                for (int i = 0; i < 4; ++i) { const f32x4 w = *(const f32x4*)(wrt + e * 1024 + 256 * i + lane * 4); a += (v[i][0] * w[0] + v[i][1] * w[1]) + (v[i][2] * w[2] + v[i][3] * w[3]); }
                lg[e] = wave_sum(a) + P.b_router[e]; }
            int e1 = 0; float v1 = lg[0];
#pragma unroll
            for (int e = 1; e < 8; ++e) if (lg[e] > v1) { v1 = lg[e]; e1 = e; }
            int e2 = -1; float v2 = -3.0e38f;
#pragma unroll
            for (int e = 0; e < 8; ++e) if (e != e1 && lg[e] > v2) { v2 = lg[e]; e2 = e; }
            const float ex = __expf(v2 - v1), w1 = 1.0f / (1.0f + ex), w2 = ex / (1.0f + ex);
            if (lane == 0) { const int p1 = atomicAdd(lcnt + e1, 1), p2 = atomicAdd(lcnt + e2, 1); int* ri = rinfo + (kiter * 8 + wid) * 6;
                ri[0] = e1; ri[1] = p1; ri[2] = e2; ri[3] = p2; ri[4] = __float_as_int(w1); ri[5] = __float_as_int(w2); }
        }
    }
    if (MODE == 1) {
        __syncthreads();
        if (tid < 8) lcnt[8 + tid] = atomicAdd(cnt + tid, lcnt[tid]);
        __syncthreads();
        for (int lr = tid; lr < 512; lr += 512) { const int row = blockIdx.x * 8 + (lr & 7) + (lr >> 3) * gridDim.x * 8;
            if (row < T_) { const int* ri = rinfo + lr * 6; const int e1 = ri[0], e2 = ri[2], p1 = lcnt[8 + e1] + ri[1], p2 = lcnt[8 + e2] + ri[3];
                lists[e1 * T_ + p1] = row; lists[e2 * T_ + p2] = row;
                toki[row * 8 + 0] = e1; toki[row * 8 + 1] = p1; toki[row * 8 + 2] = e2; toki[row * 8 + 3] = p2; toki[row * 8 + 4] = ri[4]; toki[row * 8 + 5] = ri[5]; } }
    }
}

__device__ void gather_phase(const Params& P) {
    const int tid = threadIdx.x, wid = tid >> 6, lane = tid & 63;
    const int* cnt = (const int*)(P.ws + WS_CNT); const int* lists = (const int*)(P.ws + WS_LIST);
    const bf16_t* h16 = (const bf16_t*)(P.ws + WS_H16); bf16_t* ga = (bf16_t*)(P.ws + WS_GA);
    int base[9], c[8]; base[0] = 0;
#pragma unroll
    for (int e = 0; e < 8; ++e) { c[e] = cnt[e]; base[e + 1] = base[e] + (((c[e] + 255) >> 8) << 8); }
    for (int r = blockIdx.x * 8 + wid; r < base[8]; r += gridDim.x * 8) {
        int e = 0;
#pragma unroll
        for (int k = 1; k < 8; ++k) e += (r >= base[k]) ? 1 : 0;
        int be = 0, ce = 0;
#pragma unroll
        for (int k = 0; k < 8; ++k) { be = (e == k) ? base[k] : be; ce = (e == k) ? c[k] : ce; }
        const int pos = r - be; u32x4 a = {0u, 0u, 0u, 0u}, b = a;
        if (pos < ce) { const int tok = lists[e * T_ + pos]; a = *(const u32x4*)(h16 + (size_t)tok * 1024 + lane * 8); b = *(const u32x4*)(h16 + (size_t)tok * 1024 + 512 + lane * 8); }
        *(u32x4*)(ga + (size_t)r * 1024 + lane * 8) = a; *(u32x4*)(ga + (size_t)r * 1024 + 512 + lane * 8) = b;
    }
}

__device__ void attn_phase(const Params& P, unsigned char* lds) {
    const int tid = threadIdx.x, wid = tid >> 6, lane = tid & 63, n = lane & 31, hh = lane >> 5;
    bf16_t* Ks = (bf16_t*)lds;
    bf16_t* Vt = (bf16_t*)(lds + 256 * 144);
    const bf16_t* QB = (const bf16_t*)(P.ws + WS_BIG); const bf16_t* KB = (const bf16_t*)(P.ws + WS_BIG + 64 * MiB); const bf16_t* VB = (const bf16_t*)(P.ws + WS_BIG + 80 * MiB);
    bf16_t* OB = (bf16_t*)(P.ws + WS_BIG + 96 * MiB);
#ifdef DUP_ATT
    constexpr int NITEM = 2048;
#else
    constexpr int NITEM = 1024;
#endif
    u32x4 kreg[4], vreg0[2], vreg1[2];
#define ATT_LOAD(it) do { const int kvh_ = (it) & 3, nb_ = ((it) >> 2) & 15, b_ = ((it) >> 6) & 15, tok_ = b_ * 2048 + nb_ * 128; \
        _Pragma("unroll") for (int i = 0; i < 4; ++i) { const int piece = tid + 512 * i, s = piece >> 3, pc = piece & 7; kreg[i] = (u32x4){0u, 0u, 0u, 0u}; \
            if (nb_ > 0 || s >= 128) kreg[i] = *(const u32x4*)(KB + (size_t)(tok_ - 128 + s) * 256 + kvh_ * 64 + pc * 8); } \
        _Pragma("unroll") for (int i = 0; i < 2; ++i) { const int s = 2 * (tid & 127), pc = (tid >> 7) + 4 * i; vreg0[i] = (u32x4){0u, 0u, 0u, 0u}; vreg1[i] = vreg0[i]; \
            if (nb_ > 0 || s >= 128) { vreg0[i] = *(const u32x4*)(VB + (size_t)(tok_ - 128 + s) * 256 + kvh_ * 64 + pc * 8); vreg1[i] = *(const u32x4*)(VB + (size_t)(tok_ - 127 + s) * 256 + kvh_ * 64 + pc * 8); } } } while (0)
    if ((int)blockIdx.x < NITEM) ATT_LOAD((int)blockIdx.x);
    for (int item = blockIdx.x; item < NITEM; item += gridDim.x) {
        const int kvh = item & 3, nb = (item >> 2) & 15, b = (item >> 6) & 15;
        const int tok0 = b * 2048 + nb * 128;
        __syncthreads();
#pragma unroll
        for (int i = 0; i < 4; ++i) { const int piece = tid + 512 * i, s = piece >> 3, pc = piece & 7; *(u32x4*)(Ks + s * 72 + pc * 8) = kreg[i]; }
#pragma unroll
        for (int i = 0; i < 2; ++i) { const int s = 2 * (tid & 127), pc = (tid >> 7) + 4 * i; const u32x4 v0 = vreg0[i], v1 = vreg1[i];
            unsigned* vt = (unsigned*)(Vt + (pc * 8) * 264 + s);
            vt[0 * 132] = (v0.x & 0xffffu) | (v1.x << 16); vt[1 * 132] = (v0.x >> 16) | (v1.x & 0xffff0000u);
            vt[2 * 132] = (v0.y & 0xffffu) | (v1.y << 16); vt[3 * 132] = (v0.y >> 16) | (v1.y & 0xffff0000u);
            vt[4 * 132] = (v0.z & 0xffffu) | (v1.z << 16); vt[5 * 132] = (v0.z >> 16) | (v1.z & 0xffff0000u);
            vt[6 * 132] = (v0.w & 0xffffu) | (v1.w << 16); vt[7 * 132] = (v0.w >> 16) | (v1.w & 0xffff0000u); }
        __syncthreads();
        if (item + (int)gridDim.x < NITEM) ATT_LOAD(item + (int)gridDim.x);
        const int hq = kvh * 4 + (wid >> 1);
        const float sink = P.sinks[hq] * 1.4426950408889634f;
#pragma unroll 1
        for (int qq = 0; qq < 2; ++qq) {
            const int kb0 = (wid & 1) * 2 + qq, i0 = 32 * kb0, qi = i0 + n;
            const bf16_t* qp = QB + (size_t)(tok0 + qi) * 1024 + hq * 64 + 8 * hh;
            bf16x8 qf[4];
#pragma unroll
            for (int ks = 0; ks < 4; ++ks) qf[ks] = *(const bf16x8*)(qp + 16 * ks);
            f32x16 sacc[5];
#pragma unroll
            for (int kb = 0; kb < 5; ++kb) {
#pragma unroll
                for (int i = 0; i < 16; ++i) sacc[kb][i] = 0.f;
                const bf16_t* kp = Ks + (32 * (kb0 + kb) + n) * 72 + 8 * hh;
#pragma unroll
                for (int ks = 0; ks < 4; ++ks) { const bf16x8 a = *(const bf16x8*)(kp + 16 * ks); sacc[kb] = __builtin_amdgcn_mfma_f32_32x32x16_bf16(a, qf[ks], sacc[kb], 0, 0, 0); }
                asm volatile("" ::: "memory"); }
            const int nn4 = n - 4 * hh;
#pragma unroll
            for (int i = 0; i < 16; ++i) { const int r = 8 * (i >> 2) + (i & 3);
                sacc[0][i] = (r > nn4) ? sacc[0][i] : -1.0e30f; sacc[4][i] = (r <= nn4) ? sacc[4][i] : -1.0e30f; }
            if (nb == 0) {
#pragma unroll
                for (int kb = 0; kb < 4; ++kb) if (kb0 + kb < 4) {
#pragma unroll
                    for (int i = 0; i < 16; ++i) sacc[kb][i] = -1.0e30f; } }
            float mx = sink;
#pragma unroll
            for (int kb = 0; kb < 5; ++kb)
#pragma unroll
                for (int i = 0; i < 16; ++i) mx = fmaxf(mx, sacc[kb][i]);
            mx = fmaxf(mx, __shfl_xor(mx, 32));
            float sum = 0.f;
#pragma unroll
            for (int kb = 0; kb < 5; ++kb)
#pragma unroll
                for (int i = 0; i < 16; ++i) { const float p = __builtin_amdgcn_exp2f(sacc[kb][i] - mx); sacc[kb][i] = p; sum += p; }
            sum += __shfl_xor(sum, 32); sum += __builtin_amdgcn_exp2f(sink - mx);
            f32x16 oacc[2];
#pragma unroll
            for (int i = 0; i < 16; ++i) { oacc[0][i] = 0.f; oacc[1][i] = 0.f; }
#pragma unroll
            for (int kb = 0; kb < 5; ++kb)
#pragma unroll
                for (int sl = 0; sl < 2; ++sl) {
                    union { u32x4 u; bf16x8 v; } pb;
                    pb.u.x = pk_bf16(sacc[kb][8 * sl + 0], sacc[kb][8 * sl + 1]); pb.u.y = pk_bf16(sacc[kb][8 * sl + 2], sacc[kb][8 * sl + 3]);
                    pb.u.z = pk_bf16(sacc[kb][8 * sl + 4], sacc[kb][8 * sl + 5]); pb.u.w = pk_bf16(sacc[kb][8 * sl + 6], sacc[kb][8 * sl + 7]);
#pragma unroll
                    for (int mb = 0; mb < 2; ++mb) { const bf16_t* vp = Vt + (32 * mb + n) * 264 + 32 * (kb0 + kb) + 16 * sl + 4 * hh;
                        union { u32x4 u; bf16x8 v; } va; const u32x2 lo = *(const u32x2*)vp, hi = *(const u32x2*)(vp + 8); va.u.x = lo.x; va.u.y = lo.y; va.u.z = hi.x; va.u.w = hi.y;
                        oacc[mb] = __builtin_amdgcn_mfma_f32_32x32x16_bf16(va.v, pb.v, oacc[mb], 0, 0, 0); }
                    asm volatile("" ::: "memory"); }
            const float inv = 1.0f / sum;
            bf16_t* op = OB + (size_t)(tok0 + qi) * 1024 + hq * 64 + 4 * hh;
#pragma unroll
            for (int mb = 0; mb < 2; ++mb)
#pragma unroll
                for (int g4 = 0; g4 < 4; ++g4) { u32x2 w; w.x = pk_bf16(oacc[mb][4 * g4 + 0] * inv, oacc[mb][4 * g4 + 1] * inv); w.y = pk_bf16(oacc[mb][4 * g4 + 2] * inv, oacc[mb][4 * g4 + 3] * inv);
                    *(u32x2*)(op + 32 * mb + 8 * g4) = w; }
        }
    }
}

#if defined(__HIP_DEVICE_COMPILE__)
typedef const Params __attribute__((address_space(4)))* KParams;
__device__ __forceinline__ Params load_params() { KParams p = (KParams)__builtin_amdgcn_kernarg_segment_ptr(); asm volatile("" : "+s"(p)); return *p; }
#else
__device__ __forceinline__ Params load_params() { return Params{}; }
#endif
#define LP const Params P = load_params(); unsigned char* const ws = P.ws; float* const H = P.out; (void)ws; (void)H
__global__ void __launch_bounds__(512, 2) yoco_fwd(Params P_arg) {
    extern __shared__ __attribute__((aligned(16))) unsigned char lds[];
    cg::grid_group grid = cg::this_grid();
    LAS unsigned char* ldsl = (LAS unsigned char*)lds;
    const int G = gridDim.x, c = blockIdx.x;
    if (threadIdx.x == 0) { ((LAS unsigned*)(ldsl + 131072))[0] = 0u; ((LAS unsigned*)(ldsl + 131072))[1] = 0u; }
    __syncthreads();
#define GSYNC() do { LP; xcd_barrier((unsigned*)(ws + WS_BAR), (volatile LAS unsigned*)(ldsl + 131072)); } while (0)

#ifdef PROF_A_HI
#define STAMP(k) do { LP; if (((k) == PROF_A_LO || (k) == PROF_A_HI || (k) == PROF_B_LO || (k) == PROF_B_HI) && blockIdx.x == 0 && threadIdx.x == 0) ((unsigned long long*)(P.ws + WS_CNT + 1024))[k] = __builtin_amdgcn_s_memrealtime(); } while (0)
#else
#define STAMP(k) do { } while (0)
#endif
#ifdef DUP_ALL
#pragma unroll 1
    for (int pass = 0; pass < 2; ++pass) {
#else
    { const int pass = 0;
#endif
    STAMP(0);
    if (pass != 0) GSYNC();
    { LP; p0_prep(P, lds, (P.skip & 1) ? 0 : (15 & ~(P.skip >> 16))); if (pass == 0 && blockIdx.x == 0) for (int i = threadIdx.x; i < XCD_BAR_WORDS; i += 512) ((unsigned*)(ws + WS_BAR))[i] = 0u; }
    if (pass == 0) { grid.sync();
        { LP; if (threadIdx.x == 0) (void)xb_add(&((unsigned*)(ws + WS_BAR))[XB_XCNT(xb_xcc_id())], 1u); } }
    else GSYNC();
#ifdef DUP_SYNC
#pragma unroll 1
    for (int r = 0; r < 16; ++r) GSYNC();
#endif
#ifdef DUP_P0
    { LP; p0_prep(P, lds, DUP_P0); }
    GSYNC();
#endif
    STAMP(1);
#if LEVEL >= 1
#pragma unroll 1
    for (int rep = 0; rep < NREP_S1; ++rep) {
    {   LP; if (!((P.skip >> 1) & 1)) {
        pg8::SchedSsm S; S.init(256, 512, G, c); pg8::EpiS1 E{(float*)(ws + WS_SST)};
        pg8::gemm_phase<false>(ldsl, (const char*)(ws + WS_XA), (const char*)(ws + WS_BT1), 512, S, E);
        asm volatile("s_waitcnt vmcnt(0)" ::: "memory"); __syncthreads();
        pg8::Unit u; for (int i = 0; S.next(i, u); ++i) scan_unit(P, u.aux, u.pm); } }
    GSYNC(); } STAMP(2);
#pragma unroll 1
    for (int rep = 0; rep < NREP_S2; ++rep) {
    {   LP; if (!((P.skip >> 2) & 1)) {
        pg8::SchedSsm S; S.init(512, 640, G, c); pg8::EpiS2 E{(const bf16_t*)(ws + WS_XA), P.ssm_d, (bf16_t*)(ws + WS_BIG)};
        pg8::gemm_phase<false>(ldsl, (const char*)(ws + WS_XA), (const char*)(ws + WS_BT2), 640, S, E); } }
    GSYNC(); } STAMP(4);
#pragma unroll 1
    for (int rep = 0; rep < NREP_GLU; ++rep) {
    {   LP; if (!((P.skip >> 3) & 1)) {
        pg8::SchedDense S; S.init(T_, 2048, 1024, 1024, G, c); pg8::EpiUp<1> E{(bf16_t*)(ws + WS_GA), 1024};
        pg8::gemm_phase<false>(ldsl, (const char*)(ws + WS_BIG), (const char*)(ws + WS_WGLU), 1024, S, E); } }
    GSYNC(); } STAMP(5);
#endif
    { LP; if (!((P.skip >> 4) & 1)) ln_phase<0, true>(P, (LEVEL >= 1) ? P.x : H, P.ln_g, P.ln_b, lds, H, (bf16_t*)(ws + WS_H16), (LEVEL >= 1) ? (const bf16_t*)(ws + WS_GA) : nullptr); }
    GSYNC(); STAMP(6);
#if LEVEL >= 2
#pragma unroll 1
    for (int rep = 0; rep < NREP_FUP; ++rep) {
    {   LP; if (!((P.skip >> 5) & 1)) {
        pg8::SchedDense S; S.init(T_, 2 * FF_, 1024, 1024, G, c); pg8::EpiUp<0> E{(bf16_t*)(ws + WS_BIG), FF_};
        pg8::gemm_phase<true>(ldsl, (const char*)(ws + WS_H16), (const char*)(ws + WS_WUP), 1024, S, E); } }
    GSYNC(); } STAMP(7);
#pragma unroll 1
    for (int rep = 0; rep < NREP_FDN; ++rep) {
    {   LP; if (!((P.skip >> 6) & 1)) {
#define NREP_CUR NREP_FDN
        pg8::SchedDense S; S.init(T_, 1024, FF_, FF_, G, c); pg8::EpiBf16 E{(bf16_t*)(ws + WS_GA), 1024};
        pg8::gemm_phase<false>(ldsl, (const char*)(ws + WS_BIG), (const char*)(ws + WS_WDN), FF_, S, E); } }
    GSYNC(); } STAMP(8);
#endif
    { LP; if (!((P.skip >> 7) & 1)) ln_phase<0, false>(P, H, P.ln_g + 1024, P.ln_b + 1024, lds, H, (bf16_t*)(ws + WS_H16), (LEVEL >= 2) ? (const bf16_t*)(ws + WS_GA) : nullptr); }
    GSYNC(); STAMP(9);
#if LEVEL >= 3
#pragma unroll 1
    for (int rep = 0; rep < NREP_QKV; ++rep) {
    {   LP; if (!((P.skip >> 8) & 1)) {
        pg8::SchedDense S; S.init(T_, 1536, 1024, 1024, G, c);
        pg8::EpiQkv E{(bf16_t*)(ws + WS_BIG), (bf16_t*)(ws + WS_BIG + 64 * MiB), (bf16_t*)(ws + WS_BIG + 80 * MiB), (const float*)(ws + WS_ROPEC), (const float*)(ws + WS_ROPES)};
        pg8::gemm_phase<true>(ldsl, (const char*)(ws + WS_H16), (const char*)(ws + WS_WQKV), 1024, S, E); } }
    GSYNC(); } STAMP(10);
#ifndef SKIP_ATT
    { LP; if (!((P.skip >> 9) & 1)) attn_phase(P, lds); }
#endif
    GSYNC(); STAMP(11);
#pragma unroll 1
    for (int rep = 0; rep < NREP_OUT; ++rep) {
    {   LP; if (!((P.skip >> 10) & 1)) {
#undef NREP_CUR
#define NREP_CUR NREP_OUT
        pg8::SchedDense S; S.init(T_, 1024, 1024, 1024, G, c);
        pg8::EpiBf16 E{(bf16_t*)(ws + WS_GA), 1024};
        pg8::gemm_phase<false>(ldsl, (const char*)(ws + WS_BIG + 96 * MiB), (const char*)(ws + WS_WO), 1024, S, E); } }
    GSYNC(); } STAMP(12);
#endif
#if LEVEL >= 4
    { LP; if (!((P.skip >> 11) & 1)) ln_phase<1, false>(P, H, P.ln_g + 2048, P.ln_b + 2048, lds, H, (bf16_t*)(ws + WS_H16), (const bf16_t*)(ws + WS_GA)); }
    GSYNC(); STAMP(13);
#pragma unroll 1
    for (int rep = 0; rep < NREP_GATH; ++rep) {
    { LP; if (!((P.skip >> 12) & 1)) gather_phase(P); }
    GSYNC(); } STAMP(14);
#pragma unroll 1
    for (int rep = 0; rep < NREP_MUP; ++rep) {
    {   LP; if (!((P.skip >> 13) & 1)) {
        pg8::SchedMoe S; S.init((const int*)(ws + WS_CNT), 2048, 1024, (size_t)2048 * 1024 * 2, G, c); pg8::EpiUp<0> E{(bf16_t*)(ws + WS_BIG), 1024};
        pg8::gemm_phase<true>(ldsl, (const char*)(ws + WS_GA), (const char*)(ws + WS_WMUP), 1024, S, E); } }
    GSYNC(); } STAMP(15);
#pragma unroll 1
    for (int rep = 0; rep < NREP_MDN; ++rep) {
    {   LP; if (!((P.skip >> 14) & 1)) {
        pg8::SchedMoe S; S.init((const int*)(ws + WS_CNT), 1024, 1024, (size_t)1024 * 1024 * 2, G, c); pg8::EpiBf16 E{(bf16_t*)(ws + WS_Y), 1024};
        pg8::gemm_phase<false>(ldsl, (const char*)(ws + WS_BIG), (const char*)(ws + WS_WMDN), 1024, S, E); } }
    GSYNC(); } STAMP(16);
    { LP; if (!((P.skip >> 15) & 1)) ln_phase<2, false>(P, H, P.ln_g + 3072, P.ln_b + 3072, lds, H, (bf16_t*)(ws + WS_H16), nullptr); }
#ifdef PROF_A_HI
    GSYNC(); STAMP(17);
    {   LP; const unsigned long long* stamps = (const unsigned long long*)(P.ws + WS_CNT + 1024);
        const float tA = (float)(stamps[PROF_A_HI] - stamps[PROF_A_LO]) * 0.01f, tB = (float)(stamps[PROF_B_HI] - stamps[PROF_B_LO]) * 0.01f;
        for (int i = blockIdx.x * 512 + threadIdx.x; i < (1 << 22); i += gridDim.x * 512) H[(size_t)i * 8 + 1] = tB;
        if (blockIdx.x == 0 && threadIdx.x == 0) H[0] = 64.0f * tA; }
#endif
#ifdef PROF_A_HI
#endif
    }
#else
    { LP; ln_phase<0, false>(P, H, P.ln_g + 2048, P.ln_b + 2048, lds, H, (bf16_t*)(ws + WS_H16), (LEVEL >= 3) ? (const bf16_t*)(ws + WS_GA) : nullptr); }
    GSYNC(); STAMP(13);
    { LP; ln_phase<0, false>(P, H, P.ln_g + 3072, P.ln_b + 3072, lds, H, (bf16_t*)(ws + WS_H16), nullptr); }
#endif
}

extern "C" void kernel_launch(void* const* d_in, const int* in_sizes, int n_in, void* d_out, int out_size, void* d_ws, size_t ws_size, hipStream_t stream) {
    static int grid_blocks = 0;
    if (grid_blocks == 0) {
        if (n_in != 25 || out_size != T_ * D_ || ws_size < WS_END) { fprintf(stderr, "kernel_launch: unexpected shapes (n_in %d out %d ws %zu)\n", n_in, out_size, ws_size); grid_blocks = -1; return; }
        int dev = 0, cus = 0, per_cu = 0;
        hipGetDevice(&dev); hipDeviceGetAttribute(&cus, hipDeviceAttributeMultiprocessorCount, dev);
        if (hipFuncSetAttribute((const void*)yoco_fwd, hipFuncAttributeMaxDynamicSharedMemorySize, LDS_BYTES) != hipSuccess) { fprintf(stderr, "kernel_launch: hipFuncSetAttribute failed\n"); grid_blocks = -1; return; }
        if (hipOccupancyMaxActiveBlocksPerMultiprocessor(&per_cu, (const void*)yoco_fwd, 512, LDS_BYTES) != hipSuccess || per_cu < 1) { fprintf(stderr, "kernel_launch: occupancy query says %d\n", per_cu); per_cu = 1; (void)hipGetLastError(); }
        grid_blocks = cus * 1;
    }
    if (grid_blocks < 0) return;
    Params p{};
    p.x = (const float*)d_in[0]; p.pos = (const int*)d_in[1]; p.ln_g = (const float*)d_in[2]; p.ln_b = (const float*)d_in[3];
    p.lam_re = (const float*)d_in[4]; p.lam_im = (const float*)d_in[5]; p.log_step = (const float*)d_in[6]; p.b_re = (const float*)d_in[7]; p.b_im = (const float*)d_in[8];
    p.c_re = (const float*)d_in[9]; p.c_im = (const float*)d_in[10]; p.ssm_d = (const float*)d_in[11]; p.w_glu = (const float*)d_in[12]; p.kv_w = (const float*)d_in[13];
    p.w_q = (const float*)d_in[14]; p.sinks = (const float*)d_in[15]; p.w_out = (const float*)d_in[16]; p.ffn_g = (const float*)d_in[17]; p.ffn_u = (const float*)d_in[18]; p.ffn_d = (const float*)d_in[19];
    p.w_router = (const float*)d_in[20]; p.b_router = (const float*)d_in[21]; p.moe_g = (const float*)d_in[22]; p.moe_u = (const float*)d_in[23]; p.moe_d = (const float*)d_in[24];
    p.out = (float*)d_out; p.ws = (unsigned char*)d_ws;
    void* args[] = {&p};
#ifdef SKIP_PROBE
    p.skip = SKIP_PROBE; (void)hipLaunchCooperativeKernel((const void*)yoco_fwd, dim3(grid_blocks), dim3(512), args, LDS_BYTES, stream); p.skip = 0;
#endif
    hipError_t e = hipLaunchCooperativeKernel((const void*)yoco_fwd, dim3(grid_blocks), dim3(512), args, LDS_BYTES, stream);
    if (e != hipSuccess) fprintf(stderr, "cooperative launch failed: %s (grid %d)\n", hipGetErrorString(e), grid_blocks);
}
```

```cpp
#include <hip/hip_runtime.h>
#include <hip/hip_cooperative_groups.h>
#include <cstdio>
namespace cg = cooperative_groups;

#ifndef LEVEL
#define LEVEL 4
#endif

#ifdef DUP_S1
#define NREP_S1 2
#else
#define NREP_S1 1
#endif
#ifdef DUP_S2
#define NREP_S2 2
#else
#define NREP_S2 1
#endif
#ifdef DUP_GLU
#define NREP_GLU 2
#else
#define NREP_GLU 1
#endif
#ifdef DUP_FUP
#define NREP_FUP 2
#else
#define NREP_FUP 1
#endif
#if defined(DUP_FDN) || defined(DUP_FDNNULL)
#define NREP_FDN 2
#else
#define NREP_FDN 1
#endif
#ifdef DUP_QKV
#define NREP_QKV 2
#else
#define NREP_QKV 1
#endif
#if defined(DUP_OUT) || defined(DUP_OUTNULL)
#define NREP_OUT 2
#else
#define NREP_OUT 1
#endif
#ifdef DUP_MUP
#define NREP_MUP 2
#else
#define NREP_MUP 1
#endif
#ifdef DUP_MDN
#define NREP_MDN 2
#else
#define NREP_MDN 1
#endif
#ifdef DUP_SCAN
#define NREP_SCAN 2
#else
#define NREP_SCAN 1
#endif
#ifdef DUP_GATH
#define NREP_GATH 2
#else
#define NREP_GATH 1
#endif
#ifdef DUP_OUTNULL
#define SKIP_EPI_OUT (rep == 0)
#else
#define SKIP_EPI_OUT false
#endif
#ifdef DUP_FDNNULL
#define SKIP_EPI_FDN (rep == 0)
#else
#define SKIP_EPI_FDN false
#endif
#define LAS __attribute__((address_space(3)))
typedef unsigned short bf16_t;
typedef short bf16x8 __attribute__((ext_vector_type(8)));
typedef float f32x4 __attribute__((ext_vector_type(4)));
typedef float f32x16 __attribute__((ext_vector_type(16)));
typedef unsigned u32x4 __attribute__((ext_vector_type(4)));
typedef unsigned u32x2 __attribute__((ext_vector_type(2)));

constexpr int T_ = 32768, D_ = 1024, FF_ = 2816;
constexpr float ALPHA = 1.41421356237309515f;
constexpr float LN_EPS = 1e-5f;
constexpr size_t MiB = 1ull << 20;
constexpr size_t WS_CNT = 0, WS_BAR = 4096, WS_A32 = 65536, WS_ROPEC = 1 * MiB, WS_ROPES = 2 * MiB, WS_LIST = 3 * MiB, WS_TOK = 4 * MiB;
constexpr size_t WS_WMUP = 8 * MiB, WS_WMDN = 40 * MiB, WS_WGLU = 56 * MiB, WS_WUP = 60 * MiB, WS_WDN = 71 * MiB, WS_WQKV = 77 * MiB, WS_WO = 80 * MiB;
constexpr size_t WS_H16 = 82 * MiB, WS_BT2 = 146 * MiB, WS_BT1 = 186 * MiB, WS_XA = 202 * MiB, WS_SST = 282 * MiB, WS_GA = 146 * MiB, WS_Y = 146 * MiB;
constexpr size_t WS_BIG = 314 * MiB, WS_END = 490 * MiB;
constexpr int LDS_BYTES = 131072 + 16;

struct Params {
    const float* x; const int* pos; const float* ln_g; const float* ln_b;
    const float* lam_re; const float* lam_im; const float* log_step; const float* b_re; const float* b_im; const float* c_re; const float* c_im;
    const float* ssm_d; const float* w_glu; const float* kv_w; const float* w_q; const float* sinks; const float* w_out;
    const float* ffn_g; const float* ffn_u; const float* ffn_d; const float* w_router; const float* b_router;
    const float* moe_g; const float* moe_u; const float* moe_d;
    float* out; unsigned char* ws; int skip; int pad;
};

__device__ __forceinline__ unsigned pk_bf16(float lo, float hi) { unsigned r; asm volatile("v_cvt_pk_bf16_f32 %0, %1, %2" : "=v"(r) : "v"(lo), "v"(hi)); return r; }
typedef _Float16 f16x8 __attribute__((ext_vector_type(8)));
typedef _Float16 f16x2 __attribute__((ext_vector_type(2)));
__device__ __forceinline__ unsigned pk_f16(float lo, float hi) { union { f16x2 h; unsigned u; } c; c.h = (f16x2){(_Float16)lo, (_Float16)hi}; return c.u; }
__device__ __forceinline__ float hf_lo(unsigned w) { union { unsigned u; f16x2 h; } c; c.u = w; return (float)c.h[0]; }
__device__ __forceinline__ float hf_hi(unsigned w) { union { unsigned u; f16x2 h; } c; c.u = w; return (float)c.h[1]; }
__device__ __forceinline__ float bf_lo(unsigned w) { return __uint_as_float(w << 16); }
__device__ __forceinline__ float bf_hi(unsigned w) { return __uint_as_float(w & 0xffff0000u); }
__device__ __forceinline__ float sigmoidf_(float x) { return __builtin_amdgcn_rcpf(1.0f + __expf(-x)); }
__device__ __forceinline__ float gelu_tanh(float y) { const float u = 1.5957691216057308f * (y + 0.044715f * y * y * y); return y * sigmoidf_(u); }
__device__ __forceinline__ float xor16(float v) { const unsigned u = __float_as_uint(v); const auto r = __builtin_amdgcn_permlane16_swap(u, u, false, false); return __uint_as_float(r[0] == u ? r[1] : r[0]); }
__device__ __forceinline__ float wave_sum(float v) {
    v += __shfl_xor(v, 32); v += __shfl_xor(v, 16); v += __shfl_xor(v, 8); v += __shfl_xor(v, 4); v += __shfl_xor(v, 2); v += __shfl_xor(v, 1); return v; }


#define XB_TMO      128
#define XB_XCNT(j)  (256  + 64 * (j))
#define XB_XSUB(j)  (1280 + 64 * (j))
#define XB_XGEN(j)  (2304 + 64 * (j))
#define XB_TOP      3328
#define XB_TOPGEN   3392
#define XCD_BAR_WORDS 3456
#define XB_SPIN_CAP (1u << 22)
__device__ __forceinline__ unsigned xb_ld(unsigned* p)              { return __hip_atomic_load(p, __ATOMIC_RELAXED, __HIP_MEMORY_SCOPE_AGENT); }
__device__ __forceinline__ unsigned xb_add(unsigned* p, unsigned v) { return __hip_atomic_fetch_add(p, v, __ATOMIC_RELAXED, __HIP_MEMORY_SCOPE_AGENT); }
__device__ __forceinline__ unsigned xb_xcc_id() { return (unsigned)__builtin_amdgcn_s_getreg((3 << 11) | 20) & 0xFu; }
#define XB_SPIN(cond, bar) do { unsigned _sp = 0; while (cond) { __builtin_amdgcn_s_sleep(1); \
    if ((++_sp & 255u) == 0u) { if (xb_ld(&(bar)[XB_TMO])) break; if (_sp > XB_SPIN_CAP) { atomicAdd(&(bar)[XB_TMO], 1u); break; } } } } while (0)
__device__ __forceinline__ void xcd_barrier_complete(unsigned* bar, unsigned x, unsigned& nloc, unsigned& nx) {
    const unsigned G = gridDim.x * gridDim.y * gridDim.z;
    unsigned sum, cnt, mine, sp = 0u;
    for (;;) {
        sum = 0u; cnt = 0u; mine = 0u;
#pragma unroll
        for (unsigned j = 0; j < 16; ++j) { const unsigned c = xb_ld(&bar[XB_XCNT(j)]); sum += c; cnt += (c > 0u) ? 1u : 0u; mine = (j == x) ? c : mine; }
        if (sum == G) break;
        __builtin_amdgcn_s_sleep(1);
        if ((++sp & 255u) == 0u) { if (xb_ld(&bar[XB_TMO])) break; if (sp > XB_SPIN_CAP) { atomicAdd(&bar[XB_TMO], 1u); break; } }
    }
    nloc = mine > 0u ? mine : 1u; nx = cnt > 0u ? cnt : 1u;
}
__device__ __forceinline__ void xcd_barrier(unsigned* bar, volatile LAS unsigned* st) {
    asm volatile("s_waitcnt vmcnt(0)" ::: "memory");
    __syncthreads();
    if (threadIdx.x == 0) {
        const unsigned x = xb_xcc_id();
        __builtin_amdgcn_s_waitcnt(0);
        unsigned nloc = st[0], nx = st[1];
        if (nloc == 0u) { xcd_barrier_complete(bar, x, nloc, nx); st[0] = nloc; st[1] = nx; }
        const unsigned old = xb_add(&bar[XB_XSUB(x)], 1u);
        const unsigned gen = old / nloc;
        if (old + 1u == (gen + 1u) * nloc) {
            __builtin_amdgcn_fence(__ATOMIC_RELEASE, "agent");
            asm volatile("s_waitcnt vmcnt(0)" ::: "memory");
            const unsigned og = xb_add(&bar[XB_TOP], 1u);
            const unsigned tg = og / nx;
            if (og + 1u == (tg + 1u) * nx) xb_add(&bar[XB_TOPGEN], 1u);
            else XB_SPIN(xb_ld(&bar[XB_TOPGEN]) == tg, bar);
            __builtin_amdgcn_fence(__ATOMIC_ACQUIRE, "agent");
            xb_add(&bar[XB_XGEN(x)], 1u);
            asm volatile("s_waitcnt vmcnt(0)" ::: "memory");
        } else {
            XB_SPIN(xb_ld(&bar[XB_XGEN(x)]) == gen, bar);
            __builtin_amdgcn_fence(__ATOMIC_ACQUIRE, "agent");
            asm volatile("s_waitcnt vmcnt(0)" ::: "memory");
        }
    }
    __syncthreads();
}

namespace pg8 {
constexpr int BM = 256, BK = 64, HALF = 128, HTB = HALF * BK * 2, NXCD = 8, WGM = 8;
__device__ __forceinline__ int lds_byte(int r, int c) { const int st = (r >> 4) * 2 + (c >> 5), rr = r & 15, cc = c & 31, ob = rr * 64 + cc * 2; return st * 1024 + (ob ^ (((ob >> 9) & 1) << 5)); }
__device__ __forceinline__ void stage_rc(int b, int& R, int& C) { const int st = b / 1024, sb = b % 1024, swz = sb ^ (((sb >> 9) & 1) << 5); R = (st >> 1) * 16 + swz / 64; C = (st & 1) * 32 + (swz % 64) / 2; }
__device__ __forceinline__ int perm32(int rho) { const int n = rho >> 4, i = rho & 15; return 8 * (i >> 2) + 4 * n + (i & 3); }
__device__ __forceinline__ int xcd_remap(int L, int nwg) { const int q = nwg / NXCD, r = nwg % NXCD, xcd = L % NXCD, off = L / NXCD; return (xcd < r ? xcd * (q + 1) : r * (q + 1) + (xcd - r) * q) + off; }

struct Unit { int pm, pn, aux, pad; size_t a_off, b_off; };

struct SchedDense {
    int nM, nN, nwg, G, c, lda, K;
    __device__ __forceinline__ void init(int M, int N, int K_, int lda_, int G_, int c_) { nM = M / BM; nN = N / BM; nwg = nM * nN; G = G_; c = c_; lda = lda_; K = K_; }
    __device__ __forceinline__ bool next(int i, Unit& u) const {
        const int L = i * G + c; if (L >= nwg) return false;
        const int wgid = xcd_remap(L, nwg);
        const int nig = WGM * nN, gid = wgid / nig, fm = gid * WGM, gsz = (nM - fm) < WGM ? (nM - fm) : WGM;
        u.pm = fm + ((wgid % nig) % gsz); u.pn = (wgid % nig) / gsz; u.aux = 0; u.pad = 0;
        u.a_off = (size_t)u.pm * BM * lda * 2; u.b_off = (size_t)u.pn * BM * K * 2; return true;
    }
    __device__ __forceinline__ unsigned voffA(int R, int C) const { return (unsigned)(R * lda + C) * 2u; }
    __device__ __forceinline__ size_t a_kstep() const { return BK * 2; }
    __device__ __forceinline__ size_t a_hstep() const { return (size_t)HALF * lda * 2; }
};
struct SchedMoe {
    int nM, nN, nwg, G, c, K; int tb[9]; size_t estride;
    __device__ __forceinline__ void init(const int* cnt, int N, int K_, size_t estride_, int G_, int c_) {
        tb[0] = 0;
#pragma unroll
        for (int e = 0; e < 8; ++e) tb[e + 1] = tb[e] + ((cnt[e] + 255) >> 8);
        nM = tb[8]; nN = N / BM; nwg = nM * nN; G = G_; c = c_; K = K_; estride = estride_; }
    __device__ __forceinline__ bool next(int i, Unit& u) const {
        const int L = i * G + c; if (L >= nwg) return false;
        const int wgid = xcd_remap(L, nwg);
        const int nig = WGM * nN, gid = wgid / nig, fm = gid * WGM, gsz = (nM - fm) < WGM ? (nM - fm) : WGM;
        u.pm = fm + ((wgid % nig) % gsz); u.pn = (wgid % nig) / gsz; int e = 0;
#pragma unroll
        for (int k = 1; k < 8; ++k) e += (u.pm >= tb[k]) ? 1 : 0;
        u.aux = e; u.pad = 0;
        u.a_off = (size_t)u.pm * BM * 1024 * 2; u.b_off = (size_t)e * estride + (size_t)u.pn * BM * K * 2; return true;
    }
    __device__ __forceinline__ unsigned voffA(int R, int C) const { return (unsigned)(R * 1024 + C) * 2u; }
    __device__ __forceinline__ size_t a_kstep() const { return BK * 2; }
    __device__ __forceinline__ size_t a_hstep() const { return (size_t)HALF * 1024 * 2; }
};
struct SchedSsm {
    int nN, nwg, G, c, K, N;
    __device__ __forceinline__ void init(int N_, int K_, int G_, int c_) { N = N_; nN = N_ / BM; nwg = 64 * 4 * nN; G = G_; c = c_; K = K_; }
    __device__ __forceinline__ bool next(int i, Unit& u) const {
        const int L = i * G + c; if (L >= nwg) return false;
        const int wgid = xcd_remap(L, nwg);
        const int per = 4 * nN, g = (wgid / (4 * per)) * 4 + (wgid & 3), rem = (wgid >> 2) % per;
        u.pm = rem & 3; u.pn = rem >> 2; u.aux = g; u.pad = 0;
        u.a_off = ((size_t)u.pm * BM * 40 * 1024 + (size_t)g * 16) * 2; u.b_off = (size_t)g * N * K * 2 + (size_t)u.pn * BM * K * 2; return true;
    }
    __device__ __forceinline__ unsigned voffA(int R, int C) const { return (unsigned)((R * 40 + (C >> 4)) * 1024 + (C & 15)) * 2u; }
    __device__ __forceinline__ size_t a_kstep() const { return 4 * 1024 * 2; }
    __device__ __forceinline__ size_t a_hstep() const { return (size_t)HALF * 40 * 1024 * 2; }
};

template <bool F16, class Epi, class Sched>
__device__ __forceinline__ void gemm_phase(LAS unsigned char* lds, const char* Ab, const char* Bb, const int K, const Sched& S, const Epi& E) {
    const int tid = threadIdx.x, wid = __builtin_amdgcn_readfirstlane(tid >> 6), lane = tid & 63, wr = wid >> 2, wc = wid & 3, fr = lane & 15, fq = lane >> 4;
    const int nt = K / BK;
    unsigned voffA[2], voffB[2];
#pragma unroll
    for (int i = 0; i < 2; ++i) { int R, C; stage_rc(tid * 16 + i * 8192, R, C); const int Rb = Epi::PERM ? ((R & ~31) + perm32(R & 31)) : R;
        voffA[i] = S.voffA(R, C); voffB[i] = (unsigned)(Rb * K + C) * 2u; }
    const size_t kstepA = S.a_kstep(), hstepA = S.a_hstep(), kstepB = (size_t)(BK * 2), hstepB = (size_t)HALF * K * 2;
    const unsigned ldsw = (unsigned)wid * 1024u;
    const int aoff = lds_byte(wr * 64 + fr, fq * 8), boff = lds_byte(wc * 32 + fr, fq * 8);
#define PG8_SA(b, h) (((b) * 2 + (h)) * HTB)
#define PG8_SB(b, h) ((4 + (b) * 2 + (h)) * HTB)
#define PG8_STAGE(bufoff, gbase, voff) do { _Pragma("unroll") for (int _i = 0; _i < 2; ++_i) \
        __builtin_amdgcn_global_load_lds((const unsigned*)((const char*)(gbase) + (voff)[_i]), (LAS unsigned*)(lds + (bufoff) + ldsw + _i * 8192), 16, 0, 0); } while (0)
#define PG8_LDA(dst, b, h) do { _Pragma("unroll") for (int m = 0; m < 4; ++m) _Pragma("unroll") for (int k = 0; k < 2; ++k) dst[m][k] = *(const LAS bf16x8*)(lds + PG8_SA(b, h) + aoff + m * 2048 + k * 1024); } while (0)
#define PG8_LDB(dst, b, h) do { _Pragma("unroll") for (int n = 0; n < 2; ++n) _Pragma("unroll") for (int k = 0; k < 2; ++k) dst[n][k] = *(const LAS bf16x8*)(lds + PG8_SB(b, h) + boff + n * 2048 + k * 1024); } while (0)
#define PG8_MMA(ai, bj, At, Bt) do { __builtin_amdgcn_s_setprio(1); _Pragma("unroll") for (int m = 0; m < 4; ++m) _Pragma("unroll") for (int n = 0; n < 2; ++n) _Pragma("unroll") for (int k = 0; k < 2; ++k) \
        acc[ai][bj][m][n] = F16 ? __builtin_amdgcn_mfma_f32_16x16x32_f16(__builtin_bit_cast(f16x8, Bt[n][k]), __builtin_bit_cast(f16x8, At[m][k]), acc[ai][bj][m][n], 0, 0, 0) : __builtin_amdgcn_mfma_f32_16x16x32_bf16(Bt[n][k], At[m][k], acc[ai][bj][m][n], 0, 0, 0); __builtin_amdgcn_s_setprio(0); } while (0)
#define PG8_WAIT_V(n) asm volatile("s_waitcnt vmcnt(" #n ")" ::: "memory")
#define PG8_WAIT_L(n) asm volatile("s_waitcnt lgkmcnt(" #n ")" ::: "memory")
#define PG8_BAR __builtin_amdgcn_s_barrier()
#define PG8_SCHED __builtin_amdgcn_sched_barrier(0)
    Unit cur, nxt; int ui = 0;
    if (!S.next(0, cur)) return;
    f32x4 acc[2][2][4][2];
#pragma unroll
    for (int a = 0; a < 2; ++a)
#pragma unroll
        for (int b = 0; b < 2; ++b)
#pragma unroll
            for (int m = 0; m < 4; ++m)
#pragma unroll
                for (int n = 0; n < 2; ++n) acc[a][b][m][n] = (f32x4){0.f, 0.f, 0.f, 0.f};
    bf16x8 At[4][2], B0[2][2], B1[2][2];
    const char* cA = Ab + cur.a_off; const char* cB = Bb + cur.b_off;
    PG8_STAGE(PG8_SB(0, 0), cB, voffB); PG8_STAGE(PG8_SA(0, 0), cA, voffA); PG8_STAGE(PG8_SB(0, 1), cB + hstepB, voffB); PG8_STAGE(PG8_SA(0, 1), cA + hstepA, voffA);
    if (wr == 1) PG8_BAR;
    PG8_WAIT_V(4); PG8_BAR;
    PG8_STAGE(PG8_SB(1, 0), cB + kstepB, voffB); PG8_STAGE(PG8_SA(1, 0), cA + kstepA, voffA); PG8_STAGE(PG8_SB(1, 1), cB + hstepB + kstepB, voffB);
    PG8_WAIT_V(6); PG8_BAR;
    for (;;) {
        const bool has_next = S.next(ui + 1, nxt);
        const char* nA = has_next ? Ab + nxt.a_off : cA; const char* nB = has_next ? Bb + nxt.b_off : cB;
        for (int t = 0; t < nt; t += 2) {
            const bool last = (t == nt - 2);
            const char* a1 = cA + (size_t)(t + 1) * kstepA;
            const char* a2 = last ? nA : cA + (size_t)(t + 2) * kstepA; const char* b2 = last ? nB : cB + (size_t)(t + 2) * kstepB;
            const char* a3 = a2 + kstepA; const char* b3 = b2 + kstepB;
            PG8_LDB(B0, 0, 0); PG8_SCHED; PG8_LDA(At, 0, 0); PG8_STAGE(PG8_SA(1, 1), a1 + hstepA, voffA);
            PG8_WAIT_L(8); PG8_BAR; PG8_WAIT_L(0); PG8_MMA(0, 0, At, B0); PG8_BAR; PG8_SCHED;
            PG8_LDB(B1, 0, 1); PG8_STAGE(PG8_SB(0, 0), b2, voffB);
            PG8_BAR; PG8_WAIT_L(0); PG8_MMA(0, 1, At, B1); PG8_BAR;
            PG8_LDA(At, 0, 1); PG8_STAGE(PG8_SA(0, 0), a2, voffA);
            PG8_BAR; PG8_WAIT_L(0); PG8_MMA(1, 0, At, B0); PG8_BAR; PG8_SCHED;
            PG8_STAGE(PG8_SB(0, 1), b2 + hstepB, voffB);
            PG8_WAIT_V(6); PG8_BAR; PG8_MMA(1, 1, At, B1); PG8_BAR;
            PG8_LDB(B0, 1, 0); PG8_SCHED; PG8_LDA(At, 1, 0); PG8_STAGE(PG8_SA(0, 1), a2 + hstepA, voffA);
            PG8_WAIT_L(8); PG8_BAR; PG8_WAIT_L(0); PG8_MMA(0, 0, At, B0); PG8_BAR; PG8_SCHED;
            PG8_LDB(B1, 1, 1); PG8_STAGE(PG8_SB(1, 0), b3, voffB);
            PG8_BAR; PG8_WAIT_L(0); PG8_MMA(0, 1, At, B1); PG8_BAR;
            PG8_LDA(At, 1, 1); PG8_STAGE(PG8_SA(1, 0), a3, voffA);
            PG8_BAR; PG8_WAIT_L(0); PG8_MMA(1, 0, At, B0); PG8_BAR; PG8_SCHED;
            PG8_STAGE(PG8_SB(1, 1), b3 + hstepB, voffB);
            PG8_WAIT_V(6); PG8_BAR; PG8_MMA(1, 1, At, B1); PG8_BAR;
        }
        E(acc, cur, wr, wc, fr, fq);
        if (!has_next) break;
#pragma unroll
        for (int a = 0; a < 2; ++a)
#pragma unroll
            for (int b = 0; b < 2; ++b)
#pragma unroll
                for (int m = 0; m < 4; ++m)
#pragma unroll
                    for (int n = 0; n < 2; ++n) acc[a][b][m][n] = (f32x4){0.f, 0.f, 0.f, 0.f};
        cur = nxt; cA = nA; cB = nB; ++ui;
    }
    PG8_WAIT_V(0);
    if (wr == 0) PG8_BAR;
    PG8_BAR;
#undef PG8_SA
#undef PG8_SB
#undef PG8_STAGE
#undef PG8_LDA
#undef PG8_LDB
#undef PG8_MMA
#undef PG8_WAIT_V
#undef PG8_WAIT_L
#undef PG8_BAR
#undef PG8_SCHED
}

typedef const f32x4 (&AccRef)[2][2][4][2];

struct EpiS1 {
    static constexpr bool PERM = false; float* sst;
    __device__ __forceinline__ void operator()(AccRef acc, const Unit& u, int wr, int wc, int fr, int fq) const {
#pragma unroll
        for (int ai = 0; ai < 2; ++ai)
#pragma unroll
            for (int m = 0; m < 4; ++m) { const int row = u.pm * BM + ai * HALF + wr * 64 + m * 16 + fr; float* rp = sst + ((size_t)row * 64 + u.aux) * 128 + wc * 32 + 4 * fq;
#pragma unroll
                for (int n = 0; n < 2; ++n) *(f32x4*)(rp + 16 * n) = acc[ai][0][m][n]; }
    }
};
struct EpiS2 {
    static constexpr bool PERM = true; bf16_t* g16;
    __device__ __forceinline__ void operator()(AccRef acc, const Unit& u, int wr, int wc, int fr, int fq) const {
        const int ch = u.aux * 16 + 8 * (fq & 1);
#pragma unroll
        for (int ai = 0; ai < 2; ++ai)
#pragma unroll
            for (int m = 0; m < 4; ++m) { const int row = u.pm * BM + ai * HALF + wr * 64 + m * 16 + fr;
#pragma unroll
                for (int bj = 0; bj < 2; ++bj) { const int t = 16 * u.pn + 8 * bj + 2 * wc + (fq >> 1);
                    const f32x4 y0 = acc[ai][bj][m][0], y1 = acc[ai][bj][m][1];
                    u32x4 w; w.x = pk_bf16(gelu_tanh(y0[0]), gelu_tanh(y0[1])); w.y = pk_bf16(gelu_tanh(y0[2]), gelu_tanh(y0[3]));
                    w.z = pk_bf16(gelu_tanh(y1[0]), gelu_tanh(y1[1])); w.w = pk_bf16(gelu_tanh(y1[2]), gelu_tanh(y1[3]));
                    *(u32x4*)(g16 + ((size_t)row * 32 + t) * 1024 + ch) = w; } }
    }
};
struct EpiGlu {
    static constexpr bool PERM = false; const float* x; float* out;
    __device__ __forceinline__ void operator()(AccRef acc, const Unit& u, int wr, int wc, int fr, int fq) const {
#pragma unroll
        for (int ai = 0; ai < 2; ++ai)
#pragma unroll
            for (int m = 0; m < 4; ++m) { const int row = u.pm * BM + ai * HALF + wr * 64 + m * 16 + fr; const size_t off = (size_t)row * 1024 + u.pn * 128 + wc * 32 + 4 * fq;
#pragma unroll
                for (int n = 0; n < 2; ++n) { const f32x4 xv = *(const f32x4*)(x + off + 16 * n); const f32x4 v = acc[ai][0][m][n], g = acc[ai][1][m][n]; f32x4 o;
#pragma unroll
                    for (int j = 0; j < 4; ++j) o[j] = ALPHA * xv[j] + v[j] * sigmoidf_(g[j]);
                    *(f32x4*)(out + off + 16 * n) = o; } }
    }
};
template <int ACT> struct EpiUp {
    static constexpr bool PERM = true; bf16_t* act; int ld;
    __device__ __forceinline__ void operator()(AccRef acc, const Unit& u, int wr, int wc, int fr, int fq) const {
#pragma unroll
        for (int ai = 0; ai < 2; ++ai)
#pragma unroll
            for (int m = 0; m < 4; ++m) { const int row = u.pm * BM + ai * HALF + wr * 64 + m * 16 + fr; float r[8];
#pragma unroll
                for (int n = 0; n < 2; ++n)
#pragma unroll
                    for (int j = 0; j < 4; ++j) { const float g = acc[ai][0][m][n][j], up = acc[ai][1][m][n][j]; r[4 * n + j] = (ACT == 0) ? g * sigmoidf_(g) * up : g * sigmoidf_(up); }
                u32x4 w; w.x = pk_bf16(r[0], r[1]); w.y = pk_bf16(r[2], r[3]); w.z = pk_bf16(r[4], r[5]); w.w = pk_bf16(r[6], r[7]);
                *(u32x4*)(act + (size_t)row * ld + u.pn * 128 + wc * 32 + 8 * fq) = w; }
    }
};
struct EpiRes {
    static constexpr bool PERM = false; const float* hin; float* h; bool skip;
    __device__ __forceinline__ void operator()(AccRef acc, const Unit& u, int wr, int wc, int fr, int fq) const {
        if (skip) return;
#pragma unroll
        for (int ai = 0; ai < 2; ++ai)
#pragma unroll
            for (int m = 0; m < 4; ++m) { const int row = u.pm * BM + ai * HALF + wr * 64 + m * 16 + fr; const size_t ro = (size_t)row * 1024 + u.pn * BM + wc * 32 + 4 * fq;
#pragma unroll
                for (int bj = 0; bj < 2; ++bj)
#pragma unroll
                    for (int n = 0; n < 2; ++n) { const size_t o = ro + bj * HALF + 16 * n; const f32x4 hv = *(const f32x4*)(hin + o); *(f32x4*)(h + o) = ALPHA * hv + acc[ai][bj][m][n]; } }
    }
};
struct EpiQkv {
    static constexpr bool PERM = true; bf16_t* q; bf16_t* k; bf16_t* v; const float* rc; const float* rs;
    __device__ __forceinline__ void operator()(AccRef acc, const Unit& u, int wr, int wc, int fr, int fq) const {
        const bool rope = (u.pn <= 4) && ((wc & 1) == 0);
        bf16_t* base; int ld, colt; float scale = 1.0f;
        if (u.pn < 4) { base = q; ld = 1024; colt = u.pn * BM; scale = 0.125f * 1.4426950408889634f; } else if (u.pn == 4) { base = k; ld = 256; colt = 0; } else { base = v; ld = 256; colt = 0; }
#pragma unroll
        for (int ai = 0; ai < 2; ++ai)
#pragma unroll
            for (int m = 0; m < 4; ++m) { const int row = u.pm * BM + ai * HALF + wr * 64 + m * 16 + fr;
                f32x4 c0 = {1.f, 1.f, 1.f, 1.f}, c1 = c0, s0 = {0.f, 0.f, 0.f, 0.f}, s1 = s0;
                if (rope && fq < 2) { c0 = *(const f32x4*)(rc + (size_t)row * 8); c1 = *(const f32x4*)(rc + (size_t)row * 8 + 4); s0 = *(const f32x4*)(rs + (size_t)row * 8); s1 = *(const f32x4*)(rs + (size_t)row * 8 + 4);
                    if (fq == 0) { s0 = -s0; s1 = -s1; } }
#pragma unroll
                for (int bj = 0; bj < 2; ++bj) { f32x4 v0 = acc[ai][bj][m][0], v1 = acc[ai][bj][m][1];
                    if (rope) { f32x4 p0, p1;
#pragma unroll
                        for (int j = 0; j < 4; ++j) { p0[j] = xor16(v0[j]); p1[j] = xor16(v1[j]); }
                        v0 = v0 * c0 + p0 * s0; v1 = v1 * c1 + p1 * s1; }
                    v0 = v0 * scale; v1 = v1 * scale;
                    u32x4 w; w.x = pk_bf16(v0[0], v0[1]); w.y = pk_bf16(v0[2], v0[3]); w.z = pk_bf16(v1[0], v1[1]); w.w = pk_bf16(v1[2], v1[3]);
                    *(u32x4*)(base + (size_t)row * ld + colt + bj * HALF + wc * 32 + 8 * fq) = w; } }
    }
};
struct EpiBf16 {
    static constexpr bool PERM = true; bf16_t* o; int ld;
    __device__ __forceinline__ void operator()(AccRef acc, const Unit& u, int wr, int wc, int fr, int fq) const {
#pragma unroll
        for (int ai = 0; ai < 2; ++ai)
#pragma unroll
            for (int m = 0; m < 4; ++m) { const int row = u.pm * BM + ai * HALF + wr * 64 + m * 16 + fr;
#pragma unroll
                for (int bj = 0; bj < 2; ++bj) { const f32x4 v0 = acc[ai][bj][m][0], v1 = acc[ai][bj][m][1];
                    u32x4 w; w.x = pk_bf16(v0[0], v0[1]); w.y = pk_bf16(v0[2], v0[3]); w.z = pk_bf16(v1[0], v1[1]); w.w = pk_bf16(v1[2], v1[3]);
                    *(u32x4*)(o + (size_t)row * ld + u.pn * BM + bj * HALF + wc * 32 + 8 * fq) = w; } }
    }
};
struct EpiNull {
    static constexpr bool PERM = false; float* h;
    __device__ __forceinline__ void operator()(AccRef acc, const Unit& u, int wr, int wc, int fr, int fq) const {
        if (u.pm < 0) {
#pragma unroll
            for (int ai = 0; ai < 2; ++ai)
#pragma unroll
                for (int m = 0; m < 4; ++m)
#pragma unroll
                    for (int bj = 0; bj < 2; ++bj)
#pragma unroll
                        for (int n = 0; n < 2; ++n) *(f32x4*)(h + ((ai * 4 + m) * 4 + bj * 2 + n) * 256 + fr * 16 + fq * 4) = acc[ai][bj][m][n]; }
    }
};
}

struct TJob { const float* s0; const float* s1; bf16_t* dst; int ld, k0, Kd, n0, f16; };
__device__ __forceinline__ void tjob_decode(const Params& P, int jt, TJob& j) {
    if (jt < 128) { const int pn = jt & 7, kt = jt >> 3;
        j.s0 = P.w_glu + 128 * pn; j.s1 = P.w_glu + 1024 + 128 * pn; j.ld = 2048; j.k0 = kt * 64; j.dst = (bf16_t*)(P.ws + WS_WGLU); j.Kd = 1024; j.n0 = 256 * pn; j.f16 = 0; }
    else if ((jt -= 128) < 352) { const int pn = jt % 22, kt = jt / 22;
        j.s0 = P.ffn_g + 128 * pn; j.s1 = P.ffn_u + 128 * pn; j.ld = 2816; j.k0 = kt * 64; j.dst = (bf16_t*)(P.ws + WS_WUP); j.Kd = 1024; j.n0 = 256 * pn; j.f16 = 1; }
    else if ((jt -= 352) < 176) { const int pn = jt & 3, kt = jt >> 2;
        j.s0 = P.ffn_d + 256 * pn; j.s1 = j.s0 + 128; j.ld = 1024; j.k0 = kt * 64; j.dst = (bf16_t*)(P.ws + WS_WDN); j.Kd = 2816; j.n0 = 256 * pn; j.f16 = 0; }
    else if ((jt -= 176) < 64) { const int pn = jt & 3, kt = jt >> 2;
        j.s0 = P.w_q + 256 * pn; j.s1 = j.s0 + 128; j.ld = 1024; j.k0 = kt * 64; j.dst = (bf16_t*)(P.ws + WS_WQKV); j.Kd = 1024; j.n0 = 256 * pn; j.f16 = 1; }
    else if ((jt -= 64) < 32) { const int pn = jt & 1, kt = jt >> 1;
        j.s0 = P.kv_w + 256 * pn; j.s1 = j.s0 + 128; j.ld = 512; j.k0 = kt * 64; j.dst = (bf16_t*)(P.ws + WS_WQKV); j.Kd = 1024; j.n0 = 1024 + 256 * pn; j.f16 = 1; }
    else if ((jt -= 32) < 64) { const int pn = jt & 3, kt = jt >> 2;
        j.s0 = P.w_out + 256 * pn; j.s1 = j.s0 + 128; j.ld = 1024; j.k0 = kt * 64; j.dst = (bf16_t*)(P.ws + WS_WO); j.Kd = 1024; j.n0 = 256 * pn; j.f16 = 0; }
    else if ((jt -= 64) < 1024) { const int e = jt & 7, r = jt >> 3, pn = r & 7, kt = r >> 3;
        j.s0 = P.moe_g + (size_t)e * 1048576 + 128 * pn; j.s1 = P.moe_u + (size_t)e * 1048576 + 128 * pn; j.ld = 1024; j.k0 = kt * 64; j.dst = (bf16_t*)(P.ws + WS_WMUP) + (size_t)e * 2048 * 1024; j.Kd = 1024; j.n0 = 256 * pn; j.f16 = 1; }
    else { jt -= 1024; const int e = jt & 7, r = jt >> 3, pn = r & 3, kt = r >> 2;
        j.s0 = P.moe_d + (size_t)e * 1048576 + 256 * pn; j.s1 = j.s0 + 128; j.ld = 1024; j.k0 = kt * 64; j.dst = (bf16_t*)(P.ws + WS_WMDN) + (size_t)e * 1048576; j.Kd = 1024; j.n0 = 256 * pn; j.f16 = 0; }
}
#define TJ_LOAD(J, V) do { const int nn_ = (tid & 63) * 4, kb_ = tid >> 6; const float* sp_ = (nn_ < 128) ? ((J).s0 + nn_) : ((J).s1 + (nn_ - 128)); \
    _Pragma("unroll") for (int i = 0; i < 8; ++i) (V)[i] = *(const f32x4*)(sp_ + (size_t)((J).k0 + kb_ + 8 * i) * (J).ld); } while (0)
__device__ void transposes_phase(const Params& P, float* tile) {
    constexpr int J_T = 2352;
    const int tid = threadIdx.x, G = gridDim.x;
    int jt = blockIdx.x; TJob cur, nxt; f32x4 v[8], vn[8];
    if (jt < J_T) { tjob_decode(P, jt, cur); TJ_LOAD(cur, v); }
    while (jt < J_T) {
        { const int nn = (tid & 63) * 4, kb = tid >> 6;
#pragma unroll
          for (int i = 0; i < 8; ++i) { float* t = tile + (kb + 8 * i) * 257 + nn; t[0] = v[i][0]; t[1] = v[i][1]; t[2] = v[i][2]; t[3] = v[i][3]; } }
        __syncthreads();
        const int jn = jt + G;
        if (jn < J_T) { tjob_decode(P, jn, nxt); TJ_LOAD(nxt, vn); }
        { const int ks = (tid & 7) * 8;
#pragma unroll
          for (int i = 0; i < 4; ++i) { const int n = (tid >> 3) + 64 * i; float r[8];
#pragma unroll
              for (int j = 0; j < 8; ++j) r[j] = tile[(ks + j) * 257 + n];
              u32x4 w; if (cur.f16) { w.x = pk_f16(r[0], r[1]); w.y = pk_f16(r[2], r[3]); w.z = pk_f16(r[4], r[5]); w.w = pk_f16(r[6], r[7]); } else { w.x = pk_bf16(r[0], r[1]); w.y = pk_bf16(r[2], r[3]); w.z = pk_bf16(r[4], r[5]); w.w = pk_bf16(r[6], r[7]); }
              *(u32x4*)(cur.dst + (size_t)(cur.n0 + n) * cur.Kd + cur.k0 + ks) = w; } }
        __syncthreads();
        cur = nxt; jt = jn;
#pragma unroll
        for (int i = 0; i < 8; ++i) v[i] = vn[i];
    }
}

__device__ void ssm_tables(const Params& P, int g, int qtr, unsigned char* lds) {
    const int tid = threadIdx.x;
    float* apr = (float*)lds;
    float* api = apr + 33 * 64;
    float* bbr = api + 33 * 64;
    float* bbi = bbr + 1024;
    float* ccr = bbi + 1024;
    float* cci = ccr + 1024;
    float* kg = cci + 1024;
    const float dtf = expf(P.log_step[g]);
    for (int idx = tid; idx < 33 * 64; idx += 512) { const int tau = idx >> 6, p = idx & 63;
        const float lr = P.lam_re[g * 64 + p], li = P.lam_im[g * 64 + p];
        const double dt = (double)dtf; double rev = (double)li * dt * (double)tau * 0.15915494309189535; rev -= floor(rev);
        const float ang = (float)(rev * 6.283185307179586); float sn, cs; sincosf(ang, &sn, &cs);
        const float mag = expf((float)((double)lr * dt * (double)tau));
        apr[idx] = mag * cs; api[idx] = mag * sn; }
    for (int idx = tid; idx < 1024; idx += 512) { ccr[idx] = P.c_re[g * 1024 + idx]; cci[idx] = P.c_im[g * 1024 + idx]; }
    __syncthreads();
    for (int idx = tid; idx < 1024; idx += 512) { const int p = idx >> 4;
        const float lr = P.lam_re[g * 64 + p], li = P.lam_im[g * 64 + p], ar = apr[64 + p], ai = api[64 + p];
        const float nr = ar - 1.0f, den = lr * lr + li * li, kr = (nr * lr + ai * li) / den, ki = (ai * lr - nr * li) / den;
        const float br = P.b_re[g * 1024 + idx], bi = P.b_im[g * 1024 + idx];
        bbr[idx] = kr * br - ki * bi; bbi[idx] = kr * bi + ki * br; }
    __syncthreads();
    { const int cp = tid & 15, c = 4 * qtr + ((tid >> 4) & 3), t0 = tid >> 6;
      for (int i = 0; i < 4; ++i) { const int tau = t0 + 8 * i; float s = 0.f;
          for (int p = 0; p < 64; ++p) { const float cr = ccr[c * 64 + p], ci = cci[c * 64 + p], ar = apr[tau * 64 + p], ai = api[tau * 64 + p];
              const float zr = cr * ar - ci * ai, zi = cr * ai + ci * ar; s += zr * bbr[p * 16 + cp] - zi * bbi[p * 16 + cp]; }
          if (tau == 0 && cp == c) s += P.ssm_d[g * 16 + c];
          kg[(tau * 16 + c) * 16 + cp] = s; } }
    __syncthreads();
    bf16_t* bt2 = (bf16_t*)(P.ws + WS_BT2) + (size_t)g * 512 * 640;
    for (int pc = tid; pc < 128 * 80; pc += 512) { const int nq = pc / 80, k8 = (pc % 80) * 8, t = nq >> 2, c = 4 * qtr + (nq & 3), n = t * 16 + c; float r[8];
        if (k8 < 512) { const int s = k8 >> 4, c0 = k8 & 15;
#pragma unroll
            for (int j = 0; j < 8; ++j) r[j] = (t >= s) ? kg[((t - s) * 16 + c) * 16 + c0 + j] : 0.f;
        } else { const int q0 = k8 - 512;
#pragma unroll
            for (int j = 0; j < 8; j += 2) { const int p = (q0 + j) >> 1; const float cr = ccr[c * 64 + p], ci = cci[c * 64 + p], ar = apr[(t + 1) * 64 + p], ai = api[(t + 1) * 64 + p];
                r[j] = cr * ar - ci * ai; r[j + 1] = -(cr * ai + ci * ar); } }
        u32x4 w; w.x = pk_bf16(r[0], r[1]); w.y = pk_bf16(r[2], r[3]); w.z = pk_bf16(r[4], r[5]); w.w = pk_bf16(r[6], r[7]);
        *(u32x4*)(bt2 + (size_t)n * 640 + k8) = w; }
    bf16_t* bt1 = (bf16_t*)(P.ws + WS_BT1) + (size_t)g * 256 * 512;
    for (int pc = tid; pc < 64 * 64; pc += 512) { const int q = 64 * qtr + (pc >> 6), k8 = (pc & 63) * 8; float r[8];
        if (q < 128) { const int p = q >> 1, s = k8 >> 4, c0 = k8 & 15; const float ar = apr[(31 - s) * 64 + p], ai = api[(31 - s) * 64 + p];
#pragma unroll
            for (int j = 0; j < 8; ++j) { const float br = bbr[p * 16 + c0 + j], bi = bbi[p * 16 + c0 + j]; r[j] = (q & 1) ? (ar * bi + ai * br) : (ar * br - ai * bi); }
        } else {
#pragma unroll
            for (int j = 0; j < 8; ++j) r[j] = 0.f; }
        u32x4 w; w.x = pk_bf16(r[0], r[1]); w.y = pk_bf16(r[2], r[3]); w.z = pk_bf16(r[4], r[5]); w.w = pk_bf16(r[6], r[7]);
        *(u32x4*)(bt1 + (size_t)q * 512 + k8) = w; }
    float* a32 = (float*)(P.ws + WS_A32);
    if (qtr == 0 && tid < 64) { a32[(g * 64 + tid) * 2] = apr[32 * 64 + tid]; a32[(g * 64 + tid) * 2 + 1] = api[32 * 64 + tid]; }
    __syncthreads();
}

__device__ void p0_prep(const Params& P, unsigned char* lds, const int mask) {
    const int tid = threadIdx.x, G = gridDim.x;
    if (blockIdx.x == 0 && tid < 8) ((int*)(P.ws + WS_CNT))[tid] = 0;
    constexpr int J_SSM = 256, J_X = 512, J_ROPE = 512;
    constexpr int NJ = J_SSM + J_X + J_ROPE;
    const bool tfirst = (blockIdx.x & 1) != 0;
    if (tfirst && (mask & 8)) { transposes_phase(P, (float*)lds); __syncthreads(); }
    for (int job = blockIdx.x; job < NJ; job += G) {
        if (job < J_SSM) {
#if LEVEL >= 1
            if (mask & 1) ssm_tables(P, job >> 2, job & 3, lds);
#endif
        }
        else if (job < J_SSM + J_X) { if (!(mask & 2)) continue;
            const int r0 = (job - J_SSM) * 64; bf16_t* xa = (bf16_t*)(P.ws + WS_XA);
#pragma unroll 4
            for (int i = 0; i < 16; ++i) { const int piece = tid + 512 * i, r = r0 + (piece >> 7), c8 = (piece & 127) * 8;
                const f32x4 a = *(const f32x4*)(P.x + (size_t)r * 1024 + c8), b = *(const f32x4*)(P.x + (size_t)r * 1024 + c8 + 4);
                u32x4 w; w.x = pk_bf16(a[0], a[1]); w.y = pk_bf16(a[2], a[3]); w.z = pk_bf16(b[0], b[1]); w.w = pk_bf16(b[2], b[3]);
                *(u32x4*)(xa + ((size_t)(r >> 5) * 40 + (r & 31)) * 1024 + c8) = w;
#if LEVEL < 1
                *(f32x4*)(P.out + (size_t)r * 1024 + c8) = a; *(f32x4*)(P.out + (size_t)r * 1024 + c8 + 4) = b;
#endif
            }
        }
        else if (job < J_SSM + J_X + J_ROPE) { if (!(mask & 4)) continue;
            const int tok = (job - J_SSM - J_X) * 64 + (tid >> 3), i = tid & 7;
            const float invf[8] = {1.0f, 0.19392274474868576f, 0.03760603093086393f, 0.007292664737217109f, 0.001414213562373095f, 0.0002742481756762073f, 5.318295896944988e-05f, 1.031338537721246e-05f};
            float f = invf[0];
#pragma unroll
            for (int k = 1; k < 8; ++k) f = (i == k) ? invf[k] : f;
            const float ang = (float)P.pos[tok] * f; float sn, cs; sincosf(ang, &sn, &cs);
            ((float*)(P.ws + WS_ROPEC))[tok * 8 + i] = cs; ((float*)(P.ws + WS_ROPES))[tok * 8 + i] = sn;
        }
    }
    if (!tfirst && (mask & 8)) { __syncthreads(); transposes_phase(P, (float*)lds); }
}

__device__ void scan_unit(const Params& P, int g, int pm) {
    const float* sst = (const float*)(P.ws + WS_SST); const float* a32 = (const float*)(P.ws + WS_A32); bf16_t* xa = (bf16_t*)(P.ws + WS_XA);
    const int tid = threadIdx.x;
    if (tid < 256) {
        const int p = tid & 63, b = pm * 4 + (tid >> 6), q = 2 * p;
        const float ar = a32[(g * 64 + p) * 2], ai = a32[(g * 64 + p) * 2 + 1];
        float hr = 0.f, hi = 0.f;
#pragma unroll 1
        for (int jb = 0; jb < 64; jb += 16) {
            float2 s[16];
#pragma unroll
            for (int j = 0; j < 16; ++j) s[j] = *(const float2*)(sst + ((size_t)(b * 64 + jb + j) * 64 + g) * 128 + q);
#pragma unroll
            for (int j = 0; j < 16; ++j) { const int row = b * 64 + jb + j;
                *(unsigned*)(xa + ((size_t)row * 40 + 32 + (q >> 4)) * 1024 + g * 16 + (q & 15)) = pk_bf16(hr, hi);
                const float nr = ar * hr - ai * hi + s[j].x, ni = ar * hi + ai * hr + s[j].y; hr = nr; hi = ni; }
        }
    }
}

template <int MODE, bool IN32>
__device__ void ln_phase(const Params& P, const float* h, const float* gam, const float* bet, unsigned char* lds, float* hout, bf16_t* h16, const bf16_t* d16) {
    const int tid = threadIdx.x, wid = tid >> 6, lane = tid & 63;
    float* wrt = (float*)lds;
    int* cnt = (int*)(P.ws + WS_CNT); int* lists = (int*)(P.ws + WS_LIST); int* toki = (int*)(P.ws + WS_TOK);
    const bf16_t* Y = (const bf16_t*)(P.ws + WS_Y);
    int base[8];
    int* lcnt = (int*)(lds + 32768);
    int* rinfo = (int*)(lds + 32768 + 64);
    if (MODE == 1) { for (int k = 0; k < 16; ++k) { const int idx = tid + 512 * k; wrt[(idx & 7) * 1024 + (idx >> 3)] = P.w_router[idx]; } if (tid < 8) lcnt[tid] = 0; __syncthreads(); }
    int kiter = 0;
    if (MODE == 2) { int acc = 0;
#pragma unroll
        for (int e = 0; e < 8; ++e) { base[e] = acc; acc += ((cnt[e] + 255) >> 8) << 8; } }
    f32x4 gv[4], bv[4];
#pragma unroll
    for (int i = 0; i < 4; ++i) { gv[i] = *(const f32x4*)(gam + 256 * i + lane * 4); bv[i] = *(const f32x4*)(bet + 256 * i + lane * 4); }
    f32x4 nf[4]; u32x2 nh[4], nd[4], na[4], nb2[4]; float nw1 = 0.f, nw2 = 0.f;
#pragma unroll
    for (int i = 0; i < 4; ++i) { nf[i] = (f32x4){0.f, 0.f, 0.f, 0.f}; nh[i] = (u32x2){0u, 0u}; nd[i] = nh[i]; na[i] = nh[i]; nb2[i] = nh[i]; }
#define LN_FETCH(R) do { const size_t ro_ = (size_t)(R) * 1024 + lane * 4; \
        if (IN32) { _Pragma("unroll") for (int i = 0; i < 4; ++i) nf[i] = *(const f32x4*)(h + ro_ + 256 * i); } \
        else { _Pragma("unroll") for (int i = 0; i < 4; ++i) nh[i] = *(const u32x2*)(h16 + ro_ + 256 * i); } \
        if (MODE != 2 && d16 != nullptr) { _Pragma("unroll") for (int i = 0; i < 4; ++i) nd[i] = *(const u32x2*)(d16 + ro_ + 256 * i); } \
        if (MODE == 2) { const int e1_ = toki[(R) * 8 + 0], p1_ = toki[(R) * 8 + 1], e2_ = toki[(R) * 8 + 2], p2_ = toki[(R) * 8 + 3]; \
            nw1 = __int_as_float(toki[(R) * 8 + 4]); nw2 = __int_as_float(toki[(R) * 8 + 5]); int b1_ = 0, b2_ = 0; \
            _Pragma("unroll") for (int e = 0; e < 8; ++e) { b1_ = (e1_ == e) ? base[e] : b1_; b2_ = (e2_ == e) ? base[e] : b2_; } \
            const bf16_t* y1_ = Y + (size_t)(b1_ + p1_) * 1024 + lane * 4; const bf16_t* y2_ = Y + (size_t)(b2_ + p2_) * 1024 + lane * 4; \
            _Pragma("unroll") for (int i = 0; i < 4; ++i) { na[i] = *(const u32x2*)(y1_ + 256 * i); nb2[i] = *(const u32x2*)(y2_ + 256 * i); } } } while (0)
    const int rstride = gridDim.x * 8;
    int row = blockIdx.x * 8 + wid;
    if (row < T_) LN_FETCH(row);
    for (; row < T_; row += rstride, ++kiter) {
        f32x4 v[4];
        if (IN32) {
#pragma unroll
            for (int i = 0; i < 4; ++i) v[i] = nf[i];
        } else {
#pragma unroll
            for (int i = 0; i < 4; ++i) v[i] = (f32x4){hf_lo(nh[i].x), hf_hi(nh[i].x), hf_lo(nh[i].y), hf_hi(nh[i].y)};
        }
        if (MODE != 2 && d16 != nullptr) {
#pragma unroll
            for (int i = 0; i < 4; ++i) { const u32x2 a = nd[i];
                v[i][0] = ALPHA * v[i][0] + bf_lo(a.x); v[i][1] = ALPHA * v[i][1] + bf_hi(a.x); v[i][2] = ALPHA * v[i][2] + bf_lo(a.y); v[i][3] = ALPHA * v[i][3] + bf_hi(a.y); }
        }
        if (MODE == 2) { const float w1 = nw1, w2 = nw2;
#pragma unroll
            for (int i = 0; i < 4; ++i) { const u32x2 a = na[i], b = nb2[i];
                v[i][0] = ALPHA * v[i][0] + (w1 * bf_lo(a.x) + w2 * bf_lo(b.x)); v[i][1] = ALPHA * v[i][1] + (w1 * bf_hi(a.x) + w2 * bf_hi(b.x));
                v[i][2] = ALPHA * v[i][2] + (w1 * bf_lo(a.y) + w2 * bf_lo(b.y)); v[i][3] = ALPHA * v[i][3] + (w1 * bf_hi(a.y) + w2 * bf_hi(b.y)); }
        }
        { const int nrow = row + rstride; if (nrow < T_) LN_FETCH(nrow); }
        float s = 0.f;
#pragma unroll
        for (int i = 0; i < 4; ++i) s += (v[i][0] + v[i][1]) + (v[i][2] + v[i][3]);
        const float mu = wave_sum(s) * (1.0f / 1024.0f);
        float q = 0.f;
#pragma unroll
        for (int i = 0; i < 4; ++i) { v[i] = v[i] - mu; q += (v[i][0] * v[i][0] + v[i][1] * v[i][1]) + (v[i][2] * v[i][2] + v[i][3] * v[i][3]); }
        const float rstd = rsqrtf(wave_sum(q) * (1.0f / 1024.0f) + LN_EPS);
#pragma unroll
        for (int i = 0; i < 4; ++i) { v[i] = v[i] * rstd * gv[i] + bv[i]; if (MODE == 2) *(f32x4*)(hout + (size_t)row * 1024 + 256 * i + lane * 4) = v[i];
            if (MODE != 2) { u32x2 w; w.x = pk_f16(v[i][0], v[i][1]); w.y = pk_f16(v[i][2], v[i][3]); *(u32x2*)(h16 + (size_t)row * 1024 + 256 * i + lane * 4) = w; } }
        if (MODE == 1) {
            float lg[8];
#pragma unroll
            for (int e = 0; e < 8; ++e) { float a = 0.f;
#pragma unroll
                for (int i = 0; i < 4; ++i) { const f32x4 w = *(const f32x4*)(wrt + e * 1024 + 256 * i + lane * 4); a += (v[i][0] * w[0] + v[i][1] * w[1]) + (v[i][2] * w[2] + v[i][3] * w[3]); }
                lg[e] = wave_sum(a) + P.b_router[e]; }
            int e1 = 0; float v1 = lg[0];
#pragma unroll
            for (int e = 1; e < 8; ++e) if (lg[e] > v1) { v1 = lg[e]; e1 = e; }
            int e2 = -1; float v2 = -3.0e38f;
#pragma unroll
            for (int e = 0; e < 8; ++e) if (e != e1 && lg[e] > v2) { v2 = lg[e]; e2 = e; }
            const float ex = __expf(v2 - v1), w1 = 1.0f / (1.0f + ex), w2 = ex / (1.0f + ex);
            if (lane == 0) { const int p1 = atomicAdd(lcnt + e1, 1), p2 = atomicAdd(lcnt + e2, 1); int* ri = rinfo + (kiter * 8 + wid) * 6;
                ri[0] = e1; ri[1] = p1; ri[2] = e2; ri[3] = p2; ri[4] = __float_as_int(w1); ri[5] = __float_as_int(w2); }
        }
    }
    if (MODE == 1) {
        __syncthreads();
        if (tid < 8) lcnt[8 + tid] = atomicAdd(cnt + tid, lcnt[tid]);
        __syncthreads();
        for (int lr = tid; lr < 512; lr += 512) { const int row = blockIdx.x * 8 + (lr & 7) + (lr >> 3) * gridDim.x * 8;
            if (row < T_) { const int* ri = rinfo + lr * 6; const int e1 = ri[0], e2 = ri[2], p1 = lcnt[8 + e1] + ri[1], p2 = lcnt[8 + e2] + ri[3];
                lists[e1 * T_ + p1] = row; lists[e2 * T_ + p2] = row;
                toki[row * 8 + 0] = e1; toki[row * 8 + 1] = p1; toki[row * 8 + 2] = e2; toki[row * 8 + 3] = p2; toki[row * 8 + 4] = ri[4]; toki[row * 8 + 5] = ri[5]; } }
    }
}

__device__ void gather_phase(const Params& P) {
    const int tid = threadIdx.x, wid = tid >> 6, lane = tid & 63;
    const int* cnt = (const int*)(P.ws + WS_CNT); const int* lists = (const int*)(P.ws + WS_LIST);
    const bf16_t* h16 = (const bf16_t*)(P.ws + WS_H16); bf16_t* ga = (bf16_t*)(P.ws + WS_GA);
    int base[9], c[8]; base[0] = 0;
#pragma unroll
    for (int e = 0; e < 8; ++e) { c[e] = cnt[e]; base[e + 1] = base[e] + (((c[e] + 255) >> 8) << 8); }
    for (int r = blockIdx.x * 8 + wid; r < base[8]; r += gridDim.x * 8) {
        int e = 0;
#pragma unroll
        for (int k = 1; k < 8; ++k) e += (r >= base[k]) ? 1 : 0;
        int be = 0, ce = 0;
#pragma unroll
        for (int k = 0; k < 8; ++k) { be = (e == k) ? base[k] : be; ce = (e == k) ? c[k] : ce; }
        const int pos = r - be; u32x4 a = {0u, 0u, 0u, 0u}, b = a;
        if (pos < ce) { const int tok = lists[e * T_ + pos]; a = *(const u32x4*)(h16 + (size_t)tok * 1024 + lane * 8); b = *(const u32x4*)(h16 + (size_t)tok * 1024 + 512 + lane * 8); }
        *(u32x4*)(ga + (size_t)r * 1024 + lane * 8) = a; *(u32x4*)(ga + (size_t)r * 1024 + 512 + lane * 8) = b;
    }
}

__device__ void attn_phase(const Params& P, unsigned char* lds) {
    const int tid = threadIdx.x, wid = tid >> 6, lane = tid & 63, n = lane & 31, hh = lane >> 5;
    bf16_t* Ks = (bf16_t*)lds;
    bf16_t* Vt = (bf16_t*)(lds + 256 * 144);
    const bf16_t* QB = (const bf16_t*)(P.ws + WS_BIG); const bf16_t* KB = (const bf16_t*)(P.ws + WS_BIG + 64 * MiB); const bf16_t* VB = (const bf16_t*)(P.ws + WS_BIG + 80 * MiB);
    bf16_t* OB = (bf16_t*)(P.ws + WS_BIG + 96 * MiB);
#ifdef DUP_ATT
    constexpr int NITEM = 2048;
#else
    constexpr int NITEM = 1024;
#endif
    u32x4 kreg[4], vreg0[2], vreg1[2];
#define ATT_LOAD(it) do { const int kvh_ = (it) & 3, nb_ = ((it) >> 2) & 15, b_ = ((it) >> 6) & 15, tok_ = b_ * 2048 + nb_ * 128; \
        _Pragma("unroll") for (int i = 0; i < 4; ++i) { const int piece = tid + 512 * i, s = piece >> 3, pc = piece & 7; kreg[i] = (u32x4){0u, 0u, 0u, 0u}; \
            if (nb_ > 0 || s >= 128) kreg[i] = *(const u32x4*)(KB + (size_t)(tok_ - 128 + s) * 256 + kvh_ * 64 + pc * 8); } \
        _Pragma("unroll") for (int i = 0; i < 2; ++i) { const int s = 2 * (tid & 127), pc = (tid >> 7) + 4 * i; vreg0[i] = (u32x4){0u, 0u, 0u, 0u}; vreg1[i] = vreg0[i]; \
            if (nb_ > 0 || s >= 128) { vreg0[i] = *(const u32x4*)(VB + (size_t)(tok_ - 128 + s) * 256 + kvh_ * 64 + pc * 8); vreg1[i] = *(const u32x4*)(VB + (size_t)(tok_ - 127 + s) * 256 + kvh_ * 64 + pc * 8); } } } while (0)
    if ((int)blockIdx.x < NITEM) ATT_LOAD((int)blockIdx.x);
    for (int item = blockIdx.x; item < NITEM; item += gridDim.x) {
        const int kvh = item & 3, nb = (item >> 2) & 15, b = (item >> 6) & 15;
        const int tok0 = b * 2048 + nb * 128;
        __syncthreads();
#pragma unroll
        for (int i = 0; i < 4; ++i) { const int piece = tid + 512 * i, s = piece >> 3, pc = piece & 7; *(u32x4*)(Ks + s * 72 + pc * 8) = kreg[i]; }
#pragma unroll
        for (int i = 0; i < 2; ++i) { const int s = 2 * (tid & 127), pc = (tid >> 7) + 4 * i; const u32x4 v0 = vreg0[i], v1 = vreg1[i];
            unsigned* vt = (unsigned*)(Vt + (pc * 8) * 264 + s);
            vt[0 * 132] = (v0.x & 0xffffu) | (v1.x << 16); vt[1 * 132] = (v0.x >> 16) | (v1.x & 0xffff0000u);
            vt[2 * 132] = (v0.y & 0xffffu) | (v1.y << 16); vt[3 * 132] = (v0.y >> 16) | (v1.y & 0xffff0000u);
            vt[4 * 132] = (v0.z & 0xffffu) | (v1.z << 16); vt[5 * 132] = (v0.z >> 16) | (v1.z & 0xffff0000u);
            vt[6 * 132] = (v0.w & 0xffffu) | (v1.w << 16); vt[7 * 132] = (v0.w >> 16) | (v1.w & 0xffff0000u); }
        __syncthreads();
        if (item + (int)gridDim.x < NITEM) ATT_LOAD(item + (int)gridDim.x);
        const int hq = kvh * 4 + (wid >> 1);
        const float sink = P.sinks[hq] * 1.4426950408889634f;
#pragma unroll 1
        for (int qq = 0; qq < 2; ++qq) {
            const int kb0 = (wid & 1) * 2 + qq, i0 = 32 * kb0, qi = i0 + n;
            const bf16_t* qp = QB + (size_t)(tok0 + qi) * 1024 + hq * 64 + 8 * hh;
            bf16x8 qf[4];
#pragma unroll
            for (int ks = 0; ks < 4; ++ks) qf[ks] = *(const bf16x8*)(qp + 16 * ks);
            f32x16 sacc[5];
#pragma unroll
            for (int kb = 0; kb < 5; ++kb) {
#pragma unroll
                for (int i = 0; i < 16; ++i) sacc[kb][i] = 0.f;
                const bf16_t* kp = Ks + (32 * (kb0 + kb) + n) * 72 + 8 * hh;
#pragma unroll
                for (int ks = 0; ks < 4; ++ks) { const bf16x8 a = *(const bf16x8*)(kp + 16 * ks); sacc[kb] = __builtin_amdgcn_mfma_f32_32x32x16_bf16(a, qf[ks], sacc[kb], 0, 0, 0); }
                asm volatile("" ::: "memory"); }
            const int nn4 = n - 4 * hh;
#pragma unroll
            for (int i = 0; i < 16; ++i) { const int r = 8 * (i >> 2) + (i & 3);
                sacc[0][i] = (r > nn4) ? sacc[0][i] : -1.0e30f; sacc[4][i] = (r <= nn4) ? sacc[4][i] : -1.0e30f; }
            if (nb == 0) {
#pragma unroll
                for (int kb = 0; kb < 4; ++kb) if (kb0 + kb < 4) {
#pragma unroll
                    for (int i = 0; i < 16; ++i) sacc[kb][i] = -1.0e30f; } }
            float mx = sink;
#pragma unroll
            for (int kb = 0; kb < 5; ++kb)
#pragma unroll
                for (int i = 0; i < 16; ++i) mx = fmaxf(mx, sacc[kb][i]);
            mx = fmaxf(mx, __shfl_xor(mx, 32));
            float sum = 0.f;
#pragma unroll
            for (int kb = 0; kb < 5; ++kb)
#pragma unroll
                for (int i = 0; i < 16; ++i) { const float p = __builtin_amdgcn_exp2f(sacc[kb][i] - mx); sacc[kb][i] = p; sum += p; }
            sum += __shfl_xor(sum, 32); sum += __builtin_amdgcn_exp2f(sink - mx);
            f32x16 oacc[2];
#pragma unroll
            for (int i = 0; i < 16; ++i) { oacc[0][i] = 0.f; oacc[1][i] = 0.f; }
#pragma unroll
            for (int kb = 0; kb < 5; ++kb)
#pragma unroll
                for (int sl = 0; sl < 2; ++sl) {
                    union { u32x4 u; bf16x8 v; } pb;
                    pb.u.x = pk_bf16(sacc[kb][8 * sl + 0], sacc[kb][8 * sl + 1]); pb.u.y = pk_bf16(sacc[kb][8 * sl + 2], sacc[kb][8 * sl + 3]);
                    pb.u.z = pk_bf16(sacc[kb][8 * sl + 4], sacc[kb][8 * sl + 5]); pb.u.w = pk_bf16(sacc[kb][8 * sl + 6], sacc[kb][8 * sl + 7]);
#pragma unroll
                    for (int mb = 0; mb < 2; ++mb) { const bf16_t* vp = Vt + (32 * mb + n) * 264 + 32 * (kb0 + kb) + 16 * sl + 4 * hh;
                        union { u32x4 u; bf16x8 v; } va; const u32x2 lo = *(const u32x2*)vp, hi = *(const u32x2*)(vp + 8); va.u.x = lo.x; va.u.y = lo.y; va.u.z = hi.x; va.u.w = hi.y;
                        oacc[mb] = __builtin_amdgcn_mfma_f32_32x32x16_bf16(va.v, pb.v, oacc[mb], 0, 0, 0); }
                    asm volatile("" ::: "memory"); }
            const float inv = 1.0f / sum;
            bf16_t* op = OB + (size_t)(tok0 + qi) * 1024 + hq * 64 + 4 * hh;
#pragma unroll
            for (int mb = 0; mb < 2; ++mb)
#pragma unroll
                for (int g4 = 0; g4 < 4; ++g4) { u32x2 w; w.x = pk_bf16(oacc[mb][4 * g4 + 0] * inv, oacc[mb][4 * g4 + 1] * inv); w.y = pk_bf16(oacc[mb][4 * g4 + 2] * inv, oacc[mb][4 * g4 + 3] * inv);
                    *(u32x2*)(op + 32 * mb + 8 * g4) = w; }
        }
    }
}

#if defined(__HIP_DEVICE_COMPILE__)
typedef const Params __attribute__((address_space(4)))* KParams;
__device__ __forceinline__ Params load_params() { KParams p = (KParams)__builtin_amdgcn_kernarg_segment_ptr(); asm volatile("" : "+s"(p)); return *p; }
#else
__device__ __forceinline__ Params load_params() { return Params{}; }
#endif
#define LP const Params P = load_params(); unsigned char* const ws = P.ws; float* const H = P.out; (void)ws; (void)H
__global__ void __launch_bounds__(512, 2) yoco_fwd(Params P_arg) {
    extern __shared__ __attribute__((aligned(16))) unsigned char lds[];
    cg::grid_group grid = cg::this_grid();
    LAS unsigned char* ldsl = (LAS unsigned char*)lds;
    const int G = gridDim.x, c = blockIdx.x;
    if (threadIdx.x == 0) { ((LAS unsigned*)(ldsl + 131072))[0] = 0u; ((LAS unsigned*)(ldsl + 131072))[1] = 0u; }
    __syncthreads();
#define GSYNC() do { LP; xcd_barrier((unsigned*)(ws + WS_BAR), (volatile LAS unsigned*)(ldsl + 131072)); } while (0)

#ifdef PROF_A_HI
#define STAMP(k) do { LP; if (((k) == PROF_A_LO || (k) == PROF_A_HI || (k) == PROF_B_LO || (k) == PROF_B_HI) && blockIdx.x == 0 && threadIdx.x == 0) ((unsigned long long*)(P.ws + WS_CNT + 1024))[k] = __builtin_amdgcn_s_memrealtime(); } while (0)
#else
#define STAMP(k) do { } while (0)
#endif
#ifdef DUP_ALL
#pragma unroll 1
    for (int pass = 0; pass < 2; ++pass) {
#else
    { const int pass = 0;
#endif
    STAMP(0);
    if (pass != 0) GSYNC();
    { LP; p0_prep(P, lds, (P.skip & 1) ? 0 : (15 & ~(P.skip >> 16))); if (pass == 0 && blockIdx.x == 0) for (int i = threadIdx.x; i < XCD_BAR_WORDS; i += 512) ((unsigned*)(ws + WS_BAR))[i] = 0u; }
    if (pass == 0) { grid.sync();
        { LP; if (threadIdx.x == 0) (void)xb_add(&((unsigned*)(ws + WS_BAR))[XB_XCNT(xb_xcc_id())], 1u); } }
    else GSYNC();
#ifdef DUP_SYNC
#pragma unroll 1
    for (int r = 0; r < 16; ++r) GSYNC();
#endif
#ifdef DUP_P0
    { LP; p0_prep(P, lds, DUP_P0); }
    GSYNC();
#endif
    STAMP(1);
#if LEVEL >= 1
#pragma unroll 1
    for (int rep = 0; rep < NREP_S1; ++rep) {
    {   LP; if (!((P.skip >> 1) & 1)) {
        pg8::SchedSsm S; S.init(256, 512, G, c); pg8::EpiS1 E{(float*)(ws + WS_SST)};
        pg8::gemm_phase<false>(ldsl, (const char*)(ws + WS_XA), (const char*)(ws + WS_BT1), 512, S, E);
        asm volatile("s_waitcnt vmcnt(0)" ::: "memory"); __syncthreads();
        pg8::Unit u; for (int i = 0; S.next(i, u); ++i) scan_unit(P, u.aux, u.pm); } }
    GSYNC(); } STAMP(2);
#pragma unroll 1
    for (int rep = 0; rep < NREP_S2; ++rep) {
    {   LP; if (!((P.skip >> 2) & 1)) {
        pg8::SchedSsm S; S.init(512, 640, G, c); pg8::EpiS2 E{(bf16_t*)(ws + WS_BIG)};
        pg8::gemm_phase<false>(ldsl, (const char*)(ws + WS_XA), (const char*)(ws + WS_BT2), 640, S, E); } }
    GSYNC(); } STAMP(4);
#pragma unroll 1
    for (int rep = 0; rep < NREP_GLU; ++rep) {
    {   LP; if (!((P.skip >> 3) & 1)) {
        pg8::SchedDense S; S.init(T_, 2048, 1024, 1024, G, c); pg8::EpiUp<1> E{(bf16_t*)(ws + WS_GA), 1024};
        pg8::gemm_phase<false>(ldsl, (const char*)(ws + WS_BIG), (const char*)(ws + WS_WGLU), 1024, S, E); } }
    GSYNC(); } STAMP(5);
#endif
    { LP; if (!((P.skip >> 4) & 1)) ln_phase<0, true>(P, (LEVEL >= 1) ? P.x : H, P.ln_g, P.ln_b, lds, H, (bf16_t*)(ws + WS_H16), (LEVEL >= 1) ? (const bf16_t*)(ws + WS_GA) : nullptr); }
    GSYNC(); STAMP(6);
#if LEVEL >= 2
#pragma unroll 1
    for (int rep = 0; rep < NREP_FUP; ++rep) {
    {   LP; if (!((P.skip >> 5) & 1)) {
        pg8::SchedDense S; S.init(T_, 2 * FF_, 1024, 1024, G, c); pg8::EpiUp<0> E{(bf16_t*)(ws + WS_BIG), FF_};
        pg8::gemm_phase<true>(ldsl, (const char*)(ws + WS_H16), (const char*)(ws + WS_WUP), 1024, S, E); } }
    GSYNC(); } STAMP(7);
#pragma unroll 1
    for (int rep = 0; rep < NREP_FDN; ++rep) {
    {   LP; if (!((P.skip >> 6) & 1)) {
#define NREP_CUR NREP_FDN
        pg8::SchedDense S; S.init(T_, 1024, FF_, FF_, G, c); pg8::EpiBf16 E{(bf16_t*)(ws + WS_GA), 1024};
        pg8::gemm_phase<false>(ldsl, (const char*)(ws + WS_BIG), (const char*)(ws + WS_WDN), FF_, S, E); } }
    GSYNC(); } STAMP(8);
#endif
    { LP; if (!((P.skip >> 7) & 1)) ln_phase<0, false>(P, H, P.ln_g + 1024, P.ln_b + 1024, lds, H, (bf16_t*)(ws + WS_H16), (LEVEL >= 2) ? (const bf16_t*)(ws + WS_GA) : nullptr); }
    GSYNC(); STAMP(9);
#if LEVEL >= 3
#pragma unroll 1
    for (int rep = 0; rep < NREP_QKV; ++rep) {
    {   LP; if (!((P.skip >> 8) & 1)) {
        pg8::SchedDense S; S.init(T_, 1536, 1024, 1024, G, c);
        pg8::EpiQkv E{(bf16_t*)(ws + WS_BIG), (bf16_t*)(ws + WS_BIG + 64 * MiB), (bf16_t*)(ws + WS_BIG + 80 * MiB), (const float*)(ws + WS_ROPEC), (const float*)(ws + WS_ROPES)};
        pg8::gemm_phase<true>(ldsl, (const char*)(ws + WS_H16), (const char*)(ws + WS_WQKV), 1024, S, E); } }
    GSYNC(); } STAMP(10);
#ifndef SKIP_ATT
    { LP; if (!((P.skip >> 9) & 1)) attn_phase(P, lds); }
#endif
    GSYNC(); STAMP(11);
#pragma unroll 1
    for (int rep = 0; rep < NREP_OUT; ++rep) {
    {   LP; if (!((P.skip >> 10) & 1)) {
#undef NREP_CUR
#define NREP_CUR NREP_OUT
        pg8::SchedDense S; S.init(T_, 1024, 1024, 1024, G, c);
        pg8::EpiBf16 E{(bf16_t*)(ws + WS_GA), 1024};
        pg8::gemm_phase<false>(ldsl, (const char*)(ws + WS_BIG + 96 * MiB), (const char*)(ws + WS_WO), 1024, S, E); } }
    GSYNC(); } STAMP(12);
#endif
#if LEVEL >= 4
    { LP; if (!((P.skip >> 11) & 1)) ln_phase<1, false>(P, H, P.ln_g + 2048, P.ln_b + 2048, lds, H, (bf16_t*)(ws + WS_H16), (const bf16_t*)(ws + WS_GA)); }
    GSYNC(); STAMP(13);
#pragma unroll 1
    for (int rep = 0; rep < NREP_GATH; ++rep) {
    { LP; if (!((P.skip >> 12) & 1)) gather_phase(P); }
    GSYNC(); } STAMP(14);
#pragma unroll 1
    for (int rep = 0; rep < NREP_MUP; ++rep) {
    {   LP; if (!((P.skip >> 13) & 1)) {
        pg8::SchedMoe S; S.init((const int*)(ws + WS_CNT), 2048, 1024, (size_t)2048 * 1024 * 2, G, c); pg8::EpiUp<0> E{(bf16_t*)(ws + WS_BIG), 1024};
        pg8::gemm_phase<true>(ldsl, (const char*)(ws + WS_GA), (const char*)(ws + WS_WMUP), 1024, S, E); } }
    GSYNC(); } STAMP(15);
#pragma unroll 1
    for (int rep = 0; rep < NREP_MDN; ++rep) {
    {   LP; if (!((P.skip >> 14) & 1)) {
        pg8::SchedMoe S; S.init((const int*)(ws + WS_CNT), 1024, 1024, (size_t)1024 * 1024 * 2, G, c); pg8::EpiBf16 E{(bf16_t*)(ws + WS_Y), 1024};
        pg8::gemm_phase<false>(ldsl, (const char*)(ws + WS_BIG), (const char*)(ws + WS_WMDN), 1024, S, E); } }
    GSYNC(); } STAMP(16);
    { LP; if (!((P.skip >> 15) & 1)) ln_phase<2, false>(P, H, P.ln_g + 3072, P.ln_b + 3072, lds, H, (bf16_t*)(ws + WS_H16), nullptr); }
#ifdef PROF_A_HI
    GSYNC(); STAMP(17);
    {   LP; const unsigned long long* stamps = (const unsigned long long*)(P.ws + WS_CNT + 1024);
        const float tA = (float)(stamps[PROF_A_HI] - stamps[PROF_A_LO]) * 0.01f, tB = (float)(stamps[PROF_B_HI] - stamps[PROF_B_LO]) * 0.01f;
        for (int i = blockIdx.x * 512 + threadIdx.x; i < (1 << 22); i += gridDim.x * 512) H[(size_t)i * 8 + 1] = tB;
        if (blockIdx.x == 0 && threadIdx.x == 0) H[0] = 64.0f * tA; }
#endif
#ifdef PROF_A_HI
#endif
    }
#else
    { LP; ln_phase<0, false>(P, H, P.ln_g + 2048, P.ln_b + 2048, lds, H, (bf16_t*)(ws + WS_H16), (LEVEL >= 3) ? (const bf16_t*)(ws + WS_GA) : nullptr); }
    GSYNC(); STAMP(13);
    { LP; ln_phase<0, false>(P, H, P.ln_g + 3072, P.ln_b + 3072, lds, H, (bf16_t*)(ws + WS_H16), nullptr); }
#endif
}

extern "C" void kernel_launch(void* const* d_in, const int* in_sizes, int n_in, void* d_out, int out_size, void* d_ws, size_t ws_size, hipStream_t stream) {
    static int grid_blocks = 0;
    if (grid_blocks == 0) {
        if (n_in != 25 || out_size != T_ * D_ || ws_size < WS_END) { fprintf(stderr, "kernel_launch: unexpected shapes (n_in %d out %d ws %zu)\n", n_in, out_size, ws_size); grid_blocks = -1; return; }
        int dev = 0, cus = 0, per_cu = 0;
        hipGetDevice(&dev); hipDeviceGetAttribute(&cus, hipDeviceAttributeMultiprocessorCount, dev);
        if (hipFuncSetAttribute((const void*)yoco_fwd, hipFuncAttributeMaxDynamicSharedMemorySize, LDS_BYTES) != hipSuccess) { fprintf(stderr, "kernel_launch: hipFuncSetAttribute failed\n"); grid_blocks = -1; return; }
        if (hipOccupancyMaxActiveBlocksPerMultiprocessor(&per_cu, (const void*)yoco_fwd, 512, LDS_BYTES) != hipSuccess || per_cu < 1) { fprintf(stderr, "kernel_launch: occupancy query says %d\n", per_cu); per_cu = 1; (void)hipGetLastError(); }
        grid_blocks = cus * 1;
    }
    if (grid_blocks < 0) return;
    Params p{};
    p.x = (const float*)d_in[0]; p.pos = (const int*)d_in[1]; p.ln_g = (const float*)d_in[2]; p.ln_b = (const float*)d_in[3];
    p.lam_re = (const float*)d_in[4]; p.lam_im = (const float*)d_in[5]; p.log_step = (const float*)d_in[6]; p.b_re = (const float*)d_in[7]; p.b_im = (const float*)d_in[8];
    p.c_re = (const float*)d_in[9]; p.c_im = (const float*)d_in[10]; p.ssm_d = (const float*)d_in[11]; p.w_glu = (const float*)d_in[12]; p.kv_w = (const float*)d_in[13];
    p.w_q = (const float*)d_in[14]; p.sinks = (const float*)d_in[15]; p.w_out = (const float*)d_in[16]; p.ffn_g = (const float*)d_in[17]; p.ffn_u = (const float*)d_in[18]; p.ffn_d = (const float*)d_in[19];
    p.w_router = (const float*)d_in[20]; p.b_router = (const float*)d_in[21]; p.moe_g = (const float*)d_in[22]; p.moe_u = (const float*)d_in[23]; p.moe_d = (const float*)d_in[24];
    p.out = (float*)d_out; p.ws = (unsigned char*)d_ws;
    void* args[] = {&p};
#ifdef SKIP_PROBE
    p.skip = SKIP_PROBE; (void)hipLaunchCooperativeKernel((const void*)yoco_fwd, dim3(grid_blocks), dim3(512), args, LDS_BYTES, stream); p.skip = 0;
#endif
    hipError_t e = hipLaunchCooperativeKernel((const void*)yoco_fwd, dim3(grid_blocks), dim3(512), args, LDS_BYTES, stream);
    if (e != hipSuccess) fprintf(stderr, "cooperative launch failed: %s (grid %d)\n", hipGetErrorString(e), grid_blocks);
}
```

```cpp
#include <hip/hip_runtime.h>
#include <hip/hip_cooperative_groups.h>
#include <cstdio>
namespace cg = cooperative_groups;

#ifndef LEVEL
#define LEVEL 4
#endif

#ifdef DUP_S1
#define NREP_S1 2
#else
#define NREP_S1 1
#endif
#ifdef DUP_S2
#define NREP_S2 2
#else
#define NREP_S2 1
#endif
#ifdef DUP_GLU
#define NREP_GLU 2
#else
#define NREP_GLU 1
#endif
#ifdef DUP_FUP
#define NREP_FUP 2
#else
#define NREP_FUP 1
#endif
#if defined(DUP_FDN) || defined(DUP_FDNNULL)
#define NREP_FDN 2
#else
#define NREP_FDN 1
#endif
#ifdef DUP_QKV
#define NREP_QKV 2
#else
#define NREP_QKV 1
#endif
#if defined(DUP_OUT) || defined(DUP_OUTNULL)
#define NREP_OUT 2
#else
#define NREP_OUT 1
#endif
#ifdef DUP_MUP
#define NREP_MUP 2
#else
#define NREP_MUP 1
#endif
#ifdef DUP_MDN
#define NREP_MDN 2
#else
#define NREP_MDN 1
#endif
#ifdef DUP_SCAN
#define NREP_SCAN 2
#else
#define NREP_SCAN 1
#endif
#ifdef DUP_GATH
#define NREP_GATH 2
#else
#define NREP_GATH 1
#endif
#ifdef DUP_OUTNULL
#define SKIP_EPI_OUT (rep == 0)
#else
#define SKIP_EPI_OUT false
#endif
#ifdef DUP_FDNNULL
#define SKIP_EPI_FDN (rep == 0)
#else
#define SKIP_EPI_FDN false
#endif
#define LAS __attribute__((address_space(3)))
typedef unsigned short bf16_t;
typedef short bf16x8 __attribute__((ext_vector_type(8)));
typedef float f32x4 __attribute__((ext_vector_type(4)));
typedef float f32x16 __attribute__((ext_vector_type(16)));
typedef unsigned u32x4 __attribute__((ext_vector_type(4)));
typedef unsigned u32x2 __attribute__((ext_vector_type(2)));

constexpr int T_ = 32768, D_ = 1024, FF_ = 2816;
constexpr float ALPHA = 1.41421356237309515f;
constexpr float LN_EPS = 1e-5f;
constexpr size_t MiB = 1ull << 20;
constexpr size_t WS_CNT = 0, WS_BAR = 4096, WS_A32 = 65536, WS_ROPEC = 1 * MiB, WS_ROPES = 2 * MiB, WS_LIST = 3 * MiB, WS_TOK = 4 * MiB;
constexpr size_t WS_WMUP = 8 * MiB, WS_WMDN = 40 * MiB, WS_WGLU = 56 * MiB, WS_WUP = 60 * MiB, WS_WDN = 71 * MiB, WS_WQKV = 77 * MiB, WS_WO = 80 * MiB;
constexpr size_t WS_H16 = 82 * MiB, WS_BT2 = 146 * MiB, WS_BT1 = 186 * MiB, WS_XA = 202 * MiB, WS_SST = 282 * MiB, WS_GA = 146 * MiB, WS_Y = 146 * MiB;
constexpr size_t WS_BIG = 314 * MiB, WS_END = 490 * MiB;
constexpr size_t XAG_GSTRIDE = (size_t)1024 * 640 * 2;
constexpr int LDS_BYTES = 131072 + 16;

struct Params {
    const float* x; const int* pos; const float* ln_g; const float* ln_b;
    const float* lam_re; const float* lam_im; const float* log_step; const float* b_re; const float* b_im; const float* c_re; const float* c_im;
    const float* ssm_d; const float* w_glu; const float* kv_w; const float* w_q; const float* sinks; const float* w_out;
    const float* ffn_g; const float* ffn_u; const float* ffn_d; const float* w_router; const float* b_router;
    const float* moe_g; const float* moe_u; const float* moe_d;
    float* out; unsigned char* ws; int skip; int pad;
};

__device__ __forceinline__ unsigned pk_bf16(float lo, float hi) { unsigned r; asm volatile("v_cvt_pk_bf16_f32 %0, %1, %2" : "=v"(r) : "v"(lo), "v"(hi)); return r; }
typedef _Float16 f16x8 __attribute__((ext_vector_type(8)));
typedef _Float16 f16x2 __attribute__((ext_vector_type(2)));
__device__ __forceinline__ unsigned pk_f16(float lo, float hi) { union { f16x2 h; unsigned u; } c; c.h = (f16x2){(_Float16)lo, (_Float16)hi}; return c.u; }
__device__ __forceinline__ float hf_lo(unsigned w) { union { unsigned u; f16x2 h; } c; c.u = w; return (float)c.h[0]; }
__device__ __forceinline__ float hf_hi(unsigned w) { union { unsigned u; f16x2 h; } c; c.u = w; return (float)c.h[1]; }
__device__ __forceinline__ float bf_lo(unsigned w) { return __uint_as_float(w << 16); }
__device__ __forceinline__ float bf_hi(unsigned w) { return __uint_as_float(w & 0xffff0000u); }
__device__ __forceinline__ float sigmoidf_(float x) { return __builtin_amdgcn_rcpf(1.0f + __expf(-x)); }
__device__ __forceinline__ float gelu_tanh(float y) { const float u = 1.5957691216057308f * (y + 0.044715f * y * y * y); return y * sigmoidf_(u); }
__device__ __forceinline__ float xor16(float v) { const unsigned u = __float_as_uint(v); const auto r = __builtin_amdgcn_permlane16_swap(u, u, false, false); return __uint_as_float(r[0] == u ? r[1] : r[0]); }
__device__ __forceinline__ float wave_sum(float v) {
    v += __shfl_xor(v, 32); v += __shfl_xor(v, 16); v += __shfl_xor(v, 8); v += __shfl_xor(v, 4); v += __shfl_xor(v, 2); v += __shfl_xor(v, 1); return v; }


#define XB_TMO      128
#define XB_XCNT(j)  (256  + 64 * (j))
#define XB_XSUB(j)  (1280 + 64 * (j))
#define XB_XGEN(j)  (2304 + 64 * (j))
#define XB_TOP      3328
#define XB_TOPGEN   3392
#define XCD_BAR_WORDS 3456
#define XB_SPIN_CAP (1u << 22)
__device__ __forceinline__ unsigned xb_ld(unsigned* p)              { return __hip_atomic_load(p, __ATOMIC_RELAXED, __HIP_MEMORY_SCOPE_AGENT); }
__device__ __forceinline__ unsigned xb_add(unsigned* p, unsigned v) { return __hip_atomic_fetch_add(p, v, __ATOMIC_RELAXED, __HIP_MEMORY_SCOPE_AGENT); }
__device__ __forceinline__ unsigned xb_xcc_id() { return (unsigned)__builtin_amdgcn_s_getreg((3 << 11) | 20) & 0xFu; }
#define XB_SPIN(cond, bar) do { unsigned _sp = 0; while (cond) { __builtin_amdgcn_s_sleep(1); \
    if ((++_sp & 255u) == 0u) { if (xb_ld(&(bar)[XB_TMO])) break; if (_sp > XB_SPIN_CAP) { atomicAdd(&(bar)[XB_TMO], 1u); break; } } } } while (0)
__device__ __forceinline__ void xcd_barrier_complete(unsigned* bar, unsigned x, unsigned& nloc, unsigned& nx) {
    const unsigned G = gridDim.x * gridDim.y * gridDim.z;
    unsigned sum, cnt, mine, sp = 0u;
    for (;;) {
        sum = 0u; cnt = 0u; mine = 0u;
#pragma unroll
        for (unsigned j = 0; j < 16; ++j) { const unsigned c = xb_ld(&bar[XB_XCNT(j)]); sum += c; cnt += (c > 0u) ? 1u : 0u; mine = (j == x) ? c : mine; }
        if (sum == G) break;
        __builtin_amdgcn_s_sleep(1);
        if ((++sp & 255u) == 0u) { if (xb_ld(&bar[XB_TMO])) break; if (sp > XB_SPIN_CAP) { atomicAdd(&bar[XB_TMO], 1u); break; } }
    }
    nloc = mine > 0u ? mine : 1u; nx = cnt > 0u ? cnt : 1u;
}
__device__ __forceinline__ void xcd_barrier(unsigned* bar, volatile LAS unsigned* st) {
    asm volatile("s_waitcnt vmcnt(0)" ::: "memory");
    __syncthreads();
    if (threadIdx.x == 0) {
        const unsigned x = xb_xcc_id();
        __builtin_amdgcn_s_waitcnt(0);
        unsigned nloc = st[0], nx = st[1];
        if (nloc == 0u) { xcd_barrier_complete(bar, x, nloc, nx); st[0] = nloc; st[1] = nx; }
        const unsigned old = xb_add(&bar[XB_XSUB(x)], 1u);
        const unsigned gen = old / nloc;
        if (old + 1u == (gen + 1u) * nloc) {
            __builtin_amdgcn_fence(__ATOMIC_RELEASE, "agent");
            asm volatile("s_waitcnt vmcnt(0)" ::: "memory");
            const unsigned og = xb_add(&bar[XB_TOP], 1u);
            const unsigned tg = og / nx;
            if (og + 1u == (tg + 1u) * nx) xb_add(&bar[XB_TOPGEN], 1u);
            else XB_SPIN(xb_ld(&bar[XB_TOPGEN]) == tg, bar);
            __builtin_amdgcn_fence(__ATOMIC_ACQUIRE, "agent");
            xb_add(&bar[XB_XGEN(x)], 1u);
            asm volatile("s_waitcnt vmcnt(0)" ::: "memory");
        } else {
            XB_SPIN(xb_ld(&bar[XB_XGEN(x)]) == gen, bar);
            __builtin_amdgcn_fence(__ATOMIC_ACQUIRE, "agent");
            asm volatile("s_waitcnt vmcnt(0)" ::: "memory");
        }
    }
    __syncthreads();
}

namespace pg8 {
constexpr int BM = 256, BK = 64, HALF = 128, HTB = HALF * BK * 2, NXCD = 8, WGM = 8;
__device__ __forceinline__ int lds_byte(int r, int c) { const int st = (r >> 4) * 2 + (c >> 5), rr = r & 15, cc = c & 31, ob = rr * 64 + cc * 2; return st * 1024 + (ob ^ (((ob >> 9) & 1) << 5)); }
__device__ __forceinline__ void stage_rc(int b, int& R, int& C) { const int st = b / 1024, sb = b % 1024, swz = sb ^ (((sb >> 9) & 1) << 5); R = (st >> 1) * 16 + swz / 64; C = (st & 1) * 32 + (swz % 64) / 2; }
__device__ __forceinline__ int perm32(int rho) { const int n = rho >> 4, i = rho & 15; return 8 * (i >> 2) + 4 * n + (i & 3); }
__device__ __forceinline__ int xcd_remap(int L, int nwg) { const int q = nwg / NXCD, r = nwg % NXCD, xcd = L % NXCD, off = L / NXCD; return (xcd < r ? xcd * (q + 1) : r * (q + 1) + (xcd - r) * q) + off; }

struct Unit { int pm, pn, aux, pad; size_t a_off, b_off; };

struct SchedDense {
    int nM, nN, nwg, G, c, lda, K;
    __device__ __forceinline__ void init(int M, int N, int K_, int lda_, int G_, int c_) { nM = M / BM; nN = N / BM; nwg = nM * nN; G = G_; c = c_; lda = lda_; K = K_; }
    __device__ __forceinline__ bool next(int i, Unit& u) const {
        const int L = i * G + c; if (L >= nwg) return false;
        const int wgid = xcd_remap(L, nwg);
        const int nig = WGM * nN, gid = wgid / nig, fm = gid * WGM, gsz = (nM - fm) < WGM ? (nM - fm) : WGM;
        u.pm = fm + ((wgid % nig) % gsz); u.pn = (wgid % nig) / gsz; u.aux = 0; u.pad = 0;
        u.a_off = (size_t)u.pm * BM * lda * 2; u.b_off = (size_t)u.pn * BM * K * 2; return true;
    }
    __device__ __forceinline__ unsigned voffA(int R, int C) const { return (unsigned)(R * lda + C) * 2u; }
    __device__ __forceinline__ size_t a_kstep() const { return BK * 2; }
    __device__ __forceinline__ size_t a_hstep() const { return (size_t)HALF * lda * 2; }
};
struct SchedMoe {
    int nM, nN, nwg, G, c, K; int tb[9]; size_t estride;
    __device__ __forceinline__ void init(const int* cnt, int N, int K_, size_t estride_, int G_, int c_) {
        tb[0] = 0;
#pragma unroll
        for (int e = 0; e < 8; ++e) tb[e + 1] = tb[e] + ((cnt[e] + 255) >> 8);
        nM = tb[8]; nN = N / BM; nwg = nM * nN; G = G_; c = c_; K = K_; estride = estride_; }
    __device__ __forceinline__ bool next(int i, Unit& u) const {
        const int L = i * G + c; if (L >= nwg) return false;
        const int wgid = xcd_remap(L, nwg);
        const int nig = WGM * nN, gid = wgid / nig, fm = gid * WGM, gsz = (nM - fm) < WGM ? (nM - fm) : WGM;
        u.pm = fm + ((wgid % nig) % gsz); u.pn = (wgid % nig) / gsz; int e = 0;
#pragma unroll
        for (int k = 1; k < 8; ++k) e += (u.pm >= tb[k]) ? 1 : 0;
        u.aux = e; u.pad = 0;
        u.a_off = (size_t)u.pm * BM * 1024 * 2; u.b_off = (size_t)e * estride + (size_t)u.pn * BM * K * 2; return true;
    }
    __device__ __forceinline__ unsigned voffA(int R, int C) const { return (unsigned)(R * 1024 + C) * 2u; }
    __device__ __forceinline__ size_t a_kstep() const { return BK * 2; }
    __device__ __forceinline__ size_t a_hstep() const { return (size_t)HALF * 1024 * 2; }
};
struct SchedSsm {
    int nN, nwg, G, c, K, N;
    __device__ __forceinline__ void init(int N_, int K_, int G_, int c_) { N = N_; nN = N_ / BM; nwg = 64 * 4 * nN; G = G_; c = c_; K = K_; }
    __device__ __forceinline__ bool next(int i, Unit& u) const {
        const int L = i * G + c; if (L >= nwg) return false;
        const int wgid = xcd_remap(L, nwg);
        const int per = 4 * nN, g = (wgid / (4 * per)) * 4 + (wgid & 3), rem = (wgid >> 2) % per;
        u.pm = rem & 3; u.pn = rem >> 2; u.aux = g; u.pad = 0;
        u.a_off = (size_t)g * XAG_GSTRIDE + (size_t)u.pm * BM * 640 * 2; u.b_off = (size_t)g * N * K * 2 + (size_t)u.pn * BM * K * 2; return true;
    }
    __device__ __forceinline__ unsigned voffA(int R, int C) const { return (unsigned)(R * 640 + C) * 2u; }
    __device__ __forceinline__ size_t a_kstep() const { return BK * 2; }
    __device__ __forceinline__ size_t a_hstep() const { return (size_t)HALF * 640 * 2; }
};

template <bool F16, class Epi, class Sched>
__device__ __forceinline__ void gemm_phase(LAS unsigned char* lds, const char* Ab, const char* Bb, const int K, const Sched& S, const Epi& E) {
    const int tid = threadIdx.x, wid = __builtin_amdgcn_readfirstlane(tid >> 6), lane = tid & 63, wr = wid >> 2, wc = wid & 3, fr = lane & 15, fq = lane >> 4;
    const int nt = K / BK;
    unsigned voffA[2], voffB[2];
#pragma unroll
    for (int i = 0; i < 2; ++i) { int R, C; stage_rc(tid * 16 + i * 8192, R, C); const int Rb = Epi::PERM ? ((R & ~31) + perm32(R & 31)) : R;
        voffA[i] = S.voffA(R, C); voffB[i] = (unsigned)(Rb * K + C) * 2u; }
    const size_t kstepA = S.a_kstep(), hstepA = S.a_hstep(), kstepB = (size_t)(BK * 2), hstepB = (size_t)HALF * K * 2;
    const unsigned ldsw = (unsigned)wid * 1024u;
    const int aoff = lds_byte(wr * 64 + fr, fq * 8), boff = lds_byte(wc * 32 + fr, fq * 8);
#define PG8_SA(b, h) (((b) * 2 + (h)) * HTB)
#define PG8_SB(b, h) ((4 + (b) * 2 + (h)) * HTB)
#define PG8_STAGE(bufoff, gbase, voff) do { _Pragma("unroll") for (int _i = 0; _i < 2; ++_i) \
        __builtin_amdgcn_global_load_lds((const unsigned*)((const char*)(gbase) + (voff)[_i]), (LAS unsigned*)(lds + (bufoff) + ldsw + _i * 8192), 16, 0, 0); } while (0)
#define PG8_LDA(dst, b, h) do { _Pragma("unroll") for (int m = 0; m < 4; ++m) _Pragma("unroll") for (int k = 0; k < 2; ++k) dst[m][k] = *(const LAS bf16x8*)(lds + PG8_SA(b, h) + aoff + m * 2048 + k * 1024); } while (0)
#define PG8_LDB(dst, b, h) do { _Pragma("unroll") for (int n = 0; n < 2; ++n) _Pragma("unroll") for (int k = 0; k < 2; ++k) dst[n][k] = *(const LAS bf16x8*)(lds + PG8_SB(b, h) + boff + n * 2048 + k * 1024); } while (0)
#define PG8_MMA(ai, bj, At, Bt) do { __builtin_amdgcn_s_setprio(1); _Pragma("unroll") for (int m = 0; m < 4; ++m) _Pragma("unroll") for (int n = 0; n < 2; ++n) _Pragma("unroll") for (int k = 0; k < 2; ++k) \
        acc[ai][bj][m][n] = F16 ? __builtin_amdgcn_mfma_f32_16x16x32_f16(__builtin_bit_cast(f16x8, Bt[n][k]), __builtin_bit_cast(f16x8, At[m][k]), acc[ai][bj][m][n], 0, 0, 0) : __builtin_amdgcn_mfma_f32_16x16x32_bf16(Bt[n][k], At[m][k], acc[ai][bj][m][n], 0, 0, 0); __builtin_amdgcn_s_setprio(0); } while (0)
#define PG8_WAIT_V(n) asm volatile("s_waitcnt vmcnt(" #n ")" ::: "memory")
#define PG8_WAIT_L(n) asm volatile("s_waitcnt lgkmcnt(" #n ")" ::: "memory")
#define PG8_BAR __builtin_amdgcn_s_barrier()
#define PG8_SCHED __builtin_amdgcn_sched_barrier(0)
    Unit cur, nxt; int ui = 0;
    if (!S.next(0, cur)) return;
    f32x4 acc[2][2][4][2];
#pragma unroll
    for (int a = 0; a < 2; ++a)
#pragma unroll
        for (int b = 0; b < 2; ++b)
#pragma unroll
            for (int m = 0; m < 4; ++m)
#pragma unroll
                for (int n = 0; n < 2; ++n) acc[a][b][m][n] = (f32x4){0.f, 0.f, 0.f, 0.f};
    bf16x8 At[4][2], B0[2][2], B1[2][2];
    const char* cA = Ab + cur.a_off; const char* cB = Bb + cur.b_off;
    PG8_STAGE(PG8_SB(0, 0), cB, voffB); PG8_STAGE(PG8_SA(0, 0), cA, voffA); PG8_STAGE(PG8_SB(0, 1), cB + hstepB, voffB); PG8_STAGE(PG8_SA(0, 1), cA + hstepA, voffA);
    if (wr == 1) PG8_BAR;
    PG8_WAIT_V(4); PG8_BAR;
    PG8_STAGE(PG8_SB(1, 0), cB + kstepB, voffB); PG8_STAGE(PG8_SA(1, 0), cA + kstepA, voffA); PG8_STAGE(PG8_SB(1, 1), cB + hstepB + kstepB, voffB);
    PG8_WAIT_V(6); PG8_BAR;
    for (;;) {
        const bool has_next = S.next(ui + 1, nxt);
        const char* nA = has_next ? Ab + nxt.a_off : cA; const char* nB = has_next ? Bb + nxt.b_off : cB;
        for (int t = 0; t < nt; t += 2) {
            const bool last = (t == nt - 2);
            const char* a1 = cA + (size_t)(t + 1) * kstepA;
            const char* a2 = last ? nA : cA + (size_t)(t + 2) * kstepA; const char* b2 = last ? nB : cB + (size_t)(t + 2) * kstepB;
            const char* a3 = a2 + kstepA; const char* b3 = b2 + kstepB;
            PG8_LDB(B0, 0, 0); PG8_SCHED; PG8_LDA(At, 0, 0); PG8_STAGE(PG8_SA(1, 1), a1 + hstepA, voffA);
            PG8_WAIT_L(8); PG8_BAR; PG8_WAIT_L(0); PG8_MMA(0, 0, At, B0); PG8_BAR; PG8_SCHED;
            PG8_LDB(B1, 0, 1); PG8_STAGE(PG8_SB(0, 0), b2, voffB);
            PG8_BAR; PG8_WAIT_L(0); PG8_MMA(0, 1, At, B1); PG8_BAR;
            PG8_LDA(At, 0, 1); PG8_STAGE(PG8_SA(0, 0), a2, voffA);
            PG8_BAR; PG8_WAIT_L(0); PG8_MMA(1, 0, At, B0); PG8_BAR; PG8_SCHED;
            PG8_STAGE(PG8_SB(0, 1), b2 + hstepB, voffB);
            PG8_WAIT_V(6); PG8_BAR; PG8_MMA(1, 1, At, B1); PG8_BAR;
            PG8_LDB(B0, 1, 0); PG8_SCHED; PG8_LDA(At, 1, 0); PG8_STAGE(PG8_SA(0, 1), a2 + hstepA, voffA);
            PG8_WAIT_L(8); PG8_BAR; PG8_WAIT_L(0); PG8_MMA(0, 0, At, B0); PG8_BAR; PG8_SCHED;
            PG8_LDB(B1, 1, 1); PG8_STAGE(PG8_SB(1, 0), b3, voffB);
            PG8_BAR; PG8_WAIT_L(0); PG8_MMA(0, 1, At, B1); PG8_BAR;
            PG8_LDA(At, 1, 1); PG8_STAGE(PG8_SA(1, 0), a3, voffA);
            PG8_BAR; PG8_WAIT_L(0); PG8_MMA(1, 0, At, B0); PG8_BAR; PG8_SCHED;
            PG8_STAGE(PG8_SB(1, 1), b3 + hstepB, voffB);
            PG8_WAIT_V(6); PG8_BAR; PG8_MMA(1, 1, At, B1); PG8_BAR;
        }
        E(acc, cur, wr, wc, fr, fq);
        if (!has_next) break;
#pragma unroll
        for (int a = 0; a < 2; ++a)
#pragma unroll
            for (int b = 0; b < 2; ++b)
#pragma unroll
                for (int m = 0; m < 4; ++m)
#pragma unroll
                    for (int n = 0; n < 2; ++n) acc[a][b][m][n] = (f32x4){0.f, 0.f, 0.f, 0.f};
        cur = nxt; cA = nA; cB = nB; ++ui;
    }
    PG8_WAIT_V(0);
    if (wr == 0) PG8_BAR;
    PG8_BAR;
#undef PG8_SA
#undef PG8_SB
#undef PG8_STAGE
#undef PG8_LDA
#undef PG8_LDB
#undef PG8_MMA
#undef PG8_WAIT_V
#undef PG8_WAIT_L
#undef PG8_BAR
#undef PG8_SCHED
}

typedef const f32x4 (&AccRef)[2][2][4][2];

struct EpiS1 {
    static constexpr bool PERM = false; float* sst;
    __device__ __forceinline__ void operator()(AccRef acc, const Unit& u, int wr, int wc, int fr, int fq) const {
#pragma unroll
        for (int ai = 0; ai < 2; ++ai)
#pragma unroll
            for (int m = 0; m < 4; ++m) { const int row = u.pm * BM + ai * HALF + wr * 64 + m * 16 + fr; float* rp = sst + ((size_t)row * 64 + u.aux) * 128 + wc * 32 + 4 * fq;
#pragma unroll
                for (int n = 0; n < 2; ++n) *(f32x4*)(rp + 16 * n) = acc[ai][0][m][n]; }
    }
};
struct EpiS2 {
    static constexpr bool PERM = true; bf16_t* g16;
    __device__ __forceinline__ void operator()(AccRef acc, const Unit& u, int wr, int wc, int fr, int fq) const {
        const int ch = u.aux * 16 + 8 * (fq & 1);
#pragma unroll
        for (int ai = 0; ai < 2; ++ai)
#pragma unroll
            for (int m = 0; m < 4; ++m) { const int row = u.pm * BM + ai * HALF + wr * 64 + m * 16 + fr;
#pragma unroll
                for (int bj = 0; bj < 2; ++bj) { const int t = 16 * u.pn + 8 * bj + 2 * wc + (fq >> 1);
                    const f32x4 y0 = acc[ai][bj][m][0], y1 = acc[ai][bj][m][1];
                    u32x4 w; w.x = pk_bf16(gelu_tanh(y0[0]), gelu_tanh(y0[1])); w.y = pk_bf16(gelu_tanh(y0[2]), gelu_tanh(y0[3]));
                    w.z = pk_bf16(gelu_tanh(y1[0]), gelu_tanh(y1[1])); w.w = pk_bf16(gelu_tanh(y1[2]), gelu_tanh(y1[3]));
                    *(u32x4*)(g16 + ((size_t)row * 32 + t) * 1024 + ch) = w; } }
    }
};
struct EpiGlu {
    static constexpr bool PERM = false; const float* x; float* out;
    __device__ __forceinline__ void operator()(AccRef acc, const Unit& u, int wr, int wc, int fr, int fq) const {
#pragma unroll
        for (int ai = 0; ai < 2; ++ai)
#pragma unroll
            for (int m = 0; m < 4; ++m) { const int row = u.pm * BM + ai * HALF + wr * 64 + m * 16 + fr; const size_t off = (size_t)row * 1024 + u.pn * 128 + wc * 32 + 4 * fq;
#pragma unroll
                for (int n = 0; n < 2; ++n) { const f32x4 xv = *(const f32x4*)(x + off + 16 * n); const f32x4 v = acc[ai][0][m][n], g = acc[ai][1][m][n]; f32x4 o;
#pragma unroll
                    for (int j = 0; j < 4; ++j) o[j] = ALPHA * xv[j] + v[j] * sigmoidf_(g[j]);
                    *(f32x4*)(out + off + 16 * n) = o; } }
    }
};
template <int ACT> struct EpiUp {
    static constexpr bool PERM = true; bf16_t* act; int ld;
    __device__ __forceinline__ void operator()(AccRef acc, const Unit& u, int wr, int wc, int fr, int fq) const {
#pragma unroll
        for (int ai = 0; ai < 2; ++ai)
#pragma unroll
            for (int m = 0; m < 4; ++m) { const int row = u.pm * BM + ai * HALF + wr * 64 + m * 16 + fr; float r[8];
#pragma unroll
                for (int n = 0; n < 2; ++n)
#pragma unroll
                    for (int j = 0; j < 4; ++j) { const float g = acc[ai][0][m][n][j], up = acc[ai][1][m][n][j]; r[4 * n + j] = (ACT == 0) ? g * sigmoidf_(g) * up : g * sigmoidf_(up); }
                u32x4 w; w.x = pk_bf16(r[0], r[1]); w.y = pk_bf16(r[2], r[3]); w.z = pk_bf16(r[4], r[5]); w.w = pk_bf16(r[6], r[7]);
                *(u32x4*)(act + (size_t)row * ld + u.pn * 128 + wc * 32 + 8 * fq) = w; }
    }
};
struct EpiRes {
    static constexpr bool PERM = false; const float* hin; float* h; bool skip;
    __device__ __forceinline__ void operator()(AccRef acc, const Unit& u, int wr, int wc, int fr, int fq) const {
        if (skip) return;
#pragma unroll
        for (int ai = 0; ai < 2; ++ai)
#pragma unroll
            for (int m = 0; m < 4; ++m) { const int row = u.pm * BM + ai * HALF + wr * 64 + m * 16 + fr; const size_t ro = (size_t)row * 1024 + u.pn * BM + wc * 32 + 4 * fq;
#pragma unroll
                for (int bj = 0; bj < 2; ++bj)
#pragma unroll
                    for (int n = 0; n < 2; ++n) { const size_t o = ro + bj * HALF + 16 * n; const f32x4 hv = *(const f32x4*)(hin + o); *(f32x4*)(h + o) = ALPHA * hv + acc[ai][bj][m][n]; } }
    }
};
struct EpiQkv {
    static constexpr bool PERM = true; bf16_t* q; bf16_t* k; bf16_t* v; const float* rc; const float* rs;
    __device__ __forceinline__ void operator()(AccRef acc, const Unit& u, int wr, int wc, int fr, int fq) const {
        const bool rope = (u.pn <= 4) && ((wc & 1) == 0);
        bf16_t* base; int ld, colt; float scale = 1.0f;
        if (u.pn < 4) { base = q; ld = 1024; colt = u.pn * BM; scale = 0.125f * 1.4426950408889634f; } else if (u.pn == 4) { base = k; ld = 256; colt = 0; } else { base = v; ld = 256; colt = 0; }
#pragma unroll
        for (int ai = 0; ai < 2; ++ai)
#pragma unroll
            for (int m = 0; m < 4; ++m) { const int row = u.pm * BM + ai * HALF + wr * 64 + m * 16 + fr;
                f32x4 c0 = {1.f, 1.f, 1.f, 1.f}, c1 = c0, s0 = {0.f, 0.f, 0.f, 0.f}, s1 = s0;
                if (rope && fq < 2) { c0 = *(const f32x4*)(rc + (size_t)row * 8); c1 = *(const f32x4*)(rc + (size_t)row * 8 + 4); s0 = *(const f32x4*)(rs + (size_t)row * 8); s1 = *(const f32x4*)(rs + (size_t)row * 8 + 4);
                    if (fq == 0) { s0 = -s0; s1 = -s1; } }
#pragma unroll
                for (int bj = 0; bj < 2; ++bj) { f32x4 v0 = acc[ai][bj][m][0], v1 = acc[ai][bj][m][1];
                    if (rope) { f32x4 p0, p1;
#pragma unroll
                        for (int j = 0; j < 4; ++j) { p0[j] = xor16(v0[j]); p1[j] = xor16(v1[j]); }
                        v0 = v0 * c0 + p0 * s0; v1 = v1 * c1 + p1 * s1; }
                    v0 = v0 * scale; v1 = v1 * scale;
                    u32x4 w; w.x = pk_bf16(v0[0], v0[1]); w.y = pk_bf16(v0[2], v0[3]); w.z = pk_bf16(v1[0], v1[1]); w.w = pk_bf16(v1[2], v1[3]);
                    *(u32x4*)(base + (size_t)row * ld + colt + bj * HALF + wc * 32 + 8 * fq) = w; } }
    }
};
struct EpiBf16 {
    static constexpr bool PERM = true; bf16_t* o; int ld;
    __device__ __forceinline__ void operator()(AccRef acc, const Unit& u, int wr, int wc, int fr, int fq) const {
#pragma unroll
        for (int ai = 0; ai < 2; ++ai)
#pragma unroll
            for (int m = 0; m < 4; ++m) { const int row = u.pm * BM + ai * HALF + wr * 64 + m * 16 + fr;
#pragma unroll
                for (int bj = 0; bj < 2; ++bj) { const f32x4 v0 = acc[ai][bj][m][0], v1 = acc[ai][bj][m][1];
                    u32x4 w; w.x = pk_bf16(v0[0], v0[1]); w.y = pk_bf16(v0[2], v0[3]); w.z = pk_bf16(v1[0], v1[1]); w.w = pk_bf16(v1[2], v1[3]);
                    *(u32x4*)(o + (size_t)row * ld + u.pn * BM + bj * HALF + wc * 32 + 8 * fq) = w; } }
    }
};
struct EpiNull {
    static constexpr bool PERM = false; float* h;
    __device__ __forceinline__ void operator()(AccRef acc, const Unit& u, int wr, int wc, int fr, int fq) const {
        if (u.pm < 0) {
#pragma unroll
            for (int ai = 0; ai < 2; ++ai)
#pragma unroll
                for (int m = 0; m < 4; ++m)
#pragma unroll
                    for (int bj = 0; bj < 2; ++bj)
#pragma unroll
                        for (int n = 0; n < 2; ++n) *(f32x4*)(h + ((ai * 4 + m) * 4 + bj * 2 + n) * 256 + fr * 16 + fq * 4) = acc[ai][bj][m][n]; }
    }
};
}

struct TJob { const float* s0; const float* s1; bf16_t* dst; int ld, k0, Kd, n0, f16; };
__device__ __forceinline__ void tjob_decode(const Params& P, int jt, TJob& j) {
    if (jt < 128) { const int pn = jt & 7, kt = jt >> 3;
        j.s0 = P.w_glu + 128 * pn; j.s1 = P.w_glu + 1024 + 128 * pn; j.ld = 2048; j.k0 = kt * 64; j.dst = (bf16_t*)(P.ws + WS_WGLU); j.Kd = 1024; j.n0 = 256 * pn; j.f16 = 0; }
    else if ((jt -= 128) < 352) { const int pn = jt % 22, kt = jt / 22;
        j.s0 = P.ffn_g + 128 * pn; j.s1 = P.ffn_u + 128 * pn; j.ld = 2816; j.k0 = kt * 64; j.dst = (bf16_t*)(P.ws + WS_WUP); j.Kd = 1024; j.n0 = 256 * pn; j.f16 = 1; }
    else if ((jt -= 352) < 176) { const int pn = jt & 3, kt = jt >> 2;
        j.s0 = P.ffn_d + 256 * pn; j.s1 = j.s0 + 128; j.ld = 1024; j.k0 = kt * 64; j.dst = (bf16_t*)(P.ws + WS_WDN); j.Kd = 2816; j.n0 = 256 * pn; j.f16 = 0; }
    else if ((jt -= 176) < 64) { const int pn = jt & 3, kt = jt >> 2;
        j.s0 = P.w_q + 256 * pn; j.s1 = j.s0 + 128; j.ld = 1024; j.k0 = kt * 64; j.dst = (bf16_t*)(P.ws + WS_WQKV); j.Kd = 1024; j.n0 = 256 * pn; j.f16 = 1; }
    else if ((jt -= 64) < 32) { const int pn = jt & 1, kt = jt >> 1;
        j.s0 = P.kv_w + 256 * pn; j.s1 = j.s0 + 128; j.ld = 512; j.k0 = kt * 64; j.dst = (bf16_t*)(P.ws + WS_WQKV); j.Kd = 1024; j.n0 = 1024 + 256 * pn; j.f16 = 1; }
    else if ((jt -= 32) < 64) { const int pn = jt & 3, kt = jt >> 2;
        j.s0 = P.w_out + 256 * pn; j.s1 = j.s0 + 128; j.ld = 1024; j.k0 = kt * 64; j.dst = (bf16_t*)(P.ws + WS_WO); j.Kd = 1024; j.n0 = 256 * pn; j.f16 = 0; }
    else if ((jt -= 64) < 1024) { const int e = jt & 7, r = jt >> 3, pn = r & 7, kt = r >> 3;
        j.s0 = P.moe_g + (size_t)e * 1048576 + 128 * pn; j.s1 = P.moe_u + (size_t)e * 1048576 + 128 * pn; j.ld = 1024; j.k0 = kt * 64; j.dst = (bf16_t*)(P.ws + WS_WMUP) + (size_t)e * 2048 * 1024; j.Kd = 1024; j.n0 = 256 * pn; j.f16 = 1; }
    else { jt -= 1024; const int e = jt & 7, r = jt >> 3, pn = r & 3, kt = r >> 2;
        j.s0 = P.moe_d + (size_t)e * 1048576 + 256 * pn; j.s1 = j.s0 + 128; j.ld = 1024; j.k0 = kt * 64; j.dst = (bf16_t*)(P.ws + WS_WMDN) + (size_t)e * 1048576; j.Kd = 1024; j.n0 = 256 * pn; j.f16 = 0; }
}
#define TJ_LOAD(J, V) do { const int nn_ = (tid & 63) * 4, kb_ = tid >> 6; const float* sp_ = (nn_ < 128) ? ((J).s0 + nn_) : ((J).s1 + (nn_ - 128)); \
    _Pragma("unroll") for (int i = 0; i < 8; ++i) (V)[i] = *(const f32x4*)(sp_ + (size_t)((J).k0 + kb_ + 8 * i) * (J).ld); } while (0)
__device__ void transposes_phase(const Params& P, float* tile) {
    constexpr int J_T = 2352;
    const int tid = threadIdx.x, G = gridDim.x;
    int jt = blockIdx.x; TJob cur, nxt; f32x4 v[8], vn[8];
    if (jt < J_T) { tjob_decode(P, jt, cur); TJ_LOAD(cur, v); }
    while (jt < J_T) {
        { const int nn = (tid & 63) * 4, kb = tid >> 6;
#pragma unroll
          for (int i = 0; i < 8; ++i) { float* t = tile + (kb + 8 * i) * 257 + nn; t[0] = v[i][0]; t[1] = v[i][1]; t[2] = v[i][2]; t[3] = v[i][3]; } }
        __syncthreads();
        const int jn = jt + G;
        if (jn < J_T) { tjob_decode(P, jn, nxt); TJ_LOAD(nxt, vn); }
        { const int ks = (tid & 7) * 8;
#pragma unroll
          for (int i = 0; i < 4; ++i) { const int n = (tid >> 3) + 64 * i; float r[8];
#pragma unroll
              for (int j = 0; j < 8; ++j) r[j] = tile[(ks + j) * 257 + n];
              u32x4 w; if (cur.f16) { w.x = pk_f16(r[0], r[1]); w.y = pk_f16(r[2], r[3]); w.z = pk_f16(r[4], r[5]); w.w = pk_f16(r[6], r[7]); } else { w.x = pk_bf16(r[0], r[1]); w.y = pk_bf16(r[2], r[3]); w.z = pk_bf16(r[4], r[5]); w.w = pk_bf16(r[6], r[7]); }
              *(u32x4*)(cur.dst + (size_t)(cur.n0 + n) * cur.Kd + cur.k0 + ks) = w; } }
        __syncthreads();
        cur = nxt; jt = jn;
#pragma unroll
        for (int i = 0; i < 8; ++i) v[i] = vn[i];
    }
}

__device__ void ssm_tables(const Params& P, int g, int qtr, unsigned char* lds) {
    const int tid = threadIdx.x;
    float* apr = (float*)lds;
    float* api = apr + 33 * 64;
    float* bbr = api + 33 * 64;
    float* bbi = bbr + 1024;
    float* ccr = bbi + 1024;
    float* cci = ccr + 1024;
    float* kg = cci + 1024;
    const float dtf = expf(P.log_step[g]);
    for (int idx = tid; idx < 33 * 64; idx += 512) { const int tau = idx >> 6, p = idx & 63;
        const float lr = P.lam_re[g * 64 + p], li = P.lam_im[g * 64 + p];
        const double dt = (double)dtf; double rev = (double)li * dt * (double)tau * 0.15915494309189535; rev -= floor(rev);
        const float ang = (float)(rev * 6.283185307179586); float sn, cs; sincosf(ang, &sn, &cs);
        const float mag = expf((float)((double)lr * dt * (double)tau));
        apr[idx] = mag * cs; api[idx] = mag * sn; }
    for (int idx = tid; idx < 1024; idx += 512) { ccr[idx] = P.c_re[g * 1024 + idx]; cci[idx] = P.c_im[g * 1024 + idx]; }
    __syncthreads();
    for (int idx = tid; idx < 1024; idx += 512) { const int p = idx >> 4;
        const float lr = P.lam_re[g * 64 + p], li = P.lam_im[g * 64 + p], ar = apr[64 + p], ai = api[64 + p];
        const float nr = ar - 1.0f, den = lr * lr + li * li, kr = (nr * lr + ai * li) / den, ki = (ai * lr - nr * li) / den;
        const float br = P.b_re[g * 1024 + idx], bi = P.b_im[g * 1024 + idx];
        bbr[idx] = kr * br - ki * bi; bbi[idx] = kr * bi + ki * br; }
    __syncthreads();
    { const int cp = tid & 15, c = 4 * qtr + ((tid >> 4) & 3), t0 = tid >> 6;
      for (int i = 0; i < 4; ++i) { const int tau = t0 + 8 * i; float s = 0.f;
          for (int p = 0; p < 64; ++p) { const float cr = ccr[c * 64 + p], ci = cci[c * 64 + p], ar = apr[tau * 64 + p], ai = api[tau * 64 + p];
              const float zr = cr * ar - ci * ai, zi = cr * ai + ci * ar; s += zr * bbr[p * 16 + cp] - zi * bbi[p * 16 + cp]; }
          if (tau == 0 && cp == c) s += P.ssm_d[g * 16 + c];
          kg[(tau * 16 + c) * 16 + cp] = s; } }
    __syncthreads();
    bf16_t* bt2 = (bf16_t*)(P.ws + WS_BT2) + (size_t)g * 512 * 640;
    for (int pc = tid; pc < 128 * 80; pc += 512) { const int nq = pc / 80, k8 = (pc % 80) * 8, t = nq >> 2, c = 4 * qtr + (nq & 3), n = t * 16 + c; float r[8];
        if (k8 < 512) { const int s = k8 >> 4, c0 = k8 & 15;
#pragma unroll
            for (int j = 0; j < 8; ++j) r[j] = (t >= s) ? kg[((t - s) * 16 + c) * 16 + c0 + j] : 0.f;
        } else { const int q0 = k8 - 512;
#pragma unroll
            for (int j = 0; j < 8; j += 2) { const int p = (q0 + j) >> 1; const float cr = ccr[c * 64 + p], ci = cci[c * 64 + p], ar = apr[(t + 1) * 64 + p], ai = api[(t + 1) * 64 + p];
                r[j] = cr * ar - ci * ai; r[j + 1] = -(cr * ai + ci * ar); } }
        u32x4 w; w.x = pk_bf16(r[0], r[1]); w.y = pk_bf16(r[2], r[3]); w.z = pk_bf16(r[4], r[5]); w.w = pk_bf16(r[6], r[7]);
        *(u32x4*)(bt2 + (size_t)n * 640 + k8) = w; }
    bf16_t* bt1 = (bf16_t*)(P.ws + WS_BT1) + (size_t)g * 256 * 512;
    for (int pc = tid; pc < 64 * 64; pc += 512) { const int q = 64 * qtr + (pc >> 6), k8 = (pc & 63) * 8; float r[8];
        if (q < 128) { const int p = q >> 1, s = k8 >> 4, c0 = k8 & 15; const float ar = apr[(31 - s) * 64 + p], ai = api[(31 - s) * 64 + p];
#pragma unroll
            for (int j = 0; j < 8; ++j) { const float br = bbr[p * 16 + c0 + j], bi = bbi[p * 16 + c0 + j]; r[j] = (q & 1) ? (ar * bi + ai * br) : (ar * br - ai * bi); }
        } else {
#pragma unroll
            for (int j = 0; j < 8; ++j) r[j] = 0.f; }
        u32x4 w; w.x = pk_bf16(r[0], r[1]); w.y = pk_bf16(r[2], r[3]); w.z = pk_bf16(r[4], r[5]); w.w = pk_bf16(r[6], r[7]);
        *(u32x4*)(bt1 + (size_t)q * 512 + k8) = w; }
    float* a32 = (float*)(P.ws + WS_A32);
    if (qtr == 0 && tid < 64) { a32[(g * 64 + tid) * 2] = apr[32 * 64 + tid]; a32[(g * 64 + tid) * 2 + 1] = api[32 * 64 + tid]; }
    __syncthreads();
}

__device__ void p0_prep(const Params& P, unsigned char* lds, const int mask) {
    const int tid = threadIdx.x, G = gridDim.x;
    if (blockIdx.x == 0 && tid < 8) ((int*)(P.ws + WS_CNT))[tid] = 0;
    constexpr int J_SSM = 256, J_X = 1024, J_ROPE = 512;
    constexpr int NJ = J_SSM + J_X + J_ROPE;
    const bool tfirst = (blockIdx.x & 1) != 0;
    if (tfirst && (mask & 8)) { transposes_phase(P, (float*)lds); __syncthreads(); }
    for (int job = blockIdx.x; job < NJ; job += G) {
        if (job < J_SSM) {
#if LEVEL >= 1
            if (mask & 1) ssm_tables(P, job >> 2, job & 3, lds);
#endif
        }
        else if (job < J_SSM + J_X) { if (!(mask & 2)) continue;
            const int r = job - J_SSM;
            bf16_t* xa = (bf16_t*)(P.ws + WS_XA); bf16_t* st = (bf16_t*)lds;
            __syncthreads();
            f32x4 xa_[8], xb_[8];
#pragma unroll
            for (int i = 0; i < 8; ++i) { const int piece = tid + 512 * i, s = piece >> 7, c8 = (piece & 127) * 8; const float* xp = P.x + ((size_t)r * 32 + s) * 1024 + c8;
                xa_[i] = *(const f32x4*)xp; xb_[i] = *(const f32x4*)(xp + 4); }
#pragma unroll
            for (int i = 0; i < 8; ++i) { const int piece = tid + 512 * i, s = piece >> 7, c8 = (piece & 127) * 8;
                u32x4 w; w.x = pk_bf16(xa_[i][0], xa_[i][1]); w.y = pk_bf16(xa_[i][2], xa_[i][3]); w.z = pk_bf16(xb_[i][0], xb_[i][1]); w.w = pk_bf16(xb_[i][2], xb_[i][3]);
                *(u32x4*)(st + s * 1032 + c8) = w;
#if LEVEL < 1
                *(f32x4*)(P.out + ((size_t)r * 32 + s) * 1024 + c8) = xa_[i]; *(f32x4*)(P.out + ((size_t)r * 32 + s) * 1024 + c8 + 4) = xb_[i];
#endif
            }
            __syncthreads();
            { const int wv = tid >> 6, ln = tid & 63, s = ln >> 1, hf = ln & 1;
#pragma unroll
              for (int i = 0; i < 8; ++i) { const int g = wv * 8 + i;
                  const u32x4 w = *(const u32x4*)(st + s * 1032 + g * 16 + hf * 8);
                  *(u32x4*)(xa + (size_t)g * (XAG_GSTRIDE / 2) + (size_t)r * 640 + s * 16 + hf * 8) = w; } }
        }
        else if (job < J_SSM + J_X + J_ROPE) { if (!(mask & 4)) continue;
            const int tok = (job - J_SSM - J_X) * 64 + (tid >> 3), i = tid & 7;
            const float invf[8] = {1.0f, 0.19392274474868576f, 0.03760603093086393f, 0.007292664737217109f, 0.001414213562373095f, 0.0002742481756762073f, 5.318295896944988e-05f, 1.031338537721246e-05f};
            float f = invf[0];
#pragma unroll
            for (int k = 1; k < 8; ++k) f = (i == k) ? invf[k] : f;
            const float ang = (float)P.pos[tok] * f; float sn, cs; sincosf(ang, &sn, &cs);
            ((float*)(P.ws + WS_ROPEC))[tok * 8 + i] = cs; ((float*)(P.ws + WS_ROPES))[tok * 8 + i] = sn;
        }
    }
    if (!tfirst && (mask & 8)) { __syncthreads(); transposes_phase(P, (float*)lds); }
}

__device__ void scan_unit(const Params& P, int g, int pm) {
    const float* sst = (const float*)(P.ws + WS_SST); const float* a32 = (const float*)(P.ws + WS_A32); bf16_t* xa = (bf16_t*)(P.ws + WS_XA);
    const int tid = threadIdx.x;
    if (tid < 256) {
        const int p = tid & 63, b = pm * 4 + (tid >> 6), q = 2 * p;
        const float ar = a32[(g * 64 + p) * 2], ai = a32[(g * 64 + p) * 2 + 1];
        float hr = 0.f, hi = 0.f;
#pragma unroll 1
        for (int jb = 0; jb < 64; jb += 16) {
            float2 s[16];
#pragma unroll
            for (int j = 0; j < 16; ++j) s[j] = *(const float2*)(sst + ((size_t)(b * 64 + jb + j) * 64 + g) * 128 + q);
#pragma unroll
            for (int j = 0; j < 16; ++j) { const int row = b * 64 + jb + j;
                *(unsigned*)(xa + (size_t)g * (XAG_GSTRIDE / 2) + (size_t)row * 640 + 512 + q) = pk_bf16(hr, hi);
                const float nr = ar * hr - ai * hi + s[j].x, ni = ar * hi + ai * hr + s[j].y; hr = nr; hi = ni; }
        }
    }
}

template <int MODE, bool IN32>
__device__ void ln_phase(const Params& P, const float* h, const float* gam, const float* bet, unsigned char* lds, float* hout, bf16_t* h16, const bf16_t* d16) {
    const int tid = threadIdx.x, wid = tid >> 6, lane = tid & 63;
    float* wrt = (float*)lds;
    int* cnt = (int*)(P.ws + WS_CNT); int* lists = (int*)(P.ws + WS_LIST); int* toki = (int*)(P.ws + WS_TOK);
    const bf16_t* Y = (const bf16_t*)(P.ws + WS_Y);
    int base[8];
    int* lcnt = (int*)(lds + 32768);
    int* rinfo = (int*)(lds + 32768 + 64);
    if (MODE == 1) { for (int k = 0; k < 16; ++k) { const int idx = tid + 512 * k; wrt[(idx & 7) * 1024 + (idx >> 3)] = P.w_router[idx]; } if (tid < 8) lcnt[tid] = 0; __syncthreads(); }
    int kiter = 0;
    if (MODE == 2) { int acc = 0;
#pragma unroll
        for (int e = 0; e < 8; ++e) { base[e] = acc; acc += ((cnt[e] + 255) >> 8) << 8; } }
    f32x4 gv[4], bv[4];
#pragma unroll
    for (int i = 0; i < 4; ++i) { gv[i] = *(const f32x4*)(gam + 256 * i + lane * 4); bv[i] = *(const f32x4*)(bet + 256 * i + lane * 4); }
    f32x4 nf[4]; u32x2 nh[4], nd[4], na[4], nb2[4]; float nw1 = 0.f, nw2 = 0.f;
#pragma unroll
    for (int i = 0; i < 4; ++i) { nf[i] = (f32x4){0.f, 0.f, 0.f, 0.f}; nh[i] = (u32x2){0u, 0u}; nd[i] = nh[i]; na[i] = nh[i]; nb2[i] = nh[i]; }
#define LN_FETCH(R) do { const size_t ro_ = (size_t)(R) * 1024 + lane * 4; \
        if (IN32) { _Pragma("unroll") for (int i = 0; i < 4; ++i) nf[i] = *(const f32x4*)(h + ro_ + 256 * i); } \
        else { _Pragma("unroll") for (int i = 0; i < 4; ++i) nh[i] = *(const u32x2*)(h16 + ro_ + 256 * i); } \
        if (MODE != 2 && d16 != nullptr) { _Pragma("unroll") for (int i = 0; i < 4; ++i) nd[i] = *(const u32x2*)(d16 + ro_ + 256 * i); } \
        if (MODE == 2) { const int e1_ = toki[(R) * 8 + 0], p1_ = toki[(R) * 8 + 1], e2_ = toki[(R) * 8 + 2], p2_ = toki[(R) * 8 + 3]; \
            nw1 = __int_as_float(toki[(R) * 8 + 4]); nw2 = __int_as_float(toki[(R) * 8 + 5]); int b1_ = 0, b2_ = 0; \
            _Pragma("unroll") for (int e = 0; e < 8; ++e) { b1_ = (e1_ == e) ? base[e] : b1_; b2_ = (e2_ == e) ? base[e] : b2_; } \
            const bf16_t* y1_ = Y + (size_t)(b1_ + p1_) * 1024 + lane * 4; const bf16_t* y2_ = Y + (size_t)(b2_ + p2_) * 1024 + lane * 4; \
            _Pragma("unroll") for (int i = 0; i < 4; ++i) { na[i] = *(const u32x2*)(y1_ + 256 * i); nb2[i] = *(const u32x2*)(y2_ + 256 * i); } } } while (0)
    const int rstride = gridDim.x * 8;
    int row = blockIdx.x * 8 + wid;
    if (row < T_) LN_FETCH(row);
    for (; row < T_; row += rstride, ++kiter) {
        f32x4 v[4];
        if (IN32) {
#pragma unroll
            for (int i = 0; i < 4; ++i) v[i] = nf[i];
        } else {
#pragma unroll
            for (int i = 0; i < 4; ++i) v[i] = (f32x4){hf_lo(nh[i].x), hf_hi(nh[i].x), hf_lo(nh[i].y), hf_hi(nh[i].y)};
        }
        if (MODE != 2 && d16 != nullptr) {
#pragma unroll
            for (int i = 0; i < 4; ++i) { const u32x2 a = nd[i];
                v[i][0] = ALPHA * v[i][0] + bf_lo(a.x); v[i][1] = ALPHA * v[i][1] + bf_hi(a.x); v[i][2] = ALPHA * v[i][2] + bf_lo(a.y); v[i][3] = ALPHA * v[i][3] + bf_hi(a.y); }
        }
        if (MODE == 2) { const float w1 = nw1, w2 = nw2;
#pragma unroll
            for (int i = 0; i < 4; ++i) { const u32x2 a = na[i], b = nb2[i];
                v[i][0] = ALPHA * v[i][0] + (w1 * bf_lo(a.x) + w2 * bf_lo(b.x)); v[i][1] = ALPHA * v[i][1] + (w1 * bf_hi(a.x) + w2 * bf_hi(b.x));
                v[i][2] = ALPHA * v[i][2] + (w1 * bf_lo(a.y) + w2 * bf_lo(b.y)); v[i][3] = ALPHA * v[i][3] + (w1 * bf_hi(a.y) + w2 * bf_hi(b.y)); }
        }
        { const int nrow = row + rstride; if (nrow < T_) LN_FETCH(nrow); }
        float s = 0.f;
#pragma unroll
        for (int i = 0; i < 4; ++i) s += (v[i][0] + v[i][1]) + (v[i][2] + v[i][3]);
        const float mu = wave_sum(s) * (1.0f / 1024.0f);
        float q = 0.f;
#pragma unroll
        for (int i = 0; i < 4; ++i) { v[i] = v[i] - mu; q += (v[i][0] * v[i][0] + v[i][1] * v[i][1]) + (v[i][2] * v[i][2] + v[i][3] * v[i][3]); }
        const float rstd = rsqrtf(wave_sum(q) * (1.0f / 1024.0f) + LN_EPS);
#pragma unroll
        for (int i = 0; i < 4; ++i) { v[i] = v[i] * rstd * gv[i] + bv[i]; if (MODE == 2) *(f32x4*)(hout + (size_t)row * 1024 + 256 * i + lane * 4) = v[i];
            if (MODE != 2) { u32x2 w; w.x = pk_f16(v[i][0], v[i][1]); w.y = pk_f16(v[i][2], v[i][3]); *(u32x2*)(h16 + (size_t)row * 1024 + 256 * i + lane * 4) = w; } }
        if (MODE == 1) {
            float lg[8];
#pragma unroll
            for (int e = 0; e < 8; ++e) { float a = 0.f;
#pragma unroll
                for (int i = 0; i < 4; ++i) { const f32x4 w = *(const f32x4*)(wrt + e * 1024 + 256 * i + lane * 4); a += (v[i][0] * w[0] + v[i][1] * w[1]) + (v[i][2] * w[2] + v[i][3] * w[3]); }
                lg[e] = wave_sum(a) + P.b_router[e]; }
            int e1 = 0; float v1 = lg[0];
#pragma unroll
            for (int e = 1; e < 8; ++e) if (lg[e] > v1) { v1 = lg[e]; e1 = e; }
            int e2 = -1; float v2 = -3.0e38f;
#pragma unroll
            for (int e = 0; e < 8; ++e) if (e != e1 && lg[e] > v2) { v2 = lg[e]; e2 = e; }
            const float ex = __expf(v2 - v1), w1 = 1.0f / (1.0f + ex), w2 = ex / (1.0f + ex);
            if (lane == 0) { const int p1 = atomicAdd(lcnt + e1, 1), p2 = atomicAdd(lcnt + e2, 1); int* ri = rinfo + (kiter * 8 + wid) * 6;
                ri[0] = e1; ri[1] = p1; ri[2] = e2; ri[3] = p2; ri[4] = __float_as_int(w1); ri[5] = __float_as_int(w2); }
        }
    }
    if (MODE == 1) {
        __syncthreads();
        if (tid < 8) lcnt[8 + tid] = atomicAdd(cnt + tid, lcnt[tid]);
        __syncthreads();
        for (int lr = tid; lr < 512; lr += 512) { const int row = blockIdx.x * 8 + (lr & 7) + (lr >> 3) * gridDim.x * 8;
            if (row < T_) { const int* ri = rinfo + lr * 6; const int e1 = ri[0], e2 = ri[2], p1 = lcnt[8 + e1] + ri[1], p2 = lcnt[8 + e2] + ri[3];
                lists[e1 * T_ + p1] = row; lists[e2 * T_ + p2] = row;
                toki[row * 8 + 0] = e1; toki[row * 8 + 1] = p1; toki[row * 8 + 2] = e2; toki[row * 8 + 3] = p2; toki[row * 8 + 4] = ri[4]; toki[row * 8 + 5] = ri[5]; } }
    }
}

__device__ void gather_phase(const Params& P) {
    const int tid = threadIdx.x, wid = tid >> 6, lane = tid & 63;
    const int* cnt = (const int*)(P.ws + WS_CNT); const int* lists = (const int*)(P.ws + WS_LIST);
    const bf16_t* h16 = (const bf16_t*)(P.ws + WS_H16); bf16_t* ga = (bf16_t*)(P.ws + WS_GA);
    int base[9], c[8]; base[0] = 0;
#pragma unroll
    for (int e = 0; e < 8; ++e) { c[e] = cnt[e]; base[e + 1] = base[e] + (((c[e] + 255) >> 8) << 8); }
    for (int r = blockIdx.x * 8 + wid; r < base[8]; r += gridDim.x * 8) {
        int e = 0;
#pragma unroll
        for (int k = 1; k < 8; ++k) e += (r >= base[k]) ? 1 : 0;
        int be = 0, ce = 0;
#pragma unroll
        for (int k = 0; k < 8; ++k) { be = (e == k) ? base[k] : be; ce = (e == k) ? c[k] : ce; }
        const int pos = r - be; u32x4 a = {0u, 0u, 0u, 0u}, b = a;
        if (pos < ce) { const int tok = lists[e * T_ + pos]; a = *(const u32x4*)(h16 + (size_t)tok * 1024 + lane * 8); b = *(const u32x4*)(h16 + (size_t)tok * 1024 + 512 + lane * 8); }
        *(u32x4*)(ga + (size_t)r * 1024 + lane * 8) = a; *(u32x4*)(ga + (size_t)r * 1024 + 512 + lane * 8) = b;
    }
}

__device__ void attn_phase(const Params& P, unsigned char* lds) {
    const int tid = threadIdx.x, wid = tid >> 6, lane = tid & 63, n = lane & 31, hh = lane >> 5;
    bf16_t* Ks = (bf16_t*)lds;
    bf16_t* Vt = (bf16_t*)(lds + 256 * 144);
    const bf16_t* QB = (const bf16_t*)(P.ws + WS_BIG); const bf16_t* KB = (const bf16_t*)(P.ws + WS_BIG + 64 * MiB); const bf16_t* VB = (const bf16_t*)(P.ws + WS_BIG + 80 * MiB);
    bf16_t* OB = (bf16_t*)(P.ws + WS_BIG + 96 * MiB);
#ifdef DUP_ATT
    constexpr int NITEM = 2048;
#else
    constexpr int NITEM = 1024;
#endif
    u32x4 kreg[4], vreg0[2], vreg1[2];
#define ATT_LOAD(it) do { const int kvh_ = (it) & 3, nb_ = ((it) >> 2) & 15, b_ = ((it) >> 6) & 15, tok_ = b_ * 2048 + nb_ * 128; \
        _Pragma("unroll") for (int i = 0; i < 4; ++i) { const int piece = tid + 512 * i, s = piece >> 3, pc = piece & 7; kreg[i] = (u32x4){0u, 0u, 0u, 0u}; \
            if (nb_ > 0 || s >= 128) kreg[i] = *(const u32x4*)(KB + (size_t)(tok_ - 128 + s) * 256 + kvh_ * 64 + pc * 8); } \
        _Pragma("unroll") for (int i = 0; i < 2; ++i) { const int s = 2 * (tid & 127), pc = (tid >> 7) + 4 * i; vreg0[i] = (u32x4){0u, 0u, 0u, 0u}; vreg1[i] = vreg0[i]; \
            if (nb_ > 0 || s >= 128) { vreg0[i] = *(const u32x4*)(VB + (size_t)(tok_ - 128 + s) * 256 + kvh_ * 64 + pc * 8); vreg1[i] = *(const u32x4*)(VB + (size_t)(tok_ - 127 + s) * 256 + kvh_ * 64 + pc * 8); } } } while (0)
    if ((int)blockIdx.x < NITEM) ATT_LOAD((int)blockIdx.x);
    for (int item = blockIdx.x; item < NITEM; item += gridDim.x) {
        const int kvh = item & 3, nb = (item >> 2) & 15, b = (item >> 6) & 15;
        const int tok0 = b * 2048 + nb * 128;
        __syncthreads();
#pragma unroll
        for (int i = 0; i < 4; ++i) { const int piece = tid + 512 * i, s = piece >> 3, pc = piece & 7; *(u32x4*)(Ks + s * 72 + pc * 8) = kreg[i]; }
#pragma unroll
        for (int i = 0; i < 2; ++i) { const int s = 2 * (tid & 127), pc = (tid >> 7) + 4 * i; const u32x4 v0 = vreg0[i], v1 = vreg1[i];
            unsigned* vt = (unsigned*)(Vt + (pc * 8) * 264 + s);
            vt[0 * 132] = (v0.x & 0xffffu) | (v1.x << 16); vt[1 * 132] = (v0.x >> 16) | (v1.x & 0xffff0000u);
            vt[2 * 132] = (v0.y & 0xffffu) | (v1.y << 16); vt[3 * 132] = (v0.y >> 16) | (v1.y & 0xffff0000u);
            vt[4 * 132] = (v0.z & 0xffffu) | (v1.z << 16); vt[5 * 132] = (v0.z >> 16) | (v1.z & 0xffff0000u);
            vt[6 * 132] = (v0.w & 0xffffu) | (v1.w << 16); vt[7 * 132] = (v0.w >> 16) | (v1.w & 0xffff0000u); }
        __syncthreads();
        if (item + (int)gridDim.x < NITEM) ATT_LOAD(item + (int)gridDim.x);
        const int hq = kvh * 4 + (wid >> 1);
        const float sink = P.sinks[hq] * 1.4426950408889634f;
#pragma unroll 1
        for (int qq = 0; qq < 2; ++qq) {
            const int kb0 = (wid & 1) * 2 + qq, i0 = 32 * kb0, qi = i0 + n;
            const bf16_t* qp = QB + (size_t)(tok0 + qi) * 1024 + hq * 64 + 8 * hh;
            bf16x8 qf[4];
#pragma unroll
            for (int ks = 0; ks < 4; ++ks) qf[ks] = *(const bf16x8*)(qp + 16 * ks);
            f32x16 sacc[5];
#pragma unroll
            for (int kb = 0; kb < 5; ++kb) {
#pragma unroll
                for (int i = 0; i < 16; ++i) sacc[kb][i] = 0.f;
                const bf16_t* kp = Ks + (32 * (kb0 + kb) + n) * 72 + 8 * hh;
#pragma unroll
                for (int ks = 0; ks < 4; ++ks) { const bf16x8 a = *(const bf16x8*)(kp + 16 * ks); sacc[kb] = __builtin_amdgcn_mfma_f32_32x32x16_bf16(a, qf[ks], sacc[kb], 0, 0, 0); }
                asm volatile("" ::: "memory"); }
            const int nn4 = n - 4 * hh;
#pragma unroll
            for (int i = 0; i < 16; ++i) { const int r = 8 * (i >> 2) + (i & 3);
                sacc[0][i] = (r > nn4) ? sacc[0][i] : -1.0e30f; sacc[4][i] = (r <= nn4) ? sacc[4][i] : -1.0e30f; }
            if (nb == 0) {
#pragma unroll
                for (int kb = 0; kb < 4; ++kb) if (kb0 + kb < 4) {
#pragma unroll
                    for (int i = 0; i < 16; ++i) sacc[kb][i] = -1.0e30f; } }
            float mx = sink;
#pragma unroll
            for (int kb = 0; kb < 5; ++kb)
#pragma unroll
                for (int i = 0; i < 16; ++i) mx = fmaxf(mx, sacc[kb][i]);
            mx = fmaxf(mx, __shfl_xor(mx, 32));
            float sum = 0.f;
#pragma unroll
            for (int kb = 0; kb < 5; ++kb)
#pragma unroll
                for (int i = 0; i < 16; ++i) { const float p = __builtin_amdgcn_exp2f(sacc[kb][i] - mx); sacc[kb][i] = p; sum += p; }
            sum += __shfl_xor(sum, 32); sum += __builtin_amdgcn_exp2f(sink - mx);
            f32x16 oacc[2];
#pragma unroll
            for (int i = 0; i < 16; ++i) { oacc[0][i] = 0.f; oacc[1][i] = 0.f; }
#pragma unroll
            for (int kb = 0; kb < 5; ++kb)
#pragma unroll
                for (int sl = 0; sl < 2; ++sl) {
                    union { u32x4 u; bf16x8 v; } pb;
                    pb.u.x = pk_bf16(sacc[kb][8 * sl + 0], sacc[kb][8 * sl + 1]); pb.u.y = pk_bf16(sacc[kb][8 * sl + 2], sacc[kb][8 * sl + 3]);
                    pb.u.z = pk_bf16(sacc[kb][8 * sl + 4], sacc[kb][8 * sl + 5]); pb.u.w = pk_bf16(sacc[kb][8 * sl + 6], sacc[kb][8 * sl + 7]);
#pragma unroll
                    for (int mb = 0; mb < 2; ++mb) { const bf16_t* vp = Vt + (32 * mb + n) * 264 + 32 * (kb0 + kb) + 16 * sl + 4 * hh;
                        union { u32x4 u; bf16x8 v; } va; const u32x2 lo = *(const u32x2*)vp, hi = *(const u32x2*)(vp + 8); va.u.x = lo.x; va.u.y = lo.y; va.u.z = hi.x; va.u.w = hi.y;
                        oacc[mb] = __builtin_amdgcn_mfma_f32_32x32x16_bf16(va.v, pb.v, oacc[mb], 0, 0, 0); }
                    asm volatile("" ::: "memory"); }
            const float inv = 1.0f / sum;
            bf16_t* op = OB + (size_t)(tok0 + qi) * 1024 + hq * 64 + 4 * hh;
#pragma unroll
            for (int mb = 0; mb < 2; ++mb)
#pragma unroll
                for (int g4 = 0; g4 < 4; ++g4) { u32x2 w; w.x = pk_bf16(oacc[mb][4 * g4 + 0] * inv, oacc[mb][4 * g4 + 1] * inv); w.y = pk_bf16(oacc[mb][4 * g4 + 2] * inv, oacc[mb][4 * g4 + 3] * inv);
                    *(u32x2*)(op + 32 * mb + 8 * g4) = w; }
        }
    }
}

#if defined(__HIP_DEVICE_COMPILE__)
typedef const Params __attribute__((address_space(4)))* KParams;
__device__ __forceinline__ Params load_params() { KParams p = (KParams)__builtin_amdgcn_kernarg_segment_ptr(); asm volatile("" : "+s"(p)); return *p; }
#else
__device__ __forceinline__ Params load_params() { return Params{}; }
#endif
#define LP const Params P = load_params(); unsigned char* const ws = P.ws; float* const H = P.out; (void)ws; (void)H
__global__ void __launch_bounds__(512, 2) yoco_fwd(Params P_arg) {
    extern __shared__ __attribute__((aligned(16))) unsigned char lds[];
    cg::grid_group grid = cg::this_grid();
    LAS unsigned char* ldsl = (LAS unsigned char*)lds;
    const int G = gridDim.x, c = blockIdx.x;
    if (threadIdx.x == 0) { ((LAS unsigned*)(ldsl + 131072))[0] = 0u; ((LAS unsigned*)(ldsl + 131072))[1] = 0u; }
    __syncthreads();
#define GSYNC() do { LP; xcd_barrier((unsigned*)(ws + WS_BAR), (volatile LAS unsigned*)(ldsl + 131072)); } while (0)

#ifdef PROF_A_HI
#define STAMP(k) do { LP; if (((k) == PROF_A_LO || (k) == PROF_A_HI || (k) == PROF_B_LO || (k) == PROF_B_HI) && blockIdx.x == 0 && threadIdx.x == 0) ((unsigned long long*)(P.ws + WS_CNT + 1024))[k] = __builtin_amdgcn_s_memrealtime(); } while (0)
#else
#define STAMP(k) do { } while (0)
#endif
#ifdef DUP_ALL
#pragma unroll 1
    for (int pass = 0; pass < 2; ++pass) {
#else
    { const int pass = 0;
#endif
    STAMP(0);
    if (pass != 0) GSYNC();
    { LP; p0_prep(P, lds, (P.skip & 1) ? 0 : (15 & ~(P.skip >> 16))); if (pass == 0 && blockIdx.x == 0) for (int i = threadIdx.x; i < XCD_BAR_WORDS; i += 512) ((unsigned*)(ws + WS_BAR))[i] = 0u; }
    if (pass == 0) { grid.sync();
        { LP; if (threadIdx.x == 0) (void)xb_add(&((unsigned*)(ws + WS_BAR))[XB_XCNT(xb_xcc_id())], 1u); } }
    else GSYNC();
#ifdef DUP_SYNC
#pragma unroll 1
    for (int r = 0; r < 16; ++r) GSYNC();
#endif
#ifdef DUP_P0
    { LP; p0_prep(P, lds, DUP_P0); }
    GSYNC();
#endif
    STAMP(1);
#if LEVEL >= 1
#pragma unroll 1
    for (int rep = 0; rep < NREP_S1; ++rep) {
    {   LP; if (!((P.skip >> 1) & 1)) {
        pg8::SchedSsm S; S.init(256, 512, G, c); pg8::EpiS1 E{(float*)(ws + WS_SST)};
        pg8::gemm_phase<false>(ldsl, (const char*)(ws + WS_XA), (const char*)(ws + WS_BT1), 512, S, E);
        asm volatile("s_waitcnt vmcnt(0)" ::: "memory"); __syncthreads();
        pg8::Unit u; for (int i = 0; S.next(i, u); ++i) scan_unit(P, u.aux, u.pm); } }
    GSYNC(); } STAMP(2);
#pragma unroll 1
    for (int rep = 0; rep < NREP_S2; ++rep) {
    {   LP; if (!((P.skip >> 2) & 1)) {
        pg8::SchedSsm S; S.init(512, 640, G, c); pg8::EpiS2 E{(bf16_t*)(ws + WS_BIG)};
        pg8::gemm_phase<false>(ldsl, (const char*)(ws + WS_XA), (const char*)(ws + WS_BT2), 640, S, E); } }
    GSYNC(); } STAMP(4);
#pragma unroll 1
    for (int rep = 0; rep < NREP_GLU; ++rep) {
    {   LP; if (!((P.skip >> 3) & 1)) {
        pg8::SchedDense S; S.init(T_, 2048, 1024, 1024, G, c); pg8::EpiUp<1> E{(bf16_t*)(ws + WS_GA), 1024};
        pg8::gemm_phase<false>(ldsl, (const char*)(ws + WS_BIG), (const char*)(ws + WS_WGLU), 1024, S, E); } }
    GSYNC(); } STAMP(5);
#endif
    { LP; if (!((P.skip >> 4) & 1)) ln_phase<0, true>(P, (LEVEL >= 1) ? P.x : H, P.ln_g, P.ln_b, lds, H, (bf16_t*)(ws + WS_H16), (LEVEL >= 1) ? (const bf16_t*)(ws + WS_GA) : nullptr); }
    GSYNC(); STAMP(6);
#if LEVEL >= 2
#pragma unroll 1
    for (int rep = 0; rep < NREP_FUP; ++rep) {
    {   LP; if (!((P.skip >> 5) & 1)) {
        pg8::SchedDense S; S.init(T_, 2 * FF_, 1024, 1024, G, c); pg8::EpiUp<0> E{(bf16_t*)(ws + WS_BIG), FF_};
        pg8::gemm_phase<true>(ldsl, (const char*)(ws + WS_H16), (const char*)(ws + WS_WUP), 1024, S, E); } }
    GSYNC(); } STAMP(7);
#pragma unroll 1
    for (int rep = 0; rep < NREP_FDN; ++rep) {
    {   LP; if (!((P.skip >> 6) & 1)) {
#define NREP_CUR NREP_FDN
        pg8::SchedDense S; S.init(T_, 1024, FF_, FF_, G, c); pg8::EpiBf16 E{(bf16_t*)(ws + WS_GA), 1024};
        pg8::gemm_phase<false>(ldsl, (const char*)(ws + WS_BIG), (const char*)(ws + WS_WDN), FF_, S, E); } }
    GSYNC(); } STAMP(8);
#endif
    { LP; if (!((P.skip >> 7) & 1)) ln_phase<0, false>(P, H, P.ln_g + 1024, P.ln_b + 1024, lds, H, (bf16_t*)(ws + WS_H16), (LEVEL >= 2) ? (const bf16_t*)(ws + WS_GA) : nullptr); }
    GSYNC(); STAMP(9);
#if LEVEL >= 3
#pragma unroll 1
    for (int rep = 0; rep < NREP_QKV; ++rep) {
    {   LP; if (!((P.skip >> 8) & 1)) {
        pg8::SchedDense S; S.init(T_, 1536, 1024, 1024, G, c);
        pg8::EpiQkv E{(bf16_t*)(ws + WS_BIG), (bf16_t*)(ws + WS_BIG + 64 * MiB), (bf16_t*)(ws + WS_BIG + 80 * MiB), (const float*)(ws + WS_ROPEC), (const float*)(ws + WS_ROPES)};
        pg8::gemm_phase<true>(ldsl, (const char*)(ws + WS_H16), (const char*)(ws + WS_WQKV), 1024, S, E); } }
    GSYNC(); } STAMP(10);
#ifndef SKIP_ATT
    { LP; if (!((P.skip >> 9) & 1)) attn_phase(P, lds); }
#endif
    GSYNC(); STAMP(11);
#pragma unroll 1
    for (int rep = 0; rep < NREP_OUT; ++rep) {
    {   LP; if (!((P.skip >> 10) & 1)) {
#undef NREP_CUR
#define NREP_CUR NREP_OUT
        pg8::SchedDense S; S.init(T_, 1024, 1024, 1024, G, c);
        pg8::EpiBf16 E{(bf16_t*)(ws + WS_GA), 1024};
        pg8::gemm_phase<false>(ldsl, (const char*)(ws + WS_BIG + 96 * MiB), (const char*)(ws + WS_WO), 1024, S, E); } }
    GSYNC(); } STAMP(12);
#endif
#if LEVEL >= 4
    { LP; if (!((P.skip >> 11) & 1)) ln_phase<1, false>(P, H, P.ln_g + 2048, P.ln_b + 2048, lds, H, (bf16_t*)(ws + WS_H16), (const bf16_t*)(ws + WS_GA)); }
    GSYNC(); STAMP(13);
#pragma unroll 1
    for (int rep = 0; rep < NREP_GATH; ++rep) {
    { LP; if (!((P.skip >> 12) & 1)) gather_phase(P); }
    GSYNC(); } STAMP(14);
#pragma unroll 1
    for (int rep = 0; rep < NREP_MUP; ++rep) {
    {   LP; if (!((P.skip >> 13) & 1)) {
        pg8::SchedMoe S; S.init((const int*)(ws + WS_CNT), 2048, 1024, (size_t)2048 * 1024 * 2, G, c); pg8::EpiUp<0> E{(bf16_t*)(ws + WS_BIG), 1024};
        pg8::gemm_phase<true>(ldsl, (const char*)(ws + WS_GA), (const char*)(ws + WS_WMUP), 1024, S, E); } }
    GSYNC(); } STAMP(15);
#pragma unroll 1
    for (int rep = 0; rep < NREP_MDN; ++rep) {
    {   LP; if (!((P.skip >> 14) & 1)) {
        pg8::SchedMoe S; S.init((const int*)(ws + WS_CNT), 1024, 1024, (size_t)1024 * 1024 * 2, G, c); pg8::EpiBf16 E{(bf16_t*)(ws + WS_Y), 1024};
        pg8::gemm_phase<false>(ldsl, (const char*)(ws + WS_BIG), (const char*)(ws + WS_WMDN), 1024, S, E); } }
    GSYNC(); } STAMP(16);
    { LP; if (!((P.skip >> 15) & 1)) ln_phase<2, false>(P, H, P.ln_g + 3072, P.ln_b + 3072, lds, H, (bf16_t*)(ws + WS_H16), nullptr); }
#ifdef PROF_A_HI
    GSYNC(); STAMP(17);
    {   LP; const unsigned long long* stamps = (const unsigned long long*)(P.ws + WS_CNT + 1024);
        const float tA = (float)(stamps[PROF_A_HI] - stamps[PROF_A_LO]) * 0.01f, tB = (float)(stamps[PROF_B_HI] - stamps[PROF_B_LO]) * 0.01f;
        for (int i = blockIdx.x * 512 + threadIdx.x; i < (1 << 22); i += gridDim.x * 512) H[(size_t)i * 8 + 1] = tB;
        if (blockIdx.x == 0 && threadIdx.x == 0) H[0] = 64.0f * tA; }
#endif
#ifdef PROF_A_HI
#endif
    }
#else
    { LP; ln_phase<0, false>(P, H, P.ln_g + 2048, P.ln_b + 2048, lds, H, (bf16_t*)(ws + WS_H16), (LEVEL >= 3) ? (const bf16_t*)(ws + WS_GA) : nullptr); }
    GSYNC(); STAMP(13);
    { LP; ln_phase<0, false>(P, H, P.ln_g + 3072, P.ln_b + 3072, lds, H, (bf16_t*)(ws + WS_H16), nullptr); }
#endif
}

extern "C" void kernel_launch(void* const* d_in, const int* in_sizes, int n_in, void* d_out, int out_size, void* d_ws, size_t ws_size, hipStream_t stream) {
    static int grid_blocks = 0;
    if (grid_blocks == 0) {
        if (n_in != 25 || out_size != T_ * D_ || ws_size < WS_END) { fprintf(stderr, "kernel_launch: unexpected shapes (n_in %d out %d ws %zu)\n", n_in, out_size, ws_size); grid_blocks = -1; return; }
        int dev = 0, cus = 0, per_cu = 0;
        hipGetDevice(&dev); hipDeviceGetAttribute(&cus, hipDeviceAttributeMultiprocessorCount, dev);
        if (hipFuncSetAttribute((const void*)yoco_fwd, hipFuncAttributeMaxDynamicSharedMemorySize, LDS_BYTES) != hipSuccess) { fprintf(stderr, "kernel_launch: hipFuncSetAttribute failed\n"); grid_blocks = -1; return; }
        if (hipOccupancyMaxActiveBlocksPerMultiprocessor(&per_cu, (const void*)yoco_fwd, 512, LDS_BYTES) != hipSuccess || per_cu < 1) { fprintf(stderr, "kernel_launch: occupancy query says %d\n", per_cu); per_cu = 1; (void)hipGetLastError(); }
        grid_blocks = cus * 1;
    }
    if (grid_blocks < 0) return;
    Params p{};
    p.x = (const float*)d_in[0]; p.pos = (const int*)d_in[1]; p.ln_g = (const float*)d_in[2]; p.ln_b = (const float*)d_in[3];
    p.lam_re = (const float*)d_in[4]; p.lam_im = (const float*)d_in[5]; p.log_step = (const float*)d_in[6]; p.b_re = (const float*)d_in[7]; p.b_im = (const float*)d_in[8];
    p.c_re = (const float*)d_in[9]; p.c_im = (const float*)d_in[10]; p.ssm_d = (const float*)d_in[11]; p.w_glu = (const float*)d_in[12]; p.kv_w = (const float*)d_in[13];
    p.w_q = (const float*)d_in[14]; p.sinks = (const float*)d_in[15]; p.w_out = (const float*)d_in[16]; p.ffn_g = (const float*)d_in[17]; p.ffn_u = (const float*)d_in[18]; p.ffn_d = (const float*)d_in[19];
    p.w_router = (const float*)d_in[20]; p.b_router = (const float*)d_in[21]; p.moe_g = (const float*)d_in[22]; p.moe_u = (const float*)d_in[23]; p.moe_d = (const float*)d_in[24];
    p.out = (float*)d_out; p.ws = (unsigned char*)d_ws;
    void* args[] = {&p};
#ifdef SKIP_PROBE
    p.skip = SKIP_PROBE; (void)hipLaunchCooperativeKernel((const void*)yoco_fwd, dim3(grid_blocks), dim3(512), args, LDS_BYTES, stream); p.skip = 0;
#endif
    hipError_t e = hipLaunchCooperativeKernel((const void*)yoco_fwd, dim3(grid_blocks), dim3(512), args, LDS_BYTES, stream);
    if (e != hipSuccess) fprintf(stderr, "cooperative launch failed: %s (grid %d)\n", hipGetErrorString(e), grid_blocks);
}
```

```cpp
#include <hip/hip_runtime.h>
#include <hip/hip_cooperative_groups.h>
#include <cstdio>
namespace cg = cooperative_groups;

#ifndef LEVEL
#define LEVEL 4
#endif

#ifdef DUP_S1
#define NREP_S1 2
#else
#define NREP_S1 1
#endif
#ifdef DUP_S2
#define NREP_S2 2
#else
#define NREP_S2 1
#endif
#ifdef DUP_GLU
#define NREP_GLU 2
#else
#define NREP_GLU 1
#endif
#ifdef DUP_FUP
#define NREP_FUP 2
#else
#define NREP_FUP 1
#endif
#if defined(DUP_FDN) || defined(DUP_FDNNULL)
#define NREP_FDN 2
#else
#define NREP_FDN 1
#endif
#ifdef DUP_QKV
#define NREP_QKV 2
#else
#define NREP_QKV 1
#endif
#if defined(DUP_OUT) || defined(DUP_OUTNULL)
#define NREP_OUT 2
#else
#define NREP_OUT 1
#endif
#ifdef DUP_MUP
#define NREP_MUP 2
#else
#define NREP_MUP 1
#endif
#ifdef DUP_MDN
#define NREP_MDN 2
#else
#define NREP_MDN 1
#endif
#ifdef DUP_SCAN
#define NREP_SCAN 2
#else
#define NREP_SCAN 1
#endif
#ifdef DUP_GATH
#define NREP_GATH 2
#else
#define NREP_GATH 1
#endif
#ifdef DUP_OUTNULL
#define SKIP_EPI_OUT (rep == 0)
#else
#define SKIP_EPI_OUT false
#endif
#ifdef DUP_FDNNULL
#define SKIP_EPI_FDN (rep == 0)
#else
#define SKIP_EPI_FDN false
#endif
#define LAS __attribute__((address_space(3)))
typedef unsigned short bf16_t;
typedef short bf16x8 __attribute__((ext_vector_type(8)));
typedef float f32x4 __attribute__((ext_vector_type(4)));
typedef float f32x16 __attribute__((ext_vector_type(16)));
typedef unsigned u32x4 __attribute__((ext_vector_type(4)));
typedef unsigned u32x2 __attribute__((ext_vector_type(2)));

constexpr int T_ = 32768, D_ = 1024, FF_ = 2816;
constexpr float ALPHA = 1.41421356237309515f;
constexpr float LN_EPS = 1e-5f;
constexpr size_t MiB = 1ull << 20;
constexpr size_t WS_CNT = 0, WS_BAR = 4096, WS_A32 = 65536, WS_ROPEC = 1 * MiB, WS_ROPES = 2 * MiB, WS_LIST = 3 * MiB, WS_TOK = 4 * MiB;
constexpr size_t WS_WMUP = 8 * MiB, WS_WMDN = 40 * MiB, WS_WGLU = 56 * MiB, WS_WUP = 60 * MiB, WS_WDN = 71 * MiB, WS_WQKV = 77 * MiB, WS_WO = 80 * MiB;
constexpr size_t WS_H16 = 82 * MiB, WS_BT2 = 146 * MiB, WS_BT1 = 186 * MiB, WS_XA = 202 * MiB, WS_SST = 282 * MiB, WS_GA = 146 * MiB, WS_Y = 146 * MiB;
constexpr size_t WS_BIG = 314 * MiB, WS_END = 490 * MiB;
constexpr size_t XAG_GSTRIDE = (size_t)1024 * 640 * 2;
constexpr int LDS_BYTES = 131072 + 16;

struct Params {
    const float* x; const int* pos; const float* ln_g; const float* ln_b;
    const float* lam_re; const float* lam_im; const float* log_step; const float* b_re; const float* b_im; const float* c_re; const float* c_im;
    const float* ssm_d; const float* w_glu; const float* kv_w; const float* w_q; const float* sinks; const float* w_out;
    const float* ffn_g; const float* ffn_u; const float* ffn_d; const float* w_router; const float* b_router;
    const float* moe_g; const float* moe_u; const float* moe_d;
    float* out; unsigned char* ws; int skip; int pad;
};

__device__ __forceinline__ unsigned pk_bf16(float lo, float hi) { unsigned r; asm volatile("v_cvt_pk_bf16_f32 %0, %1, %2" : "=v"(r) : "v"(lo), "v"(hi)); return r; }
typedef _Float16 f16x8 __attribute__((ext_vector_type(8)));
typedef _Float16 f16x2 __attribute__((ext_vector_type(2)));
__device__ __forceinline__ unsigned pk_f16(float lo, float hi) { union { f16x2 h; unsigned u; } c; c.h = (f16x2){(_Float16)lo, (_Float16)hi}; return c.u; }
__device__ __forceinline__ float hf_lo(unsigned w) { union { unsigned u; f16x2 h; } c; c.u = w; return (float)c.h[0]; }
__device__ __forceinline__ float hf_hi(unsigned w) { union { unsigned u; f16x2 h; } c; c.u = w; return (float)c.h[1]; }
__device__ __forceinline__ float bf_lo(unsigned w) { return __uint_as_float(w << 16); }
__device__ __forceinline__ float bf_hi(unsigned w) { return __uint_as_float(w & 0xffff0000u); }
__device__ __forceinline__ float sigmoidf_(float x) { return __builtin_amdgcn_rcpf(1.0f + __expf(-x)); }
__device__ __forceinline__ float gelu_tanh(float y) { const float u = 1.5957691216057308f * (y + 0.044715f * y * y * y); return y * sigmoidf_(u); }
__device__ __forceinline__ float xor16(float v) { const unsigned u = __float_as_uint(v); const auto r = __builtin_amdgcn_permlane16_swap(u, u, false, false); return __uint_as_float(r[0] == u ? r[1] : r[0]); }
__device__ __forceinline__ float wave_sum(float v) {
    v += __shfl_xor(v, 32); v += __shfl_xor(v, 16); v += __shfl_xor(v, 8); v += __shfl_xor(v, 4); v += __shfl_xor(v, 2); v += __shfl_xor(v, 1); return v; }


#define XB_TMO      128
#define XB_XCNT(j)  (256  + 64 * (j))
#define XB_XSUB(j)  (1280 + 64 * (j))
#define XB_XGEN(j)  (2304 + 64 * (j))
#define XB_TOP      3328
#define XB_TOPGEN   3392
#define XCD_BAR_WORDS 3456
#define XB_SPIN_CAP (1u << 22)
__device__ __forceinline__ unsigned xb_ld(unsigned* p)              { return __hip_atomic_load(p, __ATOMIC_RELAXED, __HIP_MEMORY_SCOPE_AGENT); }
__device__ __forceinline__ unsigned xb_add(unsigned* p, unsigned v) { return __hip_atomic_fetch_add(p, v, __ATOMIC_RELAXED, __HIP_MEMORY_SCOPE_AGENT); }
__device__ __forceinline__ unsigned xb_xcc_id() { return (unsigned)__builtin_amdgcn_s_getreg((3 << 11) | 20) & 0xFu; }
#define XB_SPIN(cond, bar) do { unsigned _sp = 0; while (cond) { __builtin_amdgcn_s_sleep(1); \
    if ((++_sp & 255u) == 0u) { if (xb_ld(&(bar)[XB_TMO])) break; if (_sp > XB_SPIN_CAP) { atomicAdd(&(bar)[XB_TMO], 1u); break; } } } } while (0)
__device__ __forceinline__ void xcd_barrier_complete(unsigned* bar, unsigned x, unsigned& nloc, unsigned& nx) {
    const unsigned G = gridDim.x * gridDim.y * gridDim.z;
    unsigned sum, cnt, mine, sp = 0u;
    for (;;) {
        sum = 0u; cnt = 0u; mine = 0u;
#pragma unroll
        for (unsigned j = 0; j < 16; ++j) { const unsigned c = xb_ld(&bar[XB_XCNT(j)]); sum += c; cnt += (c > 0u) ? 1u : 0u; mine = (j == x) ? c : mine; }
        if (sum == G) break;
        __builtin_amdgcn_s_sleep(1);
        if ((++sp & 255u) == 0u) { if (xb_ld(&bar[XB_TMO])) break; if (sp > XB_SPIN_CAP) { atomicAdd(&bar[XB_TMO], 1u); break; } }
    }
    nloc = mine > 0u ? mine : 1u; nx = cnt > 0u ? cnt : 1u;
}
__device__ __forceinline__ void xcd_barrier(unsigned* bar, volatile LAS unsigned* st) {
    asm volatile("s_waitcnt vmcnt(0)" ::: "memory");
    __syncthreads();
    if (threadIdx.x == 0) {
        const unsigned x = xb_xcc_id();
        __builtin_amdgcn_s_waitcnt(0);
        unsigned nloc = st[0], nx = st[1];
        if (nloc == 0u) { xcd_barrier_complete(bar, x, nloc, nx); st[0] = nloc; st[1] = nx; }
        const unsigned old = xb_add(&bar[XB_XSUB(x)], 1u);
        const unsigned gen = old / nloc;
        if (old + 1u == (gen + 1u) * nloc) {
            __builtin_amdgcn_fence(__ATOMIC_RELEASE, "agent");
            asm volatile("s_waitcnt vmcnt(0)" ::: "memory");
            const unsigned og = xb_add(&bar[XB_TOP], 1u);
            const unsigned tg = og / nx;
            if (og + 1u == (tg + 1u) * nx) xb_add(&bar[XB_TOPGEN], 1u);
            else XB_SPIN(xb_ld(&bar[XB_TOPGEN]) == tg, bar);
            __builtin_amdgcn_fence(__ATOMIC_ACQUIRE, "agent");
            xb_add(&bar[XB_XGEN(x)], 1u);
            asm volatile("s_waitcnt vmcnt(0)" ::: "memory");
        } else {
            XB_SPIN(xb_ld(&bar[XB_XGEN(x)]) == gen, bar);
            __builtin_amdgcn_fence(__ATOMIC_ACQUIRE, "agent");
            asm volatile("s_waitcnt vmcnt(0)" ::: "memory");
        }
    }
    __syncthreads();
}

namespace pg8 {
constexpr int BM = 256, BK = 64, HALF = 128, HTB = HALF * BK * 2, NXCD = 8, WGM = 8;
__device__ __forceinline__ int lds_byte(int r, int c) { const int st = (r >> 4) * 2 + (c >> 5), rr = r & 15, cc = c & 31, ob = rr * 64 + cc * 2; return st * 1024 + (ob ^ (((ob >> 9) & 1) << 5)); }
__device__ __forceinline__ void stage_rc(int b, int& R, int& C) { const int st = b / 1024, sb = b % 1024, swz = sb ^ (((sb >> 9) & 1) << 5); R = (st >> 1) * 16 + swz / 64; C = (st & 1) * 32 + (swz % 64) / 2; }
__device__ __forceinline__ int perm32(int rho) { const int n = rho >> 4, i = rho & 15; return 8 * (i >> 2) + 4 * n + (i & 3); }
__device__ __forceinline__ int xcd_remap(int L, int nwg) { const int q = nwg / NXCD, r = nwg % NXCD, xcd = L % NXCD, off = L / NXCD; return (xcd < r ? xcd * (q + 1) : r * (q + 1) + (xcd - r) * q) + off; }

struct Unit { int pm, pn, aux, pad; size_t a_off, b_off; };

struct SchedDense {
    int nM, nN, nwg, G, c, lda, K;
    __device__ __forceinline__ void init(int M, int N, int K_, int lda_, int G_, int c_) { nM = M / BM; nN = N / BM; nwg = nM * nN; G = G_; c = c_; lda = lda_; K = K_; }
    __device__ __forceinline__ bool next(int i, Unit& u) const {
        const int L = i * G + c; if (L >= nwg) return false;
        const int wgid = xcd_remap(L, nwg);
        const int nig = WGM * nN, gid = wgid / nig, fm = gid * WGM, gsz = (nM - fm) < WGM ? (nM - fm) : WGM;
        u.pm = fm + ((wgid % nig) % gsz); u.pn = (wgid % nig) / gsz; u.aux = 0; u.pad = 0;
        u.a_off = (size_t)u.pm * BM * lda * 2; u.b_off = (size_t)u.pn * BM * K * 2; return true;
    }
    __device__ __forceinline__ unsigned voffA(int R, int C) const { return (unsigned)(R * lda + C) * 2u; }
    __device__ __forceinline__ size_t a_kstep() const { return BK * 2; }
    __device__ __forceinline__ size_t a_hstep() const { return (size_t)HALF * lda * 2; }
};
struct SchedMoe {
    int nM, nN, nwg, G, c, K; int tb[9]; size_t estride;
    __device__ __forceinline__ void init(const int* cnt, int N, int K_, size_t estride_, int G_, int c_) {
        tb[0] = 0;
#pragma unroll
        for (int e = 0; e < 8; ++e) tb[e + 1] = tb[e] + ((cnt[e] + 255) >> 8);
        nM = tb[8]; nN = N / BM; nwg = nM * nN; G = G_; c = c_; K = K_; estride = estride_; }
    __device__ __forceinline__ bool next(int i, Unit& u) const {
        const int L = i * G + c; if (L >= nwg) return false;
        const int wgid = xcd_remap(L, nwg);
        const int nig = WGM * nN, gid = wgid / nig, fm = gid * WGM, gsz = (nM - fm) < WGM ? (nM - fm) : WGM;
        u.pm = fm + ((wgid % nig) % gsz); u.pn = (wgid % nig) / gsz; int e = 0;
#pragma unroll
        for (int k = 1; k < 8; ++k) e += (u.pm >= tb[k]) ? 1 : 0;
        u.aux = e; u.pad = 0;
        u.a_off = (size_t)u.pm * BM * 1024 * 2; u.b_off = (size_t)e * estride + (size_t)u.pn * BM * K * 2; return true;
    }
    __device__ __forceinline__ unsigned voffA(int R, int C) const { return (unsigned)(R * 1024 + C) * 2u; }
    __device__ __forceinline__ size_t a_kstep() const { return BK * 2; }
    __device__ __forceinline__ size_t a_hstep() const { return (size_t)HALF * 1024 * 2; }
};
struct SchedSsm {
    int nN, nwg, G, c, K, N;
    __device__ __forceinline__ void init(int N_, int K_, int G_, int c_) { N = N_; nN = N_ / BM; nwg = 64 * 4 * nN; G = G_; c = c_; K = K_; }
    __device__ __forceinline__ bool next(int i, Unit& u) const {
        const int L = i * G + c; if (L >= nwg) return false;
        const int wgid = xcd_remap(L, nwg);
        const int per = 4 * nN, g = (wgid / (4 * per)) * 4 + (wgid & 3), rem = (wgid >> 2) % per;
        u.pm = rem & 3; u.pn = rem >> 2; u.aux = g; u.pad = 0;
        u.a_off = (size_t)g * XAG_GSTRIDE + (size_t)u.pm * BM * 640 * 2; u.b_off = (size_t)g * N * K * 2 + (size_t)u.pn * BM * K * 2; return true;
    }
    __device__ __forceinline__ unsigned voffA(int R, int C) const { return (unsigned)(R * 640 + C) * 2u; }
    __device__ __forceinline__ size_t a_kstep() const { return BK * 2; }
    __device__ __forceinline__ size_t a_hstep() const { return (size_t)HALF * 640 * 2; }
};

template <bool F16, class Epi, class Sched>
__device__ __forceinline__ void gemm_phase(LAS unsigned char* lds, const char* Ab, const char* Bb, const int K, const Sched& S, const Epi& E) {
    const int tid = threadIdx.x, wid = __builtin_amdgcn_readfirstlane(tid >> 6), lane = tid & 63, wr = wid >> 2, wc = wid & 3, fr = lane & 15, fq = lane >> 4;
    const int nt = K / BK;
    unsigned voffA[2], voffB[2];
#pragma unroll
    for (int i = 0; i < 2; ++i) { int R, C; stage_rc(tid * 16 + i * 8192, R, C); const int Rb = Epi::PERM ? ((R & ~31) + perm32(R & 31)) : R;
        voffA[i] = S.voffA(R, C); voffB[i] = (unsigned)(Rb * K + C) * 2u; }
    const size_t kstepA = S.a_kstep(), hstepA = S.a_hstep(), kstepB = (size_t)(BK * 2), hstepB = (size_t)HALF * K * 2;
    const unsigned ldsw = (unsigned)wid * 1024u;
    const int aoff = lds_byte(wr * 64 + fr, fq * 8), boff = lds_byte(wc * 32 + fr, fq * 8);
#define PG8_SA(b, h) (((b) * 2 + (h)) * HTB)
#define PG8_SB(b, h) ((4 + (b) * 2 + (h)) * HTB)
#define PG8_STAGE(bufoff, gbase, voff) do { _Pragma("unroll") for (int _i = 0; _i < 2; ++_i) \
        __builtin_amdgcn_global_load_lds((const unsigned*)((const char*)(gbase) + (voff)[_i]), (LAS unsigned*)(lds + (bufoff) + ldsw + _i * 8192), 16, 0, 0); } while (0)
#define PG8_LDA(dst, b, h) do { _Pragma("unroll") for (int m = 0; m < 4; ++m) _Pragma("unroll") for (int k = 0; k < 2; ++k) dst[m][k] = *(const LAS bf16x8*)(lds + PG8_SA(b, h) + aoff + m * 2048 + k * 1024); } while (0)
#define PG8_LDB(dst, b, h) do { _Pragma("unroll") for (int n = 0; n < 2; ++n) _Pragma("unroll") for (int k = 0; k < 2; ++k) dst[n][k] = *(const LAS bf16x8*)(lds + PG8_SB(b, h) + boff + n * 2048 + k * 1024); } while (0)
#define PG8_MMA(ai, bj, At, Bt) do { __builtin_amdgcn_s_setprio(1); _Pragma("unroll") for (int m = 0; m < 4; ++m) _Pragma("unroll") for (int n = 0; n < 2; ++n) _Pragma("unroll") for (int k = 0; k < 2; ++k) \
        acc[ai][bj][m][n] = F16 ? __builtin_amdgcn_mfma_f32_16x16x32_f16(__builtin_bit_cast(f16x8, Bt[n][k]), __builtin_bit_cast(f16x8, At[m][k]), acc[ai][bj][m][n], 0, 0, 0) : __builtin_amdgcn_mfma_f32_16x16x32_bf16(Bt[n][k], At[m][k], acc[ai][bj][m][n], 0, 0, 0); __builtin_amdgcn_s_setprio(0); } while (0)
#define PG8_WAIT_V(n) asm volatile("s_waitcnt vmcnt(" #n ")" ::: "memory")
#define PG8_WAIT_L(n) asm volatile("s_waitcnt lgkmcnt(" #n ")" ::: "memory")
#define PG8_BAR __builtin_amdgcn_s_barrier()
#define PG8_SCHED __builtin_amdgcn_sched_barrier(0)
    Unit cur, nxt; int ui = 0;
    if (!S.next(0, cur)) return;
    f32x4 acc[2][2][4][2];
#pragma unroll
    for (int a = 0; a < 2; ++a)
#pragma unroll
        for (int b = 0; b < 2; ++b)
#pragma unroll
            for (int m = 0; m < 4; ++m)
#pragma unroll
                for (int n = 0; n < 2; ++n) acc[a][b][m][n] = (f32x4){0.f, 0.f, 0.f, 0.f};
    bf16x8 At[4][2], B0[2][2], B1[2][2];
    const char* cA = Ab + cur.a_off; const char* cB = Bb + cur.b_off;
    PG8_STAGE(PG8_SB(0, 0), cB, voffB); PG8_STAGE(PG8_SA(0, 0), cA, voffA); PG8_STAGE(PG8_SB(0, 1), cB + hstepB, voffB); PG8_STAGE(PG8_SA(0, 1), cA + hstepA, voffA);
    if (wr == 1) PG8_BAR;
    PG8_WAIT_V(4); PG8_BAR;
    PG8_STAGE(PG8_SB(1, 0), cB + kstepB, voffB); PG8_STAGE(PG8_SA(1, 0), cA + kstepA, voffA); PG8_STAGE(PG8_SB(1, 1), cB + hstepB + kstepB, voffB);
    PG8_WAIT_V(6); PG8_BAR;
    for (;;) {
        const bool has_next = S.next(ui + 1, nxt);
        const char* nA = has_next ? Ab + nxt.a_off : cA; const char* nB = has_next ? Bb + nxt.b_off : cB;
        for (int t = 0; t < nt; t += 2) {
            const bool last = (t == nt - 2);
            const char* a1 = cA + (size_t)(t + 1) * kstepA;
            const char* a2 = last ? nA : cA + (size_t)(t + 2) * kstepA; const char* b2 = last ? nB : cB + (size_t)(t + 2) * kstepB;
            const char* a3 = a2 + kstepA; const char* b3 = b2 + kstepB;
            PG8_LDB(B0, 0, 0); PG8_SCHED; PG8_LDA(At, 0, 0); PG8_STAGE(PG8_SA(1, 1), a1 + hstepA, voffA);
            PG8_WAIT_L(8); PG8_BAR; PG8_WAIT_L(0); PG8_MMA(0, 0, At, B0); PG8_BAR; PG8_SCHED;
            PG8_LDB(B1, 0, 1); PG8_STAGE(PG8_SB(0, 0), b2, voffB);
            PG8_BAR; PG8_WAIT_L(0); PG8_MMA(0, 1, At, B1); PG8_BAR;
            PG8_LDA(At, 0, 1); PG8_STAGE(PG8_SA(0, 0), a2, voffA);
            PG8_BAR; PG8_WAIT_L(0); PG8_MMA(1, 0, At, B0); PG8_BAR; PG8_SCHED;
            PG8_STAGE(PG8_SB(0, 1), b2 + hstepB, voffB);
            PG8_WAIT_V(6); PG8_BAR; PG8_MMA(1, 1, At, B1); PG8_BAR;
            PG8_LDB(B0, 1, 0); PG8_SCHED; PG8_LDA(At, 1, 0); PG8_STAGE(PG8_SA(0, 1), a2 + hstepA, voffA);
            PG8_WAIT_L(8); PG8_BAR; PG8_WAIT_L(0); PG8_MMA(0, 0, At, B0); PG8_BAR; PG8_SCHED;
            PG8_LDB(B1, 1, 1); PG8_STAGE(PG8_SB(1, 0), b3, voffB);
            PG8_BAR; PG8_WAIT_L(0); PG8_MMA(0, 1, At, B1); PG8_BAR;
            PG8_LDA(At, 1, 1); PG8_STAGE(PG8_SA(1, 0), a3, voffA);
            PG8_BAR; PG8_WAIT_L(0); PG8_MMA(1, 0, At, B0); PG8_BAR; PG8_SCHED;
            PG8_STAGE(PG8_SB(1, 1), b3 + hstepB, voffB);
            PG8_WAIT_V(6); PG8_BAR; PG8_MMA(1, 1, At, B1); PG8_BAR;
        }
        E(acc, cur, wr, wc, fr, fq);
        if (!has_next) break;
#pragma unroll
        for (int a = 0; a < 2; ++a)
#pragma unroll
            for (int b = 0; b < 2; ++b)
#pragma unroll
                for (int m = 0; m < 4; ++m)
#pragma unroll
                    for (int n = 0; n < 2; ++n) acc[a][b][m][n] = (f32x4){0.f, 0.f, 0.f, 0.f};
        cur = nxt; cA = nA; cB = nB; ++ui;
    }
    PG8_WAIT_V(0);
    if (wr == 0) PG8_BAR;
    PG8_BAR;
#undef PG8_SA
#undef PG8_SB
#undef PG8_STAGE
#undef PG8_LDA
#undef PG8_LDB
#undef PG8_MMA
#undef PG8_WAIT_V
#undef PG8_WAIT_L
#undef PG8_BAR
#undef PG8_SCHED
}

typedef const f32x4 (&AccRef)[2][2][4][2];

struct EpiS1 {
    static constexpr bool PERM = false; float* sst;
    __device__ __forceinline__ void operator()(AccRef acc, const Unit& u, int wr, int wc, int fr, int fq) const {
#pragma unroll
        for (int ai = 0; ai < 2; ++ai)
#pragma unroll
            for (int m = 0; m < 4; ++m) { const int row = u.pm * BM + ai * HALF + wr * 64 + m * 16 + fr; float* rp = sst + ((size_t)row * 64 + u.aux) * 128 + wc * 32 + 4 * fq;
#pragma unroll
                for (int n = 0; n < 2; ++n) *(f32x4*)(rp + 16 * n) = acc[ai][0][m][n]; }
    }
};
struct EpiS2 {
    static constexpr bool PERM = true; bf16_t* g16;
    __device__ __forceinline__ void operator()(AccRef acc, const Unit& u, int wr, int wc, int fr, int fq) const {
        const int ch = u.aux * 16 + 8 * (fq & 1);
#pragma unroll
        for (int ai = 0; ai < 2; ++ai)
#pragma unroll
            for (int m = 0; m < 4; ++m) { const int row = u.pm * BM + ai * HALF + wr * 64 + m * 16 + fr;
#pragma unroll
                for (int bj = 0; bj < 2; ++bj) { const int t = 16 * u.pn + 8 * bj + 2 * wc + (fq >> 1);
                    const f32x4 y0 = acc[ai][bj][m][0], y1 = acc[ai][bj][m][1];
                    u32x4 w; w.x = pk_bf16(gelu_tanh(y0[0]), gelu_tanh(y0[1])); w.y = pk_bf16(gelu_tanh(y0[2]), gelu_tanh(y0[3]));
                    w.z = pk_bf16(gelu_tanh(y1[0]), gelu_tanh(y1[1])); w.w = pk_bf16(gelu_tanh(y1[2]), gelu_tanh(y1[3]));
                    *(u32x4*)(g16 + ((size_t)row * 32 + t) * 1024 + ch) = w; } }
    }
};
struct EpiGlu {
    static constexpr bool PERM = false; const float* x; float* out;
    __device__ __forceinline__ void operator()(AccRef acc, const Unit& u, int wr, int wc, int fr, int fq) const {
#pragma unroll
        for (int ai = 0; ai < 2; ++ai)
#pragma unroll
            for (int m = 0; m < 4; ++m) { const int row = u.pm * BM + ai * HALF + wr * 64 + m * 16 + fr; const size_t off = (size_t)row * 1024 + u.pn * 128 + wc * 32 + 4 * fq;
#pragma unroll
                for (int n = 0; n < 2; ++n) { const f32x4 xv = *(const f32x4*)(x + off + 16 * n); const f32x4 v = acc[ai][0][m][n], g = acc[ai][1][m][n]; f32x4 o;
#pragma unroll
                    for (int j = 0; j < 4; ++j) o[j] = ALPHA * xv[j] + v[j] * sigmoidf_(g[j]);
                    *(f32x4*)(out + off + 16 * n) = o; } }
    }
};
template <int ACT> struct EpiUp {
    static constexpr bool PERM = true; bf16_t* act; int ld;
    __device__ __forceinline__ void operator()(AccRef acc, const Unit& u, int wr, int wc, int fr, int fq) const {
#pragma unroll
        for (int ai = 0; ai < 2; ++ai)
#pragma unroll
            for (int m = 0; m < 4; ++m) { const int row = u.pm * BM + ai * HALF + wr * 64 + m * 16 + fr; float r[8];
#pragma unroll
                for (int n = 0; n < 2; ++n)
#pragma unroll
                    for (int j = 0; j < 4; ++j) { const float g = acc[ai][0][m][n][j], up = acc[ai][1][m][n][j]; r[4 * n + j] = (ACT == 0) ? g * sigmoidf_(g) * up : g * sigmoidf_(up); }
                u32x4 w; w.x = pk_bf16(r[0], r[1]); w.y = pk_bf16(r[2], r[3]); w.z = pk_bf16(r[4], r[5]); w.w = pk_bf16(r[6], r[7]);
                *(u32x4*)(act + (size_t)row * ld + u.pn * 128 + wc * 32 + 8 * fq) = w; }
    }
};
struct EpiRes {
    static constexpr bool PERM = false; const float* hin; float* h; bool skip;
    __device__ __forceinline__ void operator()(AccRef acc, const Unit& u, int wr, int wc, int fr, int fq) const {
        if (skip) return;
#pragma unroll
        for (int ai = 0; ai < 2; ++ai)
#pragma unroll
            for (int m = 0; m < 4; ++m) { const int row = u.pm * BM + ai * HALF + wr * 64 + m * 16 + fr; const size_t ro = (size_t)row * 1024 + u.pn * BM + wc * 32 + 4 * fq;
#pragma unroll
                for (int bj = 0; bj < 2; ++bj)
#pragma unroll
                    for (int n = 0; n < 2; ++n) { const size_t o = ro + bj * HALF + 16 * n; const f32x4 hv = *(const f32x4*)(hin + o); *(f32x4*)(h + o) = ALPHA * hv + acc[ai][bj][m][n]; } }
    }
};
struct EpiQkv {
    static constexpr bool PERM = true; bf16_t* q; bf16_t* k; bf16_t* v; const float* rc; const float* rs;
    __device__ __forceinline__ void operator()(AccRef acc, const Unit& u, int wr, int wc, int fr, int fq) const {
        const bool rope = (u.pn <= 4) && ((wc & 1) == 0);
        bf16_t* base; int ld, colt; float scale = 1.0f;
        if (u.pn < 4) { base = q; ld = 1024; colt = u.pn * BM; scale = 0.125f * 1.4426950408889634f; } else if (u.pn == 4) { base = k; ld = 256; colt = 0; } else { base = v; ld = 256; colt = 0; }
#pragma unroll
        for (int ai = 0; ai < 2; ++ai)
#pragma unroll
            for (int m = 0; m < 4; ++m) { const int row = u.pm * BM + ai * HALF + wr * 64 + m * 16 + fr;
                f32x4 c0 = {1.f, 1.f, 1.f, 1.f}, c1 = c0, s0 = {0.f, 0.f, 0.f, 0.f}, s1 = s0;
                if (rope && fq < 2) { c0 = *(const f32x4*)(rc + (size_t)row * 8); c1 = *(const f32x4*)(rc + (size_t)row * 8 + 4); s0 = *(const f32x4*)(rs + (size_t)row * 8); s1 = *(const f32x4*)(rs + (size_t)row * 8 + 4);
                    if (fq == 0) { s0 = -s0; s1 = -s1; } }
#pragma unroll
                for (int bj = 0; bj < 2; ++bj) { f32x4 v0 = acc[ai][bj][m][0], v1 = acc[ai][bj][m][1];
                    if (rope) { f32x4 p0, p1;
#pragma unroll
                        for (int j = 0; j < 4; ++j) { p0[j] = xor16(v0[j]); p1[j] = xor16(v1[j]); }
                        v0 = v0 * c0 + p0 * s0; v1 = v1 * c1 + p1 * s1; }
                    v0 = v0 * scale; v1 = v1 * scale;
                    u32x4 w; w.x = pk_bf16(v0[0], v0[1]); w.y = pk_bf16(v0[2], v0[3]); w.z = pk_bf16(v1[0], v1[1]); w.w = pk_bf16(v1[2], v1[3]);
                    *(u32x4*)(base + (size_t)row * ld + colt + bj * HALF + wc * 32 + 8 * fq) = w; } }
    }
};
struct EpiBf16 {
    static constexpr bool PERM = true; bf16_t* o; int ld;
    __device__ __forceinline__ void operator()(AccRef acc, const Unit& u, int wr, int wc, int fr, int fq) const {
#pragma unroll
        for (int ai = 0; ai < 2; ++ai)
#pragma unroll
            for (int m = 0; m < 4; ++m) { const int row = u.pm * BM + ai * HALF + wr * 64 + m * 16 + fr;
#pragma unroll
                for (int bj = 0; bj < 2; ++bj) { const f32x4 v0 = acc[ai][bj][m][0], v1 = acc[ai][bj][m][1];
                    u32x4 w; w.x = pk_bf16(v0[0], v0[1]); w.y = pk_bf16(v0[2], v0[3]); w.z = pk_bf16(v1[0], v1[1]); w.w = pk_bf16(v1[2], v1[3]);
                    *(u32x4*)(o + (size_t)row * ld + u.pn * BM + bj * HALF + wc * 32 + 8 * fq) = w; } }
    }
};
struct EpiNull {
    static constexpr bool PERM = false; float* h;
    __device__ __forceinline__ void operator()(AccRef acc, const Unit& u, int wr, int wc, int fr, int fq) const {
        if (u.pm < 0) {
#pragma unroll
            for (int ai = 0; ai < 2; ++ai)
#pragma unroll
                for (int m = 0; m < 4; ++m)
#pragma unroll
                    for (int bj = 0; bj < 2; ++bj)
#pragma unroll
                        for (int n = 0; n < 2; ++n) *(f32x4*)(h + ((ai * 4 + m) * 4 + bj * 2 + n) * 256 + fr * 16 + fq * 4) = acc[ai][bj][m][n]; }
    }
};
}

struct TJob { const float* s0; const float* s1; bf16_t* dst; int ld, k0, Kd, n0, f16; };
__device__ __forceinline__ void tjob_decode(const Params& P, int jt, TJob& j) {
    if (jt < 128) { const int pn = jt & 7, kt = jt >> 3;
        j.s0 = P.w_glu + 128 * pn; j.s1 = P.w_glu + 1024 + 128 * pn; j.ld = 2048; j.k0 = kt * 64; j.dst = (bf16_t*)(P.ws + WS_WGLU); j.Kd = 1024; j.n0 = 256 * pn; j.f16 = 0; }
    else if ((jt -= 128) < 352) { const int pn = jt % 22, kt = jt / 22;
        j.s0 = P.ffn_g + 128 * pn; j.s1 = P.ffn_u + 128 * pn; j.ld = 2816; j.k0 = kt * 64; j.dst = (bf16_t*)(P.ws + WS_WUP); j.Kd = 1024; j.n0 = 256 * pn; j.f16 = 1; }
    else if ((jt -= 352) < 176) { const int pn = jt & 3, kt = jt >> 2;
        j.s0 = P.ffn_d + 256 * pn; j.s1 = j.s0 + 128; j.ld = 1024; j.k0 = kt * 64; j.dst = (bf16_t*)(P.ws + WS_WDN); j.Kd = 2816; j.n0 = 256 * pn; j.f16 = 0; }
    else if ((jt -= 176) < 64) { const int pn = jt & 3, kt = jt >> 2;
        j.s0 = P.w_q + 256 * pn; j.s1 = j.s0 + 128; j.ld = 1024; j.k0 = kt * 64; j.dst = (bf16_t*)(P.ws + WS_WQKV); j.Kd = 1024; j.n0 = 256 * pn; j.f16 = 1; }
    else if ((jt -= 64) < 32) { const int pn = jt & 1, kt = jt >> 1;
        j.s0 = P.kv_w + 256 * pn; j.s1 = j.s0 + 128; j.ld = 512; j.k0 = kt * 64; j.dst = (bf16_t*)(P.ws + WS_WQKV); j.Kd = 1024; j.n0 = 1024 + 256 * pn; j.f16 = 1; }
    else if ((jt -= 32) < 64) { const int pn = jt & 3, kt = jt >> 2;
        j.s0 = P.w_out + 256 * pn; j.s1 = j.s0 + 128; j.ld = 1024; j.k0 = kt * 64; j.dst = (bf16_t*)(P.ws + WS_WO); j.Kd = 1024; j.n0 = 256 * pn; j.f16 = 0; }
    else if ((jt -= 64) < 1024) { const int e = jt & 7, r = jt >> 3, pn = r & 7, kt = r >> 3;
        j.s0 = P.moe_g + (size_t)e * 1048576 + 128 * pn; j.s1 = P.moe_u + (size_t)e * 1048576 + 128 * pn; j.ld = 1024; j.k0 = kt * 64; j.dst = (bf16_t*)(P.ws + WS_WMUP) + (size_t)e * 2048 * 1024; j.Kd = 1024; j.n0 = 256 * pn; j.f16 = 1; }
    else { jt -= 1024; const int e = jt & 7, r = jt >> 3, pn = r & 3, kt = r >> 2;
        j.s0 = P.moe_d + (size_t)e * 1048576 + 256 * pn; j.s1 = j.s0 + 128; j.ld = 1024; j.k0 = kt * 64; j.dst = (bf16_t*)(P.ws + WS_WMDN) + (size_t)e * 1048576; j.Kd = 1024; j.n0 = 256 * pn; j.f16 = 0; }
}
#define TJ_LOAD(J, V) do { const int nn_ = (tid & 63) * 4, kb_ = tid >> 6; const float* sp_ = (nn_ < 128) ? ((J).s0 + nn_) : ((J).s1 + (nn_ - 128)); \
    _Pragma("unroll") for (int i = 0; i < 8; ++i) (V)[i] = *(const f32x4*)(sp_ + (size_t)((J).k0 + kb_ + 8 * i) * (J).ld); } while (0)
__device__ void transposes_phase(const Params& P, float* tile) {
    constexpr int J_T = 2352;
    const int tid = threadIdx.x, G = gridDim.x;
    int jt = blockIdx.x; TJob cur, nxt; f32x4 v[8], vn[8];
    if (jt < J_T) { tjob_decode(P, jt, cur); TJ_LOAD(cur, v); }
    while (jt < J_T) {
        { const int nn = (tid & 63) * 4, kb = tid >> 6;
#pragma unroll
          for (int i = 0; i < 8; ++i) { float* t = tile + (kb + 8 * i) * 257 + nn; t[0] = v[i][0]; t[1] = v[i][1]; t[2] = v[i][2]; t[3] = v[i][3]; } }
        __syncthreads();
        const int jn = jt + G;
        if (jn < J_T) { tjob_decode(P, jn, nxt); TJ_LOAD(nxt, vn); }
        { const int ks = (tid & 7) * 8;
#pragma unroll
          for (int i = 0; i < 4; ++i) { const int n = (tid >> 3) + 64 * i; float r[8];
#pragma unroll
              for (int j = 0; j < 8; ++j) r[j] = tile[(ks + j) * 257 + n];
              u32x4 w; if (cur.f16) { w.x = pk_f16(r[0], r[1]); w.y = pk_f16(r[2], r[3]); w.z = pk_f16(r[4], r[5]); w.w = pk_f16(r[6], r[7]); } else { w.x = pk_bf16(r[0], r[1]); w.y = pk_bf16(r[2], r[3]); w.z = pk_bf16(r[4], r[5]); w.w = pk_bf16(r[6], r[7]); }
              *(u32x4*)(cur.dst + (size_t)(cur.n0 + n) * cur.Kd + cur.k0 + ks) = w; } }
        __syncthreads();
        cur = nxt; jt = jn;
#pragma unroll
        for (int i = 0; i < 8; ++i) v[i] = vn[i];
    }
}

__device__ void ssm_tables(const Params& P, int g, int qtr, unsigned char* lds) {
    const int tid = threadIdx.x;
    float* apr = (float*)lds;
    float* api = apr + 33 * 64;
    float* bbr = api + 33 * 64;
    float* bbi = bbr + 1024;
    float* ccr = bbi + 1024;
    float* cci = ccr + 1024;
    float* kg = cci + 1024;
    const float dtf = expf(P.log_step[g]);
    for (int idx = tid; idx < 33 * 64; idx += 512) { const int tau = idx >> 6, p = idx & 63;
        const float lr = P.lam_re[g * 64 + p], li = P.lam_im[g * 64 + p];
        const double dt = (double)dtf; double rev = (double)li * dt * (double)tau * 0.15915494309189535; rev -= floor(rev);
        const float ang = (float)(rev * 6.283185307179586); float sn, cs; sincosf(ang, &sn, &cs);
        const float mag = expf((float)((double)lr * dt * (double)tau));
        apr[idx] = mag * cs; api[idx] = mag * sn; }
    for (int idx = tid; idx < 1024; idx += 512) { ccr[idx] = P.c_re[g * 1024 + idx]; cci[idx] = P.c_im[g * 1024 + idx]; }
    __syncthreads();
    for (int idx = tid; idx < 1024; idx += 512) { const int p = idx >> 4;
        const float lr = P.lam_re[g * 64 + p], li = P.lam_im[g * 64 + p], ar = apr[64 + p], ai = api[64 + p];
        const float nr = ar - 1.0f, den = lr * lr + li * li, kr = (nr * lr + ai * li) / den, ki = (ai * lr - nr * li) / den;
        const float br = P.b_re[g * 1024 + idx], bi = P.b_im[g * 1024 + idx];
        bbr[idx] = kr * br - ki * bi; bbi[idx] = kr * bi + ki * br; }
    __syncthreads();
    { const int cp = tid & 15, c = 4 * qtr + ((tid >> 4) & 3), t0 = tid >> 6;
      for (int i = 0; i < 4; ++i) { const int tau = t0 + 8 * i; float s = 0.f;
          for (int p = 0; p < 64; ++p) { const float cr = ccr[c * 64 + p], ci = cci[c * 64 + p], ar = apr[tau * 64 + p], ai = api[tau * 64 + p];
              const float zr = cr * ar - ci * ai, zi = cr * ai + ci * ar; s += zr * bbr[p * 16 + cp] - zi * bbi[p * 16 + cp]; }
          if (tau == 0 && cp == c) s += P.ssm_d[g * 16 + c];
          kg[(tau * 16 + c) * 16 + cp] = s; } }
    __syncthreads();
    bf16_t* bt2 = (bf16_t*)(P.ws + WS_BT2) + (size_t)g * 512 * 640;
    for (int pc = tid; pc < 128 * 80; pc += 512) { const int nq = pc / 80, k8 = (pc % 80) * 8, t = nq >> 2, c = 4 * qtr + (nq & 3), n = t * 16 + c; float r[8];
        if (k8 < 512) { const int s = k8 >> 4, c0 = k8 & 15;
#pragma unroll
            for (int j = 0; j < 8; ++j) r[j] = (t >= s) ? kg[((t - s) * 16 + c) * 16 + c0 + j] : 0.f;
        } else { const int q0 = k8 - 512;
#pragma unroll
            for (int j = 0; j < 8; j += 2) { const int p = (q0 + j) >> 1; const float cr = ccr[c * 64 + p], ci = cci[c * 64 + p], ar = apr[(t + 1) * 64 + p], ai = api[(t + 1) * 64 + p];
                r[j] = cr * ar - ci * ai; r[j + 1] = -(cr * ai + ci * ar); } }
        u32x4 w; w.x = pk_bf16(r[0], r[1]); w.y = pk_bf16(r[2], r[3]); w.z = pk_bf16(r[4], r[5]); w.w = pk_bf16(r[6], r[7]);
        *(u32x4*)(bt2 + (size_t)n * 640 + k8) = w; }
    bf16_t* bt1 = (bf16_t*)(P.ws + WS_BT1) + (size_t)g * 256 * 512;
    for (int pc = tid; pc < 64 * 64; pc += 512) { const int q = 64 * qtr + (pc >> 6), k8 = (pc & 63) * 8; float r[8];
        if (q < 128) { const int p = q >> 1, s = k8 >> 4, c0 = k8 & 15; const float ar = apr[(31 - s) * 64 + p], ai = api[(31 - s) * 64 + p];
#pragma unroll
            for (int j = 0; j < 8; ++j) { const float br = bbr[p * 16 + c0 + j], bi = bbi[p * 16 + c0 + j]; r[j] = (q & 1) ? (ar * bi + ai * br) : (ar * br - ai * bi); }
        } else {
#pragma unroll
            for (int j = 0; j < 8; ++j) r[j] = 0.f; }
        u32x4 w; w.x = pk_bf16(r[0], r[1]); w.y = pk_bf16(r[2], r[3]); w.z = pk_bf16(r[4], r[5]); w.w = pk_bf16(r[6], r[7]);
        *(u32x4*)(bt1 + (size_t)q * 512 + k8) = w; }
    float* a32 = (float*)(P.ws + WS_A32);
    if (qtr == 0 && tid < 64) { a32[(g * 64 + tid) * 2] = apr[32 * 64 + tid]; a32[(g * 64 + tid) * 2 + 1] = api[32 * 64 + tid]; }
    __syncthreads();
}

__device__ void p0_prep(const Params& P, unsigned char* lds, const int mask) {
    const int tid = threadIdx.x, G = gridDim.x;
    if (blockIdx.x == 0 && tid < 8) ((int*)(P.ws + WS_CNT))[tid] = 0;
    constexpr int J_SSM = 256, J_X = 1024, J_ROPE = 512;
    constexpr int NJ = J_SSM + J_X + J_ROPE;
    const bool tfirst = (blockIdx.x & 1) != 0;
    if (tfirst && (mask & 8)) { transposes_phase(P, (float*)lds); __syncthreads(); }
    for (int job = blockIdx.x; job < NJ; job += G) {
        if (job < J_SSM) {
#if LEVEL >= 1
            if (mask & 1) ssm_tables(P, job >> 2, job & 3, lds);
#endif
        }
        else if (job < J_SSM + J_X) { if (!(mask & 2)) continue;
            const int r = job - J_SSM;
            bf16_t* xa = (bf16_t*)(P.ws + WS_XA); bf16_t* st = (bf16_t*)lds;
            __syncthreads();
            f32x4 xa_[8], xb_[8];
#pragma unroll
            for (int i = 0; i < 8; ++i) { const int piece = tid + 512 * i, s = piece >> 7, c8 = (piece & 127) * 8; const float* xp = P.x + ((size_t)r * 32 + s) * 1024 + c8;
                xa_[i] = *(const f32x4*)xp; xb_[i] = *(const f32x4*)(xp + 4); }
#pragma unroll
            for (int i = 0; i < 8; ++i) { const int piece = tid + 512 * i, s = piece >> 7, c8 = (piece & 127) * 8;
                u32x4 w; w.x = pk_bf16(xa_[i][0], xa_[i][1]); w.y = pk_bf16(xa_[i][2], xa_[i][3]); w.z = pk_bf16(xb_[i][0], xb_[i][1]); w.w = pk_bf16(xb_[i][2], xb_[i][3]);
                *(u32x4*)(st + s * 1032 + c8) = w;
#if LEVEL < 1
                *(f32x4*)(P.out + ((size_t)r * 32 + s) * 1024 + c8) = xa_[i]; *(f32x4*)(P.out + ((size_t)r * 32 + s) * 1024 + c8 + 4) = xb_[i];
#endif
            }
            __syncthreads();
            { const int wv = tid >> 6, ln = tid & 63, s = ln >> 1, hf = ln & 1;
#pragma unroll
              for (int i = 0; i < 8; ++i) { const int g = wv * 8 + i;
                  const u32x4 w = *(const u32x4*)(st + s * 1032 + g * 16 + hf * 8);
                  *(u32x4*)(xa + (size_t)g * (XAG_GSTRIDE / 2) + (size_t)r * 640 + s * 16 + hf * 8) = w; } }
        }
        else if (job < J_SSM + J_X + J_ROPE) { if (!(mask & 4)) continue;
            const int tok = (job - J_SSM - J_X) * 64 + (tid >> 3), i = tid & 7;
            const float invf[8] = {1.0f, 0.19392274474868576f, 0.03760603093086393f, 0.007292664737217109f, 0.001414213562373095f, 0.0002742481756762073f, 5.318295896944988e-05f, 1.031338537721246e-05f};
            float f = invf[0];
#pragma unroll
            for (int k = 1; k < 8; ++k) f = (i == k) ? invf[k] : f;
            const float ang = (float)P.pos[tok] * f; float sn, cs; sincosf(ang, &sn, &cs);
            ((float*)(P.ws + WS_ROPEC))[tok * 8 + i] = cs; ((float*)(P.ws + WS_ROPES))[tok * 8 + i] = sn;
        }
    }
    if (!tfirst && (mask & 8)) { __syncthreads(); transposes_phase(P, (float*)lds); }
}

__device__ void scan_unit(const Params& P, int g, int pm) {
    const float* sst = (const float*)(P.ws + WS_SST); const float* a32 = (const float*)(P.ws + WS_A32); bf16_t* xa = (bf16_t*)(P.ws + WS_XA);
    const int tid = threadIdx.x;
    if (tid < 256) {
        const int p = tid & 63, b = pm * 4 + (tid >> 6), q = 2 * p;
        const float ar = a32[(g * 64 + p) * 2], ai = a32[(g * 64 + p) * 2 + 1];
        float hr = 0.f, hi = 0.f;
#pragma unroll 1
        for (int jb = 0; jb < 64; jb += 16) {
            float2 s[16];
#pragma unroll
            for (int j = 0; j < 16; ++j) s[j] = *(const float2*)(sst + ((size_t)(b * 64 + jb + j) * 64 + g) * 128 + q);
#pragma unroll
            for (int j = 0; j < 16; ++j) { const int row = b * 64 + jb + j;
                *(unsigned*)(xa + (size_t)g * (XAG_GSTRIDE / 2) + (size_t)row * 640 + 512 + q) = pk_bf16(hr, hi);
                const float nr = ar * hr - ai * hi + s[j].x, ni = ar * hi + ai * hr + s[j].y; hr = nr; hi = ni; }
        }
    }
}

template <int MODE, bool IN32>
__device__ void ln_phase(const Params& P, const float* h, const float* gam, const float* bet, unsigned char* lds, float* hout, bf16_t* h16, const bf16_t* d16) {
    const int tid = threadIdx.x, wid = tid >> 6, lane = tid & 63;
    float* wrt = (float*)lds;
    int* cnt = (int*)(P.ws + WS_CNT); int* lists = (int*)(P.ws + WS_LIST); int* toki = (int*)(P.ws + WS_TOK);
    const bf16_t* Y = (const bf16_t*)(P.ws + WS_Y);
    int base[8];
    int* lcnt = (int*)(lds + 32768);
    int* rinfo = (int*)(lds + 32768 + 64);
    if (MODE == 1) { for (int k = 0; k < 16; ++k) { const int idx = tid + 512 * k; wrt[(idx & 7) * 1024 + (idx >> 3)] = P.w_router[idx]; } if (tid < 8) lcnt[tid] = 0; __syncthreads(); }
    int kiter = 0;
    if (MODE == 2) { int acc = 0;
#pragma unroll
        for (int e = 0; e < 8; ++e) { base[e] = acc; acc += ((cnt[e] + 255) >> 8) << 8; } }
    f32x4 gv[4], bv[4];
#pragma unroll
    for (int i = 0; i < 4; ++i) { gv[i] = *(const f32x4*)(gam + 256 * i + lane * 4); bv[i] = *(const f32x4*)(bet + 256 * i + lane * 4); }
    f32x4 nf[4]; u32x2 nh[4], nd[4], na[4], nb2[4]; float nw1 = 0.f, nw2 = 0.f;
#pragma unroll
    for (int i = 0; i < 4; ++i) { nf[i] = (f32x4){0.f, 0.f, 0.f, 0.f}; nh[i] = (u32x2){0u, 0u}; nd[i] = nh[i]; na[i] = nh[i]; nb2[i] = nh[i]; }
#define LN_FETCH(R) do { const size_t ro_ = (size_t)(R) * 1024 + lane * 4; \
        if (IN32) { _Pragma("unroll") for (int i = 0; i < 4; ++i) nf[i] = *(const f32x4*)(h + ro_ + 256 * i); } \
        else { _Pragma("unroll") for (int i = 0; i < 4; ++i) nh[i] = *(const u32x2*)(h16 + ro_ + 256 * i); } \
        if (MODE != 2 && d16 != nullptr) { _Pragma("unroll") for (int i = 0; i < 4; ++i) nd[i] = *(const u32x2*)(d16 + ro_ + 256 * i); } \
        if (MODE == 2) { const int e1_ = toki[(R) * 8 + 0], p1_ = toki[(R) * 8 + 1], e2_ = toki[(R) * 8 + 2], p2_ = toki[(R) * 8 + 3]; \
            nw1 = __int_as_float(toki[(R) * 8 + 4]); nw2 = __int_as_float(toki[(R) * 8 + 5]); int b1_ = 0, b2_ = 0; \
            _Pragma("unroll") for (int e = 0; e < 8; ++e) { b1_ = (e1_ == e) ? base[e] : b1_; b2_ = (e2_ == e) ? base[e] : b2_; } \
            const bf16_t* y1_ = Y + (size_t)(b1_ + p1_) * 1024 + lane * 4; const bf16_t* y2_ = Y + (size_t)(b2_ + p2_) * 1024 + lane * 4; \
            _Pragma("unroll") for (int i = 0; i < 4; ++i) { na[i] = *(const u32x2*)(y1_ + 256 * i); nb2[i] = *(const u32x2*)(y2_ + 256 * i); } } } while (0)
    const int rstride = gridDim.x * 8;
    int row = blockIdx.x * 8 + wid;
    if (row < T_) LN_FETCH(row);
    for (; row < T_; row += rstride, ++kiter) {
        f32x4 v[4];
        if (IN32) {
#pragma unroll
            for (int i = 0; i < 4; ++i) v[i] = nf[i];
        } else {
#pragma unroll
            for (int i = 0; i < 4; ++i) v[i] = (f32x4){hf_lo(nh[i].x), hf_hi(nh[i].x), hf_lo(nh[i].y), hf_hi(nh[i].y)};
        }
        if (MODE != 2 && d16 != nullptr) {
#pragma unroll
            for (int i = 0; i < 4; ++i) { const u32x2 a = nd[i];
                v[i][0] = ALPHA * v[i][0] + bf_lo(a.x); v[i][1] = ALPHA * v[i][1] + bf_hi(a.x); v[i][2] = ALPHA * v[i][2] + bf_lo(a.y); v[i][3] = ALPHA * v[i][3] + bf_hi(a.y); }
        }
        if (MODE == 2) { const float w1 = nw1, w2 = nw2;
#pragma unroll
            for (int i = 0; i < 4; ++i) { const u32x2 a = na[i], b = nb2[i];
                v[i][0] = ALPHA * v[i][0] + (w1 * bf_lo(a.x) + w2 * bf_lo(b.x)); v[i][1] = ALPHA * v[i][1] + (w1 * bf_hi(a.x) + w2 * bf_hi(b.x));
                v[i][2] = ALPHA * v[i][2] + (w1 * bf_lo(a.y) + w2 * bf_lo(b.y)); v[i][3] = ALPHA * v[i][3] + (w1 * bf_hi(a.y) + w2 * bf_hi(b.y)); }
        }
        { const int nrow = row + rstride; if (nrow < T_) LN_FETCH(nrow); }
        float s = 0.f;
#pragma unroll
        for (int i = 0; i < 4; ++i) s += (v[i][0] + v[i][1]) + (v[i][2] + v[i][3]);
        const float mu = wave_sum(s) * (1.0f / 1024.0f);
        float q = 0.f;
#pragma unroll
        for (int i = 0; i < 4; ++i) { v[i] = v[i] - mu; q += (v[i][0] * v[i][0] + v[i][1] * v[i][1]) + (v[i][2] * v[i][2] + v[i][3] * v[i][3]); }
        const float rstd = rsqrtf(wave_sum(q) * (1.0f / 1024.0f) + LN_EPS);
#pragma unroll
        for (int i = 0; i < 4; ++i) { v[i] = v[i] * rstd * gv[i] + bv[i]; if (MODE == 2) *(f32x4*)(hout + (size_t)row * 1024 + 256 * i + lane * 4) = v[i];
            if (MODE != 2) { u32x2 w; w.x = pk_f16(v[i][0], v[i][1]); w.y = pk_f16(v[i][2], v[i][3]); *(u32x2*)(h16 + (size_t)row * 1024 + 256 * i + lane * 4) = w; } }
        if (MODE == 1) {
            float lg[8];
#pragma unroll
            for (int e = 0; e < 8; ++e) { float a = 0.f;
#pragma unroll
                for (int i = 0; i < 4; ++i) { const f32x4 w = *(const f32x4*)(wrt + e * 1024 + 256 * i + lane * 4); a += (v[i][0] * w[0] + v[i][1] * w[1]) + (v[i][2] * w[2] + v[i][3] * w[3]); }
                lg[e] = wave_sum(a) + P.b_router[e]; }
            int e1 = 0; float v1 = lg[0];
#pragma unroll
            for (int e = 1; e < 8; ++e) if (lg[e] > v1) { v1 = lg[e]; e1 = e; }
            int e2 = -1; float v2 = -3.0e38f;
#pragma unroll
            for (int e = 0; e < 8; ++e) if (e != e1 && lg[e] > v2) { v2 = lg[e]; e2 = e; }
            const float ex = __expf(v2 - v1), w1 = 1.0f / (1.0f + ex), w2 = ex / (1.0f + ex);
            if (lane == 0) { const int p1 = atomicAdd(lcnt + e1, 1), p2 = atomicAdd(lcnt + e2, 1); int* ri = rinfo + (kiter * 8 + wid) * 6;
                ri[0] = e1; ri[1] = p1; ri[2] = e2; ri[3] = p2; ri[4] = __float_as_int(w1); ri[5] = __float_as_int(w2); }
        }
    }
    if (MODE == 1) {
        __syncthreads();
        if (tid < 8) lcnt[8 + tid] = atomicAdd(cnt + tid, lcnt[tid]);
        __syncthreads();
        for (int lr = tid; lr < 512; lr += 512) { const int row = blockIdx.x * 8 + (lr & 7) + (lr >> 3) * gridDim.x * 8;
            if (row < T_) { const int* ri = rinfo + lr * 6; const int e1 = ri[0], e2 = ri[2], p1 = lcnt[8 + e1] + ri[1], p2 = lcnt[8 + e2] + ri[3];
                lists[e1 * T_ + p1] = row; lists[e2 * T_ + p2] = row;
                toki[row * 8 + 0] = e1; toki[row * 8 + 1] = p1; toki[row * 8 + 2] = e2; toki[row * 8 + 3] = p2; toki[row * 8 + 4] = ri[4]; toki[row * 8 + 5] = ri[5]; } }
    }
}

__device__ void gather_phase(const Params& P) {
    const int tid = threadIdx.x, wid = tid >> 6, lane = tid & 63;
    const int* cnt = (const int*)(P.ws + WS_CNT); const int* lists = (const int*)(P.ws + WS_LIST);
    const bf16_t* h16 = (const bf16_t*)(P.ws + WS_H16); bf16_t* ga = (bf16_t*)(P.ws + WS_GA);
    int base[9], c[8]; base[0] = 0;
#pragma unroll
    for (int e = 0; e < 8; ++e) { c[e] = cnt[e]; base[e + 1] = base[e] + (((c[e] + 255) >> 8) << 8); }
    for (int r = blockIdx.x * 8 + wid; r < base[8]; r += gridDim.x * 8) {
        int e = 0;
#pragma unroll
        for (int k = 1; k < 8; ++k) e += (r >= base[k]) ? 1 : 0;
        int be = 0, ce = 0;
#pragma unroll
        for (int k = 0; k < 8; ++k) { be = (e == k) ? base[k] : be; ce = (e == k) ? c[k] : ce; }
        const int pos = r - be; u32x4 a = {0u, 0u, 0u, 0u}, b = a;
        if (pos < ce) { const int tok = lists[e * T_ + pos]; a = *(const u32x4*)(h16 + (size_t)tok * 1024 + lane * 8); b = *(const u32x4*)(h16 + (size_t)tok * 1024 + 512 + lane * 8); }
        *(u32x4*)(ga + (size_t)r * 1024 + lane * 8) = a; *(u32x4*)(ga + (size_t)r * 1024 + 512 + lane * 8) = b;
    }
}

__device__ void attn_phase(const Params& P, unsigned char* lds) {
    const int tid = threadIdx.x, wid = tid >> 6, lane = tid & 63, n = lane & 31, hh = lane >> 5;
    bf16_t* Ks = (bf16_t*)lds;
    bf16_t* Vt = (bf16_t*)(lds + 256 * 144);
    const bf16_t* QB = (const bf16_t*)(P.ws + WS_BIG); const bf16_t* KB = (const bf16_t*)(P.ws + WS_BIG + 64 * MiB); const bf16_t* VB = (const bf16_t*)(P.ws + WS_BIG + 80 * MiB);
    bf16_t* OB = (bf16_t*)(P.ws + WS_BIG + 96 * MiB);
#ifdef DUP_ATT
    constexpr int NITEM = 2048;
#else
    constexpr int NITEM = 1024;
#endif
    u32x4 kreg[4], vreg0[2], vreg1[2];
#define ATT_LOAD(it) do { const int kvh_ = (it) & 3, nb_ = ((it) >> 2) & 15, b_ = ((it) >> 6) & 15, tok_ = b_ * 2048 + nb_ * 128; \
        _Pragma("unroll") for (int i = 0; i < 4; ++i) { const int piece = tid + 512 * i, s = piece >> 3, pc = piece & 7; kreg[i] = (u32x4){0u, 0u, 0u, 0u}; \
            if (nb_ > 0 || s >= 128) kreg[i] = *(const u32x4*)(KB + (size_t)(tok_ - 128 + s) * 256 + kvh_ * 64 + pc * 8); } \
        _Pragma("unroll") for (int i = 0; i < 2; ++i) { const int s = 2 * (tid & 127), pc = (tid >> 7) + 4 * i; vreg0[i] = (u32x4){0u, 0u, 0u, 0u}; vreg1[i] = vreg0[i]; \
            if (nb_ > 0 || s >= 128) { vreg0[i] = *(const u32x4*)(VB + (size_t)(tok_ - 128 + s) * 256 + kvh_ * 64 + pc * 8); vreg1[i] = *(const u32x4*)(VB + (size_t)(tok_ - 127 + s) * 256 + kvh_ * 64 + pc * 8); } } } while (0)
    if ((int)blockIdx.x < NITEM) ATT_LOAD((int)blockIdx.x);
    for (int item = blockIdx.x; item < NITEM; item += gridDim.x) {
        const int kvh = item & 3, nb = (item >> 2) & 15, b = (item >> 6) & 15;
        const int tok0 = b * 2048 + nb * 128;
        __syncthreads();
#pragma unroll
        for (int i = 0; i < 4; ++i) { const int piece = tid + 512 * i, s = piece >> 3, pc = piece & 7; *(u32x4*)(Ks + s * 72 + pc * 8) = kreg[i]; }
#pragma unroll
        for (int i = 0; i < 2; ++i) { const int s = 2 * (tid & 127), pc = (tid >> 7) + 4 * i; const u32x4 v0 = vreg0[i], v1 = vreg1[i];
            unsigned* vt = (unsigned*)(Vt + (pc * 8) * 264 + s);
            vt[0 * 132] = (v0.x & 0xffffu) | (v1.x << 16); vt[1 * 132] = (v0.x >> 16) | (v1.x & 0xffff0000u);
            vt[2 * 132] = (v0.y & 0xffffu) | (v1.y << 16); vt[3 * 132] = (v0.y >> 16) | (v1.y & 0xffff0000u);
            vt[4 * 132] = (v0.z & 0xffffu) | (v1.z << 16); vt[5 * 132] = (v0.z >> 16) | (v1.z & 0xffff0000u);
            vt[6 * 132] = (v0.w & 0xffffu) | (v1.w << 16); vt[7 * 132] = (v0.w >> 16) | (v1.w & 0xffff0000u); }
        __syncthreads();
        if (item + (int)gridDim.x < NITEM) ATT_LOAD(item + (int)gridDim.x);
        const int hq = kvh * 4 + (wid >> 1);
        const float sink = P.sinks[hq] * 1.4426950408889634f;
#pragma unroll 1
        for (int qq = 0; qq < 2; ++qq) {
            const int kb0 = (wid & 1) * 2 + qq, i0 = 32 * kb0, qi = i0 + n;
            const bf16_t* qp = QB + (size_t)(tok0 + qi) * 1024 + hq * 64 + 8 * hh;
            bf16x8 qf[4];
#pragma unroll
            for (int ks = 0; ks < 4; ++ks) qf[ks] = *(const bf16x8*)(qp + 16 * ks);
            f32x16 sacc[5];
#pragma unroll
            for (int kb = 0; kb < 5; ++kb) {
#pragma unroll
                for (int i = 0; i < 16; ++i) sacc[kb][i] = 0.f;
                const bf16_t* kp = Ks + (32 * (kb0 + kb) + n) * 72 + 8 * hh;
#pragma unroll
                for (int ks = 0; ks < 4; ++ks) { const bf16x8 a = *(const bf16x8*)(kp + 16 * ks); sacc[kb] = __builtin_amdgcn_mfma_f32_32x32x16_bf16(a, qf[ks], sacc[kb], 0, 0, 0); }
                asm volatile("" ::: "memory"); }
            const int nn4 = n - 4 * hh;
#pragma unroll
            for (int i = 0; i < 16; ++i) { const int r = 8 * (i >> 2) + (i & 3);
                sacc[0][i] = (r > nn4) ? sacc[0][i] : -1.0e30f; sacc[4][i] = (r <= nn4) ? sacc[4][i] : -1.0e30f; }
            if (nb == 0) {
#pragma unroll
                for (int kb = 0; kb < 4; ++kb) if (kb0 + kb < 4) {
#pragma unroll
                    for (int i = 0; i < 16; ++i) sacc[kb][i] = -1.0e30f; } }
            float mx = sink;
#pragma unroll
            for (int kb = 0; kb < 5; ++kb)
#pragma unroll
                for (int i = 0; i < 16; ++i) mx = fmaxf(mx, sacc[kb][i]);
            mx = fmaxf(mx, __shfl_xor(mx, 32));
            float sum = 0.f;
#pragma unroll
            for (int kb = 0; kb < 5; ++kb)
#pragma unroll
                for (int i = 0; i < 16; ++i) { const float p = __builtin_amdgcn_exp2f(sacc[kb][i] - mx); sacc[kb][i] = p; sum += p; }
            sum += __shfl_xor(sum, 32); sum += __builtin_amdgcn_exp2f(sink - mx);
            f32x16 oacc[2];
#pragma unroll
            for (int i = 0; i < 16; ++i) { oacc[0][i] = 0.f; oacc[1][i] = 0.f; }
#pragma unroll
            for (int kb = 0; kb < 5; ++kb)
#pragma unroll
                for (int sl = 0; sl < 2; ++sl) {
                    union { u32x4 u; bf16x8 v; } pb;
                    pb.u.x = pk_bf16(sacc[kb][8 * sl + 0], sacc[kb][8 * sl + 1]); pb.u.y = pk_bf16(sacc[kb][8 * sl + 2], sacc[kb][8 * sl + 3]);
                    pb.u.z = pk_bf16(sacc[kb][8 * sl + 4], sacc[kb][8 * sl + 5]); pb.u.w = pk_bf16(sacc[kb][8 * sl + 6], sacc[kb][8 * sl + 7]);
#pragma unroll
                    for (int mb = 0; mb < 2; ++mb) { const bf16_t* vp = Vt + (32 * mb + n) * 264 + 32 * (kb0 + kb) + 16 * sl + 4 * hh;
                        union { u32x4 u; bf16x8 v; } va; const u32x2 lo = *(const u32x2*)vp, hi = *(const u32x2*)(vp + 8); va.u.x = lo.x; va.u.y = lo.y; va.u.z = hi.x; va.u.w = hi.y;
                        oacc[mb] = __builtin_amdgcn_mfma_f32_32x32x16_bf16(va.v, pb.v, oacc[mb], 0, 0, 0); }
                    asm volatile("" ::: "memory"); }
            const float inv = 1.0f / sum;
            bf16_t* op = OB + (size_t)(tok0 + qi) * 1024 + hq * 64 + 4 * hh;
#pragma unroll
            for (int mb = 0; mb < 2; ++mb)
#pragma unroll
                for (int g4 = 0; g4 < 4; ++g4) { u32x2 w; w.x = pk_bf16(oacc[mb][4 * g4 + 0] * inv, oacc[mb][4 * g4 + 1] * inv); w.y = pk_bf16(oacc[mb][4 * g4 + 2] * inv, oacc[mb][4 * g4 + 3] * inv);
                    *(u32x2*)(op + 32 * mb + 8 * g4) = w; }
        }
    }
}

#if defined(__HIP_DEVICE_COMPILE__)
typedef const Params __attribute__((address_space(4)))* KParams;
__device__ __forceinline__ Params load_params() { KParams p = (KParams)__builtin_amdgcn_kernarg_segment_ptr(); asm volatile("" : "+s"(p)); return *p; }
#else
__device__ __forceinline__ Params load_params() { return Params{}; }
#endif
#define LP const Params P = load_params(); unsigned char* const ws = P.ws; float* const H = P.out; (void)ws; (void)H
__global__ void __launch_bounds__(512, 2) yoco_fwd(Params P_arg) {
    extern __shared__ __attribute__((aligned(16))) unsigned char lds[];
    cg::grid_group grid = cg::this_grid();
    LAS unsigned char* ldsl = (LAS unsigned char*)lds;
    const int G = gridDim.x, c = blockIdx.x;
    if (threadIdx.x == 0) { ((LAS unsigned*)(ldsl + 131072))[0] = 0u; ((LAS unsigned*)(ldsl + 131072))[1] = 0u; }
    __syncthreads();
#define GSYNC() do { LP; xcd_barrier((unsigned*)(ws + WS_BAR), (volatile LAS unsigned*)(ldsl + 131072)); } while (0)

#ifdef PROF_A_HI
#define STAMP(k) do { LP; if (((k) == PROF_A_LO || (k) == PROF_A_HI || (k) == PROF_B_LO || (k) == PROF_B_HI) && blockIdx.x == 0 && threadIdx.x == 0) ((unsigned long long*)(P.ws + WS_CNT + 1024))[k] = __builtin_amdgcn_s_memrealtime(); } while (0)
#else
#define STAMP(k) do { } while (0)
#endif
#ifdef DUP_ALL
#pragma unroll 1
    for (int pass = 0; pass < 2; ++pass) {
#else
    { const int pass = 0;
#endif
    STAMP(0);
    if (pass != 0) GSYNC();
    { LP; if (ws == nullptr) grid.sync();
      if (pass == 0 && threadIdx.x == 0) (void)xb_add(&((unsigned*)(ws + WS_BAR))[XB_XCNT(xb_xcc_id())], 1u); }
    { LP; p0_prep(P, lds, (P.skip & 1) ? 0 : (15 & ~(P.skip >> 16))); }
    GSYNC();
#ifdef DUP_SYNC
#pragma unroll 1
    for (int r = 0; r < 16; ++r) GSYNC();
#endif
#ifdef DUP_P0
    { LP; p0_prep(P, lds, DUP_P0); }
    GSYNC();
#endif
    STAMP(1);
#if LEVEL >= 1
#pragma unroll 1
    for (int rep = 0; rep < NREP_S1; ++rep) {
    {   LP; if (!((P.skip >> 1) & 1)) {
        pg8::SchedSsm S; S.init(256, 512, G, c); pg8::EpiS1 E{(float*)(ws + WS_SST)};
        pg8::gemm_phase<false>(ldsl, (const char*)(ws + WS_XA), (const char*)(ws + WS_BT1), 512, S, E);
        asm volatile("s_waitcnt vmcnt(0)" ::: "memory"); __syncthreads();
        pg8::Unit u; for (int i = 0; S.next(i, u); ++i) scan_unit(P, u.aux, u.pm); } }
    GSYNC(); } STAMP(2);
#pragma unroll 1
    for (int rep = 0; rep < NREP_S2; ++rep) {
    {   LP; if (!((P.skip >> 2) & 1)) {
        pg8::SchedSsm S; S.init(512, 640, G, c); pg8::EpiS2 E{(bf16_t*)(ws + WS_BIG)};
        pg8::gemm_phase<false>(ldsl, (const char*)(ws + WS_XA), (const char*)(ws + WS_BT2), 640, S, E); } }
    GSYNC(); } STAMP(4);
#pragma unroll 1
    for (int rep = 0; rep < NREP_GLU; ++rep) {
    {   LP; if (!((P.skip >> 3) & 1)) {
        pg8::SchedDense S; S.init(T_, 2048, 1024, 1024, G, c); pg8::EpiUp<1> E{(bf16_t*)(ws + WS_GA), 1024};
        pg8::gemm_phase<false>(ldsl, (const char*)(ws + WS_BIG), (const char*)(ws + WS_WGLU), 1024, S, E); } }
    GSYNC(); } STAMP(5);
#endif
    { LP; if (!((P.skip >> 4) & 1)) ln_phase<0, true>(P, (LEVEL >= 1) ? P.x : H, P.ln_g, P.ln_b, lds, H, (bf16_t*)(ws + WS_H16), (LEVEL >= 1) ? (const bf16_t*)(ws + WS_GA) : nullptr); }
    GSYNC(); STAMP(6);
#if LEVEL >= 2
#pragma unroll 1
    for (int rep = 0; rep < NREP_FUP; ++rep) {
    {   LP; if (!((P.skip >> 5) & 1)) {
        pg8::SchedDense S; S.init(T_, 2 * FF_, 1024, 1024, G, c); pg8::EpiUp<0> E{(bf16_t*)(ws + WS_BIG), FF_};
        pg8::gemm_phase<true>(ldsl, (const char*)(ws + WS_H16), (const char*)(ws + WS_WUP), 1024, S, E); } }
    GSYNC(); } STAMP(7);
#pragma unroll 1
    for (int rep = 0; rep < NREP_FDN; ++rep) {
    {   LP; if (!((P.skip >> 6) & 1)) {
#define NREP_CUR NREP_FDN
        pg8::SchedDense S; S.init(T_, 1024, FF_, FF_, G, c); pg8::EpiBf16 E{(bf16_t*)(ws + WS_GA), 1024};
        pg8::gemm_phase<false>(ldsl, (const char*)(ws + WS_BIG), (const char*)(ws + WS_WDN), FF_, S, E); } }
    GSYNC(); } STAMP(8);
#endif
    { LP; if (!((P.skip >> 7) & 1)) ln_phase<0, false>(P, H, P.ln_g + 1024, P.ln_b + 1024, lds, H, (bf16_t*)(ws + WS_H16), (LEVEL >= 2) ? (const bf16_t*)(ws + WS_GA) : nullptr); }
    GSYNC(); STAMP(9);
#if LEVEL >= 3
#pragma unroll 1
    for (int rep = 0; rep < NREP_QKV; ++rep) {
    {   LP; if (!((P.skip >> 8) & 1)) {
        pg8::SchedDense S; S.init(T_, 1536, 1024, 1024, G, c);
        pg8::EpiQkv E{(bf16_t*)(ws + WS_BIG), (bf16_t*)(ws + WS_BIG + 64 * MiB), (bf16_t*)(ws + WS_BIG + 80 * MiB), (const float*)(ws + WS_ROPEC), (const float*)(ws + WS_ROPES)};
        pg8::gemm_phase<true>(ldsl, (const char*)(ws + WS_H16), (const char*)(ws + WS_WQKV), 1024, S, E); } }
    GSYNC(); } STAMP(10);
#ifndef SKIP_ATT
    { LP; if (!((P.skip >> 9) & 1)) attn_phase(P, lds); }
#endif
    GSYNC(); STAMP(11);
#pragma unroll 1
    for (int rep = 0; rep < NREP_OUT; ++rep) {
    {   LP; if (!((P.skip >> 10) & 1)) {
#undef NREP_CUR
#define NREP_CUR NREP_OUT
        pg8::SchedDense S; S.init(T_, 1024, 1024, 1024, G, c);
        pg8::EpiBf16 E{(bf16_t*)(ws + WS_GA), 1024};
        pg8::gemm_phase<false>(ldsl, (const char*)(ws + WS_BIG + 96 * MiB), (const char*)(ws + WS_WO), 1024, S, E); } }
    GSYNC(); } STAMP(12);
#endif
#if LEVEL >= 4
    { LP; if (!((P.skip >> 11) & 1)) ln_phase<1, false>(P, H, P.ln_g + 2048, P.ln_b + 2048, lds, H, (bf16_t*)(ws + WS_H16), (const bf16_t*)(ws + WS_GA)); }
    GSYNC(); STAMP(13);
#pragma unroll 1
    for (int rep = 0; rep < NREP_GATH; ++rep) {
    { LP; if (!((P.skip >> 12) & 1)) gather_phase(P); }
    GSYNC(); } STAMP(14);
#pragma unroll 1
    for (int rep = 0; rep < NREP_MUP; ++rep) {
    {   LP; if (!((P.skip >> 13) & 1)) {
        pg8::SchedMoe S; S.init((const int*)(ws + WS_CNT), 2048, 1024, (size_t)2048 * 1024 * 2, G, c); pg8::EpiUp<0> E{(bf16_t*)(ws + WS_BIG), 1024};
        pg8::gemm_phase<true>(ldsl, (const char*)(ws + WS_GA), (const char*)(ws + WS_WMUP), 1024, S, E); } }
    GSYNC(); } STAMP(15);
#pragma unroll 1
    for (int rep = 0; rep < NREP_MDN; ++rep) {
    {   LP; if (!((P.skip >> 14) & 1)) {
        pg8::SchedMoe S; S.init((const int*)(ws + WS_CNT), 1024, 1024, (size_t)1024 * 1024 * 2, G, c); pg8::EpiBf16 E{(bf16_t*)(ws + WS_Y), 1024};
        pg8::gemm_phase<false>(ldsl, (const char*)(ws + WS_BIG), (const char*)(ws + WS_WMDN), 1024, S, E); } }
    GSYNC(); } STAMP(16);
    { LP; if (!((P.skip >> 15) & 1)) ln_phase<2, false>(P, H, P.ln_g + 3072, P.ln_b + 3072, lds, H, (bf16_t*)(ws + WS_H16), nullptr); }
#ifdef PROF_A_HI
    GSYNC(); STAMP(17);
    {   LP; const unsigned long long* stamps = (const unsigned long long*)(P.ws + WS_CNT + 1024);
        const float tA = (float)(stamps[PROF_A_HI] - stamps[PROF_A_LO]) * 0.01f, tB = (float)(stamps[PROF_B_HI] - stamps[PROF_B_LO]) * 0.01f;
        for (int i = blockIdx.x * 512 + threadIdx.x; i < (1 << 22); i += gridDim.x * 512) H[(size_t)i * 8 + 1] = tB;
        if (blockIdx.x == 0 && threadIdx.x == 0) H[0] = 64.0f * tA; }
#endif
#ifdef PROF_A_HI
#endif
    }
#else
    { LP; ln_phase<0, false>(P, H, P.ln_g + 2048, P.ln_b + 2048, lds, H, (bf16_t*)(ws + WS_H16), (LEVEL >= 3) ? (const bf16_t*)(ws + WS_GA) : nullptr); }
    GSYNC(); STAMP(13);
    { LP; ln_phase<0, false>(P, H, P.ln_g + 3072, P.ln_b + 3072, lds, H, (bf16_t*)(ws + WS_H16), nullptr); }
#endif
}

extern "C" void kernel_launch(void* const* d_in, const int* in_sizes, int n_in, void* d_out, int out_size, void* d_ws, size_t ws_size, hipStream_t stream) {
    static int grid_blocks = 0;
    if (grid_blocks == 0) {
        if (n_in != 25 || out_size != T_ * D_ || ws_size < WS_END) { fprintf(stderr, "kernel_launch: unexpected shapes (n_in %d out %d ws %zu)\n", n_in, out_size, ws_size); grid_blocks = -1; return; }
        int dev = 0, cus = 0, per_cu = 0;
        hipGetDevice(&dev); hipDeviceGetAttribute(&cus, hipDeviceAttributeMultiprocessorCount, dev);
        if (hipFuncSetAttribute((const void*)yoco_fwd, hipFuncAttributeMaxDynamicSharedMemorySize, LDS_BYTES) != hipSuccess) { fprintf(stderr, "kernel_launch: hipFuncSetAttribute failed\n"); grid_blocks = -1; return; }
        if (hipOccupancyMaxActiveBlocksPerMultiprocessor(&per_cu, (const void*)yoco_fwd, 512, LDS_BYTES) != hipSuccess || per_cu < 1) { fprintf(stderr, "kernel_launch: occupancy query says %d\n", per_cu); per_cu = 1; (void)hipGetLastError(); }
        grid_blocks = cus * 1;
    }
    if (grid_blocks < 0) return;
    Params p{};
    p.x = (const float*)d_in[0]; p.pos = (const int*)d_in[1]; p.ln_g = (const float*)d_in[2]; p.ln_b = (const float*)d_in[3];
    p.lam_re = (const float*)d_in[4]; p.lam_im = (const float*)d_in[5]; p.log_step = (const float*)d_in[6]; p.b_re = (const float*)d_in[7]; p.b_im = (const float*)d_in[8];
    p.c_re = (const float*)d_in[9]; p.c_im = (const float*)d_in[10]; p.ssm_d = (const float*)d_in[11]; p.w_glu = (const float*)d_in[12]; p.kv_w = (const float*)d_in[13];
    p.w_q = (const float*)d_in[14]; p.sinks = (const float*)d_in[15]; p.w_out = (const float*)d_in[16]; p.ffn_g = (const float*)d_in[17]; p.ffn_u = (const float*)d_in[18]; p.ffn_d = (const float*)d_in[19];
    p.w_router = (const float*)d_in[20]; p.b_router = (const float*)d_in[21]; p.moe_g = (const float*)d_in[22]; p.moe_u = (const float*)d_in[23]; p.moe_d = (const float*)d_in[24];
    p.out = (float*)d_out; p.ws = (unsigned char*)d_ws;
    if (hipMemsetAsync((char*)d_ws + WS_BAR, 0, XCD_BAR_WORDS * 4, stream) != hipSuccess) { fprintf(stderr, "kernel_launch: memset failed\n"); return; }
    void* args[] = {&p};
#ifdef SKIP_PROBE
    p.skip = SKIP_PROBE; (void)hipLaunchCooperativeKernel((const void*)yoco_fwd, dim3(grid_blocks), dim3(512), args, LDS_BYTES, stream); p.skip = 0;
#endif
    hipError_t e = hipLaunchCooperativeKernel((const void*)yoco_fwd, dim3(grid_blocks), dim3(512), args, LDS_BYTES, stream);
    if (e != hipSuccess) fprintf(stderr, "cooperative launch failed: %s (grid %d)\n", hipGetErrorString(e), grid_blocks);
}
```
